# Optimizing an MI355X kernel written in HIP

```python
import jax
import jax.numpy as jnp
from jax import lax
import numpy as np

D_MODEL = 2048
BATCH = 4
SEQ = 2048
DEPTH = 4
DEC_BATCH = 8
DEC_SEQ = 4
PAST_LEN = 16384
PAGE_SIZE = 128

N_MIXERS = 3
LAYER_KIND = tuple(i % N_MIXERS for i in range(DEPTH))
LAYER_SLOT = tuple(i // N_MIXERS for i in range(DEPTH))
N_A = LAYER_KIND.count(0)
N_B = LAYER_KIND.count(1)
N_C = LAYER_KIND.count(2)
NORM_EPS = 1e-6

A_GROUPS = ((128, 1), (512, 4), (2048, 16))
N_A_GROUPS = len(A_GROUPS)
A_HEADS = 16
A_HEAD_DIM = D_MODEL // A_HEADS
A_WIDTH = A_HEADS * A_HEAD_DIM
A_ROT = A_HEAD_DIM // 4
A_ROPE_THETA = 500000.0
A_IN = 3 * N_A_GROUPS * A_WIDTH + A_WIDTH

B_HEADS = 8
B_DK = D_MODEL // B_HEADS
B_DV = 2 * B_DK
B_CHUNK = 128
B_ROPE_THETA = 10000.0
B_IN = 2 * B_HEADS * B_DK + 2 * B_HEADS * B_DV

C_HEADS = 4
C_DK = D_MODEL // (2 * C_HEADS)
C_DV = D_MODEL // C_HEADS
C_RANK = 16
C_TAU = 16.0
C_CHUNK = 64
C_IN = 2 * C_HEADS * C_DK + 2 * C_HEADS * C_DV + C_RANK

kernel_name = 'hybrid_dilated_retention_gla_step'

F32 = jnp.float32


def rms_norm(x, g):
    xf = x.astype(F32)
    y = xf * lax.rsqrt(jnp.mean(xf * xf, axis=-1, keepdims=True) + NORM_EPS)
    return (y * g.astype(F32)).astype(x.dtype)


def rotary(x, pos, n_rot, theta):
    half = n_rot // 2
    inv_freq = theta ** (-jnp.arange(half, dtype=F32) / half)
    ang = pos.astype(F32)[:, None] * inv_freq[None, :]
    cos = jnp.cos(ang)[None, :, None, :]
    sin = jnp.sin(ang)[None, :, None, :]
    xf = x.astype(F32)
    x1 = xf[..., :half]
    x2 = xf[..., half:n_rot]
    out = jnp.concatenate([x1 * cos - x2 * sin, x1 * sin + x2 * cos, xf[..., n_rot:]], axis=-1)
    return out.astype(x.dtype)


def softmax_with_lse(s):
    m = jnp.max(s, axis=-1, keepdims=True)
    p = jnp.exp(s - m)
    den = jnp.sum(p, axis=-1, keepdims=True)
    return p / den, (m + jnp.log(den))[..., 0]


def dilated_window_attn_prompt(q, k, v, dilation, nk):
    B, S, H, D = q.shape
    L = S // dilation
    blk = nk
    nb = -(-L // blk)
    Lp = nb * blk

    def to_sub(t):
        t = t.reshape(B, L, dilation, H, D).transpose(0, 2, 1, 3, 4)
        return jnp.pad(t, ((0, 0), (0, 0), (0, Lp - L), (0, 0), (0, 0)))

    def band(t):
        tp = jnp.pad(t, ((0, 0), (0, 0), (blk, 0), (0, 0), (0, 0))).reshape(B, dilation, nb + 1, blk, H, D)
        return jnp.concatenate([tp[:, :, :-1], tp[:, :, 1:]], axis=3)

    qb = to_sub(q).reshape(B, dilation, nb, blk, H, D)
    kb = band(to_sub(k))
    vb = band(to_sub(v))
    i = jnp.arange(blk)[:, None]
    c = jnp.arange(2 * blk)[None, :]
    local = (c >= i) & (c <= i + blk)
    started = (jnp.arange(nb)[:, None, None] > 0) | (c[None] >= blk)
    mask = local[None] & started
    s = jnp.einsum('brnqhd,brnkhd->brnhqk', qb, kb, preferred_element_type=F32) * (D ** -0.5)
    s = jnp.where(mask[None, None, :, None], s, -jnp.inf)
    p, lse = softmax_with_lse(s)
    o = jnp.einsum('brnhqk,brnkhd->brnqhd', p, vb.astype(F32))
    o = o.reshape(B, dilation, Lp, H, D)[:, :, :L].transpose(0, 2, 1, 3, 4).reshape(B, S, H, D)
    lse = lse.transpose(0, 1, 2, 4, 3).reshape(B, dilation, Lp, H)[:, :, :L]
    lse = lse.transpose(0, 2, 1, 3).reshape(B, S, H)
    return o, lse


def dilated_window_attn_sample(q, k_all, v_all, lbuf, dilation, nk):
    T = q.shape[1]
    D = q.shape[-1]
    idx = lbuf + jnp.arange(T)[:, None] - dilation * jnp.arange(nk + 1)[None, :]
    valid = idx >= 0
    idx = jnp.maximum(idx, 0)
    kg = jnp.take(k_all, idx, axis=1)
    vg = jnp.take(v_all, idx, axis=1)
    s = jnp.einsum('bthd,btkhd->bthk', q, kg, preferred_element_type=F32) * (D ** -0.5)
    s = jnp.where(valid[None, :, None, :], s, -jnp.inf)
    p, lse = softmax_with_lse(s)
    o = jnp.einsum('bthk,btkhd->bthd', p, vg.astype(F32))
    return o, lse


def a_project(h, pos, w_in):
    B, S, _ = h.shape
    z = h @ w_in
    n_qkv = 3 * N_A_GROUPS * A_WIDTH
    qkv = z[..., :n_qkv].reshape(B, S, N_A_GROUPS, 3, A_HEADS, A_HEAD_DIM)
    gate = z[..., n_qkv:]
    qs = [rotary(qkv[:, :, g, 0], pos, A_ROT, A_ROPE_THETA) for g in range(N_A_GROUPS)]
    ks = [rotary(qkv[:, :, g, 1], pos, A_ROT, A_ROPE_THETA) for g in range(N_A_GROUPS)]
    vs = [qkv[:, :, g, 2] for g in range(N_A_GROUPS)]
    return qs, ks, vs, gate


def a_merge(outs, lses, gate, w_out):
    wts = jax.nn.softmax(jnp.stack(lses), axis=0)
    o = jnp.einsum('gbsh,gbshd->bshd', wts, jnp.stack(outs))
    B, S = gate.shape[:2]
    o = o.reshape(B, S, A_WIDTH).astype(gate.dtype) * jax.nn.silu(gate)
    return o @ w_out


def attn_layer_prompt(h, pos, w_in, w_out):
    S = h.shape[1]
    qs, ks, vs, gate = a_project(h, pos, w_in)
    outs, lses, kv_rows = [], [], []
    for g, (win, dil) in enumerate(A_GROUPS):
        o, l = dilated_window_attn_prompt(qs[g], ks[g], vs[g], dil, win // dil)
        outs.append(o)
        lses.append(l)
        keep = min(win, S)
        kv_rows.append(jnp.stack([ks[g][:, S - keep:], vs[g][:, S - keep:]], axis=2))
    return a_merge(outs, lses, gate, w_out), kv_rows


def attn_layer_sample(h, pos, caches, w_in, w_out):
    qs, ks, vs, gate = a_project(h, pos, w_in)
    outs, lses, kv_rows = [], [], []
    for g, (win, dil) in enumerate(A_GROUPS):
        cache = caches[g].astype(ks[g].dtype)
        lbuf = cache.shape[1]
        k_all = jnp.concatenate([cache[:, :, 0], ks[g]], axis=1)
        v_all = jnp.concatenate([cache[:, :, 1], vs[g]], axis=1)
        o, l = dilated_window_attn_sample(qs[g], k_all, v_all, lbuf, dil, win // dil)
        outs.append(o)
        lses.append(l)
        kv_rows.append(jnp.stack([ks[g], vs[g]], axis=2))
    return a_merge(outs, lses, gate, w_out), kv_rows


def chunk_scan(chunk_fn, state0, seqs, chunk):
    B, S = seqs[0].shape[:2]
    nc = S // chunk

    def split(t):
        return t.reshape((B, nc, chunk) + t.shape[2:]).swapaxes(0, 1)

    def step(state, inp):
        out, state = chunk_fn(*inp, state)
        return state, out

    state, out = lax.scan(step, state0, tuple(split(t) for t in seqs))
    out = out.swapaxes(0, 1).reshape((B, S) + out.shape[3:])
    return out, state


def retention_log_decay():
    return jnp.log(1.0 - 2.0 ** (-5.0 - jnp.arange(B_HEADS, dtype=F32)))


def retention_chunk(q, k, v, state):
    q, k, v = q.astype(F32), k.astype(F32), v.astype(F32)
    C = q.shape[1]
    lg = retention_log_decay()
    idx = jnp.arange(C, dtype=F32)
    diff = idx[:, None] - idx[None, :]
    decay = jnp.where(diff >= 0, jnp.exp(lg[:, None, None] * jnp.maximum(diff, 0.0)), 0.0)
    scores = jnp.einsum('bqhd,bkhd->bhqk', q, k) * decay[None]
    inner = jnp.einsum('bhqk,bkhv->bqhv', scores, v)
    cross = jnp.einsum('bqhd,bhdv->bqhv', q, state) * jnp.exp(lg[None, :] * (idx[:, None] + 1.0))[None, :, :, None]
    k_dec = k * jnp.exp(lg[None, :] * (C - 1.0 - idx[:, None]))[None, :, :, None]
    new_state = jnp.exp(lg * C)[None, :, None, None] * state + jnp.einsum('bkhd,bkhv->bhdv', k_dec, v)
    return inner + cross, new_state


def retention_layer(h, pos, state0, chunk, w_in, gn, w_out):
    B, S, _ = h.shape
    z = h @ w_in
    nk = B_HEADS * B_DK
    nv = B_HEADS * B_DV
    q = rotary(z[..., :nk].reshape(B, S, B_HEADS, B_DK), pos, B_DK, B_ROPE_THETA)
    k = rotary(z[..., nk:2 * nk].reshape(B, S, B_HEADS, B_DK), pos, B_DK, B_ROPE_THETA) * (B_DK ** -0.5)
    v = z[..., 2 * nk:2 * nk + nv].reshape(B, S, B_HEADS, B_DV)
    gate = z[..., 2 * nk + nv:]
    o, state = chunk_scan(retention_chunk, state0, (q, k, v), chunk)
    mu = jnp.mean(o, axis=-1, keepdims=True)
    var = jnp.mean(jnp.square(o - mu), axis=-1, keepdims=True)
    y = (o - mu) * lax.rsqrt(var + NORM_EPS) * gn.astype(F32)
    y = y.reshape(B, S, nv).astype(h.dtype) * jax.nn.silu(gate)
    return y @ w_out, state


def gla_chunk(q, k, v, log_a, state):
    q, k, v = q.astype(F32), k.astype(F32), v.astype(F32)
    C = q.shape[1]
    b = jnp.cumsum(log_a, axis=1)
    idx = jnp.arange(C)
    tri = (idx[:, None] >= idx[None, :])[None, :, :, None, None]
    diff = b[:, :, None] - b[:, None, :]
    w = jnp.where(tri, jnp.exp(jnp.where(tri, diff, 0.0)), 0.0)
    att = jnp.einsum('btshd,bshd->bhts', q[:, :, None] * w, k)
    inner = jnp.einsum('bhts,bshv->bthv', att, v)
    cross = jnp.einsum('bthd,bhdv->bthv', q * jnp.exp(b), state)
    b_last = b[:, -1]
    new_state = jnp.exp(b_last)[..., None] * state + jnp.einsum('bshd,bshv->bhdv', k * jnp.exp(b_last[:, None] - b), v)
    return inner + cross, new_state


def gla_layer(h, state0, chunk, w_in, w_gate2, b_gate, gn, w_out):
    B, S, _ = h.shape
    z = h @ w_in
    nk = C_HEADS * C_DK
    nv = C_HEADS * C_DV
    q = z[..., :nk].reshape(B, S, C_HEADS, C_DK) * (C_DK ** -0.5)
    k = z[..., nk:2 * nk].reshape(B, S, C_HEADS, C_DK)
    v = z[..., 2 * nk:2 * nk + nv].reshape(B, S, C_HEADS, C_DV)
    gate = z[..., 2 * nk + nv:2 * nk + 2 * nv]
    low_rank = z[..., 2 * nk + 2 * nv:]
    log_a = jax.nn.log_sigmoid((low_rank @ w_gate2 + b_gate).astype(F32)) / C_TAU
    log_a = log_a.reshape(B, S, C_HEADS, C_DK)
    o, state = chunk_scan(gla_chunk, state0, (q, k, v, log_a), chunk)
    y = o * lax.rsqrt(jnp.mean(o * o, axis=-1, keepdims=True) + NORM_EPS) * gn.astype(F32)
    y = y.reshape(B, S, nv).astype(h.dtype) * jax.nn.silu(gate)
    return y @ w_out, state


def setup_inputs(seed: int = 0) -> dict:
    key = jax.random.key(seed)
    ks = jax.random.split(key, 20)

    def nrm(k, shape, scale):
        return jax.random.normal(k, shape, F32) * scale

    inp = {}
    inp['x_prompt'] = nrm(ks[0], (BATCH, SEQ, D_MODEL), 1.0)
    inp['x_sample'] = nrm(ks[1], (DEC_BATCH, DEC_SEQ, D_MODEL), 1.0)
    inp['cache_a_kv1'] = nrm(ks[2], (N_A, DEC_BATCH, min(A_GROUPS[0][0], PAST_LEN), 2, A_HEADS, A_HEAD_DIM), 1.0)
    inp['cache_a_kv2'] = nrm(ks[3], (N_A, DEC_BATCH, min(A_GROUPS[1][0], PAST_LEN), 2, A_HEADS, A_HEAD_DIM), 1.0)
    inp['cache_a_kv3'] = nrm(ks[4], (N_A, DEC_BATCH, min(A_GROUPS[2][0], PAST_LEN), 2, A_HEADS, A_HEAD_DIM), 1.0)
    inp['state_b'] = nrm(ks[5], (N_B, DEC_BATCH, B_HEADS, B_DK, B_DV), 0.1)
    inp['state_c'] = nrm(ks[6], (N_C, DEC_BATCH, C_HEADS, C_DK, C_DV), 0.1)
    inp['norm_g'] = 1.0 + nrm(ks[7], (DEPTH, D_MODEL), 0.1)
    inp['final_g'] = 1.0 + nrm(ks[8], (D_MODEL,), 0.1)
    inp['w_in_a'] = nrm(ks[9], (N_A, D_MODEL, A_IN), D_MODEL ** -0.5)
    inp['w_out_a'] = nrm(ks[10], (N_A, A_WIDTH, D_MODEL), A_WIDTH ** -0.5)
    inp['w_in_b'] = nrm(ks[11], (N_B, D_MODEL, B_IN), D_MODEL ** -0.5)
    inp['gn_b'] = 1.0 + nrm(ks[12], (N_B, B_HEADS, B_DV), 0.1)
    inp['w_out_b'] = nrm(ks[13], (N_B, B_HEADS * B_DV, D_MODEL), (B_HEADS * B_DV) ** -0.5)
    inp['w_in_c'] = nrm(ks[14], (N_C, D_MODEL, C_IN), D_MODEL ** -0.5)
    inp['w_gate2_c'] = nrm(ks[15], (N_C, C_RANK, C_HEADS * C_DK), C_RANK ** -0.5)
    inp['b_gate_c'] = nrm(ks[16], (N_C, C_HEADS * C_DK), 0.1)
    inp['gn_c'] = 1.0 + nrm(ks[17], (N_C, C_HEADS, C_DV), 0.1)
    inp['w_out_c'] = nrm(ks[18], (N_C, C_HEADS * C_DV, D_MODEL), (C_HEADS * C_DV) ** -0.5)
    return inp


def reference(x_prompt, x_sample, cache_a_kv1, cache_a_kv2, cache_a_kv3, state_b, state_c,
              norm_g, final_g, w_in_a, w_out_a, w_in_b, gn_b, w_out_b,
              w_in_c, w_gate2_c, b_gate_c, gn_c, w_out_c):
    Bp, S, _ = x_prompt.shape
    T = x_sample.shape[1]
    pos_p = jnp.arange(S)
    pos_s = PAST_LEN + jnp.arange(T)
    caches_a = (cache_a_kv1, cache_a_kv2, cache_a_kv3)
    xp, xs = x_prompt, x_sample
    a_rows_p, a_rows_s = [], []
    b_states_p, b_states_s, c_states_p, c_states_s = [], [], [], []
    for i in range(DEPTH):
        kind, slot = LAYER_KIND[i], LAYER_SLOT[i]
        hp = rms_norm(xp, norm_g[i])
        hs = rms_norm(xs, norm_g[i])
        if kind == 0:
            dp, rows_p = attn_layer_prompt(hp, pos_p, w_in_a[slot], w_out_a[slot])
            ds, rows_s = attn_layer_sample(hs, pos_s, [c[slot] for c in caches_a], w_in_a[slot], w_out_a[slot])
            a_rows_p.append(rows_p)
            a_rows_s.append(rows_s)
        elif kind == 1:
            zero_b = jnp.zeros((Bp, B_HEADS, B_DK, B_DV), F32)
            dp, st_p = retention_layer(hp, pos_p, zero_b, min(B_CHUNK, S), w_in_b[slot], gn_b[slot], w_out_b[slot])
            ds, st_s = retention_layer(hs, pos_s, state_b[slot].astype(F32), T, w_in_b[slot], gn_b[slot], w_out_b[slot])
            b_states_p.append(st_p.astype(state_b.dtype))
            b_states_s.append(st_s.astype(state_b.dtype))
        else:
            zero_c = jnp.zeros((Bp, C_HEADS, C_DK, C_DV), F32)
            dp, st_p = gla_layer(hp, zero_c, min(C_CHUNK, S), w_in_c[slot], w_gate2_c[slot], b_gate_c[slot], gn_c[slot], w_out_c[slot])
            ds, st_s = gla_layer(hs, state_c[slot].astype(F32), T, w_in_c[slot], w_gate2_c[slot], b_gate_c[slot], gn_c[slot], w_out_c[slot])
            c_states_p.append(st_p.astype(state_c.dtype))
            c_states_s.append(st_s.astype(state_c.dtype))
        xp = xp + dp
        xs = xs + ds
    y_prompt = rms_norm(xp, final_g)
    y_sample = rms_norm(xs, final_g)
    prompt_a_kv1 = jnp.stack([r[0] for r in a_rows_p])
    prompt_a_kv2 = jnp.stack([r[1] for r in a_rows_p])
    prompt_a_kv3 = jnp.stack([r[2] for r in a_rows_p])
    sample_a_kv1 = jnp.stack([r[0] for r in a_rows_s])
    sample_a_kv2 = jnp.stack([r[1] for r in a_rows_s])
    sample_a_kv3 = jnp.stack([r[2] for r in a_rows_s])
    prompt_state_b = jnp.stack(b_states_p)
    sample_state_b = jnp.stack(b_states_s)
    prompt_state_c = jnp.stack(c_states_p)
    sample_state_c = jnp.stack(c_states_s)
    return (y_prompt, y_sample, prompt_a_kv1, prompt_a_kv2, prompt_a_kv3, prompt_state_b, prompt_state_c,
            sample_a_kv1, sample_a_kv2, sample_a_kv3, sample_state_b, sample_state_c)
```

```cpp
#include <hip/hip_runtime.h>
#include <math.h>
#include <stdint.h>

namespace nv {
constexpr int D = 2048, NB = 4, S = 2048, MP = NB * S, DB = 8, T = 4, MS = DB * T, MT = MP + MS, PAST = 16384;
constexpr float EPS = 1e-6f;
constexpr int A_IN = 20480, B_IN = 12288, C_IN = 6160;

struct RotTab { double inv_a[16]; double inv_b[128]; };

__device__ __forceinline__ float wave_sum(float v) {
#pragma unroll
    for (int o = 32; o >= 1; o >>= 1) v += __shfl_xor(v, o);
    return v;
}
__device__ __forceinline__ float wave_max(float v) {
#pragma unroll
    for (int o = 32; o >= 1; o >>= 1) v = fmaxf(v, __shfl_xor(v, o));
    return v;
}
__device__ __forceinline__ float silu(float x) { return x / (1.f + expf(-x)); }
__device__ __forceinline__ void sincos_d(double a, float& s, float& c) {
    const double k = rint(a * 0.63661977236758134308);
    double r = fma(-k, 1.57079632679489655800e+00, a); r = fma(-k, 6.12323399573676603587e-17, r);
    const double r2 = r * r;
    const double sp = r * (1.0 + r2 * (-1.0 / 6 + r2 * (1.0 / 120 + r2 * (-1.0 / 5040 + r2 * (1.0 / 362880 + r2 * (-1.0 / 39916800 + r2 * (1.0 / 6227020800.0)))))));
    const double cp = 1.0 + r2 * (-0.5 + r2 * (1.0 / 24 + r2 * (-1.0 / 720 + r2 * (1.0 / 40320 + r2 * (-1.0 / 3628800 + r2 * (1.0 / 479001600.0 + r2 * (-1.0 / 87178291200.0)))))));
    const int q = (int)((long long)k & 3);
    const double ss = (q == 0) ? sp : (q == 1) ? cp : (q == 2) ? -sp : -cp;
    const double cc = (q == 0) ? cp : (q == 1) ? -sp : (q == 2) ? -cp : sp;
    s = (float)ss; c = (float)cc;
}

__global__ void k_copy_x(const float* xp, const float* xs, float* x) {
    const size_t n = (size_t)MT * D, np = (size_t)MP * D;
    for (size_t i = (size_t)blockIdx.x * blockDim.x + threadIdx.x; i < n; i += (size_t)gridDim.x * blockDim.x) x[i] = i < np ? xp[i] : xs[i - np];
}
__global__ void k_rmsnorm(const float* x, const float* g, float* h, int rows) {
    const int w = (blockIdx.x * blockDim.x + threadIdx.x) >> 6, lane = threadIdx.x & 63;
    if (w >= rows) return;
    const float* xr = x + (size_t)w * D; float* hr = h + (size_t)w * D;
    float s = 0.f;
    for (int i = lane; i < D; i += 64) { const float v = xr[i]; s += v * v; }
    s = wave_sum(s);
    const float r = rsqrtf(s / D + EPS);
    for (int i = lane; i < D; i += 64) hr[i] = xr[i] * r * g[i];
}
__global__ void __launch_bounds__(256) k_gemm(const float* A, int lda, const float* B, int ldb, float* C, int ldc, const float* R, int ldr, int M, int N, int K) {
    __shared__ float As[16][65];
    __shared__ float Bs[16][65];
    const int tx = threadIdx.x & 15, ty = threadIdx.x >> 4;
    const int m0 = blockIdx.y * 64, n0 = blockIdx.x * 64;
    float acc[4][4];
#pragma unroll
    for (int i = 0; i < 4; ++i)
#pragma unroll
        for (int j = 0; j < 4; ++j) acc[i][j] = 0.f;
    for (int k0 = 0; k0 < K; k0 += 16) {
        for (int e = threadIdx.x; e < 64 * 16; e += 256) {
            const int r = e >> 4, c = e & 15; const int gm = m0 + r;
            As[c][r] = gm < M ? A[(size_t)gm * lda + k0 + c] : 0.f;
        }
        for (int e = threadIdx.x; e < 16 * 64; e += 256) {
            const int r = e >> 6, c = e & 63; const int gn = n0 + c;
            Bs[r][c] = gn < N ? B[(size_t)(k0 + r) * ldb + gn] : 0.f;
        }
        __syncthreads();
#pragma unroll
        for (int kk = 0; kk < 16; ++kk) {
            float a[4], b[4];
#pragma unroll
            for (int i = 0; i < 4; ++i) a[i] = As[kk][ty * 4 + i];
#pragma unroll
            for (int j = 0; j < 4; ++j) b[j] = Bs[kk][tx * 4 + j];
#pragma unroll
            for (int i = 0; i < 4; ++i)
#pragma unroll
                for (int j = 0; j < 4; ++j) acc[i][j] = fmaf(a[i], b[j], acc[i][j]);
        }
        __syncthreads();
    }
#pragma unroll
    for (int i = 0; i < 4; ++i) {
        const int gm = m0 + ty * 4 + i;
#pragma unroll
        for (int j = 0; j < 4; ++j) { const int gn = n0 + tx * 4 + j;
            if (gm < M && gn < N) { float v = acc[i][j]; if (R) v += R[(size_t)gm * ldr + gn]; C[(size_t)gm * ldc + gn] = v; } }
    }
}

__device__ __forceinline__ void row_info(int row, int& b, int& t, int& pos, bool& samp) {
    if (row < MP) { b = row / S; t = row % S; pos = t; samp = false; } else { const int r = row - MP; b = r / T; t = r % T; pos = PAST + t; samp = true; }
}
__global__ void k_rot_a(float* z, int slot, RotTab rt, float* pkv1, float* pkv2, float* pkv3, float* skv1, float* skv2, float* skv3) {
    const int blk = blockIdx.x; const int h = blk % 16, g = (blk / 16) % 3, row = blk / 48; const int d = threadIdx.x;
    int b, t, pos; bool samp; row_info(row, b, t, pos, samp);
    float* zr = z + (size_t)row * A_IN; const int qcol = (g * 3) * 2048 + h * 128, kcol = (g * 3 + 1) * 2048 + h * 128, vcol = (g * 3 + 2) * 2048 + h * 128;
    float qv = zr[qcol + d], kv = zr[kcol + d]; const float vv = zr[vcol + d];
    if (d < 32) {
        const int i = d & 15; const int partner = d < 16 ? d + 16 : d - 16;
        const float qp = zr[qcol + partner], kp = zr[kcol + partner];
        float s, c; sincos_d((double)pos * rt.inv_a[i], s, c);
        if (d < 16) { qv = qv * c - qp * s; kv = kv * c - kp * s; } else { qv = qp * s + qv * c; kv = kp * s + kv * c; }
    }
    __syncthreads();
    if (d < 32) { zr[qcol + d] = qv; zr[kcol + d] = kv; }
    if (!samp) {
        const int keep = g == 0 ? 128 : (g == 1 ? 512 : 2048); float* o = g == 0 ? pkv1 : (g == 1 ? pkv2 : pkv3);
        if (t >= S - keep) { const int r = t - (S - keep); const size_t base = ((((size_t)slot * NB + b) * keep + r) * 2) * 2048 + h * 128 + d; o[base] = kv; o[base + 2048] = vv; }
    } else {
        float* o = g == 0 ? skv1 : (g == 1 ? skv2 : skv3);
        const size_t base = ((((size_t)slot * DB + b) * T + t) * 2) * 2048 + h * 128 + d; o[base] = kv; o[base + 2048] = vv;
    }
}
__global__ void __launch_bounds__(256) k_attn(const float* z, int slot, const float* c1, const float* c2, const float* c3, float* y) {
    const int wid = threadIdx.x >> 6, lane = threadIdx.x & 63; const int row = blockIdx.x >> 2, h = (blockIdx.x & 3) * 4 + wid;
    int b, t, pos; bool samp; row_info(row, b, t, pos, samp);
    const float* zr = z + (size_t)row * A_IN;
    float mrun = -INFINITY, wsum = 0.f, acc0 = 0.f, acc1 = 0.f;
    for (int g = 0; g < 3; ++g) {
        const int win = g == 0 ? 128 : (g == 1 ? 512 : 2048), dil = g == 0 ? 1 : (g == 1 ? 4 : 16);
        const float* cache = g == 0 ? c1 : (g == 1 ? c2 : c3);
        const int qcol = (g * 3) * 2048 + h * 128, kcol = qcol + 2048, vcol = qcol + 4096;
        float sc[3];
#pragma unroll
        for (int u = 0; u < 3; ++u) {
            const int j = lane + 64 * u; float s = -INFINITY;
            if (j <= 128) {
                const float* kp = nullptr;
                if (!samp) { const int tok = t - dil * j; if (tok >= 0) kp = z + (size_t)(b * S + tok) * A_IN + kcol; }
                else { const int idx = win + t - dil * j; if (idx >= win) kp = z + (size_t)(MP + b * T + (idx - win)) * A_IN + kcol; else kp = cache + ((((size_t)slot * DB + b) * win + idx) * 2) * 2048 + h * 128; }
                if (kp) { float a = 0.f; for (int d = 0; d < 128; d += 4) { const float4 kk = *(const float4*)(kp + d); const float4 qq = *(const float4*)(zr + qcol + d); a += kk.x * qq.x + kk.y * qq.y + kk.z * qq.z + kk.w * qq.w; } s = a * 0.08838834764831845f; }
            }
            sc[u] = s;
        }
        const float m = wave_max(fmaxf(sc[0], fmaxf(sc[1], sc[2])));
        float p[3]; float ps = 0.f;
#pragma unroll
        for (int u = 0; u < 3; ++u) { p[u] = expf(sc[u] - m); ps += p[u]; }
        const float den = wave_sum(ps);
        const float lse = m + logf(den);
        float o0 = 0.f, o1 = 0.f;
#pragma unroll
        for (int u = 0; u < 3; ++u) {
            const int cnt = u < 2 ? 64 : 1;
            for (int jj = 0; jj < cnt; ++jj) {
                const int j = jj + 64 * u;
                const float pj = __shfl(p[u], jj);
                if (pj == 0.f) continue;
                const float* vp;
                if (!samp) { const int tok = t - dil * j; vp = z + (size_t)(b * S + tok) * A_IN + vcol; }
                else { const int idx = win + t - dil * j; if (idx >= win) vp = z + (size_t)(MP + b * T + (idx - win)) * A_IN + vcol; else vp = cache + ((((size_t)slot * DB + b) * win + idx) * 2 + 1) * 2048 + h * 128; }
                o0 += pj * vp[lane]; o1 += pj * vp[lane + 64];
            }
        }
        o0 /= den; o1 /= den;
        const float mnew = fmaxf(mrun, lse); const float sc_old = expf(mrun - mnew), sc_new = expf(lse - mnew);
        acc0 = acc0 * sc_old + sc_new * o0; acc1 = acc1 * sc_old + sc_new * o1; wsum = wsum * sc_old + sc_new; mrun = mnew;
    }
    const float* gate = zr + 18432 + h * 128;
    float* yr = y + (size_t)row * 2048 + h * 128;
    yr[lane] = acc0 / wsum * silu(gate[lane]);
    yr[lane + 64] = acc1 / wsum * silu(gate[lane + 64]);
}
__global__ void k_prep_b(float* z, RotTab rt) {
    const int h = blockIdx.x % 8, row = blockIdx.x / 8, i = threadIdx.x;
    int b, t, pos; bool samp; row_info(row, b, t, pos, samp);
    float* zr = z + (size_t)row * B_IN;
    float s, c; sincos_d((double)pos * rt.inv_b[i], s, c);
    float* q = zr + h * 256; float* k = zr + 2048 + h * 256;
    const float q1 = q[i], q2 = q[i + 128]; q[i] = q1 * c - q2 * s; q[i + 128] = q1 * s + q2 * c;
    const float k1 = k[i], k2 = k[i + 128]; k[i] = (k1 * c - k2 * s) * 0.0625f; k[i + 128] = (k1 * s + k2 * c) * 0.0625f;
}
__global__ void k_prep_c(float* z, const float* wg2, const float* bg, float* loga) {
    const int row = blockIdx.x; float* zr = z + (size_t)row * C_IN;
    __shared__ float lr[16];
    if (threadIdx.x < 16) lr[threadIdx.x] = zr[6144 + threadIdx.x];
    __syncthreads();
    for (int c = threadIdx.x; c < 1024; c += 256) {
        zr[c] *= 0.0625f;
        float a = bg[c];
#pragma unroll
        for (int r = 0; r < 16; ++r) a += lr[r] * wg2[r * 1024 + c];
        const float ls = fminf(a, 0.f) - log1pf(expf(-fabsf(a)));
        loga[(size_t)row * 1024 + c] = ls * 0.0625f;
    }
}
template <bool GLA>
__global__ void __launch_bounds__(256) k_recur(const float* z, int ldz, int qoff, int koff, int voff, int H, int ntok, int row0, const float* state0, float* state_out, float* o, const float* loga) {
    const int vs = blockIdx.x % 16, h = (blockIdx.x / 16) % H, seq = blockIdx.x / (16 * H);
    const int d = threadIdx.x, lane = d & 63, wid = d >> 6;
    __shared__ float red[2][4][32];
    float Sreg[32];
    const size_t sbase = (((size_t)seq * H + h) * 256 + d) * 512 + vs * 32;
#pragma unroll
    for (int i = 0; i < 32; ++i) Sreg[i] = state0 ? state0[sbase + i] : 0.f;
    float gamma = 1.f;
    if (!GLA) gamma = 1.0f - exp2f(-5.0f - (float)h);
    for (int t = 0; t < ntok; ++t) {
        const int row = row0 + seq * ntok + t;
        const float* zr = z + (size_t)row * ldz;
        const float qd = zr[qoff + h * 256 + d], kd = zr[koff + h * 256 + d];
        float dec = gamma; if (GLA) dec = expf(loga[(size_t)row * (H * 256) + h * 256 + d]);
        const float* vp = zr + voff + h * 512 + vs * 32;
        float p[32];
#pragma unroll
        for (int i = 0; i < 32; ++i) { Sreg[i] = dec * Sreg[i] + kd * vp[i]; p[i] = qd * Sreg[i]; }
#pragma unroll
        for (int i = 0; i < 32; ++i) p[i] = wave_sum(p[i]);
        float mine = 0.f;
#pragma unroll
        for (int i = 0; i < 32; ++i) if (lane == i) mine = p[i];
        if (lane < 32) red[t & 1][wid][lane] = mine;
        __syncthreads();
        if (d < 32) o[(size_t)row * (H * 512) + h * 512 + vs * 32 + d] = red[t & 1][0][d] + red[t & 1][1][d] + red[t & 1][2][d] + red[t & 1][3][d];
    }
#pragma unroll
    for (int i = 0; i < 32; ++i) state_out[sbase + i] = Sreg[i];
}
template <bool MEAN>
__global__ void k_norm_gate(const float* o, int H, const float* z, int ldz, int goff, const float* gn, float* y, int rows) {
    const int w = (blockIdx.x * blockDim.x + threadIdx.x) >> 6, lane = threadIdx.x & 63;
    if (w >= rows * H) return;
    const int row = w / H, h = w % H;
    const float* orow = o + (size_t)row * (H * 512) + h * 512; const float* gate = z + (size_t)row * ldz + goff + h * 512;
    float v[8]; float s = 0.f;
#pragma unroll
    for (int i = 0; i < 8; ++i) { v[i] = orow[lane + 64 * i]; s += v[i]; }
    float mu = 0.f; if (MEAN) mu = wave_sum(s) * (1.f / 512.f);
    float q = 0.f;
#pragma unroll
    for (int i = 0; i < 8; ++i) { v[i] -= mu; q += v[i] * v[i]; }
    const float r = rsqrtf(wave_sum(q) * (1.f / 512.f) + EPS);
    float* yr = y + (size_t)row * (H * 512) + h * 512;
#pragma unroll
    for (int i = 0; i < 8; ++i) yr[lane + 64 * i] = v[i] * r * gn[h * 512 + lane + 64 * i] * silu(gate[lane + 64 * i]);
}
}

extern "C" void kernel_launch(void* const* d_in, const int* in_sizes, int n_in, void* d_out, int out_size, void* d_ws, size_t ws_size, hipStream_t stream) {
    using namespace nv;
    const float* x_prompt = (const float*)d_in[0]; const float* x_sample = (const float*)d_in[1];
    const float* cache1 = (const float*)d_in[2]; const float* cache2 = (const float*)d_in[3]; const float* cache3 = (const float*)d_in[4];
    const float* state_b = (const float*)d_in[5]; const float* state_c = (const float*)d_in[6];
    const float* norm_g = (const float*)d_in[7]; const float* final_g = (const float*)d_in[8];
    const float* w_in_a = (const float*)d_in[9]; const float* w_out_a = (const float*)d_in[10];
    const float* w_in_b = (const float*)d_in[11]; const float* gn_b = (const float*)d_in[12]; const float* w_out_b = (const float*)d_in[13];
    const float* w_in_c = (const float*)d_in[14]; const float* w_gate2_c = (const float*)d_in[15]; const float* b_gate_c = (const float*)d_in[16];
    const float* gn_c = (const float*)d_in[17]; const float* w_out_c = (const float*)d_in[18];
    float* out = (float*)d_out;
    float* y_prompt = out; float* y_sample = y_prompt + (size_t)MP * D;
    float* pkv1 = y_sample + (size_t)MS * D; float* pkv2 = pkv1 + (size_t)2 * 4 * 128 * 4096; float* pkv3 = pkv2 + (size_t)2 * 4 * 512 * 4096;
    float* pst_b = pkv3 + (size_t)2 * 4 * 2048 * 4096; float* pst_c = pst_b + (size_t)4 * 8 * 256 * 512;
    float* skv1 = pst_c + (size_t)4 * 4 * 256 * 512; float* skv2 = skv1 + (size_t)2 * 8 * 4 * 4096; float* skv3 = skv2 + (size_t)2 * 8 * 4 * 4096;
    float* sst_b = skv3 + (size_t)2 * 8 * 4 * 4096; float* sst_c = sst_b + (size_t)8 * 8 * 256 * 512;

    RotTab rt{};
    for (int i = 0; i < 16; ++i) rt.inv_a[i] = pow(500000.0, -(double)i / 16.0);
    for (int i = 0; i < 128; ++i) rt.inv_b[i] = pow(10000.0, -(double)i / 128.0);

    float* ws = (float*)d_ws;
    float* x = ws;
    float* hbuf = x + (size_t)MT * D;
    float* z = hbuf + (size_t)MT * D;
    float* ybuf = z + (size_t)MT * A_IN;
    float* obuf = ybuf + (size_t)MT * 4096;
    float* loga = obuf + (size_t)MT * 4096;

    k_copy_x<<<2048, 256, 0, stream>>>(x_prompt, x_sample, x);
    for (int layer = 0; layer < 4; ++layer) {
        const int kind = layer % 3, slot = layer / 3;
        k_rmsnorm<<<(MT * 64 + 255) / 256, 256, 0, stream>>>(x, norm_g + (size_t)layer * D, hbuf, MT);
        if (kind == 0) {
            const float* wi = w_in_a + (size_t)slot * D * A_IN; const float* wo = w_out_a + (size_t)slot * 2048 * D;
            k_gemm<<<dim3(A_IN / 64, (MT + 63) / 64), 256, 0, stream>>>(hbuf, D, wi, A_IN, z, A_IN, nullptr, 0, MT, A_IN, D);
            k_rot_a<<<MT * 48, 128, 0, stream>>>(z, slot, rt, pkv1, pkv2, pkv3, skv1, skv2, skv3);
            k_attn<<<MT * 4, 256, 0, stream>>>(z, slot, cache1, cache2, cache3, ybuf);
            k_gemm<<<dim3(D / 64, (MT + 63) / 64), 256, 0, stream>>>(ybuf, 2048, wo, D, x, D, x, D, MT, D, 2048);
        } else if (kind == 1) {
            const float* wi = w_in_b + (size_t)slot * D * B_IN; const float* wo = w_out_b + (size_t)slot * 4096 * D;
            k_gemm<<<dim3(B_IN / 64, (MT + 63) / 64), 256, 0, stream>>>(hbuf, D, wi, B_IN, z, B_IN, nullptr, 0, MT, B_IN, D);
            k_prep_b<<<MT * 8, 128, 0, stream>>>(z, rt);
            k_recur<false><<<NB * 8 * 16, 256, 0, stream>>>(z, B_IN, 0, 2048, 4096, 8, S, 0, nullptr, pst_b + (size_t)slot * 4 * 8 * 256 * 512, obuf, nullptr);
            k_recur<false><<<DB * 8 * 16, 256, 0, stream>>>(z, B_IN, 0, 2048, 4096, 8, T, MP, state_b + (size_t)slot * 8 * 8 * 256 * 512, sst_b + (size_t)slot * 8 * 8 * 256 * 512, obuf, nullptr);
            k_norm_gate<true><<<(MT * 8 * 64 + 255) / 256, 256, 0, stream>>>(obuf, 8, z, B_IN, 8192, gn_b + (size_t)slot * 4096, ybuf, MT);
            k_gemm<<<dim3(D / 64, (MT + 63) / 64), 256, 0, stream>>>(ybuf, 4096, wo, D, x, D, x, D, MT, D, 4096);
        } else {
            const float* wi = w_in_c + (size_t)slot * D * C_IN; const float* wo = w_out_c + (size_t)slot * 2048 * D;
            k_gemm<<<dim3((C_IN + 63) / 64, (MT + 63) / 64), 256, 0, stream>>>(hbuf, D, wi, C_IN, z, C_IN, nullptr, 0, MT, C_IN, D);
            k_prep_c<<<MT, 256, 0, stream>>>(z, w_gate2_c + (size_t)slot * 16 * 1024, b_gate_c + (size_t)slot * 1024, loga);
            k_recur<true><<<NB * 4 * 16, 256, 0, stream>>>(z, C_IN, 0, 1024, 2048, 4, S, 0, nullptr, pst_c + (size_t)slot * 4 * 4 * 256 * 512, obuf, loga);
            k_recur<true><<<DB * 4 * 16, 256, 0, stream>>>(z, C_IN, 0, 1024, 2048, 4, T, MP, state_c + (size_t)slot * 8 * 4 * 256 * 512, sst_c + (size_t)slot * 8 * 4 * 256 * 512, obuf, loga);
            k_norm_gate<false><<<(MT * 4 * 64 + 255) / 256, 256, 0, stream>>>(obuf, 4, z, C_IN, 4096, gn_c + (size_t)slot * 2048, ybuf, MT);
            k_gemm<<<dim3(D / 64, (MT + 63) / 64), 256, 0, stream>>>(ybuf, 2048, wo, D, x, D, x, D, MT, D, 2048);
        }
    }
    k_rmsnorm<<<(MT * 64 + 255) / 256, 256, 0, stream>>>(x, final_g, y_prompt, MT);
}
```

```cpp
#include <hip/hip_runtime.h>
#include <cstdio>
#include <cstdint>
#include <cmath>
namespace pg8 {
#define PG8_LAS __attribute__((address_space(3)))
typedef unsigned short bf16_t;
typedef short bf16x8 __attribute__((ext_vector_type(8)));
typedef float f32x4 __attribute__((ext_vector_type(4)));
typedef unsigned u32x4 __attribute__((ext_vector_type(4)));
constexpr int BM = 256, BK = 64, HALF = 128, HTB = HALF * BK * 2  , STAGE_BYTES = 8 * HTB, NXCD = 8, WGM = 8;

__host__ __device__ __forceinline__ int lds_byte(int r, int c) { const int st = (r >> 4) * 2 + (c >> 5), rr = r & 15, cc = c & 31, ob = rr * 64 + cc * 2; return st * 1024 + (ob ^ (((ob >> 9) & 1) << 5)); }
__host__ __device__ __forceinline__ void stage_rc(int b, int& R, int& C) { const int st = b / 1024, sb = b % 1024, swz = sb ^ (((sb >> 9) & 1) << 5); R = (st >> 1) * 16 + swz / 64; C = (st & 1) * 32 + (swz % 64) / 2; }
__host__ __device__ __forceinline__ int perm32(int rho) { const int n = rho >> 4, i = rho & 15; return 8 * (i >> 2) + 4 * n + (i & 3); }

struct Unit { int pm, pn; };
struct Gemm { const bf16_t* A; const bf16_t* Bt; int M, N, K; };

struct StaticOrder {
    int nM, nN, nwg, G, c;
    __host__ __device__ void init(int M, int N, int G_, int c_) { nM = M / BM; nN = N / BM; nwg = nM * nN; G = G_; c = c_; }
    __host__ __device__ bool next(int i, Unit& u) const {
        const long L = (long)i * G + c; if (L >= nwg) return false;
        int wgid = (int)L; { const int q = nwg / NXCD, r = nwg % NXCD, xcd = wgid % NXCD, off = wgid / NXCD; wgid = (xcd < r ? xcd * (q + 1) : r * (q + 1) + (xcd - r) * q) + off; }
        const int nig = WGM * nN, gid = wgid / nig, fm = gid * WGM, gsz = (nM - fm) < WGM ? (nM - fm) : WGM;
        u.pm = fm + ((wgid % nig) % gsz); u.pn = (wgid % nig) / gsz; return true;
    }
    __device__ __forceinline__ void a_ready(const Unit&) const {}
    __device__ __forceinline__ void done(const Unit&) const {}
};

__device__ __forceinline__ unsigned cvt_pk_bf16(float lo, float hi) { unsigned r; asm volatile("v_cvt_pk_bf16_f32 %0, %1, %2" : "=v"(r) : "v"(lo), "v"(hi)); return r; }
typedef float f32x2 __attribute__((ext_vector_type(2)));
typedef unsigned u32x2 __attribute__((ext_vector_type(2)));

template <int MODE> struct EpiIn {
    static constexpr bool PERM = true, AFTER_DRAIN = false;
    bf16_t* Z; int ldz; const float* sumsq; const f32x2* tab; float* kvb; int slot;
    __device__ __forceinline__ void store8(bf16_t* p, const f32x4& a, const f32x4& b) const {
        u32x4 w; w.x = cvt_pk_bf16(a[0], a[1]); w.y = cvt_pk_bf16(a[2], a[3]); w.z = cvt_pk_bf16(b[0], b[1]); w.w = cvt_pk_bf16(b[2], b[3]); *(u32x4*)p = w; }
    __device__ __forceinline__ void operator()(const f32x4 (&acc)[2][2][4][2], const Unit& u, int wr, int wc, int fr, int fq) const {
        const int row0 = u.pm * BM + wr * 64 + fr, colt = u.pn * BM;
        if constexpr (MODE == 0) {
            const int section = u.pn >> 3, kind = section < 9 ? section % 3 : 3, g = section / 3;
            const bool rot = (kind < 2) && (wc == 0);
            const int gg = g > 2 ? 2 : g, keep = 128 << (2 * gg); float* kvo = kvb + (size_t)32768 * (size_t)(128 * (((1 << (2 * gg)) - 1) / 3)) + (size_t)slot * 4 * keep * 4096;
#pragma unroll
            for (int ai = 0; ai < 2; ++ai)
#pragma unroll
                for (int m = 0; m < 4; ++m) {
                    const int row = row0 + ai * HALF + m * 16; const float rs = rsqrtf(sumsq[row] * (1.0f / 2048.0f) + 1e-6f); const int pos = row & 2047, b = row >> 11;
#pragma unroll
                    for (int bj = 0; bj < 2; ++bj) {
                        f32x4 v0 = acc[ai][bj][m][0] * rs, v1 = acc[ai][bj][m][1] * rs;
                        const int col = colt + bj * HALF + wc * 32 + 8 * fq;
                        if (rot) {
                            f32x4 p0, p1;
#pragma unroll
                            for (int j = 0; j < 4; ++j) { p0[j] = __shfl_xor(v0[j], 32); p1[j] = __shfl_xor(v1[j], 32); }
                            const f32x4* tp = (const f32x4*)(tab + pos * 16 + 8 * (fq & 1));
                            const f32x4 t0 = tp[0], t1 = tp[1], t2 = tp[2], t3 = tp[3];
                            const f32x4 c0 = {t0[0], t0[2], t1[0], t1[2]}, s0 = {t0[1], t0[3], t1[1], t1[3]}, c1 = {t2[0], t2[2], t3[0], t3[2]}, s1 = {t2[1], t2[3], t3[1], t3[3]};
                            if (fq < 2) { v0 = v0 * c0 - p0 * s0; v1 = v1 * c1 - p1 * s1; } else { v0 = p0 * s0 + v0 * c0; v1 = p1 * s1 + v1 * c1; }
                        }
                        store8(Z + (size_t)row * ldz + col, v0, v1);
                        if (kind == 1 || kind == 2) {
                            if (pos >= 2048 - keep) { float* o = kvo + (((size_t)b * keep + (pos - (2048 - keep))) * 2 + (kind - 1)) * 2048 + (col - section * 2048);
                                *(f32x4*)o = v0; *(f32x4*)(o + 4) = v1; }
                        }
                    }
                }
        } else if constexpr (MODE == 1) {
            const bool rot = u.pn < 16; const float sc = (u.pn >= 8 && u.pn < 16) ? 0.0625f : 1.0f;
#pragma unroll
            for (int ai = 0; ai < 2; ++ai)
#pragma unroll
                for (int m = 0; m < 4; ++m) {
                    const int row = row0 + ai * HALF + m * 16; const float rs = rsqrtf(sumsq[row] * (1.0f / 2048.0f) + 1e-6f) * sc; const int pos = row & 2047;
                    f32x4 x1[2], x2[2];
#pragma unroll
                    for (int n = 0; n < 2; ++n) { x1[n] = acc[ai][0][m][n] * rs; x2[n] = acc[ai][1][m][n] * rs; }
                    if (rot) {
#pragma unroll
                        for (int n = 0; n < 2; ++n) {
                            const f32x4* tp = (const f32x4*)(tab + pos * 128 + wc * 32 + 8 * fq + 4 * n);
                            const f32x4 t0 = tp[0], t1 = tp[1];
                            const f32x4 c = {t0[0], t0[2], t1[0], t1[2]}, s = {t0[1], t0[3], t1[1], t1[3]};
                            const f32x4 a = x1[n], bb = x2[n];
                            x1[n] = a * c - bb * s; x2[n] = a * s + bb * c;
                        }
                    }
                    bf16_t* zp = Z + (size_t)row * ldz + colt + wc * 32 + 8 * fq;
                    store8(zp, x1[0], x1[1]); store8(zp + HALF, x2[0], x2[1]);
                }
        } else {
            const float sc = u.pn < 4 ? 0.0625f : 1.0f;
#pragma unroll
            for (int ai = 0; ai < 2; ++ai)
#pragma unroll
                for (int m = 0; m < 4; ++m) {
                    const int row = row0 + ai * HALF + m * 16; const float rs = rsqrtf(sumsq[row] * (1.0f / 2048.0f) + 1e-6f) * sc;
                    bf16_t* zp = Z + (size_t)row * ldz + colt + wc * 32 + 8 * fq;
#pragma unroll
                    for (int bj = 0; bj < 2; ++bj) store8(zp + bj * HALF, acc[ai][bj][m][0] * rs, acc[ai][bj][m][1] * rs);
                }
        }
    }
};
struct EpiOut {
    static constexpr bool PERM = false, AFTER_DRAIN = false;
    float* xres; bf16_t* xb; float* sumsq_next;
    __device__ __forceinline__ void operator()(const f32x4 (&acc)[2][2][4][2], const Unit& u, int wr, int wc, int fr, int fq) const {
        const int row0 = u.pm * BM + wr * 64 + fr, col0 = u.pn * BM + wc * 32 + 4 * fq;
#pragma unroll
        for (int ai = 0; ai < 2; ++ai)
#pragma unroll
            for (int m = 0; m < 4; ++m) {
                const int row = row0 + ai * HALF + m * 16; float ss = 0.f;
                float* xr = xres + (size_t)row * 2048 + col0; bf16_t* br = xb + (size_t)row * 2048 + col0;
#pragma unroll
                for (int bj = 0; bj < 2; ++bj)
#pragma unroll
                    for (int n = 0; n < 2; ++n) {
                        const f32x4 v = *(const f32x4*)(xr + bj * HALF + n * 16) + acc[ai][bj][m][n];
                        *(f32x4*)(xr + bj * HALF + n * 16) = v;
                        u32x2 w; w.x = cvt_pk_bf16(v[0], v[1]); w.y = cvt_pk_bf16(v[2], v[3]); *(u32x2*)(br + bj * HALF + n * 16) = w;
                        ss += (v[0] * v[0] + v[1] * v[1]) + (v[2] * v[2] + v[3] * v[3]);
                    }
                ss += __shfl_xor(ss, 16); ss += __shfl_xor(ss, 32);
                if (fq == 0) atomicAdd(sumsq_next + row, ss);
            }
    }
};
template <class Epi, class Sched, bool ALIGN_EPI = false, bool SP2 = false>
__device__ __forceinline__ void gemm_phase(PG8_LAS unsigned char* lds, const Gemm g, const Sched& S, const Epi& E) {
    const int tid = threadIdx.x, wid = __builtin_amdgcn_readfirstlane(tid >> 6), lane = tid & 63, wr = wid >> 2, wc = wid & 3, fr = lane & 15, fq = lane >> 4;
    const int K = g.K, nt = K / BK;
    unsigned voffA[2], voffB[2];
#pragma unroll
    for (int i = 0; i < 2; ++i) { int R, C; stage_rc(tid * 16 + i * 8192, R, C); const int Rb = Epi::PERM ? ((R & ~31) + perm32(R & 31)) : R;
        voffA[i] = (unsigned)(R * K + C) * 2u; voffB[i] = (unsigned)(Rb * K + C) * 2u; }
    const size_t kstep = (size_t)(BK * 2);
    const size_t hstep = (size_t)HALF * K * 2;
    const size_t tstep = 2 * hstep;
    const unsigned ldsw = (unsigned)wid * 1024u;
    const int aoff = lds_byte(wr * 64 + fr, fq * 8), boff = lds_byte(wc * 32 + fr, fq * 8);
#define PG8_SA(b, h) (((b) * 2 + (h)) * HTB)
#define PG8_SB(b, h) ((4 + (b) * 2 + (h)) * HTB)
#define PG8_STAGE(bufoff, gbase, voff) do { _Pragma("unroll") for (int _i = 0; _i < 2; ++_i) \
        __builtin_amdgcn_global_load_lds((const unsigned*)((const char*)(gbase) + (voff)[_i]), (PG8_LAS unsigned*)(lds + (bufoff) + ldsw + _i * 8192), 16, 0, 0); } while (0)
#define PG8_LDA(dst, b, h) do { _Pragma("unroll") for (int m = 0; m < 4; ++m) _Pragma("unroll") for (int k = 0; k < 2; ++k) dst[m][k] = *(const PG8_LAS bf16x8*)(lds + PG8_SA(b, h) + aoff + m * 2048 + k * 1024); } while (0)
#define PG8_LDB(dst, b, h) do { _Pragma("unroll") for (int n = 0; n < 2; ++n) _Pragma("unroll") for (int k = 0; k < 2; ++k) dst[n][k] = *(const PG8_LAS bf16x8*)(lds + PG8_SB(b, h) + boff + n * 2048 + k * 1024); } while (0)
#define PG8_MMA(ai, bj, At, Bt) do { __builtin_amdgcn_s_setprio(1); _Pragma("unroll") for (int m = 0; m < 4; ++m) _Pragma("unroll") for (int n = 0; n < 2; ++n) _Pragma("unroll") for (int k = 0; k < 2; ++k) \
        acc[ai][bj][m][n] = __builtin_amdgcn_mfma_f32_16x16x32_bf16(Bt[n][k], At[m][k], acc[ai][bj][m][n], 0, 0, 0); __builtin_amdgcn_s_setprio(0); } while (0)
#define PG8_WAIT_V(n) asm volatile("s_waitcnt vmcnt(" #n ")" ::: "memory")
#define PG8_WAIT_L(n) asm volatile("s_waitcnt lgkmcnt(" #n ")" ::: "memory")
#define PG8_BAR __builtin_amdgcn_s_barrier()
#define PG8_SCHED __builtin_amdgcn_sched_barrier(0)
    Unit cur, nxt; int ui = 0;
    if (!S.next(0, cur)) return;
    f32x4 acc[2][2][4][2];
#pragma unroll
    for (int a = 0; a < 2; ++a)
#pragma unroll
        for (int b = 0; b < 2; ++b)
#pragma unroll
            for (int m = 0; m < 4; ++m)
#pragma unroll
                for (int n = 0; n < 2; ++n) acc[a][b][m][n] = (f32x4){0.f, 0.f, 0.f, 0.f};
    bf16x8 At[4][2], B0[2][2], B1[2][2];
    const char* cA = (const char*)g.A + (size_t)cur.pm * tstep; const char* cB = (const char*)g.Bt + (size_t)cur.pn * tstep;
    S.a_ready(cur);
    if constexpr (SP2) {
        PG8_STAGE(PG8_SB(0, 0), cB, voffB); PG8_STAGE(PG8_SB(0, 1), cB + hstep, voffB); PG8_STAGE(PG8_SA(0, 0), cA, voffA); PG8_STAGE(PG8_SA(0, 1), cA + hstep, voffA);
        if (wr == 1) PG8_BAR;
        PG8_WAIT_V(2); PG8_BAR;
        PG8_STAGE(PG8_SB(1, 0), cB + kstep, voffB); PG8_STAGE(PG8_SA(1, 0), cA + kstep, voffA); PG8_STAGE(PG8_SB(1, 1), cB + hstep + kstep, voffB);
        PG8_WAIT_V(6); PG8_BAR;
    } else {
        PG8_STAGE(PG8_SB(0, 0), cB, voffB); PG8_STAGE(PG8_SA(0, 0), cA, voffA); PG8_STAGE(PG8_SB(0, 1), cB + hstep, voffB); PG8_STAGE(PG8_SA(0, 1), cA + hstep, voffA);
        if (wr == 1) PG8_BAR;
        PG8_WAIT_V(4); PG8_BAR;
        PG8_STAGE(PG8_SB(1, 0), cB + kstep, voffB); PG8_STAGE(PG8_SA(1, 0), cA + kstep, voffA); PG8_STAGE(PG8_SB(1, 1), cB + hstep + kstep, voffB);
        PG8_WAIT_V(6); PG8_BAR;
    }
    for (;;) {
        const bool has_next = S.next(ui + 1, nxt);
        const char* nA = has_next ? (const char*)g.A + (size_t)nxt.pm * tstep : cA; const char* nB = has_next ? (const char*)g.Bt + (size_t)nxt.pn * tstep : cB;
        for (int t = 0; t < nt; t += 2) {
            const bool last = (t == nt - 2);
            const char* a1 = cA + (size_t)(t + 1) * kstep;
            const char* a2 = last ? nA : cA + (size_t)(t + 2) * kstep; const char* b2 = last ? nB : cB + (size_t)(t + 2) * kstep;
            const char* a3 = a2 + kstep; const char* b3 = b2 + kstep;
            if (last && has_next) S.a_ready(nxt);
            if constexpr (SP2) {
            PG8_LDB(B0, 0, 0); PG8_LDB(B1, 0, 1); PG8_SCHED; PG8_LDA(At, 0, 0); PG8_STAGE(PG8_SA(1, 1), a1 + hstep, voffA);
            PG8_WAIT_V(8); PG8_WAIT_L(0); PG8_BAR; PG8_MMA(0, 0, At, B0); PG8_MMA(0, 1, At, B1); PG8_BAR; PG8_SCHED;
            PG8_LDA(At, 0, 1); PG8_STAGE(PG8_SB(0, 0), b2, voffB); PG8_STAGE(PG8_SB(0, 1), b2 + hstep, voffB); PG8_STAGE(PG8_SA(0, 0), a2, voffA);
            PG8_WAIT_V(8); PG8_WAIT_L(0); PG8_BAR; PG8_MMA(1, 0, At, B0); PG8_MMA(1, 1, At, B1); PG8_BAR; PG8_SCHED;
            PG8_LDB(B0, 1, 0); PG8_LDB(B1, 1, 1); PG8_SCHED; PG8_LDA(At, 1, 0); PG8_STAGE(PG8_SA(0, 1), a2 + hstep, voffA);
            PG8_WAIT_V(8); PG8_WAIT_L(0); PG8_BAR; PG8_MMA(0, 0, At, B0); PG8_MMA(0, 1, At, B1); PG8_BAR; PG8_SCHED;
            PG8_LDA(At, 1, 1); PG8_STAGE(PG8_SB(1, 0), b3, voffB); PG8_STAGE(PG8_SB(1, 1), b3 + hstep, voffB); PG8_STAGE(PG8_SA(1, 0), a3, voffA);
            PG8_WAIT_V(8); PG8_WAIT_L(0); PG8_BAR; PG8_MMA(1, 0, At, B0); PG8_MMA(1, 1, At, B1); PG8_BAR; PG8_SCHED;
            } else {
            PG8_LDB(B0, 0, 0); PG8_SCHED; PG8_LDA(At, 0, 0); PG8_STAGE(PG8_SA(1, 1), a1 + hstep, voffA);
            PG8_WAIT_L(8); PG8_BAR; PG8_WAIT_L(0); PG8_MMA(0, 0, At, B0); PG8_BAR; PG8_SCHED;
            PG8_LDB(B1, 0, 1); PG8_STAGE(PG8_SB(0, 0), b2, voffB);
            PG8_BAR; PG8_WAIT_L(0); PG8_MMA(0, 1, At, B1); PG8_BAR;
            PG8_LDA(At, 0, 1); PG8_STAGE(PG8_SA(0, 0), a2, voffA);
            PG8_BAR; PG8_WAIT_L(0); PG8_MMA(1, 0, At, B0); PG8_BAR; PG8_SCHED;
            PG8_STAGE(PG8_SB(0, 1), b2 + hstep, voffB);
            PG8_WAIT_V(6); PG8_BAR; PG8_MMA(1, 1, At, B1); PG8_BAR;
            PG8_LDB(B0, 1, 0); PG8_SCHED; PG8_LDA(At, 1, 0); PG8_STAGE(PG8_SA(0, 1), a2 + hstep, voffA);
            PG8_WAIT_L(8); PG8_BAR; PG8_WAIT_L(0); PG8_MMA(0, 0, At, B0); PG8_BAR; PG8_SCHED;
            PG8_LDB(B1, 1, 1); PG8_STAGE(PG8_SB(1, 0), b3, voffB);
            PG8_BAR; PG8_WAIT_L(0); PG8_MMA(0, 1, At, B1); PG8_BAR;
            PG8_LDA(At, 1, 1); PG8_STAGE(PG8_SA(1, 0), a3, voffA);
            PG8_BAR; PG8_WAIT_L(0); PG8_MMA(1, 0, At, B0); PG8_BAR; PG8_SCHED;
            PG8_STAGE(PG8_SB(1, 1), b3 + hstep, voffB);
            PG8_WAIT_V(6); PG8_BAR; PG8_MMA(1, 1, At, B1); PG8_BAR;
            }
        }
        if constexpr (ALIGN_EPI) { if (wr == 0) PG8_BAR; }
        if constexpr (!Epi::AFTER_DRAIN) { E(acc, cur, wr, wc, fr, fq); S.done(cur); }
        if (!has_next) break;
#pragma unroll
        for (int a = 0; a < 2; ++a)
#pragma unroll
            for (int b = 0; b < 2; ++b)
#pragma unroll
                for (int m = 0; m < 4; ++m)
#pragma unroll
                    for (int n = 0; n < 2; ++n) acc[a][b][m][n] = (f32x4){0.f, 0.f, 0.f, 0.f};
        cur = nxt; cA = nA; cB = nB; ++ui;
        if constexpr (ALIGN_EPI) { if (wr == 1) PG8_BAR; }
    }
    PG8_WAIT_V(0);
    if constexpr (!ALIGN_EPI) { if (wr == 0) PG8_BAR; }
    PG8_BAR;
    if constexpr (Epi::AFTER_DRAIN) { E.fused(acc, cur, wr, wc, fr, fq, lds, wid, lane); S.done(cur); }
#undef PG8_SA
#undef PG8_SB
#undef PG8_STAGE
#undef PG8_LDA
#undef PG8_LDB
#undef PG8_MMA
#undef PG8_WAIT_V
#undef PG8_WAIT_L
#undef PG8_BAR
#undef PG8_SCHED
}
}
#define LAS __attribute__((address_space(3)))
#define XB_TMO      128
#define XB_XCNT(j)  (256  + 64 * (j))
#define XB_XSUB(j)  (1280 + 64 * (j))
#define XB_XGEN(j)  (2304 + 64 * (j))
#define XB_TOP      3328
#define XB_TOPGEN   3392
#define XCD_BAR_WORDS 3456
#define XB_SPIN_CAP (1u << 18)

__device__ __forceinline__ unsigned xb_ld(unsigned* p)              { return __hip_atomic_load(p, __ATOMIC_RELAXED, __HIP_MEMORY_SCOPE_AGENT); }
__device__ __forceinline__ unsigned xb_add(unsigned* p, unsigned v) { return __hip_atomic_fetch_add(p, v, __ATOMIC_RELAXED, __HIP_MEMORY_SCOPE_AGENT); }
__device__ __forceinline__ unsigned xb_xcc_id() { return (unsigned)__builtin_amdgcn_s_getreg((3 << 11) | 20) & 0xFu; }
#define XB_SPIN(cond, bar) do { unsigned _sp = 0; while (cond) { __builtin_amdgcn_s_sleep(1); \
    if ((++_sp & 255u) == 0u) { if (xb_ld(&(bar)[XB_TMO])) break; if (_sp > XB_SPIN_CAP) { atomicAdd(&(bar)[XB_TMO], 1u); break; } } } } while (0)

struct XcdBarrier {
    unsigned* bar; unsigned x;
    volatile LAS unsigned* st;
};

__device__ __forceinline__ XcdBarrier xcd_barrier_post(unsigned* bar, volatile LAS unsigned* st) {
    XcdBarrier b; b.bar = bar; b.x = xb_xcc_id(); b.st = st;
    if (threadIdx.x == 0) (void)xb_add(&bar[XB_XCNT(b.x)], 1u);
    return b;
}
__device__ __forceinline__ void xcd_barrier_complete(unsigned* bar, unsigned x, unsigned& nloc, unsigned& nx) {
    const unsigned G = gridDim.x * gridDim.y * gridDim.z;
    unsigned sum, cnt, mine, sp = 0u;
    for (;;) {
        sum = 0u; cnt = 0u; mine = 0u;
#pragma unroll
        for (unsigned j = 0; j < 16; ++j) { const unsigned c = xb_ld(&bar[XB_XCNT(j)]); sum += c; cnt += (c > 0u) ? 1u : 0u; mine = (j == x) ? c : mine; }
        if (sum == G) break;
        __builtin_amdgcn_s_sleep(1);
        if ((++sp & 255u) == 0u) { if (xb_ld(&bar[XB_TMO])) break; if (sp > XB_SPIN_CAP) { atomicAdd(&bar[XB_TMO], 1u); break; } }
    }
    nloc = mine > 0u ? mine : 1u; nx = cnt > 0u ? cnt : 1u;
}

__device__ __forceinline__ void xcd_barrier(const XcdBarrier& b) {
    asm volatile("s_waitcnt vmcnt(0)" ::: "memory");
    __syncthreads();
    if (threadIdx.x == 0) {
        unsigned* bar = b.bar;
        __builtin_amdgcn_s_waitcnt(0);
        unsigned nloc = b.st[0], nx = b.st[1];
        if (nloc == 0u) { xcd_barrier_complete(bar, b.x, nloc, nx); b.st[0] = nloc; b.st[1] = nx; }
        const unsigned old = xb_add(&bar[XB_XSUB(b.x)], 1u);
        const unsigned gen = old / nloc;
        if (old + 1u == (gen + 1u) * nloc) {
            __builtin_amdgcn_fence(__ATOMIC_RELEASE, "agent");
            asm volatile("s_waitcnt vmcnt(0)" ::: "memory");
            const unsigned og = xb_add(&bar[XB_TOP], 1u);
            const unsigned tg = og / nx;
            if (og + 1u == (tg + 1u) * nx) xb_add(&bar[XB_TOPGEN], 1u);
            else XB_SPIN(xb_ld(&bar[XB_TOPGEN]) == tg, bar);
            __builtin_amdgcn_fence(__ATOMIC_ACQUIRE, "agent");
            xb_add(&bar[XB_XGEN(b.x)], 1u);
            asm volatile("s_waitcnt vmcnt(0)" ::: "memory");
        } else {
            XB_SPIN(xb_ld(&bar[XB_XGEN(b.x)]) == gen, bar);
            __builtin_amdgcn_fence(__ATOMIC_ACQUIRE, "agent");
            asm volatile("s_waitcnt vmcnt(0)" ::: "memory");
        }
    }
    __syncthreads();
}

namespace mk {
typedef unsigned short bf16;
typedef float f32x4 __attribute__((ext_vector_type(4)));
typedef float f32x2 __attribute__((ext_vector_type(2)));
typedef unsigned u32x4 __attribute__((ext_vector_type(4)));
typedef unsigned u32x2 __attribute__((ext_vector_type(2)));
typedef short bf16x8 __attribute__((ext_vector_type(8)));
constexpr int D = 2048, NB = 4, S = 2048, MP = NB * S, DB = 8, T = 4, MS = DB * T, MT = MP + MS, PAST = 16384;
constexpr float EPS = 1e-6f;
constexpr int A_IN = 20480, B_IN = 12288, C_IN = 6160, C_INM = 6144;
constexpr int NWG_THREADS = 512;
constexpr size_t MiB = 1u << 20;
constexpr size_t WS_CTL = 0, CTL_ZERO_BYTES = 1 * MiB;
constexpr size_t CTL_BAR = 16384;
constexpr size_t CTL_SUMSQ = 65536;
constexpr size_t WS_TABA = 1 * MiB;
constexpr size_t WS_TABB = WS_TABA + 512 * 1024;
constexpr size_t WS_WIA0 = 4 * MiB;
constexpr size_t WS_WIA1 = WS_WIA0 + (size_t)A_IN * D * 2;
constexpr size_t WS_WIB = WS_WIA1 + (size_t)A_IN * D * 2;
constexpr size_t WS_WIC = WS_WIB + (size_t)B_IN * D * 2;
constexpr size_t WS_WLR = WS_WIC + (size_t)C_INM * D * 2;
constexpr size_t WS_WOA0 = WS_WLR + (size_t)32 * D * 2;
constexpr size_t WS_WOA1 = WS_WOA0 + (size_t)D * 2048 * 2;
constexpr size_t WS_WOB = WS_WOA1 + (size_t)D * 2048 * 2;
constexpr size_t WS_WOC = WS_WOB + (size_t)D * 4096 * 2;
constexpr size_t WS_XRES = WS_WOC + (size_t)D * 2048 * 2;
constexpr size_t WS_XB = WS_XRES + (size_t)MT * D * 4;
constexpr size_t WS_Z = WS_XB + (size_t)MT * D * 2;
constexpr size_t WS_ZSRAW = WS_Z + (size_t)MT * A_IN * 2;
constexpr size_t WS_Y = WS_ZSRAW + (size_t)32 * A_IN * 4;
constexpr size_t WS_O = WS_Y + (size_t)MT * 4096 * 2;
constexpr size_t WS_LOGA = WS_O + (size_t)MT * 4096 * 4;
constexpr size_t WS_LR = WS_LOGA + (size_t)MT * 1024 * 4;
constexpr size_t WS_END = WS_LR + (size_t)32 * MT * 4;
constexpr int LDS_BYTES = 147456, MISC_OFF = 131072 + 320;

struct Params {
    const float* in[19]; float* out; unsigned char* ws;
    double inv_a[16]; double inv_b[128];
    int ph_lo, ph_hi;
};

__device__ __forceinline__ float bf2f(bf16 v) { return __uint_as_float(((unsigned)v) << 16); }
__device__ __forceinline__ unsigned f2bf(float f) { unsigned u = __float_as_uint(f); return (u + 0x7fffu + ((u >> 16) & 1u)) >> 16; }
__device__ __forceinline__ unsigned pk2(float lo, float hi) { return f2bf(lo) | (f2bf(hi) << 16); }
__device__ __forceinline__ float wave_sum(float v) {
#pragma unroll
    for (int o = 32; o >= 1; o >>= 1) v += __shfl_xor(v, o);
    return v;
}
__device__ __forceinline__ float wave_max(float v) {
#pragma unroll
    for (int o = 32; o >= 1; o >>= 1) v = fmaxf(v, __shfl_xor(v, o));
    return v;
}
__device__ __forceinline__ float silu(float x) { return x / (1.f + __expf(-x)); }
__device__ __forceinline__ void sincos_d(double a, float& s, float& c) {
    const double k = rint(a * 0.63661977236758134308);
    double r = fma(-k, 1.57079632679489655800e+00, a); r = fma(-k, 6.12323399573676603587e-17, r);
    const double r2 = r * r;
    const double sp = r * (1.0 + r2 * (-1.0 / 6 + r2 * (1.0 / 120 + r2 * (-1.0 / 5040 + r2 * (1.0 / 362880 + r2 * (-1.0 / 39916800 + r2 * (1.0 / 6227020800.0)))))));
    const double cp = 1.0 + r2 * (-0.5 + r2 * (1.0 / 24 + r2 * (-1.0 / 720 + r2 * (1.0 / 40320 + r2 * (-1.0 / 3628800 + r2 * (1.0 / 479001600.0 + r2 * (-1.0 / 87178291200.0)))))));
    const int q = (int)((long long)k & 3);
    const double ss = (q == 0) ? sp : (q == 1) ? cp : (q == 2) ? -sp : -cp;
    const double cc = (q == 0) ? cp : (q == 1) ? -sp : (q == 2) ? -cp : sp;
    s = (float)ss; c = (float)cc;
}
__device__ __forceinline__ void row_info(int row, int& b, int& t, int& pi, bool& samp) {
    if (row < MP) { b = row >> 11; t = row & 2047; pi = t; samp = false; } else { const int r = row - MP; b = r >> 2; t = r & 3; pi = 2048 + t; samp = true; }
}

struct Ctx {
    LAS unsigned char* lds; int tid, lane, wave, G, wg;
    const float *x_prompt, *x_sample, *cache1, *cache2, *cache3, *state_b, *state_c, *norm_g, *final_g, *w_in_a, *w_out_a, *w_in_b, *gn_b, *w_out_b, *w_in_c, *w_gate2_c, *b_gate_c, *gn_c, *w_out_c; float* out; unsigned char* ws;
    __device__ __forceinline__ float* sumsq(int l) const { return (float*)(ws + CTL_SUMSQ) + (size_t)l * MT; }
    template <class Tp> __device__ __forceinline__ Tp* wsp(size_t off) const { return (Tp*)(ws + off); }
};

__device__ __forceinline__ void p0_transpose_item(const float* W, int K, int ld, int ncols, const float* gain, bf16* WT, LAS float* scr, int item, int lane) {
    const int nblk = ncols / 32, kb = item / nblk, nb = item % nblk, k0 = 64 * kb, n0 = 32 * nb;
#pragma unroll 8
    for (int i = 0; i < 32; ++i) { const int kk = 2 * i + (lane >> 5); const float gk = gain ? gain[k0 + kk] : 1.0f; scr[kk * 33 + (lane & 31)] = W[(size_t)(k0 + kk) * ld + n0 + (lane & 31)] * gk; }
    asm volatile("s_waitcnt lgkmcnt(0)" ::: "memory");
    const int c = lane & 7;
#pragma unroll
    for (int j = 0; j < 4; ++j) { const int n = (lane >> 3) + 8 * j; const LAS float* s = scr + (8 * c) * 33 + n;
        u32x4 o; o.x = pk2(s[0 * 33], s[1 * 33]); o.y = pk2(s[2 * 33], s[3 * 33]); o.z = pk2(s[4 * 33], s[5 * 33]); o.w = pk2(s[6 * 33], s[7 * 33]);
        *(u32x4*)(WT + (size_t)(n0 + n) * K + k0 + 8 * c) = o; }
    asm volatile("s_waitcnt lgkmcnt(0)" ::: "memory");
}
__device__ __forceinline__ void p0_prologue(const Ctx& C, const Params& P) {
    LAS float* scr = (LAS float*)(C.lds + C.wave * 16384);
    const int gw = C.wg * 8 + C.wave, NGW = C.G * 8;
    const float* norm_g = C.norm_g;
    constexpr int I_A = (D / 64) * (A_IN / 32), I_B = (D / 64) * (B_IN / 32), I_C = (D / 64) * (C_INM / 32), I_OA = (2048 / 64) * (D / 32), I_OB = (4096 / 64) * (D / 32);
    constexpr int NITEMS = 2 * I_A + I_B + I_C + 3 * I_OA + I_OB;
    for (int it = gw; it < NITEMS; it += NGW) {
        int r = it;
        if (r < I_A) { p0_transpose_item(C.w_in_a, D, A_IN, A_IN, norm_g + 0 * D, C.wsp<bf16>(WS_WIA0), scr, r, C.lane); continue; } r -= I_A;
        if (r < I_A) { p0_transpose_item(C.w_in_a + (size_t)D * A_IN, D, A_IN, A_IN, norm_g + 3 * D, C.wsp<bf16>(WS_WIA1), scr, r, C.lane); continue; } r -= I_A;
        if (r < I_B) { p0_transpose_item(C.w_in_b, D, B_IN, B_IN, norm_g + 1 * D, C.wsp<bf16>(WS_WIB), scr, r, C.lane); continue; } r -= I_B;
        if (r < I_C) { p0_transpose_item(C.w_in_c, D, C_IN, C_INM, norm_g + 2 * D, C.wsp<bf16>(WS_WIC), scr, r, C.lane); continue; } r -= I_C;
        if (r < I_OA) { p0_transpose_item(C.w_out_a, 2048, D, D, nullptr, C.wsp<bf16>(WS_WOA0), scr, r, C.lane); continue; } r -= I_OA;
        if (r < I_OA) { p0_transpose_item(C.w_out_a + (size_t)2048 * D, 2048, D, D, nullptr, C.wsp<bf16>(WS_WOA1), scr, r, C.lane); continue; } r -= I_OA;
        if (r < I_OA) { p0_transpose_item(C.w_out_c, 2048, D, D, nullptr, C.wsp<bf16>(WS_WOC), scr, r, C.lane); continue; } r -= I_OA;
        p0_transpose_item(C.w_out_b, 4096, D, D, nullptr, C.wsp<bf16>(WS_WOB), scr, r, C.lane);
    }
    { bf16* wlr = C.wsp<bf16>(WS_WLR); const float* W = C.w_in_c; const float* g2 = norm_g + 2 * D;
      for (int e = C.wg * NWG_THREADS + C.tid; e < 32 * D; e += C.G * NWG_THREADS) { const int r = e / D, k = e % D; wlr[e] = r < 16 ? (bf16)f2bf(W[(size_t)k * C_IN + C_INM + r] * g2[k]) : (bf16)0; } }
    { float* xres = C.wsp<float>(WS_XRES); bf16* xb = C.wsp<bf16>(WS_XB); float* ss0 = C.sumsq(0);
      for (int row = gw; row < MT; row += NGW) {
          const float* src = row < MP ? C.x_prompt + (size_t)row * D : C.x_sample + (size_t)(row - MP) * D;
          float s = 0.f;
#pragma unroll
          for (int j = 0; j < 8; ++j) { const f32x4 v = *(const f32x4*)(src + 4 * C.lane + 256 * j); *(f32x4*)(xres + (size_t)row * D + 4 * C.lane + 256 * j) = v;
              u32x2 w; w.x = pk2(v[0], v[1]); w.y = pk2(v[2], v[3]); *(u32x2*)(xb + (size_t)row * D + 4 * C.lane + 256 * j) = w; s += (v[0] * v[0] + v[1] * v[1]) + (v[2] * v[2] + v[3] * v[3]); }
          s = wave_sum(s); if (C.lane == 0) ss0[row] = s; } }
    { f32x2* ta = C.wsp<f32x2>(WS_TABA); f32x2* tb = C.wsp<f32x2>(WS_TABB);
      for (int e = C.wg * NWG_THREADS + C.tid; e < 2052 * 16; e += C.G * NWG_THREADS) { const int pi = e >> 4, i = e & 15; const int pos = pi < 2048 ? pi : PAST + (pi - 2048); float s, c; sincos_d((double)pos * P.inv_a[i], s, c); ta[e] = (f32x2){c, s}; }
      for (int e = C.wg * NWG_THREADS + C.tid; e < 2052 * 128; e += C.G * NWG_THREADS) { const int pi = e >> 7, i = e & 127; const int pos = pi < 2048 ? pi : PAST + (pi - 2048); float s, c; sincos_d((double)pos * P.inv_b[i], s, c); tb[e] = (f32x2){c, s}; } }
}

template <int K, class EP>
__device__ __forceinline__ void skinny_gemm(const Ctx& C, const bf16* A, const bf16* Bt, int N, const EP& ep) {
    constexpr int KW = K / 8, NPASS = KW / 256, MAXCH = 5;
    const int fr = C.lane & 15, fq = C.lane >> 4, nch = N / 16;
    LAS float* part = (LAS float*)C.lds;
    for (int cb = C.wg; cb < nch; cb += C.G * MAXCH) {
        int ncur = 0;
#pragma unroll 1
        for (int j = 0; j < MAXCH; ++j) {
            const int ch = cb + j * C.G; if (ch >= nch) break;
            ++ncur;
            pg8::f32x4 acc0 = {0.f, 0.f, 0.f, 0.f}, acc1 = {0.f, 0.f, 0.f, 0.f};
#pragma unroll 1
            for (int ps = 0; ps < NPASS; ++ps) {
                const int kbase = C.wave * KW + ps * 256 + 8 * fq;
                const bf16* ap0 = A + (size_t)fr * K + kbase; const bf16* ap1 = A + (size_t)(16 + fr) * K + kbase; const bf16* bp = Bt + (size_t)(ch * 16 + fr) * K + kbase;
                bf16x8 a0[8], a1[8], bb[8];
#pragma unroll
                for (int s = 0; s < 8; ++s) { bb[s] = *(const bf16x8*)(bp + 32 * s); a0[s] = *(const bf16x8*)(ap0 + 32 * s); a1[s] = *(const bf16x8*)(ap1 + 32 * s); }
#pragma unroll
                for (int s = 0; s < 8; ++s) { acc0 = __builtin_amdgcn_mfma_f32_16x16x32_bf16(bb[s], a0[s], acc0, 0, 0, 0); acc1 = __builtin_amdgcn_mfma_f32_16x16x32_bf16(bb[s], a1[s], acc1, 0, 0, 0); }
            }
            LAS float* pj = part + ((size_t)(j * 8 + C.wave) * 2) * 4 * 64 + C.lane;
#pragma unroll
            for (int r = 0; r < 4; ++r) { pj[(0 * 4 + r) * 64] = acc0[r]; pj[(1 * 4 + r) * 64] = acc1[r]; }
        }
        __syncthreads();
        {
            const int l2 = C.tid & 63, mt = (C.tid >> 6) & 1, reg = C.tid >> 7;
            for (int j = 0; j < ncur; ++j) {
                float s = 0.f;
#pragma unroll
                for (int w = 0; w < 8; ++w) s += part[(((size_t)(j * 8 + w) * 2 + mt) * 4 + reg) * 64 + l2];
                const int ch = cb + j * C.G;
                ep(16 * mt + (l2 & 15), ch * 16 + 4 * (l2 >> 4) + reg, s);
            }
        }
        __syncthreads();
    }
}

__device__ __forceinline__ float rstd_of(const float* ss, int row) { return rsqrtf(ss[row] * (1.0f / 2048.0f) + EPS); }
__device__ __forceinline__ void sfix_a(const Ctx& C, int layer, int slot) {
    const float* zs = C.wsp<float>(WS_ZSRAW); bf16* z = C.wsp<bf16>(WS_Z); const float* ss = C.sumsq(layer); const f32x2* ta = C.wsp<f32x2>(WS_TABA);
    float* skv = C.out + (size_t)MP * D + (size_t)MS * D + (size_t)2 * 4 * (128 + 512 + 2048) * 4096 + (size_t)4 * 8 * 256 * 512 + (size_t)4 * 4 * 256 * 512;
    for (int e = C.wg * NWG_THREADS + C.tid; e < MS * A_IN; e += C.G * NWG_THREADS) {
        const int r = e / A_IN, c = e % A_IN, row = MP + r, b = r >> 2, t = r & 3; const float rs = rstd_of(ss, row);
        const int section = c >> 11, within = c & 2047, d = within & 127, kind = section < 9 ? section % 3 : 3, g = section / 3;
        float v = zs[e] * rs;
        if (kind < 2 && d < 32) { const int i = d & 15; const float pv = zs[d < 16 ? e + 16 : e - 16] * rs; const f32x2 cs = ta[(2048 + t) * 16 + i]; v = d < 16 ? v * cs.x - pv * cs.y : pv * cs.y + v * cs.x; }
        z[(size_t)row * A_IN + c] = (bf16)f2bf(v);
        if (kind == 1 || kind == 2) skv[(size_t)g * (2 * 8 * 4 * 4096) + ((((size_t)slot * DB + b) * T + t) * 2 + (kind - 1)) * 2048 + within] = v;
    }
}
__device__ __forceinline__ void sfix_b(const Ctx& C, int layer) {
    const float* zs = C.wsp<float>(WS_ZSRAW); bf16* z = C.wsp<bf16>(WS_Z); const float* ss = C.sumsq(layer); const f32x2* tb = C.wsp<f32x2>(WS_TABB);
    for (int e = C.wg * NWG_THREADS + C.tid; e < MS * B_IN; e += C.G * NWG_THREADS) {
        const int r = e / B_IN, c = e % B_IN, row = MP + r, t = r & 3; const float rs = rstd_of(ss, row);
        float v = zs[e] * rs;
        if (c < 4096) { const int d = c & 255, i = d & 127; const float pv = zs[d < 128 ? e + 128 : e - 128] * rs; const f32x2 cs = tb[(2048 + t) * 128 + i]; v = d < 128 ? v * cs.x - pv * cs.y : pv * cs.y + v * cs.x; if (c >= 2048) v *= 0.0625f; }
        z[(size_t)row * B_IN + c] = (bf16)f2bf(v);
    }
}
__device__ __forceinline__ void sfix_c(const Ctx& C, int layer) {
    const float* zs = C.wsp<float>(WS_ZSRAW); bf16* z = C.wsp<bf16>(WS_Z); const float* ss = C.sumsq(layer);
    for (int e = C.wg * NWG_THREADS + C.tid; e < MS * C_INM; e += C.G * NWG_THREADS) {
        const int r = e / C_INM, c = e % C_INM, row = MP + r; const float rs = rstd_of(ss, row);
        float v = zs[e] * rs; if (c < 1024) v *= 0.0625f;
        z[(size_t)row * C_INM + c] = (bf16)f2bf(v);
    }
    const float* lr = C.wsp<float>(WS_LR); float* loga = C.wsp<float>(WS_LOGA); const float* wg2 = C.w_gate2_c; const float* bg = C.b_gate_c;
    for (int e = C.wg * NWG_THREADS + C.tid; e < MT * 1024; e += C.G * NWG_THREADS) {
        const int row = e >> 10, c = e & 1023; const float rs = rstd_of(ss, row);
        float a = 0.f;
#pragma unroll
        for (int r = 0; r < 16; ++r) a += lr[(size_t)r * MT + row] * wg2[r * 1024 + c];
        a = a * rs + bg[c];
        loga[e] = (fminf(a, 0.f) - log1pf(__expf(-fabsf(a)))) * 0.0625f;
    }
}

__device__ __forceinline__ float dot128_bb(const bf16* q, const bf16* k) {
    float a = 0.f;
#pragma unroll 4
    for (int i = 0; i < 16; ++i) { const u32x4 x = ((const u32x4*)q)[i], y = ((const u32x4*)k)[i];
#pragma unroll
        for (int j = 0; j < 4; ++j) a += __uint_as_float(x[j] << 16) * __uint_as_float(y[j] << 16) + __uint_as_float(x[j] & 0xffff0000u) * __uint_as_float(y[j] & 0xffff0000u); }
    return a;
}
__device__ __forceinline__ float dot128_bf(const bf16* q, const float* k) {
    float a = 0.f;
#pragma unroll 4
    for (int i = 0; i < 16; ++i) { const u32x4 x = ((const u32x4*)q)[i]; const f32x4 y0 = ((const f32x4*)k)[2 * i], y1 = ((const f32x4*)k)[2 * i + 1];
        a += __uint_as_float(x[0] << 16) * y0[0] + __uint_as_float(x[0] & 0xffff0000u) * y0[1] + __uint_as_float(x[1] << 16) * y0[2] + __uint_as_float(x[1] & 0xffff0000u) * y0[3]
           + __uint_as_float(x[2] << 16) * y1[0] + __uint_as_float(x[2] & 0xffff0000u) * y1[1] + __uint_as_float(x[3] << 16) * y1[2] + __uint_as_float(x[3] & 0xffff0000u) * y1[3]; }
    return a;
}
__device__ __forceinline__ void attn_naive(const Ctx& C, int slot) {
    const bf16* z = C.wsp<bf16>(WS_Z); bf16* y = C.wsp<bf16>(WS_Y); const int lane = C.lane;
    for (int item = C.wg * 8 + C.wave; item < MT * 16; item += C.G * 8) {
        const int row = item >> 4, h = item & 15; int b, t, pi; bool samp; row_info(row, b, t, pi, samp);
        const bf16* zr = z + (size_t)row * A_IN;
        float mrun = -INFINITY, wsum = 0.f, acc0 = 0.f, acc1 = 0.f;
#pragma unroll
        for (int g = 0; g < 3; ++g) {
            const int win = g == 0 ? 128 : (g == 1 ? 512 : 2048), dil = g == 0 ? 1 : (g == 1 ? 4 : 16);
            const float* cache = C.cache1; if (g == 1) cache = C.cache2; if (g == 2) cache = C.cache3;
            const int qcol = (g * 3) * 2048 + h * 128, kcol = qcol + 2048, vcol = qcol + 4096;
            float sc[3];
#pragma unroll
            for (int u = 0; u < 3; ++u) {
                const int j = lane + 64 * u; float s = -INFINITY;
                if (j <= 128) {
                    if (!samp) { const int tok = t - dil * j; if (tok >= 0) s = dot128_bb(zr + qcol, z + (size_t)(b * S + tok) * A_IN + kcol); }
                    else { const int idx = win + t - dil * j;
                        if (idx >= win) s = dot128_bb(zr + qcol, z + (size_t)(MP + b * T + (idx - win)) * A_IN + kcol);
                        else s = dot128_bf(zr + qcol, cache + ((((size_t)slot * DB + b) * win + idx) * 2) * 2048 + h * 128); }
                    s *= 0.08838834764831845f;
                }
                sc[u] = s;
            }
            const float m = wave_max(fmaxf(sc[0], fmaxf(sc[1], sc[2])));
            float p[3]; float ps = 0.f;
#pragma unroll
            for (int u = 0; u < 3; ++u) { p[u] = __expf(sc[u] - m); ps += p[u]; }
            const float den = wave_sum(ps);
            const float lse = m + __logf(den);
            float o0 = 0.f, o1 = 0.f;
#pragma unroll
            for (int u = 0; u < 3; ++u) {
                const int cnt = u < 2 ? 64 : 1;
                for (int jj = 0; jj < cnt; ++jj) {
                    const int j = jj + 64 * u;
                    const float pj = __shfl(p[u], jj);
                    if (pj == 0.f) continue;
                    if (!samp) { const int tok = t - dil * j; const unsigned w = ((const unsigned*)(z + (size_t)(b * S + tok) * A_IN + vcol))[lane]; o0 += pj * __uint_as_float(w << 16); o1 += pj * __uint_as_float(w & 0xffff0000u); }
                    else { const int idx = win + t - dil * j;
                        if (idx >= win) { const unsigned w = ((const unsigned*)(z + (size_t)(MP + b * T + (idx - win)) * A_IN + vcol))[lane]; o0 += pj * __uint_as_float(w << 16); o1 += pj * __uint_as_float(w & 0xffff0000u); }
                        else { const f32x2 w = ((const f32x2*)(cache + ((((size_t)slot * DB + b) * win + idx) * 2 + 1) * 2048 + h * 128))[lane]; o0 += pj * w.x; o1 += pj * w.y; } }
                }
            }
            o0 /= den; o1 /= den;
            const float mnew = fmaxf(mrun, lse); const float sc_old = __expf(mrun - mnew), sc_new = __expf(lse - mnew);
            acc0 = acc0 * sc_old + sc_new * o0; acc1 = acc1 * sc_old + sc_new * o1; wsum = wsum * sc_old + sc_new; mrun = mnew;
        }
        const unsigned gw = ((const unsigned*)(zr + 18432 + h * 128))[lane];
        ((unsigned*)(y + (size_t)row * 2048 + h * 128))[lane] = pk2(acc0 / wsum * silu(__uint_as_float(gw << 16)), acc1 / wsum * silu(__uint_as_float(gw & 0xffff0000u)));
    }
}
template <bool GLA>
__device__ __forceinline__ void recur_naive(const Ctx& C, int ldz, int qoff, int koff, int voff, int H, int nseq, int ntok, int row0, const float* state0, float* state_out) {
    const bf16* z = C.wsp<bf16>(WS_Z); float* o = C.wsp<float>(WS_O); const float* loga = C.wsp<float>(WS_LOGA);
    LAS float* red = (LAS float*)C.lds;
    const int d = C.tid & 255, vh = C.tid >> 8, lane = C.lane, wave = C.wave;
    for (int item = C.wg; item < nseq * H * 8; item += C.G) {
        const int vs = item & 7, h = (item >> 3) % H, seq = (item >> 3) / H;
        const int v0 = vs * 64 + vh * 32;
        float Sreg[32];
        const size_t sbase = (((size_t)seq * H + h) * 256 + d) * 512 + v0;
#pragma unroll
        for (int i = 0; i < 32; ++i) Sreg[i] = state0 ? state0[sbase + i] : 0.f;
        float gamma = 1.f; if (!GLA) gamma = 1.0f - exp2f(-5.0f - (float)h);
        for (int t = 0; t < ntok; ++t) {
            const int row = row0 + seq * ntok + t; const bf16* zr = z + (size_t)row * ldz;
            const float qd = bf2f(zr[qoff + h * 256 + d]), kd = bf2f(zr[koff + h * 256 + d]);
            float dec = gamma; if (GLA) dec = __expf(loga[(size_t)row * 1024 + h * 256 + d]);
            const unsigned* vp = (const unsigned*)(zr + voff + h * 512 + v0);
            float p[32];
#pragma unroll
            for (int i = 0; i < 16; ++i) { const unsigned w = vp[i]; const float va = __uint_as_float(w << 16), vb = __uint_as_float(w & 0xffff0000u);
                Sreg[2 * i] = dec * Sreg[2 * i] + kd * va; Sreg[2 * i + 1] = dec * Sreg[2 * i + 1] + kd * vb; p[2 * i] = qd * Sreg[2 * i]; p[2 * i + 1] = qd * Sreg[2 * i + 1]; }
#pragma unroll
            for (int i = 0; i < 32; ++i) p[i] = wave_sum(p[i]);
            float mine = 0.f;
#pragma unroll
            for (int i = 0; i < 32; ++i) if (lane == i) mine = p[i];
            if (lane < 32) red[((t & 1) * 8 + wave) * 32 + lane] = mine;
            __syncthreads();
            if (d < 32) { const LAS float* rr = red + ((t & 1) * 8 + vh * 4) * 32 + d; o[(size_t)row * (H * 512) + h * 512 + v0 + d] = rr[0] + rr[32] + rr[64] + rr[96]; }
        }
#pragma unroll
        for (int i = 0; i < 32; ++i) state_out[sbase + i] = Sreg[i];
        __syncthreads();
    }
}
template <bool MEAN>
__device__ __forceinline__ void norm_gate(const Ctx& C, int H, int ldz, int goff, const float* gn) {
    const bf16* z = C.wsp<bf16>(WS_Z); const float* o = C.wsp<float>(WS_O); bf16* y = C.wsp<bf16>(WS_Y); const int lane = C.lane;
    for (int w = C.wg * 8 + C.wave; w < MT * H; w += C.G * 8) {
        const int row = w / H, h = w % H;
        const float* orow = o + (size_t)row * (H * 512) + h * 512; const bf16* gate = z + (size_t)row * ldz + goff + h * 512;
        const f32x4 a = ((const f32x4*)orow)[2 * lane], bq = ((const f32x4*)orow)[2 * lane + 1];
        float v[8] = {a[0], a[1], a[2], a[3], bq[0], bq[1], bq[2], bq[3]};
        float s = 0.f;
#pragma unroll
        for (int i = 0; i < 8; ++i) s += v[i];
        float mu = 0.f; if (MEAN) mu = wave_sum(s) * (1.f / 512.f);
        float q = 0.f;
#pragma unroll
        for (int i = 0; i < 8; ++i) { v[i] -= mu; q += v[i] * v[i]; }
        const float r = rsqrtf(wave_sum(q) * (1.f / 512.f) + EPS);
        const u32x4 gw = ((const u32x4*)gate)[lane]; const f32x4 g0 = ((const f32x4*)(gn + h * 512))[2 * lane], g1 = ((const f32x4*)(gn + h * 512))[2 * lane + 1];
        const float gg[8] = {g0[0], g0[1], g0[2], g0[3], g1[0], g1[1], g1[2], g1[3]};
        float ov[8];
#pragma unroll
        for (int i = 0; i < 4; ++i) { ov[2 * i] = v[2 * i] * r * gg[2 * i] * silu(__uint_as_float(gw[i] << 16)); ov[2 * i + 1] = v[2 * i + 1] * r * gg[2 * i + 1] * silu(__uint_as_float(gw[i] & 0xffff0000u)); }
        u32x4 ow; ow.x = pk2(ov[0], ov[1]); ow.y = pk2(ov[2], ov[3]); ow.z = pk2(ov[4], ov[5]); ow.w = pk2(ov[6], ov[7]);
        ((u32x4*)(y + (size_t)row * (H * 512) + h * 512))[lane] = ow;
    }
}
__device__ __forceinline__ void final_norm(const Ctx& C) {
    const float* xres = C.wsp<float>(WS_XRES); const float* ss = C.sumsq(4); const float* fg = C.final_g;
    for (int row = C.wg * 8 + C.wave; row < MT; row += C.G * 8) {
        const float rs = rstd_of(ss, row);
#pragma unroll
        for (int j = 0; j < 8; ++j) { const int c = 4 * C.lane + 256 * j; const f32x4 v = *(const f32x4*)(xres + (size_t)row * D + c), g = *(const f32x4*)(fg + c); *(f32x4*)(C.out + (size_t)row * D + c) = v * rs * g; }
    }
}

template <int MODE>
__device__ __forceinline__ void gemm_in(const Ctx& C, size_t wt_off, int N, int layer, float* kvb, int slot) {
    pg8::Gemm g{C.wsp<pg8::bf16_t>(WS_XB), C.wsp<pg8::bf16_t>(wt_off), MP, N, D}; pg8::StaticOrder So; So.init(MP, N, C.G, C.wg);
    pg8::EpiIn<MODE> E{C.wsp<pg8::bf16_t>(WS_Z), N, C.sumsq(layer), (const pg8::f32x2*)C.wsp<f32x2>(MODE == 0 ? WS_TABA : WS_TABB), kvb, slot};
    pg8::gemm_phase<pg8::EpiIn<MODE>, pg8::StaticOrder, true, true>((PG8_LAS unsigned char*)C.lds, g, So, E);
}
template <int K>
__device__ __forceinline__ void gemm_out(const Ctx& C, size_t wt_off, int layer) {
    pg8::Gemm g{C.wsp<pg8::bf16_t>(WS_Y), C.wsp<pg8::bf16_t>(wt_off), MP, D, K}; pg8::StaticOrder So; So.init(MP, D, C.G, C.wg);
    pg8::EpiOut E{C.wsp<float>(WS_XRES), C.wsp<pg8::bf16_t>(WS_XB), C.sumsq(layer + 1)};
    pg8::gemm_phase<pg8::EpiOut, pg8::StaticOrder, true, true>((PG8_LAS unsigned char*)C.lds, g, So, E);
    float* xres = C.wsp<float>(WS_XRES); bf16* xb = C.wsp<bf16>(WS_XB); float* ssn = C.sumsq(layer + 1); const int lane = C.lane;
    skinny_gemm<K>(C, C.wsp<bf16>(WS_Y) + (size_t)MP * K, C.wsp<bf16>(wt_off), D, [=](int m, int n, float v) {
        const size_t o = (size_t)(MP + m) * D + n; const float x = xres[o] + v; xres[o] = x; xb[o] = (bf16)f2bf(x);
        float s = x * x; s += __shfl_xor(s, 16); s += __shfl_xor(s, 32); if ((lane >> 4) == 0) atomicAdd(ssn + MP + m, s); });
}
__device__ __forceinline__ void skinny_in(const Ctx& C, size_t wt_off, int N) {
    float* zs = C.wsp<float>(WS_ZSRAW);
    skinny_gemm<D>(C, C.wsp<bf16>(WS_XB) + (size_t)MP * D, C.wsp<bf16>(wt_off), N, [=](int m, int n, float v) { zs[(size_t)m * N + n] = v; });
}

__global__ void __launch_bounds__(NWG_THREADS, 2) mk_fwd(Params P) {
    extern __shared__ __attribute__((aligned(16))) unsigned char lds_raw[];
    Ctx C; C.lds = (LAS unsigned char*)lds_raw; C.tid = threadIdx.x; C.lane = C.tid & 63; C.wave = __builtin_amdgcn_readfirstlane(C.tid >> 6); C.G = gridDim.x; C.wg = blockIdx.x;
    C.x_prompt = P.in[0];
    C.x_sample = P.in[1];
    C.cache1 = P.in[2];
    C.cache2 = P.in[3];
    C.cache3 = P.in[4];
    C.state_b = P.in[5];
    C.state_c = P.in[6];
    C.norm_g = P.in[7];
    C.final_g = P.in[8];
    C.w_in_a = P.in[9];
    C.w_out_a = P.in[10];
    C.w_in_b = P.in[11];
    C.gn_b = P.in[12];
    C.w_out_b = P.in[13];
    C.w_in_c = P.in[14];
    C.w_gate2_c = P.in[15];
    C.b_gate_c = P.in[16];
    C.gn_c = P.in[17];
    C.w_out_c = P.in[18];
    C.out = P.out; C.ws = P.ws;
    volatile LAS unsigned* MISC = (volatile LAS unsigned*)(C.lds + MISC_OFF);
    if (C.tid < 32) MISC[C.tid] = 0u;
    __syncthreads();
    XcdBarrier bar = xcd_barrier_post((unsigned*)(P.ws + CTL_BAR), MISC + 8);
    int ph = 0;
#define RUN (ph >= P.ph_lo && ph < P.ph_hi)
#define SEAM() do { if (ph >= P.ph_lo && ph + 1 < P.ph_hi) xcd_barrier(bar); ++ph; } while (0)
    float* out = P.out;
    float* pkv1 = out + (size_t)MP * D + (size_t)MS * D; float* pkv2 = pkv1 + (size_t)2 * 4 * 128 * 4096; float* pkv3 = pkv2 + (size_t)2 * 4 * 512 * 4096;
    float* pst_b = pkv3 + (size_t)2 * 4 * 2048 * 4096; float* pst_c = pst_b + (size_t)4 * 8 * 256 * 512;
    float* sst_b = pst_c + (size_t)4 * 4 * 256 * 512 + (size_t)3 * 2 * 8 * 4 * 4096; float* sst_c = sst_b + (size_t)8 * 8 * 256 * 512;

    if (RUN) p0_prologue(C, P);
    SEAM();
    if (RUN) { gemm_in<0>(C, WS_WIA0, A_IN, 0, pkv1, 0); skinny_in(C, WS_WIA0, A_IN); }
    SEAM();
    if (RUN) sfix_a(C, 0, 0);
    SEAM();
    if (RUN) attn_naive(C, 0);
    SEAM();
    if (RUN) gemm_out<2048>(C, WS_WOA0, 0);
    SEAM();
    if (RUN) { gemm_in<1>(C, WS_WIB, B_IN, 1, nullptr, 0); skinny_in(C, WS_WIB, B_IN); }
    SEAM();
    if (RUN) sfix_b(C, 1);
    SEAM();
    if (RUN) { recur_naive<false>(C, B_IN, 0, 2048, 4096, 8, NB, S, 0, nullptr, pst_b); recur_naive<false>(C, B_IN, 0, 2048, 4096, 8, DB, T, MP, C.state_b, sst_b); }
    SEAM();
    if (RUN) norm_gate<true>(C, 8, B_IN, 8192, C.gn_b);
    SEAM();
    if (RUN) gemm_out<4096>(C, WS_WOB, 1);
    SEAM();
    if (RUN) { gemm_in<2>(C, WS_WIC, C_INM, 2, nullptr, 0); skinny_in(C, WS_WIC, C_INM);
        float* lr = C.wsp<float>(WS_LR);
        skinny_gemm<D>(C, C.wsp<bf16>(WS_WLR), C.wsp<bf16>(WS_XB), MT, [=](int m, int n, float v) { if (m < 16) lr[(size_t)m * MT + n] = v; }); }
    SEAM();
    if (RUN) sfix_c(C, 2);
    SEAM();
    if (RUN) { recur_naive<true>(C, C_INM, 0, 1024, 2048, 4, NB, S, 0, nullptr, pst_c); recur_naive<true>(C, C_INM, 0, 1024, 2048, 4, DB, T, MP, C.state_c, sst_c); }
    SEAM();
    if (RUN) norm_gate<false>(C, 4, C_INM, 4096, C.gn_c);
    SEAM();
    if (RUN) gemm_out<2048>(C, WS_WOC, 2);
    SEAM();
    if (RUN) { gemm_in<0>(C, WS_WIA1, A_IN, 3, pkv1, 1); skinny_in(C, WS_WIA1, A_IN); }
    SEAM();
    if (RUN) sfix_a(C, 3, 1);
    SEAM();
    if (RUN) attn_naive(C, 1);
    SEAM();
    if (RUN) gemm_out<2048>(C, WS_WOA1, 3);
    SEAM();
    if (RUN) final_norm(C);
#undef RUN
#undef SEAM
}
constexpr int NPHASES = 20;
}

#ifndef MK_LAUNCHES
#define MK_LAUNCHES 1
#endif
extern "C" void kernel_launch(void* const* d_in, const int* in_sizes, int n_in, void* d_out, int out_size, void* d_ws, size_t ws_size, hipStream_t stream) {
    using namespace mk;
    static int grid = 0;
    if (grid == 0) {
        int dev = 0, cus = 0;
        if (hipGetDevice(&dev) != hipSuccess || hipDeviceGetAttribute(&cus, hipDeviceAttributeMultiprocessorCount, dev) != hipSuccess) { fprintf(stderr, "kernel_launch: device query failed\n"); grid = -1; return; }
        if (hipFuncSetAttribute((const void*)mk_fwd, hipFuncAttributeMaxDynamicSharedMemorySize, LDS_BYTES) != hipSuccess) { fprintf(stderr, "kernel_launch: hipFuncSetAttribute failed\n"); grid = -1; return; }
        int per_cu = 0;
        if (hipOccupancyMaxActiveBlocksPerMultiprocessor(&per_cu, (const void*)mk_fwd, NWG_THREADS, LDS_BYTES) != hipSuccess || per_cu < 1) fprintf(stderr, "kernel_launch: occupancy query says %d\n", per_cu);
        (void)hipGetLastError();
        if (ws_size < WS_END) { fprintf(stderr, "kernel_launch: workspace too small (%zu < %zu)\n", ws_size, (size_t)WS_END); grid = -1; return; }
        grid = cus;
    }
    if (grid < 0) return;
    (void)hipMemsetAsync((char*)d_ws + WS_CTL, 0, CTL_ZERO_BYTES, stream);
    Params p{};
    for (int i = 0; i < 19; ++i) p.in[i] = (const float*)d_in[i];
    p.out = (float*)d_out; p.ws = (unsigned char*)d_ws;
    for (int i = 0; i < 16; ++i) p.inv_a[i] = pow(500000.0, -(double)i / 16.0);
    for (int i = 0; i < 128; ++i) p.inv_b[i] = pow(10000.0, -(double)i / 128.0);
    if (MK_LAUNCHES == 1) { p.ph_lo = 0; p.ph_hi = NPHASES; hipLaunchKernelGGL(mk_fwd, dim3(grid), dim3(NWG_THREADS), LDS_BYTES, stream, p); }
    else for (int k = 0; k < NPHASES; ++k) { p.ph_lo = k; p.ph_hi = k + 1; hipLaunchKernelGGL(mk_fwd, dim3(grid), dim3(NWG_THREADS), LDS_BYTES, stream, p); }
}
```

```cpp
#include <hip/hip_runtime.h>
#include <cstdio>
#include <cstdint>
#include <cmath>
namespace pg8 {
#define PG8_LAS __attribute__((address_space(3)))
typedef unsigned short bf16_t;
typedef short bf16x8 __attribute__((ext_vector_type(8)));
typedef float f32x4 __attribute__((ext_vector_type(4)));
typedef unsigned u32x4 __attribute__((ext_vector_type(4)));
constexpr int BM = 256, BK = 64, HALF = 128, HTB = HALF * BK * 2  , STAGE_BYTES = 8 * HTB, NXCD = 8, WGM = 8;

__host__ __device__ __forceinline__ int lds_byte(int r, int c) { const int st = (r >> 4) * 2 + (c >> 5), rr = r & 15, cc = c & 31, ob = rr * 64 + cc * 2; return st * 1024 + (ob ^ (((ob >> 9) & 1) << 5)); }
__host__ __device__ __forceinline__ void stage_rc(int b, int& R, int& C) { const int st = b / 1024, sb = b % 1024, swz = sb ^ (((sb >> 9) & 1) << 5); R = (st >> 1) * 16 + swz / 64; C = (st & 1) * 32 + (swz % 64) / 2; }
__host__ __device__ __forceinline__ int perm32(int rho) { const int n = rho >> 4, i = rho & 15; return 8 * (i >> 2) + 4 * n + (i & 3); }

struct Unit { int pm, pn; };
struct Gemm { const bf16_t* A; const bf16_t* Bt; int M, N, K; };

struct StaticOrder {
    int nM, nN, nwg, G, c;
    __host__ __device__ void init(int M, int N, int G_, int c_) { nM = M / BM; nN = N / BM; nwg = nM * nN; G = G_; c = c_; }
    __host__ __device__ bool next(int i, Unit& u) const {
        const long L = (long)i * G + c; if (L >= nwg) return false;
        int wgid = (int)L; { const int q = nwg / NXCD, r = nwg % NXCD, xcd = wgid % NXCD, off = wgid / NXCD; wgid = (xcd < r ? xcd * (q + 1) : r * (q + 1) + (xcd - r) * q) + off; }
        const int nig = WGM * nN, gid = wgid / nig, fm = gid * WGM, gsz = (nM - fm) < WGM ? (nM - fm) : WGM;
        u.pm = fm + ((wgid % nig) % gsz); u.pn = (wgid % nig) / gsz; return true;
    }
    __device__ __forceinline__ void a_ready(const Unit&) const {}
    __device__ __forceinline__ void done(const Unit&) const {}
};

__device__ __forceinline__ unsigned cvt_pk_bf16(float lo, float hi) { unsigned r; asm volatile("v_cvt_pk_bf16_f32 %0, %1, %2" : "=v"(r) : "v"(lo), "v"(hi)); return r; }
typedef float f32x2 __attribute__((ext_vector_type(2)));
typedef unsigned u32x2 __attribute__((ext_vector_type(2)));

template <int MODE> struct EpiIn {
    static constexpr bool PERM = true, AFTER_DRAIN = false;
    bf16_t* Z; int ldz; const float* sumsq; const f32x2* tab; float* kvb; int slot;
    __device__ __forceinline__ void store8(bf16_t* p, const f32x4& a, const f32x4& b) const {
        u32x4 w; w.x = cvt_pk_bf16(a[0], a[1]); w.y = cvt_pk_bf16(a[2], a[3]); w.z = cvt_pk_bf16(b[0], b[1]); w.w = cvt_pk_bf16(b[2], b[3]); *(u32x4*)p = w; }
    __device__ __forceinline__ void operator()(const f32x4 (&acc)[2][2][4][2], const Unit& u, int wr, int wc, int fr, int fq) const {
        const int row0 = u.pm * BM + wr * 64 + fr, colt = u.pn * BM;
        if constexpr (MODE == 0) {
            const int section = u.pn >> 3, kind = section < 9 ? section % 3 : 3, g = section / 3;
            const bool rot = (kind < 2) && (wc == 0);
            const int gg = g > 2 ? 2 : g, keep = 128 << (2 * gg); float* kvo = kvb + (size_t)32768 * (size_t)(128 * (((1 << (2 * gg)) - 1) / 3)) + (size_t)slot * 4 * keep * 4096;
#pragma unroll
            for (int ai = 0; ai < 2; ++ai)
#pragma unroll
                for (int m = 0; m < 4; ++m) {
                    const int row = row0 + ai * HALF + m * 16; const float rs = rsqrtf(sumsq[row] * (1.0f / 2048.0f) + 1e-6f); const int pos = row & 2047, b = row >> 11;
#pragma unroll
                    for (int bj = 0; bj < 2; ++bj) {
                        f32x4 v0 = acc[ai][bj][m][0] * rs, v1 = acc[ai][bj][m][1] * rs;
                        const int col = colt + bj * HALF + wc * 32 + 8 * fq;
                        if (rot) {
                            f32x4 p0, p1;
#pragma unroll
                            for (int j = 0; j < 4; ++j) { p0[j] = __shfl_xor(v0[j], 32); p1[j] = __shfl_xor(v1[j], 32); }
                            const f32x4* tp = (const f32x4*)(tab + pos * 16 + 8 * (fq & 1));
                            const f32x4 t0 = tp[0], t1 = tp[1], t2 = tp[2], t3 = tp[3];
                            const f32x4 c0 = {t0[0], t0[2], t1[0], t1[2]}, s0 = {t0[1], t0[3], t1[1], t1[3]}, c1 = {t2[0], t2[2], t3[0], t3[2]}, s1 = {t2[1], t2[3], t3[1], t3[3]};
                            if (fq < 2) { v0 = v0 * c0 - p0 * s0; v1 = v1 * c1 - p1 * s1; } else { v0 = p0 * s0 + v0 * c0; v1 = p1 * s1 + v1 * c1; }
                        }
                        store8(Z + (size_t)row * ldz + col, v0, v1);
                        if (kind == 1 || kind == 2) {
                            if (pos >= 2048 - keep) { float* o = kvo + (((size_t)b * keep + (pos - (2048 - keep))) * 2 + (kind - 1)) * 2048 + (col - section * 2048);
                                *(f32x4*)o = v0; *(f32x4*)(o + 4) = v1; }
                        }
                    }
                }
        } else if constexpr (MODE == 1) {
            const bool rot = u.pn < 16; const float sc = (u.pn >= 8 && u.pn < 16) ? 0.0625f : 1.0f;
#pragma unroll
            for (int ai = 0; ai < 2; ++ai)
#pragma unroll
                for (int m = 0; m < 4; ++m) {
                    const int row = row0 + ai * HALF + m * 16; const float rs = rsqrtf(sumsq[row] * (1.0f / 2048.0f) + 1e-6f) * sc; const int pos = row & 2047;
                    f32x4 x1[2], x2[2];
#pragma unroll
                    for (int n = 0; n < 2; ++n) { x1[n] = acc[ai][0][m][n] * rs; x2[n] = acc[ai][1][m][n] * rs; }
                    if (rot) {
#pragma unroll
                        for (int n = 0; n < 2; ++n) {
                            const f32x4* tp = (const f32x4*)(tab + pos * 128 + wc * 32 + 8 * fq + 4 * n);
                            const f32x4 t0 = tp[0], t1 = tp[1];
                            const f32x4 c = {t0[0], t0[2], t1[0], t1[2]}, s = {t0[1], t0[3], t1[1], t1[3]};
                            const f32x4 a = x1[n], bb = x2[n];
                            x1[n] = a * c - bb * s; x2[n] = a * s + bb * c;
                        }
                    }
                    bf16_t* zp = Z + (size_t)row * ldz + colt + wc * 32 + 8 * fq;
                    store8(zp, x1[0], x1[1]); store8(zp + HALF, x2[0], x2[1]);
                }
        } else {
            const float sc = u.pn < 4 ? 0.0625f : 1.0f;
#pragma unroll
            for (int ai = 0; ai < 2; ++ai)
#pragma unroll
                for (int m = 0; m < 4; ++m) {
                    const int row = row0 + ai * HALF + m * 16; const float rs = rsqrtf(sumsq[row] * (1.0f / 2048.0f) + 1e-6f) * sc;
                    bf16_t* zp = Z + (size_t)row * ldz + colt + wc * 32 + 8 * fq;
#pragma unroll
                    for (int bj = 0; bj < 2; ++bj) store8(zp + bj * HALF, acc[ai][bj][m][0] * rs, acc[ai][bj][m][1] * rs);
                }
        }
    }
};
struct EpiOut {
    static constexpr bool PERM = false, AFTER_DRAIN = false;
    float* xres; bf16_t* xb; float* sumsq_next;
    __device__ __forceinline__ void operator()(const f32x4 (&acc)[2][2][4][2], const Unit& u, int wr, int wc, int fr, int fq) const {
        const int row0 = u.pm * BM + wr * 64 + fr, col0 = u.pn * BM + wc * 32 + 4 * fq;
#pragma unroll
        for (int ai = 0; ai < 2; ++ai)
#pragma unroll
            for (int m = 0; m < 4; ++m) {
                const int row = row0 + ai * HALF + m * 16; float ss = 0.f;
                float* xr = xres + (size_t)row * 2048 + col0; bf16_t* br = xb + (size_t)row * 2048 + col0;
#pragma unroll
                for (int bj = 0; bj < 2; ++bj)
#pragma unroll
                    for (int n = 0; n < 2; ++n) {
                        const f32x4 v = *(const f32x4*)(xr + bj * HALF + n * 16) + acc[ai][bj][m][n];
                        *(f32x4*)(xr + bj * HALF + n * 16) = v;
                        u32x2 w; w.x = cvt_pk_bf16(v[0], v[1]); w.y = cvt_pk_bf16(v[2], v[3]); *(u32x2*)(br + bj * HALF + n * 16) = w;
                        ss += (v[0] * v[0] + v[1] * v[1]) + (v[2] * v[2] + v[3] * v[3]);
                    }
                ss += __shfl_xor(ss, 16); ss += __shfl_xor(ss, 32);
                if (fq == 0) atomicAdd(sumsq_next + row, ss);
            }
    }
};
template <class Epi, class Sched, bool ALIGN_EPI = false, bool SP2 = false>
__device__ __forceinline__ void gemm_phase(PG8_LAS unsigned char* lds, const Gemm g, const Sched& S, const Epi& E) {
    const int tid = threadIdx.x, wid = __builtin_amdgcn_readfirstlane(tid >> 6), lane = tid & 63, wr = wid >> 2, wc = wid & 3, fr = lane & 15, fq = lane >> 4;
    const int K = g.K, nt = K / BK;
    unsigned voffA[2], voffB[2];
#pragma unroll
    for (int i = 0; i < 2; ++i) { int R, C; stage_rc(tid * 16 + i * 8192, R, C); const int Rb = Epi::PERM ? ((R & ~31) + perm32(R & 31)) : R;
        voffA[i] = (unsigned)(R * K + C) * 2u; voffB[i] = (unsigned)(Rb * K + C) * 2u; }
    const size_t kstep = (size_t)(BK * 2);
    const size_t hstep = (size_t)HALF * K * 2;
    const size_t tstep = 2 * hstep;
    const unsigned ldsw = (unsigned)wid * 1024u;
    const int aoff = lds_byte(wr * 64 + fr, fq * 8), boff = lds_byte(wc * 32 + fr, fq * 8);
#define PG8_SA(b, h) (((b) * 2 + (h)) * HTB)
#define PG8_SB(b, h) ((4 + (b) * 2 + (h)) * HTB)
#define PG8_STAGE(bufoff, gbase, voff) do { _Pragma("unroll") for (int _i = 0; _i < 2; ++_i) \
        __builtin_amdgcn_global_load_lds((const unsigned*)((const char*)(gbase) + (voff)[_i]), (PG8_LAS unsigned*)(lds + (bufoff) + ldsw + _i * 8192), 16, 0, 0); } while (0)
#define PG8_LDA(dst, b, h) do { _Pragma("unroll") for (int m = 0; m < 4; ++m) _Pragma("unroll") for (int k = 0; k < 2; ++k) dst[m][k] = *(const PG8_LAS bf16x8*)(lds + PG8_SA(b, h) + aoff + m * 2048 + k * 1024); } while (0)
#define PG8_LDB(dst, b, h) do { _Pragma("unroll") for (int n = 0; n < 2; ++n) _Pragma("unroll") for (int k = 0; k < 2; ++k) dst[n][k] = *(const PG8_LAS bf16x8*)(lds + PG8_SB(b, h) + boff + n * 2048 + k * 1024); } while (0)
#define PG8_MMA(ai, bj, At, Bt) do { __builtin_amdgcn_s_setprio(1); _Pragma("unroll") for (int m = 0; m < 4; ++m) _Pragma("unroll") for (int n = 0; n < 2; ++n) _Pragma("unroll") for (int k = 0; k < 2; ++k) \
        acc[ai][bj][m][n] = __builtin_amdgcn_mfma_f32_16x16x32_bf16(Bt[n][k], At[m][k], acc[ai][bj][m][n], 0, 0, 0); __builtin_amdgcn_s_setprio(0); } while (0)
#define PG8_WAIT_V(n) asm volatile("s_waitcnt vmcnt(" #n ")" ::: "memory")
#define PG8_WAIT_L(n) asm volatile("s_waitcnt lgkmcnt(" #n ")" ::: "memory")
#define PG8_BAR __builtin_amdgcn_s_barrier()
#define PG8_SCHED __builtin_amdgcn_sched_barrier(0)
    Unit cur, nxt; int ui = 0;
    if (!S.next(0, cur)) return;
    f32x4 acc[2][2][4][2];
#pragma unroll
    for (int a = 0; a < 2; ++a)
#pragma unroll
        for (int b = 0; b < 2; ++b)
#pragma unroll
            for (int m = 0; m < 4; ++m)
#pragma unroll
                for (int n = 0; n < 2; ++n) acc[a][b][m][n] = (f32x4){0.f, 0.f, 0.f, 0.f};
    bf16x8 At[4][2], B0[2][2], B1[2][2];
    const char* cA = (const char*)g.A + (size_t)cur.pm * tstep; const char* cB = (const char*)g.Bt + (size_t)cur.pn * tstep;
    S.a_ready(cur);
    if constexpr (SP2) {
        PG8_STAGE(PG8_SB(0, 0), cB, voffB); PG8_STAGE(PG8_SB(0, 1), cB + hstep, voffB); PG8_STAGE(PG8_SA(0, 0), cA, voffA); PG8_STAGE(PG8_SA(0, 1), cA + hstep, voffA);
        if (wr == 1) PG8_BAR;
        PG8_WAIT_V(2); PG8_BAR;
        PG8_STAGE(PG8_SB(1, 0), cB + kstep, voffB); PG8_STAGE(PG8_SA(1, 0), cA + kstep, voffA); PG8_STAGE(PG8_SB(1, 1), cB + hstep + kstep, voffB);
        PG8_WAIT_V(6); PG8_BAR;
    } else {
        PG8_STAGE(PG8_SB(0, 0), cB, voffB); PG8_STAGE(PG8_SA(0, 0), cA, voffA); PG8_STAGE(PG8_SB(0, 1), cB + hstep, voffB); PG8_STAGE(PG8_SA(0, 1), cA + hstep, voffA);
        if (wr == 1) PG8_BAR;
        PG8_WAIT_V(4); PG8_BAR;
        PG8_STAGE(PG8_SB(1, 0), cB + kstep, voffB); PG8_STAGE(PG8_SA(1, 0), cA + kstep, voffA); PG8_STAGE(PG8_SB(1, 1), cB + hstep + kstep, voffB);
        PG8_WAIT_V(6); PG8_BAR;
    }
    for (;;) {
        const bool has_next = S.next(ui + 1, nxt);
        const char* nA = has_next ? (const char*)g.A + (size_t)nxt.pm * tstep : cA; const char* nB = has_next ? (const char*)g.Bt + (size_t)nxt.pn * tstep : cB;
        for (int t = 0; t < nt; t += 2) {
            const bool last = (t == nt - 2);
            const char* a1 = cA + (size_t)(t + 1) * kstep;
            const char* a2 = last ? nA : cA + (size_t)(t + 2) * kstep; const char* b2 = last ? nB : cB + (size_t)(t + 2) * kstep;
            const char* a3 = a2 + kstep; const char* b3 = b2 + kstep;
            if (last && has_next) S.a_ready(nxt);
            if constexpr (SP2) {
            PG8_LDB(B0, 0, 0); PG8_LDB(B1, 0, 1); PG8_SCHED; PG8_LDA(At, 0, 0); PG8_STAGE(PG8_SA(1, 1), a1 + hstep, voffA);
            PG8_WAIT_V(8); PG8_WAIT_L(0); PG8_BAR; PG8_MMA(0, 0, At, B0); PG8_MMA(0, 1, At, B1); PG8_BAR; PG8_SCHED;
            PG8_LDA(At, 0, 1); PG8_STAGE(PG8_SB(0, 0), b2, voffB); PG8_STAGE(PG8_SB(0, 1), b2 + hstep, voffB); PG8_STAGE(PG8_SA(0, 0), a2, voffA);
            PG8_WAIT_V(8); PG8_WAIT_L(0); PG8_BAR; PG8_MMA(1, 0, At, B0); PG8_MMA(1, 1, At, B1); PG8_BAR; PG8_SCHED;
            PG8_LDB(B0, 1, 0); PG8_LDB(B1, 1, 1); PG8_SCHED; PG8_LDA(At, 1, 0); PG8_STAGE(PG8_SA(0, 1), a2 + hstep, voffA);
            PG8_WAIT_V(8); PG8_WAIT_L(0); PG8_BAR; PG8_MMA(0, 0, At, B0); PG8_MMA(0, 1, At, B1); PG8_BAR; PG8_SCHED;
            PG8_LDA(At, 1, 1); PG8_STAGE(PG8_SB(1, 0), b3, voffB); PG8_STAGE(PG8_SB(1, 1), b3 + hstep, voffB); PG8_STAGE(PG8_SA(1, 0), a3, voffA);
            PG8_WAIT_V(8); PG8_WAIT_L(0); PG8_BAR; PG8_MMA(1, 0, At, B0); PG8_MMA(1, 1, At, B1); PG8_BAR; PG8_SCHED;
            } else {
            PG8_LDB(B0, 0, 0); PG8_SCHED; PG8_LDA(At, 0, 0); PG8_STAGE(PG8_SA(1, 1), a1 + hstep, voffA);
            PG8_WAIT_L(8); PG8_BAR; PG8_WAIT_L(0); PG8_MMA(0, 0, At, B0); PG8_BAR; PG8_SCHED;
            PG8_LDB(B1, 0, 1); PG8_STAGE(PG8_SB(0, 0), b2, voffB);
            PG8_BAR; PG8_WAIT_L(0); PG8_MMA(0, 1, At, B1); PG8_BAR;
            PG8_LDA(At, 0, 1); PG8_STAGE(PG8_SA(0, 0), a2, voffA);
            PG8_BAR; PG8_WAIT_L(0); PG8_MMA(1, 0, At, B0); PG8_BAR; PG8_SCHED;
            PG8_STAGE(PG8_SB(0, 1), b2 + hstep, voffB);
            PG8_WAIT_V(6); PG8_BAR; PG8_MMA(1, 1, At, B1); PG8_BAR;
            PG8_LDB(B0, 1, 0); PG8_SCHED; PG8_LDA(At, 1, 0); PG8_STAGE(PG8_SA(0, 1), a2 + hstep, voffA);
            PG8_WAIT_L(8); PG8_BAR; PG8_WAIT_L(0); PG8_MMA(0, 0, At, B0); PG8_BAR; PG8_SCHED;
            PG8_LDB(B1, 1, 1); PG8_STAGE(PG8_SB(1, 0), b3, voffB);
            PG8_BAR; PG8_WAIT_L(0); PG8_MMA(0, 1, At, B1); PG8_BAR;
            PG8_LDA(At, 1, 1); PG8_STAGE(PG8_SA(1, 0), a3, voffA);
            PG8_BAR; PG8_WAIT_L(0); PG8_MMA(1, 0, At, B0); PG8_BAR; PG8_SCHED;
            PG8_STAGE(PG8_SB(1, 1), b3 + hstep, voffB);
            PG8_WAIT_V(6); PG8_BAR; PG8_MMA(1, 1, At, B1); PG8_BAR;
            }
        }
        if constexpr (ALIGN_EPI) { if (wr == 0) PG8_BAR; }
        if constexpr (!Epi::AFTER_DRAIN) { E(acc, cur, wr, wc, fr, fq); S.done(cur); }
        if (!has_next) break;
#pragma unroll
        for (int a = 0; a < 2; ++a)
#pragma unroll
            for (int b = 0; b < 2; ++b)
#pragma unroll
                for (int m = 0; m < 4; ++m)
#pragma unroll
                    for (int n = 0; n < 2; ++n) acc[a][b][m][n] = (f32x4){0.f, 0.f, 0.f, 0.f};
        cur = nxt; cA = nA; cB = nB; ++ui;
        if constexpr (ALIGN_EPI) { if (wr == 1) PG8_BAR; }
    }
    PG8_WAIT_V(0);
    if constexpr (!ALIGN_EPI) { if (wr == 0) PG8_BAR; }
    PG8_BAR;
    if constexpr (Epi::AFTER_DRAIN) { E.fused(acc, cur, wr, wc, fr, fq, lds, wid, lane); S.done(cur); }
#undef PG8_SA
#undef PG8_SB
#undef PG8_STAGE
#undef PG8_LDA
#undef PG8_LDB
#undef PG8_MMA
#undef PG8_WAIT_V
#undef PG8_WAIT_L
#undef PG8_BAR
#undef PG8_SCHED
}
}
#define LAS __attribute__((address_space(3)))
#define XB_TMO      128
#define XB_XCNT(j)  (256  + 64 * (j))
#define XB_XSUB(j)  (1280 + 64 * (j))
#define XB_XGEN(j)  (2304 + 64 * (j))
#define XB_TOP      3328
#define XB_TOPGEN   3392
#define XCD_BAR_WORDS 3456
#define XB_SPIN_CAP (1u << 18)

__device__ __forceinline__ unsigned xb_ld(unsigned* p)              { return __hip_atomic_load(p, __ATOMIC_RELAXED, __HIP_MEMORY_SCOPE_AGENT); }
__device__ __forceinline__ unsigned xb_add(unsigned* p, unsigned v) { return __hip_atomic_fetch_add(p, v, __ATOMIC_RELAXED, __HIP_MEMORY_SCOPE_AGENT); }
__device__ __forceinline__ unsigned xb_xcc_id() { return (unsigned)__builtin_amdgcn_s_getreg((3 << 11) | 20) & 0xFu; }
#define XB_SPIN(cond, bar) do { unsigned _sp = 0; while (cond) { __builtin_amdgcn_s_sleep(1); \
    if ((++_sp & 255u) == 0u) { if (xb_ld(&(bar)[XB_TMO])) break; if (_sp > XB_SPIN_CAP) { atomicAdd(&(bar)[XB_TMO], 1u); break; } } } } while (0)

struct XcdBarrier {
    unsigned* bar; unsigned x;
    volatile LAS unsigned* st;
};

__device__ __forceinline__ XcdBarrier xcd_barrier_post(unsigned* bar, volatile LAS unsigned* st) {
    XcdBarrier b; b.bar = bar; b.x = xb_xcc_id(); b.st = st;
    if (threadIdx.x == 0) (void)xb_add(&bar[XB_XCNT(b.x)], 1u);
    return b;
}
__device__ __forceinline__ void xcd_barrier_complete(unsigned* bar, unsigned x, unsigned& nloc, unsigned& nx) {
    const unsigned G = gridDim.x * gridDim.y * gridDim.z;
    unsigned sum, cnt, mine, sp = 0u;
    for (;;) {
        sum = 0u; cnt = 0u; mine = 0u;
#pragma unroll
        for (unsigned j = 0; j < 16; ++j) { const unsigned c = xb_ld(&bar[XB_XCNT(j)]); sum += c; cnt += (c > 0u) ? 1u : 0u; mine = (j == x) ? c : mine; }
        if (sum == G) break;
        __builtin_amdgcn_s_sleep(1);
        if ((++sp & 255u) == 0u) { if (xb_ld(&bar[XB_TMO])) break; if (sp > XB_SPIN_CAP) { atomicAdd(&bar[XB_TMO], 1u); break; } }
    }
    nloc = mine > 0u ? mine : 1u; nx = cnt > 0u ? cnt : 1u;
}

__device__ __forceinline__ void xcd_barrier(const XcdBarrier& b) {
    asm volatile("s_waitcnt vmcnt(0)" ::: "memory");
    __syncthreads();
    if (threadIdx.x == 0) {
        unsigned* bar = b.bar;
        __builtin_amdgcn_s_waitcnt(0);
        unsigned nloc = b.st[0], nx = b.st[1];
        if (nloc == 0u) { xcd_barrier_complete(bar, b.x, nloc, nx); b.st[0] = nloc; b.st[1] = nx; }
        const unsigned old = xb_add(&bar[XB_XSUB(b.x)], 1u);
        const unsigned gen = old / nloc;
        if (old + 1u == (gen + 1u) * nloc) {
            __builtin_amdgcn_fence(__ATOMIC_RELEASE, "agent");
            asm volatile("s_waitcnt vmcnt(0)" ::: "memory");
            const unsigned og = xb_add(&bar[XB_TOP], 1u);
            const unsigned tg = og / nx;
            if (og + 1u == (tg + 1u) * nx) xb_add(&bar[XB_TOPGEN], 1u);
            else XB_SPIN(xb_ld(&bar[XB_TOPGEN]) == tg, bar);
            __builtin_amdgcn_fence(__ATOMIC_ACQUIRE, "agent");
            xb_add(&bar[XB_XGEN(b.x)], 1u);
            asm volatile("s_waitcnt vmcnt(0)" ::: "memory");
        } else {
            XB_SPIN(xb_ld(&bar[XB_XGEN(b.x)]) == gen, bar);
            __builtin_amdgcn_fence(__ATOMIC_ACQUIRE, "agent");
            asm volatile("s_waitcnt vmcnt(0)" ::: "memory");
        }
    }
    __syncthreads();
}
#ifdef EMU
#include <pthread.h>
#include <cstring>
#include <cstdio>
#include <cstdlib>
#include <cmath>
#include <cstdint>
#define DEV static inline
#define LAS
struct EmuDim { int x; };
static thread_local EmuDim threadIdx;
typedef short bf16x8 __attribute__((ext_vector_type(8)));
typedef short s16x4 __attribute__((ext_vector_type(4)));
typedef float f32x4 __attribute__((ext_vector_type(4)));
typedef float f32x2 __attribute__((ext_vector_type(2)));
typedef unsigned u32x4 __attribute__((ext_vector_type(4)));
typedef unsigned u32x2 __attribute__((ext_vector_type(2)));
struct WaveX { bf16x8 a[64], b[64]; float f[64]; const void* p[64]; pthread_barrier_t bar; };
static WaveX g_wx[8];
static pthread_barrier_t g_wgbar;
static inline float emu_bf2f(short v) { unsigned u = ((unsigned)(unsigned short)v) << 16; float f; memcpy(&f, &u, 4); return f; }
static inline float __uint_as_float(unsigned u) { float f; memcpy(&f, &u, 4); return f; }
static inline unsigned __float_as_uint(float f) { unsigned u; memcpy(&u, &f, 4); return u; }
DEV f32x4 mfma16(bf16x8 a, bf16x8 b, f32x4 c) {
    const int lane = threadIdx.x & 63; WaveX& W = g_wx[threadIdx.x >> 6];
    W.a[lane] = a; W.b[lane] = b; pthread_barrier_wait(&W.bar);
    f32x4 r; const int g = lane >> 4, j = lane & 15;
    for (int rr = 0; rr < 4; ++rr) { const int i = 4 * g + rr; float s = 0.f;
        for (int k = 0; k < 32; ++k) s += emu_bf2f(W.a[i + 16 * (k / 8)][k % 8]) * emu_bf2f(W.b[j + 16 * (k / 8)][k % 8]);
        r[rr] = c[rr] + s; }
    pthread_barrier_wait(&W.bar); return r;
}
DEV s16x4 tr_read(const void* p) {
    const int lane = threadIdx.x & 63; WaveX& W = g_wx[threadIdx.x >> 6];
    W.p[lane] = p; pthread_barrier_wait(&W.bar);
    s16x4 r; const int G = lane >> 4, i = lane & 15;
    for (int q = 0; q < 4; ++q) { const short* src = (const short*)W.p[16 * G + 4 * q + i / 4]; if (((uintptr_t)src) & 7) { fprintf(stderr, "tr_read: unaligned\n"); abort(); } r[q] = src[i % 4]; }
    pthread_barrier_wait(&W.bar); return r;
}
DEV void lds_wait() {}
DEV float shflx(float v, int m) { const int lane = threadIdx.x & 63; WaveX& W = g_wx[threadIdx.x >> 6]; W.f[lane] = v; pthread_barrier_wait(&W.bar); const float r = W.f[lane ^ m]; pthread_barrier_wait(&W.bar); return r; }
DEV void wg_sync() { pthread_barrier_wait(&g_wgbar); }
DEV float fast_exp2(float x) { return exp2f(x); }
DEV float fast_log2(float x) { return log2f(x); }
DEV float fast_rcp(float x) { return 1.0f / x; }
DEV unsigned cvt_pk_bf16(float lo, float hi) { auto f = [](float x) { unsigned u = __float_as_uint(x); return (u + 0x7fffu + ((u >> 16) & 1u)) >> 16; }; return f(lo) | (f(hi) << 16); }
#else
#define DEV __device__ __forceinline__
typedef short bf16x8 __attribute__((ext_vector_type(8)));
typedef short s16x4 __attribute__((ext_vector_type(4)));
typedef float f32x4 __attribute__((ext_vector_type(4)));
typedef float f32x2 __attribute__((ext_vector_type(2)));
typedef unsigned u32x4 __attribute__((ext_vector_type(4)));
typedef unsigned u32x2 __attribute__((ext_vector_type(2)));
DEV f32x4 mfma16(bf16x8 a, bf16x8 b, f32x4 c) { return __builtin_amdgcn_mfma_f32_16x16x32_bf16(a, b, c, 0, 0, 0); }
DEV s16x4 tr_read(const LAS void* p) { s16x4 r; asm volatile("ds_read_b64_tr_b16 %0, %1" : "=&v"(r) : "v"((unsigned)(size_t)p) : "memory"); return r; }
DEV void lds_wait() { asm volatile("s_waitcnt lgkmcnt(0)" ::: "memory"); __builtin_amdgcn_sched_barrier(0); }
DEV float shflx(float v, int m) { return __shfl_xor(v, m); }
DEV void wg_sync() { __syncthreads(); }
DEV float fast_exp2(float x) { return __builtin_amdgcn_exp2f(x); }
DEV float fast_log2(float x) { return __builtin_amdgcn_logf(x); }
DEV float fast_rcp(float x) { return __builtin_amdgcn_rcpf(x); }
DEV unsigned cvt_pk_bf16(float lo, float hi) { unsigned r; asm volatile("v_cvt_pk_bf16_f32 %0, %1, %2" : "=v"(r) : "v"(lo), "v"(hi)); return r; }
#endif
typedef unsigned short bf16;
DEV bf16x8 pack8(s16x4 lo, s16x4 hi) { return (bf16x8){lo[0], lo[1], lo[2], lo[3], hi[0], hi[1], hi[2], hi[3]}; }

namespace mk {
typedef unsigned short bf16;
typedef float f32x4 __attribute__((ext_vector_type(4)));
typedef float f32x2 __attribute__((ext_vector_type(2)));
typedef unsigned u32x4 __attribute__((ext_vector_type(4)));
typedef unsigned u32x2 __attribute__((ext_vector_type(2)));
typedef short bf16x8 __attribute__((ext_vector_type(8)));
constexpr int D = 2048, NB = 4, S = 2048, MP = NB * S, DB = 8, T = 4, MS = DB * T, MT = MP + MS, PAST = 16384;
constexpr float EPS = 1e-6f;
constexpr int A_IN = 20480, B_IN = 12288, C_IN = 6160, C_INM = 6144;
constexpr int NWG_THREADS = 512;
constexpr size_t MiB = 1u << 20;
constexpr size_t WS_CTL = 0, CTL_ZERO_BYTES = 1 * MiB;
constexpr size_t CTL_BAR = 16384;
constexpr size_t CTL_SUMSQ = 65536;
constexpr size_t WS_TABA = 1 * MiB;
constexpr size_t WS_TABB = WS_TABA + 512 * 1024;
constexpr size_t WS_WIA0 = 4 * MiB;
constexpr size_t WS_WIA1 = WS_WIA0 + (size_t)A_IN * D * 2;
constexpr size_t WS_WIB = WS_WIA1 + (size_t)A_IN * D * 2;
constexpr size_t WS_WIC = WS_WIB + (size_t)B_IN * D * 2;
constexpr size_t WS_WLR = WS_WIC + (size_t)C_INM * D * 2;
constexpr size_t WS_WOA0 = WS_WLR + (size_t)32 * D * 2;
constexpr size_t WS_WOA1 = WS_WOA0 + (size_t)D * 2048 * 2;
constexpr size_t WS_WOB = WS_WOA1 + (size_t)D * 2048 * 2;
constexpr size_t WS_WOC = WS_WOB + (size_t)D * 4096 * 2;
constexpr size_t WS_XRES = WS_WOC + (size_t)D * 2048 * 2;
constexpr size_t WS_XB = WS_XRES + (size_t)MT * D * 4;
constexpr size_t WS_Z = WS_XB + (size_t)MT * D * 2;
constexpr size_t WS_ZSRAW = WS_Z + (size_t)MT * A_IN * 2;
constexpr size_t WS_Y = WS_ZSRAW + (size_t)32 * A_IN * 4;
constexpr size_t WS_O = WS_Y + (size_t)MT * 4096 * 2;
constexpr size_t WS_LOGA = WS_O + (size_t)MT * 4096 * 4;
constexpr size_t WS_LR = WS_LOGA + (size_t)MT * 1024 * 4;
constexpr size_t WS_END = WS_LR + (size_t)32 * MT * 4;
constexpr int LDS_BYTES = 147456, MISC_OFF = 131072 + 320;

struct Params {
    const float* in[19]; float* out; unsigned char* ws;
    double inv_a[16]; double inv_b[128];
    int ph_lo, ph_hi;
};

__device__ __forceinline__ float bf2f(bf16 v) { return __uint_as_float(((unsigned)v) << 16); }
__device__ __forceinline__ unsigned f2bf(float f) { unsigned u = __float_as_uint(f); return (u + 0x7fffu + ((u >> 16) & 1u)) >> 16; }
__device__ __forceinline__ unsigned pk2(float lo, float hi) { return f2bf(lo) | (f2bf(hi) << 16); }
__device__ __forceinline__ float wave_sum(float v) {
#pragma unroll
    for (int o = 32; o >= 1; o >>= 1) v += __shfl_xor(v, o);
    return v;
}
__device__ __forceinline__ float wave_max(float v) {
#pragma unroll
    for (int o = 32; o >= 1; o >>= 1) v = fmaxf(v, __shfl_xor(v, o));
    return v;
}
__device__ __forceinline__ float silu(float x) { return x / (1.f + __expf(-x)); }
__device__ __forceinline__ void sincos_d(double a, float& s, float& c) {
    const double k = rint(a * 0.63661977236758134308);
    double r = fma(-k, 1.57079632679489655800e+00, a); r = fma(-k, 6.12323399573676603587e-17, r);
    const double r2 = r * r;
    const double sp = r * (1.0 + r2 * (-1.0 / 6 + r2 * (1.0 / 120 + r2 * (-1.0 / 5040 + r2 * (1.0 / 362880 + r2 * (-1.0 / 39916800 + r2 * (1.0 / 6227020800.0)))))));
    const double cp = 1.0 + r2 * (-0.5 + r2 * (1.0 / 24 + r2 * (-1.0 / 720 + r2 * (1.0 / 40320 + r2 * (-1.0 / 3628800 + r2 * (1.0 / 479001600.0 + r2 * (-1.0 / 87178291200.0)))))));
    const int q = (int)((long long)k & 3);
    const double ss = (q == 0) ? sp : (q == 1) ? cp : (q == 2) ? -sp : -cp;
    const double cc = (q == 0) ? cp : (q == 1) ? -sp : (q == 2) ? -cp : sp;
    s = (float)ss; c = (float)cc;
}
__device__ __forceinline__ void row_info(int row, int& b, int& t, int& pi, bool& samp) {
    if (row < MP) { b = row >> 11; t = row & 2047; pi = t; samp = false; } else { const int r = row - MP; b = r >> 2; t = r & 3; pi = 2048 + t; samp = true; }
}

struct Ctx {
    LAS unsigned char* lds; int tid, lane, wave, G, wg;
    const float *x_prompt, *x_sample, *cache1, *cache2, *cache3, *state_b, *state_c, *norm_g, *final_g, *w_in_a, *w_out_a, *w_in_b, *gn_b, *w_out_b, *w_in_c, *w_gate2_c, *b_gate_c, *gn_c, *w_out_c; float* out; unsigned char* ws;
    __device__ __forceinline__ float* sumsq(int l) const { return (float*)(ws + CTL_SUMSQ) + (size_t)l * MT; }
    template <class Tp> __device__ __forceinline__ Tp* wsp(size_t off) const { return (Tp*)(ws + off); }
};

constexpr int ATT_K_OFF = 0, ATT_V_OFF = 65536;
DEV int att_off_k(int row, int ch) { return 256 * row + 16 * (ch ^ (row & 15)); }
DEV int att_off_v(int row, int ch) { return 256 * row + 16 * (ch ^ (2 * (row & 7))); }
DEV void attn_item(LAS unsigned char* lds, const bf16* z, int ldz, bf16* og, float* lse, int item, int tid) {
    const int lane = tid & 63, w = tid >> 6, G = lane >> 4, l15 = lane & 15;
    const int bh = item / 48, rem = item % 48, b = bh >> 4, h = bh & 15;
    int g, r, blk;
    if (rem < 16) { g = 0; r = 0; blk = rem; } else if (rem < 32) { g = 1; r = (rem - 16) >> 2; blk = (rem - 16) & 3; } else { g = 2; r = rem - 32; blk = 0; }
    const int dil = 1 << (2 * g);
    const int qcol = (g * 3) * 2048 + h * 128, kcol = qcol + 2048, vcol = qcol + 4096;
    const size_t tok0 = (size_t)b * 2048 + r;
#pragma unroll
    for (int j = 0; j < 8; ++j) {
        const int e = tid + 512 * j, row = e >> 4, ch = e & 15; const int p = (blk - 1) * 128 + row;
        u32x4 kv = {0u, 0u, 0u, 0u}, vv = {0u, 0u, 0u, 0u};
        if (p >= 0) { const bf16* src = z + (tok0 + (size_t)dil * p) * ldz + ch * 8; kv = *(const u32x4*)(src + kcol); vv = *(const u32x4*)(src + vcol); }
        *(LAS u32x4*)(lds + ATT_K_OFF + att_off_k(row, ch)) = kv;
        *(LAS u32x4*)(lds + ATT_V_OFF + att_off_v(row, ch)) = vv;
    }
    const int qi = 16 * w + l15; const size_t qtok = tok0 + (size_t)dil * (blk * 128 + qi);
    bf16x8 qf[4];
#pragma unroll
    for (int s = 0; s < 4; ++s) qf[s] = *(const bf16x8*)(z + qtok * ldz + qcol + 32 * s + 8 * G);
    wg_sync();
    const int m0 = w >> 1;
    f32x4 sc[10];
#pragma unroll
    for (int tt = 0; tt < 10; ++tt) {
        const int t = 2 * m0 + tt; f32x4 a = {0.f, 0.f, 0.f, 0.f};
#pragma unroll
        for (int s = 0; s < 4; ++s) { const bf16x8 kf = *(const LAS bf16x8*)(lds + ATT_K_OFF + att_off_k(16 * t + l15, 4 * s + G)); a = mfma16(kf, qf[s], a); }
        sc[tt] = a;
    }
    const float scale = 0.08838834764831845f * 1.4426950408889634f;
    float mx = -INFINITY;
#pragma unroll
    for (int tt = 0; tt < 10; ++tt)
#pragma unroll
        for (int rr = 0; rr < 4; ++rr) { const int c = 16 * (2 * m0 + tt) + 4 * G + rr; const bool ok = (c >= qi) && (c <= qi + 128) && (blk > 0 || c >= 128);
            const float v = ok ? sc[tt][rr] * scale : -INFINITY; sc[tt][rr] = v; mx = fmaxf(mx, v); }
    mx = fmaxf(mx, shflx(mx, 16)); mx = fmaxf(mx, shflx(mx, 32));
    float sum = 0.f;
#pragma unroll
    for (int tt = 0; tt < 10; ++tt)
#pragma unroll
        for (int rr = 0; rr < 4; ++rr) { const float p = fast_exp2(sc[tt][rr] - mx); sc[tt][rr] = p; sum += p; }
    sum += shflx(sum, 16); sum += shflx(sum, 32);
    f32x4 oacc[8];
#pragma unroll
    for (int dt = 0; dt < 8; ++dt) oacc[dt] = (f32x4){0.f, 0.f, 0.f, 0.f};
#pragma unroll
    for (int mm = 0; mm < 5; ++mm) {
        const f32x4 p0 = sc[2 * mm], p1 = sc[2 * mm + 1];
        u32x4 pw; pw[0] = cvt_pk_bf16(p0[0], p0[1]); pw[1] = cvt_pk_bf16(p0[2], p0[3]); pw[2] = cvt_pk_bf16(p1[0], p1[1]); pw[3] = cvt_pk_bf16(p1[2], p1[3]);
        bf16x8 pf; __builtin_memcpy(&pf, &pw, 16);
        const int krow = 32 * (m0 + mm) + 4 * G + (l15 >> 2);
#pragma unroll
        for (int dh = 0; dh < 2; ++dh) {
            s16x4 lo[4], hi[4];
#pragma unroll
            for (int d4 = 0; d4 < 4; ++d4) { const int dt = dh * 4 + d4; const int ch = 2 * dt + ((l15 >> 1) & 1);
                lo[d4] = tr_read(lds + ATT_V_OFF + att_off_v(krow, ch) + 8 * (l15 & 1)); hi[d4] = tr_read(lds + ATT_V_OFF + att_off_v(krow + 16, ch) + 8 * (l15 & 1)); }
            lds_wait();
#pragma unroll
            for (int d4 = 0; d4 < 4; ++d4) oacc[dh * 4 + d4] = mfma16(pack8(lo[d4], hi[d4]), pf, oacc[dh * 4 + d4]);
        }
    }
    const float inv = fast_rcp(sum);
    bf16* orow = og + ((size_t)g * 8192 + qtok) * 2048 + h * 128 + 4 * G;
#pragma unroll
    for (int dt = 0; dt < 8; ++dt) { u32x2 wv; wv[0] = cvt_pk_bf16(oacc[dt][0] * inv, oacc[dt][1] * inv); wv[1] = cvt_pk_bf16(oacc[dt][2] * inv, oacc[dt][3] * inv); *(u32x2*)(orow + 16 * dt) = wv; }
    if (G == 0) lse[((size_t)g * 8192 + qtok) * 16 + h] = (mx + fast_log2(sum)) * 0.6931471805599453f;
    wg_sync();
}
__device__ __forceinline__ void p0_transpose_item(const float* W, int K, int ld, int ncols, const float* gain, bf16* WT, LAS float* scr, int item, int lane) {
    const int nblk = ncols / 32, kb = item / nblk, nb = item % nblk, k0 = 64 * kb, n0 = 32 * nb;
#pragma unroll 8
    for (int i = 0; i < 32; ++i) { const int kk = 2 * i + (lane >> 5); const float gk = gain ? gain[k0 + kk] : 1.0f; scr[kk * 33 + (lane & 31)] = W[(size_t)(k0 + kk) * ld + n0 + (lane & 31)] * gk; }
    asm volatile("s_waitcnt lgkmcnt(0)" ::: "memory");
    const int c = lane & 7;
#pragma unroll
    for (int j = 0; j < 4; ++j) { const int n = (lane >> 3) + 8 * j; const LAS float* s = scr + (8 * c) * 33 + n;
        u32x4 o; o.x = pk2(s[0 * 33], s[1 * 33]); o.y = pk2(s[2 * 33], s[3 * 33]); o.z = pk2(s[4 * 33], s[5 * 33]); o.w = pk2(s[6 * 33], s[7 * 33]);
        *(u32x4*)(WT + (size_t)(n0 + n) * K + k0 + 8 * c) = o; }
    asm volatile("s_waitcnt lgkmcnt(0)" ::: "memory");
}
__device__ __forceinline__ void p0_prologue(const Ctx& C, const Params& P) {
    LAS float* scr = (LAS float*)(C.lds + C.wave * 16384);
    const int gw = C.wg * 8 + C.wave, NGW = C.G * 8;
    const float* norm_g = C.norm_g;
    constexpr int I_A = (D / 64) * (A_IN / 32), I_B = (D / 64) * (B_IN / 32), I_C = (D / 64) * (C_INM / 32), I_OA = (2048 / 64) * (D / 32), I_OB = (4096 / 64) * (D / 32);
    constexpr int NITEMS = 2 * I_A + I_B + I_C + 3 * I_OA + I_OB;
    for (int it = gw; it < NITEMS; it += NGW) {
        int r = it;
        if (r < I_A) { p0_transpose_item(C.w_in_a, D, A_IN, A_IN, norm_g + 0 * D, C.wsp<bf16>(WS_WIA0), scr, r, C.lane); continue; } r -= I_A;
        if (r < I_A) { p0_transpose_item(C.w_in_a + (size_t)D * A_IN, D, A_IN, A_IN, norm_g + 3 * D, C.wsp<bf16>(WS_WIA1), scr, r, C.lane); continue; } r -= I_A;
        if (r < I_B) { p0_transpose_item(C.w_in_b, D, B_IN, B_IN, norm_g + 1 * D, C.wsp<bf16>(WS_WIB), scr, r, C.lane); continue; } r -= I_B;
        if (r < I_C) { p0_transpose_item(C.w_in_c, D, C_IN, C_INM, norm_g + 2 * D, C.wsp<bf16>(WS_WIC), scr, r, C.lane); continue; } r -= I_C;
        if (r < I_OA) { p0_transpose_item(C.w_out_a, 2048, D, D, nullptr, C.wsp<bf16>(WS_WOA0), scr, r, C.lane); continue; } r -= I_OA;
        if (r < I_OA) { p0_transpose_item(C.w_out_a + (size_t)2048 * D, 2048, D, D, nullptr, C.wsp<bf16>(WS_WOA1), scr, r, C.lane); continue; } r -= I_OA;
        if (r < I_OA) { p0_transpose_item(C.w_out_c, 2048, D, D, nullptr, C.wsp<bf16>(WS_WOC), scr, r, C.lane); continue; } r -= I_OA;
        p0_transpose_item(C.w_out_b, 4096, D, D, nullptr, C.wsp<bf16>(WS_WOB), scr, r, C.lane);
    }
    { bf16* wlr = C.wsp<bf16>(WS_WLR); const float* W = C.w_in_c; const float* g2 = norm_g + 2 * D;
      for (int e = C.wg * NWG_THREADS + C.tid; e < 32 * D; e += C.G * NWG_THREADS) { const int r = e / D, k = e % D; wlr[e] = r < 16 ? (bf16)f2bf(W[(size_t)k * C_IN + C_INM + r] * g2[k]) : (bf16)0; } }
    { float* xres = C.wsp<float>(WS_XRES); bf16* xb = C.wsp<bf16>(WS_XB); float* ss0 = C.sumsq(0);
      for (int row = gw; row < MT; row += NGW) {
          const float* src = row < MP ? C.x_prompt + (size_t)row * D : C.x_sample + (size_t)(row - MP) * D;
          float s = 0.f;
#pragma unroll
          for (int j = 0; j < 8; ++j) { const f32x4 v = *(const f32x4*)(src + 4 * C.lane + 256 * j); *(f32x4*)(xres + (size_t)row * D + 4 * C.lane + 256 * j) = v;
              u32x2 w; w.x = pk2(v[0], v[1]); w.y = pk2(v[2], v[3]); *(u32x2*)(xb + (size_t)row * D + 4 * C.lane + 256 * j) = w; s += (v[0] * v[0] + v[1] * v[1]) + (v[2] * v[2] + v[3] * v[3]); }
          s = wave_sum(s); if (C.lane == 0) ss0[row] = s; } }
    { f32x2* ta = C.wsp<f32x2>(WS_TABA); f32x2* tb = C.wsp<f32x2>(WS_TABB);
      for (int e = C.wg * NWG_THREADS + C.tid; e < 2052 * 16; e += C.G * NWG_THREADS) { const int pi = e >> 4, i = e & 15; const int pos = pi < 2048 ? pi : PAST + (pi - 2048); float s, c; sincos_d((double)pos * P.inv_a[i], s, c); ta[e] = (f32x2){c, s}; }
      for (int e = C.wg * NWG_THREADS + C.tid; e < 2052 * 128; e += C.G * NWG_THREADS) { const int pi = e >> 7, i = e & 127; const int pos = pi < 2048 ? pi : PAST + (pi - 2048); float s, c; sincos_d((double)pos * P.inv_b[i], s, c); tb[e] = (f32x2){c, s}; } }
}

template <int K, class EP>
__device__ __forceinline__ void skinny_gemm(const Ctx& C, const bf16* A, const bf16* Bt, int N, const EP& ep) {
    constexpr int KW = K / 8, NPASS = KW / 256, MAXCH = 5;
    const int fr = C.lane & 15, fq = C.lane >> 4, nch = N / 16;
    LAS float* part = (LAS float*)C.lds;
    for (int cb = C.wg; cb < nch; cb += C.G * MAXCH) {
        int ncur = 0;
#pragma unroll 1
        for (int j = 0; j < MAXCH; ++j) {
            const int ch = cb + j * C.G; if (ch >= nch) break;
            ++ncur;
            pg8::f32x4 acc0 = {0.f, 0.f, 0.f, 0.f}, acc1 = {0.f, 0.f, 0.f, 0.f};
#pragma unroll 1
            for (int ps = 0; ps < NPASS; ++ps) {
                const int kbase = C.wave * KW + ps * 256 + 8 * fq;
                const bf16* ap0 = A + (size_t)fr * K + kbase; const bf16* ap1 = A + (size_t)(16 + fr) * K + kbase; const bf16* bp = Bt + (size_t)(ch * 16 + fr) * K + kbase;
                bf16x8 a0[8], a1[8], bb[8];
#pragma unroll
                for (int s = 0; s < 8; ++s) { bb[s] = *(const bf16x8*)(bp + 32 * s); a0[s] = *(const bf16x8*)(ap0 + 32 * s); a1[s] = *(const bf16x8*)(ap1 + 32 * s); }
#pragma unroll
                for (int s = 0; s < 8; ++s) { acc0 = __builtin_amdgcn_mfma_f32_16x16x32_bf16(bb[s], a0[s], acc0, 0, 0, 0); acc1 = __builtin_amdgcn_mfma_f32_16x16x32_bf16(bb[s], a1[s], acc1, 0, 0, 0); }
            }
            LAS float* pj = part + ((size_t)(j * 8 + C.wave) * 2) * 4 * 64 + C.lane;
#pragma unroll
            for (int r = 0; r < 4; ++r) { pj[(0 * 4 + r) * 64] = acc0[r]; pj[(1 * 4 + r) * 64] = acc1[r]; }
        }
        __syncthreads();
        {
            const int l2 = C.tid & 63, mt = (C.tid >> 6) & 1, reg = C.tid >> 7;
            for (int j = 0; j < ncur; ++j) {
                float s = 0.f;
#pragma unroll
                for (int w = 0; w < 8; ++w) s += part[(((size_t)(j * 8 + w) * 2 + mt) * 4 + reg) * 64 + l2];
                const int ch = cb + j * C.G;
                ep(16 * mt + (l2 & 15), ch * 16 + 4 * (l2 >> 4) + reg, s);
            }
        }
        __syncthreads();
    }
}

__device__ __forceinline__ float rstd_of(const float* ss, int row) { return rsqrtf(ss[row] * (1.0f / 2048.0f) + EPS); }
__device__ __forceinline__ void sfix_a(const Ctx& C, int layer, int slot) {
    const float* zs = C.wsp<float>(WS_ZSRAW); bf16* z = C.wsp<bf16>(WS_Z); const float* ss = C.sumsq(layer); const f32x2* ta = C.wsp<f32x2>(WS_TABA);
    float* skv = C.out + (size_t)MP * D + (size_t)MS * D + (size_t)2 * 4 * (128 + 512 + 2048) * 4096 + (size_t)4 * 8 * 256 * 512 + (size_t)4 * 4 * 256 * 512;
    for (int e = C.wg * NWG_THREADS + C.tid; e < MS * A_IN; e += C.G * NWG_THREADS) {
        const int r = e / A_IN, c = e % A_IN, row = MP + r, b = r >> 2, t = r & 3; const float rs = rstd_of(ss, row);
        const int section = c >> 11, within = c & 2047, d = within & 127, kind = section < 9 ? section % 3 : 3, g = section / 3;
        float v = zs[e] * rs;
        if (kind < 2 && d < 32) { const int i = d & 15; const float pv = zs[d < 16 ? e + 16 : e - 16] * rs; const f32x2 cs = ta[(2048 + t) * 16 + i]; v = d < 16 ? v * cs.x - pv * cs.y : pv * cs.y + v * cs.x; }
        z[(size_t)row * A_IN + c] = (bf16)f2bf(v);
        if (kind == 1 || kind == 2) skv[(size_t)g * (2 * 8 * 4 * 4096) + ((((size_t)slot * DB + b) * T + t) * 2 + (kind - 1)) * 2048 + within] = v;
    }
}
__device__ __forceinline__ void sfix_b(const Ctx& C, int layer) {
    const float* zs = C.wsp<float>(WS_ZSRAW); bf16* z = C.wsp<bf16>(WS_Z); const float* ss = C.sumsq(layer); const f32x2* tb = C.wsp<f32x2>(WS_TABB);
    for (int e = C.wg * NWG_THREADS + C.tid; e < MS * B_IN; e += C.G * NWG_THREADS) {
        const int r = e / B_IN, c = e % B_IN, row = MP + r, t = r & 3; const float rs = rstd_of(ss, row);
        float v = zs[e] * rs;
        if (c < 4096) { const int d = c & 255, i = d & 127; const float pv = zs[d < 128 ? e + 128 : e - 128] * rs; const f32x2 cs = tb[(2048 + t) * 128 + i]; v = d < 128 ? v * cs.x - pv * cs.y : pv * cs.y + v * cs.x; if (c >= 2048) v *= 0.0625f; }
        z[(size_t)row * B_IN + c] = (bf16)f2bf(v);
    }
}
__device__ __forceinline__ void sfix_c(const Ctx& C, int layer) {
    const float* zs = C.wsp<float>(WS_ZSRAW); bf16* z = C.wsp<bf16>(WS_Z); const float* ss = C.sumsq(layer);
    for (int e = C.wg * NWG_THREADS + C.tid; e < MS * C_INM; e += C.G * NWG_THREADS) {
        const int r = e / C_INM, c = e % C_INM, row = MP + r; const float rs = rstd_of(ss, row);
        float v = zs[e] * rs; if (c < 1024) v *= 0.0625f;
        z[(size_t)row * C_INM + c] = (bf16)f2bf(v);
    }
    const float* lr = C.wsp<float>(WS_LR); float* loga = C.wsp<float>(WS_LOGA); const float* wg2 = C.w_gate2_c; const float* bg = C.b_gate_c;
    for (int e = C.wg * NWG_THREADS + C.tid; e < MT * 1024; e += C.G * NWG_THREADS) {
        const int row = e >> 10, c = e & 1023; const float rs = rstd_of(ss, row);
        float a = 0.f;
#pragma unroll
        for (int r = 0; r < 16; ++r) a += lr[(size_t)r * MT + row] * wg2[r * 1024 + c];
        a = a * rs + bg[c];
        loga[e] = (fminf(a, 0.f) - log1pf(__expf(-fabsf(a)))) * 0.0625f;
    }
}

__device__ __forceinline__ float dot128_bb(const bf16* q, const bf16* k) {
    float a = 0.f;
#pragma unroll 4
    for (int i = 0; i < 16; ++i) { const u32x4 x = ((const u32x4*)q)[i], y = ((const u32x4*)k)[i];
#pragma unroll
        for (int j = 0; j < 4; ++j) a += __uint_as_float(x[j] << 16) * __uint_as_float(y[j] << 16) + __uint_as_float(x[j] & 0xffff0000u) * __uint_as_float(y[j] & 0xffff0000u); }
    return a;
}
__device__ __forceinline__ float dot128_bf(const bf16* q, const float* k) {
    float a = 0.f;
#pragma unroll 4
    for (int i = 0; i < 16; ++i) { const u32x4 x = ((const u32x4*)q)[i]; const f32x4 y0 = ((const f32x4*)k)[2 * i], y1 = ((const f32x4*)k)[2 * i + 1];
        a += __uint_as_float(x[0] << 16) * y0[0] + __uint_as_float(x[0] & 0xffff0000u) * y0[1] + __uint_as_float(x[1] << 16) * y0[2] + __uint_as_float(x[1] & 0xffff0000u) * y0[3]
           + __uint_as_float(x[2] << 16) * y1[0] + __uint_as_float(x[2] & 0xffff0000u) * y1[1] + __uint_as_float(x[3] << 16) * y1[2] + __uint_as_float(x[3] & 0xffff0000u) * y1[3]; }
    return a;
}
__device__ __forceinline__ void attn_naive(const Ctx& C, int slot) {
    const bf16* z = C.wsp<bf16>(WS_Z); bf16* y = C.wsp<bf16>(WS_Y); const int lane = C.lane;
    for (int item = MP * 16 + C.wg * 8 + C.wave; item < MT * 16; item += C.G * 8) {
        const int row = item >> 4, h = item & 15; int b, t, pi; bool samp; row_info(row, b, t, pi, samp);
        const bf16* zr = z + (size_t)row * A_IN;
        float mrun = -INFINITY, wsum = 0.f, acc0 = 0.f, acc1 = 0.f;
#pragma unroll
        for (int g = 0; g < 3; ++g) {
            const int win = g == 0 ? 128 : (g == 1 ? 512 : 2048), dil = g == 0 ? 1 : (g == 1 ? 4 : 16);
            const float* cache = C.cache1; if (g == 1) cache = C.cache2; if (g == 2) cache = C.cache3;
            const int qcol = (g * 3) * 2048 + h * 128, kcol = qcol + 2048, vcol = qcol + 4096;
            float sc[3];
#pragma unroll
            for (int u = 0; u < 3; ++u) {
                const int j = lane + 64 * u; float s = -INFINITY;
                if (j <= 128) {
                    if (!samp) { const int tok = t - dil * j; if (tok >= 0) s = dot128_bb(zr + qcol, z + (size_t)(b * S + tok) * A_IN + kcol); }
                    else { const int idx = win + t - dil * j;
                        if (idx >= win) s = dot128_bb(zr + qcol, z + (size_t)(MP + b * T + (idx - win)) * A_IN + kcol);
                        else s = dot128_bf(zr + qcol, cache + ((((size_t)slot * DB + b) * win + idx) * 2) * 2048 + h * 128); }
                    s *= 0.08838834764831845f;
                }
                sc[u] = s;
            }
            const float m = wave_max(fmaxf(sc[0], fmaxf(sc[1], sc[2])));
            float p[3]; float ps = 0.f;
#pragma unroll
            for (int u = 0; u < 3; ++u) { p[u] = __expf(sc[u] - m); ps += p[u]; }
            const float den = wave_sum(ps);
            const float lse = m + __logf(den);
            float o0 = 0.f, o1 = 0.f;
#pragma unroll
            for (int u = 0; u < 3; ++u) {
                const int cnt = u < 2 ? 64 : 1;
                for (int jj = 0; jj < cnt; ++jj) {
                    const int j = jj + 64 * u;
                    const float pj = __shfl(p[u], jj);
                    if (pj == 0.f) continue;
                    if (!samp) { const int tok = t - dil * j; const unsigned w = ((const unsigned*)(z + (size_t)(b * S + tok) * A_IN + vcol))[lane]; o0 += pj * __uint_as_float(w << 16); o1 += pj * __uint_as_float(w & 0xffff0000u); }
                    else { const int idx = win + t - dil * j;
                        if (idx >= win) { const unsigned w = ((const unsigned*)(z + (size_t)(MP + b * T + (idx - win)) * A_IN + vcol))[lane]; o0 += pj * __uint_as_float(w << 16); o1 += pj * __uint_as_float(w & 0xffff0000u); }
                        else { const f32x2 w = ((const f32x2*)(cache + ((((size_t)slot * DB + b) * win + idx) * 2 + 1) * 2048 + h * 128))[lane]; o0 += pj * w.x; o1 += pj * w.y; } }
                }
            }
            o0 /= den; o1 /= den;
            const float mnew = fmaxf(mrun, lse); const float sc_old = __expf(mrun - mnew), sc_new = __expf(lse - mnew);
            acc0 = acc0 * sc_old + sc_new * o0; acc1 = acc1 * sc_old + sc_new * o1; wsum = wsum * sc_old + sc_new; mrun = mnew;
        }
        const unsigned gw = ((const unsigned*)(zr + 18432 + h * 128))[lane];
        ((unsigned*)(y + (size_t)row * 2048 + h * 128))[lane] = pk2(acc0 / wsum * silu(__uint_as_float(gw << 16)), acc1 / wsum * silu(__uint_as_float(gw & 0xffff0000u)));
    }
}
template <bool GLA>
__device__ __forceinline__ void recur_naive(const Ctx& C, int ldz, int qoff, int koff, int voff, int H, int nseq, int ntok, int row0, const float* state0, float* state_out) {
    const bf16* z = C.wsp<bf16>(WS_Z); float* o = C.wsp<float>(WS_O); const float* loga = C.wsp<float>(WS_LOGA);
    LAS float* red = (LAS float*)C.lds;
    const int d = C.tid & 255, vh = C.tid >> 8, lane = C.lane, wave = C.wave;
    for (int item = C.wg; item < nseq * H * 8; item += C.G) {
        const int vs = item & 7, h = (item >> 3) % H, seq = (item >> 3) / H;
        const int v0 = vs * 64 + vh * 32;
        float Sreg[32];
        const size_t sbase = (((size_t)seq * H + h) * 256 + d) * 512 + v0;
#pragma unroll
        for (int i = 0; i < 32; ++i) Sreg[i] = state0 ? state0[sbase + i] : 0.f;
        float gamma = 1.f; if (!GLA) gamma = 1.0f - exp2f(-5.0f - (float)h);
        for (int t = 0; t < ntok; ++t) {
            const int row = row0 + seq * ntok + t; const bf16* zr = z + (size_t)row * ldz;
            const float qd = bf2f(zr[qoff + h * 256 + d]), kd = bf2f(zr[koff + h * 256 + d]);
            float dec = gamma; if (GLA) dec = __expf(loga[(size_t)row * 1024 + h * 256 + d]);
            const unsigned* vp = (const unsigned*)(zr + voff + h * 512 + v0);
            float p[32];
#pragma unroll
            for (int i = 0; i < 16; ++i) { const unsigned w = vp[i]; const float va = __uint_as_float(w << 16), vb = __uint_as_float(w & 0xffff0000u);
                Sreg[2 * i] = dec * Sreg[2 * i] + kd * va; Sreg[2 * i + 1] = dec * Sreg[2 * i + 1] + kd * vb; p[2 * i] = qd * Sreg[2 * i]; p[2 * i + 1] = qd * Sreg[2 * i + 1]; }
#pragma unroll
            for (int i = 0; i < 32; ++i) p[i] = wave_sum(p[i]);
            float mine = 0.f;
#pragma unroll
            for (int i = 0; i < 32; ++i) if (lane == i) mine = p[i];
            if (lane < 32) red[((t & 1) * 8 + wave) * 32 + lane] = mine;
            __syncthreads();
            if (d < 32) { const LAS float* rr = red + ((t & 1) * 8 + vh * 4) * 32 + d; o[(size_t)row * (H * 512) + h * 512 + v0 + d] = rr[0] + rr[32] + rr[64] + rr[96]; }
        }
#pragma unroll
        for (int i = 0; i < 32; ++i) state_out[sbase + i] = Sreg[i];
        __syncthreads();
    }
}
template <bool MEAN>
__device__ __forceinline__ void norm_gate(const Ctx& C, int H, int ldz, int goff, const float* gn) {
    const bf16* z = C.wsp<bf16>(WS_Z); const float* o = C.wsp<float>(WS_O); bf16* y = C.wsp<bf16>(WS_Y); const int lane = C.lane;
    for (int w = C.wg * 8 + C.wave; w < MT * H; w += C.G * 8) {
        const int row = w / H, h = w % H;
        const float* orow = o + (size_t)row * (H * 512) + h * 512; const bf16* gate = z + (size_t)row * ldz + goff + h * 512;
        const f32x4 a = ((const f32x4*)orow)[2 * lane], bq = ((const f32x4*)orow)[2 * lane + 1];
        float v[8] = {a[0], a[1], a[2], a[3], bq[0], bq[1], bq[2], bq[3]};
        float s = 0.f;
#pragma unroll
        for (int i = 0; i < 8; ++i) s += v[i];
        float mu = 0.f; if (MEAN) mu = wave_sum(s) * (1.f / 512.f);
        float q = 0.f;
#pragma unroll
        for (int i = 0; i < 8; ++i) { v[i] -= mu; q += v[i] * v[i]; }
        const float r = rsqrtf(wave_sum(q) * (1.f / 512.f) + EPS);
        const u32x4 gw = ((const u32x4*)gate)[lane]; const f32x4 g0 = ((const f32x4*)(gn + h * 512))[2 * lane], g1 = ((const f32x4*)(gn + h * 512))[2 * lane + 1];
        const float gg[8] = {g0[0], g0[1], g0[2], g0[3], g1[0], g1[1], g1[2], g1[3]};
        float ov[8];
#pragma unroll
        for (int i = 0; i < 4; ++i) { ov[2 * i] = v[2 * i] * r * gg[2 * i] * silu(__uint_as_float(gw[i] << 16)); ov[2 * i + 1] = v[2 * i + 1] * r * gg[2 * i + 1] * silu(__uint_as_float(gw[i] & 0xffff0000u)); }
        u32x4 ow; ow.x = pk2(ov[0], ov[1]); ow.y = pk2(ov[2], ov[3]); ow.z = pk2(ov[4], ov[5]); ow.w = pk2(ov[6], ov[7]);
        ((u32x4*)(y + (size_t)row * (H * 512) + h * 512))[lane] = ow;
    }
}
__device__ __forceinline__ void final_norm(const Ctx& C) {
    const float* xres = C.wsp<float>(WS_XRES); const float* ss = C.sumsq(4); const float* fg = C.final_g;
    for (int row = C.wg * 8 + C.wave; row < MT; row += C.G * 8) {
        const float rs = rstd_of(ss, row);
#pragma unroll
        for (int j = 0; j < 8; ++j) { const int c = 4 * C.lane + 256 * j; const f32x4 v = *(const f32x4*)(xres + (size_t)row * D + c), g = *(const f32x4*)(fg + c); *(f32x4*)(C.out + (size_t)row * D + c) = v * rs * g; }
    }
}

__device__ __forceinline__ void attn_fast_phase(const Ctx& C) {
    const bf16* z = C.wsp<bf16>(WS_Z); bf16* og = C.wsp<bf16>(WS_O); float* lse = C.wsp<float>(WS_LOGA);
    const int per = (3072 + C.G - 1) / C.G;
    for (int j = 0; j < per; ++j) { const int item = C.wg * per + j; if (item < 3072) attn_item(C.lds, z, A_IN, og, lse, item, C.tid); }
}
__device__ __forceinline__ void attn_merge(const Ctx& C) {
    const bf16* z = C.wsp<bf16>(WS_Z); const bf16* og = C.wsp<bf16>(WS_O); const float* lse = C.wsp<float>(WS_LOGA); bf16* y = C.wsp<bf16>(WS_Y);
    for (int row = C.wg * 8 + C.wave; row < MP; row += C.G * 8) {
#pragma unroll
        for (int j = 0; j < 4; ++j) {
            const int ch = C.lane + 64 * j, col = ch * 8, h = col >> 7;
            const float l0 = lse[((size_t)0 * MP + row) * 16 + h], l1 = lse[((size_t)1 * MP + row) * 16 + h], l2 = lse[((size_t)2 * MP + row) * 16 + h];
            const float m = fmaxf(l0, fmaxf(l1, l2)); float w0 = __expf(l0 - m), w1 = __expf(l1 - m), w2 = __expf(l2 - m); const float inv = 1.0f / (w0 + w1 + w2); w0 *= inv; w1 *= inv; w2 *= inv;
            const u32x4 a = *(const u32x4*)(og + ((size_t)0 * MP + row) * 2048 + col), b = *(const u32x4*)(og + ((size_t)1 * MP + row) * 2048 + col), c = *(const u32x4*)(og + ((size_t)2 * MP + row) * 2048 + col);
            const u32x4 gt = *(const u32x4*)(z + (size_t)row * A_IN + 18432 + col);
            u32x4 o;
#pragma unroll
            for (int k = 0; k < 4; ++k) {
                const float lo = (w0 * __uint_as_float(a[k] << 16) + w1 * __uint_as_float(b[k] << 16) + w2 * __uint_as_float(c[k] << 16)) * silu(__uint_as_float(gt[k] << 16));
                const float hi = (w0 * __uint_as_float(a[k] & 0xffff0000u) + w1 * __uint_as_float(b[k] & 0xffff0000u) + w2 * __uint_as_float(c[k] & 0xffff0000u)) * silu(__uint_as_float(gt[k] & 0xffff0000u));
                o[k] = pk2(lo, hi);
            }
            *(u32x4*)(y + (size_t)row * 2048 + col) = o;
        }
    }
}

template <int MODE>
__device__ __forceinline__ void gemm_in(const Ctx& C, size_t wt_off, int N, int layer, float* kvb, int slot) {
    pg8::Gemm g{C.wsp<pg8::bf16_t>(WS_XB), C.wsp<pg8::bf16_t>(wt_off), MP, N, D}; pg8::StaticOrder So; So.init(MP, N, C.G, C.wg);
    pg8::EpiIn<MODE> E{C.wsp<pg8::bf16_t>(WS_Z), N, C.sumsq(layer), (const pg8::f32x2*)C.wsp<f32x2>(MODE == 0 ? WS_TABA : WS_TABB), kvb, slot};
    pg8::gemm_phase<pg8::EpiIn<MODE>, pg8::StaticOrder, true, true>((PG8_LAS unsigned char*)C.lds, g, So, E);
}
template <int K>
__device__ __forceinline__ void gemm_out(const Ctx& C, size_t wt_off, int layer) {
    pg8::Gemm g{C.wsp<pg8::bf16_t>(WS_Y), C.wsp<pg8::bf16_t>(wt_off), MP, D, K}; pg8::StaticOrder So; So.init(MP, D, C.G, C.wg);
    pg8::EpiOut E{C.wsp<float>(WS_XRES), C.wsp<pg8::bf16_t>(WS_XB), C.sumsq(layer + 1)};
    pg8::gemm_phase<pg8::EpiOut, pg8::StaticOrder, true, true>((PG8_LAS unsigned char*)C.lds, g, So, E);
    float* xres = C.wsp<float>(WS_XRES); bf16* xb = C.wsp<bf16>(WS_XB); float* ssn = C.sumsq(layer + 1); const int lane = C.lane;
    skinny_gemm<K>(C, C.wsp<bf16>(WS_Y) + (size_t)MP * K, C.wsp<bf16>(wt_off), D, [=](int m, int n, float v) {
        const size_t o = (size_t)(MP + m) * D + n; const float x = xres[o] + v; xres[o] = x; xb[o] = (bf16)f2bf(x);
        float s = x * x; s += __shfl_xor(s, 16); s += __shfl_xor(s, 32); if ((lane >> 4) == 0) atomicAdd(ssn + MP + m, s); });
}
__device__ __forceinline__ void skinny_in(const Ctx& C, size_t wt_off, int N) {
    float* zs = C.wsp<float>(WS_ZSRAW);
    skinny_gemm<D>(C, C.wsp<bf16>(WS_XB) + (size_t)MP * D, C.wsp<bf16>(wt_off), N, [=](int m, int n, float v) { zs[(size_t)m * N + n] = v; });
}

__global__ void __launch_bounds__(NWG_THREADS, 2) mk_fwd(Params P) {
    extern __shared__ __attribute__((aligned(16))) unsigned char lds_raw[];
    Ctx C; C.lds = (LAS unsigned char*)lds_raw; C.tid = threadIdx.x; C.lane = C.tid & 63; C.wave = __builtin_amdgcn_readfirstlane(C.tid >> 6); C.G = gridDim.x; C.wg = blockIdx.x;
    C.x_prompt = P.in[0];
    C.x_sample = P.in[1];
    C.cache1 = P.in[2];
    C.cache2 = P.in[3];
    C.cache3 = P.in[4];
    C.state_b = P.in[5];
    C.state_c = P.in[6];
    C.norm_g = P.in[7];
    C.final_g = P.in[8];
    C.w_in_a = P.in[9];
    C.w_out_a = P.in[10];
    C.w_in_b = P.in[11];
    C.gn_b = P.in[12];
    C.w_out_b = P.in[13];
    C.w_in_c = P.in[14];
    C.w_gate2_c = P.in[15];
    C.b_gate_c = P.in[16];
    C.gn_c = P.in[17];
    C.w_out_c = P.in[18];
    C.out = P.out; C.ws = P.ws;
    volatile LAS unsigned* MISC = (volatile LAS unsigned*)(C.lds + MISC_OFF);
    if (C.tid < 32) MISC[C.tid] = 0u;
    __syncthreads();
    XcdBarrier bar = xcd_barrier_post((unsigned*)(P.ws + CTL_BAR), MISC + 8);
    int ph = 0;
#define RUN (ph >= P.ph_lo && ph < P.ph_hi)
#define SEAM() do { if (ph >= P.ph_lo && ph + 1 < P.ph_hi) xcd_barrier(bar); ++ph; } while (0)
    float* out = P.out;
    float* pkv1 = out + (size_t)MP * D + (size_t)MS * D; float* pkv2 = pkv1 + (size_t)2 * 4 * 128 * 4096; float* pkv3 = pkv2 + (size_t)2 * 4 * 512 * 4096;
    float* pst_b = pkv3 + (size_t)2 * 4 * 2048 * 4096; float* pst_c = pst_b + (size_t)4 * 8 * 256 * 512;
    float* sst_b = pst_c + (size_t)4 * 4 * 256 * 512 + (size_t)3 * 2 * 8 * 4 * 4096; float* sst_c = sst_b + (size_t)8 * 8 * 256 * 512;

    if (RUN) p0_prologue(C, P);
    SEAM();
    if (RUN) { gemm_in<0>(C, WS_WIA0, A_IN, 0, pkv1, 0); skinny_in(C, WS_WIA0, A_IN); }
    SEAM();
    if (RUN) sfix_a(C, 0, 0);
    SEAM();
    if (RUN) { attn_fast_phase(C); attn_naive(C, 0); }
    SEAM();
    if (RUN) attn_merge(C);
    SEAM();
    if (RUN) gemm_out<2048>(C, WS_WOA0, 0);
    SEAM();
    if (RUN) { gemm_in<1>(C, WS_WIB, B_IN, 1, nullptr, 0); skinny_in(C, WS_WIB, B_IN); }
    SEAM();
    if (RUN) sfix_b(C, 1);
    SEAM();
    if (RUN) { recur_naive<false>(C, B_IN, 0, 2048, 4096, 8, NB, S, 0, nullptr, pst_b); recur_naive<false>(C, B_IN, 0, 2048, 4096, 8, DB, T, MP, C.state_b, sst_b); }
    SEAM();
    if (RUN) norm_gate<true>(C, 8, B_IN, 8192, C.gn_b);
    SEAM();
    if (RUN) gemm_out<4096>(C, WS_WOB, 1);
    SEAM();
    if (RUN) { gemm_in<2>(C, WS_WIC, C_INM, 2, nullptr, 0); skinny_in(C, WS_WIC, C_INM);
        float* lr = C.wsp<float>(WS_LR);
        skinny_gemm<D>(C, C.wsp<bf16>(WS_WLR), C.wsp<bf16>(WS_XB), MT, [=](int m, int n, float v) { if (m < 16) lr[(size_t)m * MT + n] = v; }); }
    SEAM();
    if (RUN) sfix_c(C, 2);
    SEAM();
    if (RUN) { recur_naive<true>(C, C_INM, 0, 1024, 2048, 4, NB, S, 0, nullptr, pst_c); recur_naive<true>(C, C_INM, 0, 1024, 2048, 4, DB, T, MP, C.state_c, sst_c); }
    SEAM();
    if (RUN) norm_gate<false>(C, 4, C_INM, 4096, C.gn_c);
    SEAM();
    if (RUN) gemm_out<2048>(C, WS_WOC, 2);
    SEAM();
    if (RUN) { gemm_in<0>(C, WS_WIA1, A_IN, 3, pkv1, 1); skinny_in(C, WS_WIA1, A_IN); }
    SEAM();
    if (RUN) sfix_a(C, 3, 1);
    SEAM();
    if (RUN) { attn_fast_phase(C); attn_naive(C, 1); }
    SEAM();
    if (RUN) attn_merge(C);
    SEAM();
    if (RUN) gemm_out<2048>(C, WS_WOA1, 3);
    SEAM();
    if (RUN) final_norm(C);
#undef RUN
#undef SEAM
}
constexpr int NPHASES = 22;
}

#ifndef MK_LAUNCHES
#define MK_LAUNCHES 1
#endif
extern "C" void kernel_launch(void* const* d_in, const int* in_sizes, int n_in, void* d_out, int out_size, void* d_ws, size_t ws_size, hipStream_t stream) {
    using namespace mk;
    static int grid = 0;
    if (grid == 0) {
        int dev = 0, cus = 0;
        if (hipGetDevice(&dev) != hipSuccess || hipDeviceGetAttribute(&cus, hipDeviceAttributeMultiprocessorCount, dev) != hipSuccess) { fprintf(stderr, "kernel_launch: device query failed\n"); grid = -1; return; }
        if (hipFuncSetAttribute((const void*)mk_fwd, hipFuncAttributeMaxDynamicSharedMemorySize, LDS_BYTES) != hipSuccess) { fprintf(stderr, "kernel_launch: hipFuncSetAttribute failed\n"); grid = -1; return; }
        int per_cu = 0;
        if (hipOccupancyMaxActiveBlocksPerMultiprocessor(&per_cu, (const void*)mk_fwd, NWG_THREADS, LDS_BYTES) != hipSuccess || per_cu < 1) fprintf(stderr, "kernel_launch: occupancy query says %d\n", per_cu);
        (void)hipGetLastError();
        if (ws_size < WS_END) { fprintf(stderr, "kernel_launch: workspace too small (%zu < %zu)\n", ws_size, (size_t)WS_END); grid = -1; return; }
        grid = cus;
    }
    if (grid < 0) return;
    (void)hipMemsetAsync((char*)d_ws + WS_CTL, 0, CTL_ZERO_BYTES, stream);
    Params p{};
    for (int i = 0; i < 19; ++i) p.in[i] = (const float*)d_in[i];
    p.out = (float*)d_out; p.ws = (unsigned char*)d_ws;
    for (int i = 0; i < 16; ++i) p.inv_a[i] = pow(500000.0, -(double)i / 16.0);
    for (int i = 0; i < 128; ++i) p.inv_b[i] = pow(10000.0, -(double)i / 128.0);
    if (MK_LAUNCHES == 1) { p.ph_lo = 0; p.ph_hi = NPHASES; hipLaunchKernelGGL(mk_fwd, dim3(grid), dim3(NWG_THREADS), LDS_BYTES, stream, p); }
    else for (int k = 0; k < NPHASES; ++k) { p.ph_lo = k; p.ph_hi = k + 1; hipLaunchKernelGGL(mk_fwd, dim3(grid), dim3(NWG_THREADS), LDS_BYTES, stream, p); }
}
```

```cpp
#include <hip/hip_runtime.h>
#include <cstdio>
#include <cstdint>
#include <cmath>
namespace pg8 {
#define PG8_LAS __attribute__((address_space(3)))
typedef unsigned short bf16_t;
typedef short bf16x8 __attribute__((ext_vector_type(8)));
typedef float f32x4 __attribute__((ext_vector_type(4)));
typedef unsigned u32x4 __attribute__((ext_vector_type(4)));
constexpr int BM = 256, BK = 64, HALF = 128, HTB = HALF * BK * 2  , STAGE_BYTES = 8 * HTB, NXCD = 8, WGM = 8;

__host__ __device__ __forceinline__ int lds_byte(int r, int c) { const int st = (r >> 4) * 2 + (c >> 5), rr = r & 15, cc = c & 31, ob = rr * 64 + cc * 2; return st * 1024 + (ob ^ (((ob >> 9) & 1) << 5)); }
__host__ __device__ __forceinline__ void stage_rc(int b, int& R, int& C) { const int st = b / 1024, sb = b % 1024, swz = sb ^ (((sb >> 9) & 1) << 5); R = (st >> 1) * 16 + swz / 64; C = (st & 1) * 32 + (swz % 64) / 2; }
__host__ __device__ __forceinline__ int perm32(int rho) { const int n = rho >> 4, i = rho & 15; return 8 * (i >> 2) + 4 * n + (i & 3); }

struct Unit { int pm, pn; };
struct Gemm { const bf16_t* A; const bf16_t* Bt; int M, N, K; };

struct StaticOrder {
    int nM, nN, nwg, G, c;
    __host__ __device__ void init(int M, int N, int G_, int c_) { nM = M / BM; nN = N / BM; nwg = nM * nN; G = G_; c = c_; }
    __host__ __device__ bool next(int i, Unit& u) const {
        const long L = (long)i * G + c; if (L >= nwg) return false;
        int wgid = (int)L; { const int q = nwg / NXCD, r = nwg % NXCD, xcd = wgid % NXCD, off = wgid / NXCD; wgid = (xcd < r ? xcd * (q + 1) : r * (q + 1) + (xcd - r) * q) + off; }
        const int nig = WGM * nN, gid = wgid / nig, fm = gid * WGM, gsz = (nM - fm) < WGM ? (nM - fm) : WGM;
        u.pm = fm + ((wgid % nig) % gsz); u.pn = (wgid % nig) / gsz; return true;
    }
    __device__ __forceinline__ void a_ready(const Unit&) const {}
    __device__ __forceinline__ void done(const Unit&) const {}
};

__device__ __forceinline__ unsigned cvt_pk_bf16(float lo, float hi) { unsigned r; asm volatile("v_cvt_pk_bf16_f32 %0, %1, %2" : "=v"(r) : "v"(lo), "v"(hi)); return r; }
typedef float f32x2 __attribute__((ext_vector_type(2)));
typedef unsigned u32x2 __attribute__((ext_vector_type(2)));

template <int MODE> struct EpiIn {
    static constexpr bool PERM = true, AFTER_DRAIN = false;
    bf16_t* Z; int ldz; const float* sumsq; const f32x2* tab; float* kvb; int slot;
    __device__ __forceinline__ void store8(bf16_t* p, const f32x4& a, const f32x4& b) const {
        u32x4 w; w.x = cvt_pk_bf16(a[0], a[1]); w.y = cvt_pk_bf16(a[2], a[3]); w.z = cvt_pk_bf16(b[0], b[1]); w.w = cvt_pk_bf16(b[2], b[3]); *(u32x4*)p = w; }
    __device__ __forceinline__ void operator()(const f32x4 (&acc)[2][2][4][2], const Unit& u, int wr, int wc, int fr, int fq) const {
        const int row0 = u.pm * BM + wr * 64 + fr, colt = u.pn * BM;
        if constexpr (MODE == 0) {
            const int section = u.pn >> 3, kind = section < 9 ? section % 3 : 3, g = section / 3;
            const bool rot = (kind < 2) && (wc == 0);
            const int gg = g > 2 ? 2 : g, keep = 128 << (2 * gg); float* kvo = kvb + (size_t)32768 * (size_t)(128 * (((1 << (2 * gg)) - 1) / 3)) + (size_t)slot * 4 * keep * 4096;
#pragma unroll
            for (int ai = 0; ai < 2; ++ai)
#pragma unroll
                for (int m = 0; m < 4; ++m) {
                    const int row = row0 + ai * HALF + m * 16; const float rs = rsqrtf(sumsq[row] * (1.0f / 2048.0f) + 1e-6f); const int pos = row & 2047, b = row >> 11;
#pragma unroll
                    for (int bj = 0; bj < 2; ++bj) {
                        f32x4 v0 = acc[ai][bj][m][0] * rs, v1 = acc[ai][bj][m][1] * rs;
                        const int col = colt + bj * HALF + wc * 32 + 8 * fq;
                        if (rot) {
                            f32x4 p0, p1;
#pragma unroll
                            for (int j = 0; j < 4; ++j) { p0[j] = __shfl_xor(v0[j], 32); p1[j] = __shfl_xor(v1[j], 32); }
                            const f32x4* tp = (const f32x4*)(tab + pos * 16 + 8 * (fq & 1));
                            const f32x4 t0 = tp[0], t1 = tp[1], t2 = tp[2], t3 = tp[3];
                            const f32x4 c0 = {t0[0], t0[2], t1[0], t1[2]}, s0 = {t0[1], t0[3], t1[1], t1[3]}, c1 = {t2[0], t2[2], t3[0], t3[2]}, s1 = {t2[1], t2[3], t3[1], t3[3]};
                            if (fq < 2) { v0 = v0 * c0 - p0 * s0; v1 = v1 * c1 - p1 * s1; } else { v0 = p0 * s0 + v0 * c0; v1 = p1 * s1 + v1 * c1; }
                        }
                        store8(Z + (size_t)row * ldz + col, v0, v1);
                        if (kind == 1 || kind == 2) {
                            if (pos >= 2048 - keep) { float* o = kvo + (((size_t)b * keep + (pos - (2048 - keep))) * 2 + (kind - 1)) * 2048 + (col - section * 2048);
                                *(f32x4*)o = v0; *(f32x4*)(o + 4) = v1; }
                        }
                    }
                }
        } else if constexpr (MODE == 1) {
            const bool rot = u.pn < 16; const float sc = (u.pn >= 8 && u.pn < 16) ? 0.0625f : 1.0f;
            const float lg2 = log2f(1.0f - exp2f(-5.0f - (float)(u.pn & 7)));
#pragma unroll
            for (int ai = 0; ai < 2; ++ai)
#pragma unroll
                for (int m = 0; m < 4; ++m) {
                    const int row = row0 + ai * HALF + m * 16; const int pos = row & 2047;
                    float rs = rsqrtf(sumsq[row] * (1.0f / 2048.0f) + 1e-6f) * sc;
                    if (rot) { const float ee = (float)((pos & 127) + 1) * lg2; rs *= exp2f(u.pn < 8 ? ee : -ee); }
                    f32x4 x1[2], x2[2];
#pragma unroll
                    for (int n = 0; n < 2; ++n) { x1[n] = acc[ai][0][m][n] * rs; x2[n] = acc[ai][1][m][n] * rs; }
                    if (rot) {
#pragma unroll
                        for (int n = 0; n < 2; ++n) {
                            const f32x4* tp = (const f32x4*)(tab + pos * 128 + wc * 32 + 8 * fq + 4 * n);
                            const f32x4 t0 = tp[0], t1 = tp[1];
                            const f32x4 c = {t0[0], t0[2], t1[0], t1[2]}, s = {t0[1], t0[3], t1[1], t1[3]};
                            const f32x4 a = x1[n], bb = x2[n];
                            x1[n] = a * c - bb * s; x2[n] = a * s + bb * c;
                        }
                    }
                    bf16_t* zp = Z + (size_t)row * ldz + colt + wc * 32 + 8 * fq;
                    store8(zp, x1[0], x1[1]); store8(zp + HALF, x2[0], x2[1]);
                }
        } else {
            const float sc = u.pn < 4 ? 0.0625f : 1.0f;
#pragma unroll
            for (int ai = 0; ai < 2; ++ai)
#pragma unroll
                for (int m = 0; m < 4; ++m) {
                    const int row = row0 + ai * HALF + m * 16; const float rs = rsqrtf(sumsq[row] * (1.0f / 2048.0f) + 1e-6f) * sc;
                    bf16_t* zp = Z + (size_t)row * ldz + colt + wc * 32 + 8 * fq;
#pragma unroll
                    for (int bj = 0; bj < 2; ++bj) store8(zp + bj * HALF, acc[ai][bj][m][0] * rs, acc[ai][bj][m][1] * rs);
                }
        }
    }
};
struct EpiOut {
    static constexpr bool PERM = false, AFTER_DRAIN = false;
    float* xres; bf16_t* xb; float* sumsq_next;
    __device__ __forceinline__ void operator()(const f32x4 (&acc)[2][2][4][2], const Unit& u, int wr, int wc, int fr, int fq) const {
        const int row0 = u.pm * BM + wr * 64 + fr, col0 = u.pn * BM + wc * 32 + 4 * fq;
#pragma unroll
        for (int ai = 0; ai < 2; ++ai)
#pragma unroll
            for (int m = 0; m < 4; ++m) {
                const int row = row0 + ai * HALF + m * 16; float ss = 0.f;
                float* xr = xres + (size_t)row * 2048 + col0; bf16_t* br = xb + (size_t)row * 2048 + col0;
#pragma unroll
                for (int bj = 0; bj < 2; ++bj)
#pragma unroll
                    for (int n = 0; n < 2; ++n) {
                        const f32x4 v = *(const f32x4*)(xr + bj * HALF + n * 16) + acc[ai][bj][m][n];
                        *(f32x4*)(xr + bj * HALF + n * 16) = v;
                        u32x2 w; w.x = cvt_pk_bf16(v[0], v[1]); w.y = cvt_pk_bf16(v[2], v[3]); *(u32x2*)(br + bj * HALF + n * 16) = w;
                        ss += (v[0] * v[0] + v[1] * v[1]) + (v[2] * v[2] + v[3] * v[3]);
                    }
                ss += __shfl_xor(ss, 16); ss += __shfl_xor(ss, 32);
                if (fq == 0) atomicAdd(sumsq_next + row, ss);
            }
    }
};
template <class Epi, class Sched, bool ALIGN_EPI = false, bool SP2 = false>
__device__ __forceinline__ void gemm_phase(PG8_LAS unsigned char* lds, const Gemm g, const Sched& S, const Epi& E) {
    const int tid = threadIdx.x, wid = __builtin_amdgcn_readfirstlane(tid >> 6), lane = tid & 63, wr = wid >> 2, wc = wid & 3, fr = lane & 15, fq = lane >> 4;
    const int K = g.K, nt = K / BK;
    unsigned voffA[2], voffB[2];
#pragma unroll
    for (int i = 0; i < 2; ++i) { int R, C; stage_rc(tid * 16 + i * 8192, R, C); const int Rb = Epi::PERM ? ((R & ~31) + perm32(R & 31)) : R;
        voffA[i] = (unsigned)(R * K + C) * 2u; voffB[i] = (unsigned)(Rb * K + C) * 2u; }
    const size_t kstep = (size_t)(BK * 2);
    const size_t hstep = (size_t)HALF * K * 2;
    const size_t tstep = 2 * hstep;
    const unsigned ldsw = (unsigned)wid * 1024u;
    const int aoff = lds_byte(wr * 64 + fr, fq * 8), boff = lds_byte(wc * 32 + fr, fq * 8);
#define PG8_SA(b, h) (((b) * 2 + (h)) * HTB)
#define PG8_SB(b, h) ((4 + (b) * 2 + (h)) * HTB)
#define PG8_STAGE(bufoff, gbase, voff) do { _Pragma("unroll") for (int _i = 0; _i < 2; ++_i) \
        __builtin_amdgcn_global_load_lds((const unsigned*)((const char*)(gbase) + (voff)[_i]), (PG8_LAS unsigned*)(lds + (bufoff) + ldsw + _i * 8192), 16, 0, 0); } while (0)
#define PG8_LDA(dst, b, h) do { _Pragma("unroll") for (int m = 0; m < 4; ++m) _Pragma("unroll") for (int k = 0; k < 2; ++k) dst[m][k] = *(const PG8_LAS bf16x8*)(lds + PG8_SA(b, h) + aoff + m * 2048 + k * 1024); } while (0)
#define PG8_LDB(dst, b, h) do { _Pragma("unroll") for (int n = 0; n < 2; ++n) _Pragma("unroll") for (int k = 0; k < 2; ++k) dst[n][k] = *(const PG8_LAS bf16x8*)(lds + PG8_SB(b, h) + boff + n * 2048 + k * 1024); } while (0)
#define PG8_MMA(ai, bj, At, Bt) do { __builtin_amdgcn_s_setprio(1); _Pragma("unroll") for (int m = 0; m < 4; ++m) _Pragma("unroll") for (int n = 0; n < 2; ++n) _Pragma("unroll") for (int k = 0; k < 2; ++k) \
        acc[ai][bj][m][n] = __builtin_amdgcn_mfma_f32_16x16x32_bf16(Bt[n][k], At[m][k], acc[ai][bj][m][n], 0, 0, 0); __builtin_amdgcn_s_setprio(0); } while (0)
#define PG8_WAIT_V(n) asm volatile("s_waitcnt vmcnt(" #n ")" ::: "memory")
#define PG8_WAIT_L(n) asm volatile("s_waitcnt lgkmcnt(" #n ")" ::: "memory")
#define PG8_BAR __builtin_amdgcn_s_barrier()
#define PG8_SCHED __builtin_amdgcn_sched_barrier(0)
    Unit cur, nxt; int ui = 0;
    if (!S.next(0, cur)) return;
    f32x4 acc[2][2][4][2];
#pragma unroll
    for (int a = 0; a < 2; ++a)
#pragma unroll
        for (int b = 0; b < 2; ++b)
#pragma unroll
            for (int m = 0; m < 4; ++m)
#pragma unroll
                for (int n = 0; n < 2; ++n) acc[a][b][m][n] = (f32x4){0.f, 0.f, 0.f, 0.f};
    bf16x8 At[4][2], B0[2][2], B1[2][2];
    const char* cA = (const char*)g.A + (size_t)cur.pm * tstep; const char* cB = (const char*)g.Bt + (size_t)cur.pn * tstep;
    S.a_ready(cur);
    if constexpr (SP2) {
        PG8_STAGE(PG8_SB(0, 0), cB, voffB); PG8_STAGE(PG8_SB(0, 1), cB + hstep, voffB); PG8_STAGE(PG8_SA(0, 0), cA, voffA); PG8_STAGE(PG8_SA(0, 1), cA + hstep, voffA);
        if (wr == 1) PG8_BAR;
        PG8_WAIT_V(2); PG8_BAR;
        PG8_STAGE(PG8_SB(1, 0), cB + kstep, voffB); PG8_STAGE(PG8_SA(1, 0), cA + kstep, voffA); PG8_STAGE(PG8_SB(1, 1), cB + hstep + kstep, voffB);
        PG8_WAIT_V(6); PG8_BAR;
    } else {
        PG8_STAGE(PG8_SB(0, 0), cB, voffB); PG8_STAGE(PG8_SA(0, 0), cA, voffA); PG8_STAGE(PG8_SB(0, 1), cB + hstep, voffB); PG8_STAGE(PG8_SA(0, 1), cA + hstep, voffA);
        if (wr == 1) PG8_BAR;
        PG8_WAIT_V(4); PG8_BAR;
        PG8_STAGE(PG8_SB(1, 0), cB + kstep, voffB); PG8_STAGE(PG8_SA(1, 0), cA + kstep, voffA); PG8_STAGE(PG8_SB(1, 1), cB + hstep + kstep, voffB);
        PG8_WAIT_V(6); PG8_BAR;
    }
    for (;;) {
        const bool has_next = S.next(ui + 1, nxt);
        const char* nA = has_next ? (const char*)g.A + (size_t)nxt.pm * tstep : cA; const char* nB = has_next ? (const char*)g.Bt + (size_t)nxt.pn * tstep : cB;
        for (int t = 0; t < nt; t += 2) {
            const bool last = (t == nt - 2);
            const char* a1 = cA + (size_t)(t + 1) * kstep;
            const char* a2 = last ? nA : cA + (size_t)(t + 2) * kstep; const char* b2 = last ? nB : cB + (size_t)(t + 2) * kstep;
            const char* a3 = a2 + kstep; const char* b3 = b2 + kstep;
            if (last && has_next) S.a_ready(nxt);
            if constexpr (SP2) {
            PG8_LDB(B0, 0, 0); PG8_LDB(B1, 0, 1); PG8_SCHED; PG8_LDA(At, 0, 0); PG8_STAGE(PG8_SA(1, 1), a1 + hstep, voffA);
            PG8_WAIT_V(8); PG8_WAIT_L(0); PG8_BAR; PG8_MMA(0, 0, At, B0); PG8_MMA(0, 1, At, B1); PG8_BAR; PG8_SCHED;
            PG8_LDA(At, 0, 1); PG8_STAGE(PG8_SB(0, 0), b2, voffB); PG8_STAGE(PG8_SB(0, 1), b2 + hstep, voffB); PG8_STAGE(PG8_SA(0, 0), a2, voffA);
            PG8_WAIT_V(8); PG8_WAIT_L(0); PG8_BAR; PG8_MMA(1, 0, At, B0); PG8_MMA(1, 1, At, B1); PG8_BAR; PG8_SCHED;
            PG8_LDB(B0, 1, 0); PG8_LDB(B1, 1, 1); PG8_SCHED; PG8_LDA(At, 1, 0); PG8_STAGE(PG8_SA(0, 1), a2 + hstep, voffA);
            PG8_WAIT_V(8); PG8_WAIT_L(0); PG8_BAR; PG8_MMA(0, 0, At, B0); PG8_MMA(0, 1, At, B1); PG8_BAR; PG8_SCHED;
            PG8_LDA(At, 1, 1); PG8_STAGE(PG8_SB(1, 0), b3, voffB); PG8_STAGE(PG8_SB(1, 1), b3 + hstep, voffB); PG8_STAGE(PG8_SA(1, 0), a3, voffA);
            PG8_WAIT_V(8); PG8_WAIT_L(0); PG8_BAR; PG8_MMA(1, 0, At, B0); PG8_MMA(1, 1, At, B1); PG8_BAR; PG8_SCHED;
            } else {
            PG8_LDB(B0, 0, 0); PG8_SCHED; PG8_LDA(At, 0, 0); PG8_STAGE(PG8_SA(1, 1), a1 + hstep, voffA);
            PG8_WAIT_L(8); PG8_BAR; PG8_WAIT_L(0); PG8_MMA(0, 0, At, B0); PG8_BAR; PG8_SCHED;
            PG8_LDB(B1, 0, 1); PG8_STAGE(PG8_SB(0, 0), b2, voffB);
            PG8_BAR; PG8_WAIT_L(0); PG8_MMA(0, 1, At, B1); PG8_BAR;
            PG8_LDA(At, 0, 1); PG8_STAGE(PG8_SA(0, 0), a2, voffA);
            PG8_BAR; PG8_WAIT_L(0); PG8_MMA(1, 0, At, B0); PG8_BAR; PG8_SCHED;
            PG8_STAGE(PG8_SB(0, 1), b2 + hstep, voffB);
            PG8_WAIT_V(6); PG8_BAR; PG8_MMA(1, 1, At, B1); PG8_BAR;
            PG8_LDB(B0, 1, 0); PG8_SCHED; PG8_LDA(At, 1, 0); PG8_STAGE(PG8_SA(0, 1), a2 + hstep, voffA);
            PG8_WAIT_L(8); PG8_BAR; PG8_WAIT_L(0); PG8_MMA(0, 0, At, B0); PG8_BAR; PG8_SCHED;
            PG8_LDB(B1, 1, 1); PG8_STAGE(PG8_SB(1, 0), b3, voffB);
            PG8_BAR; PG8_WAIT_L(0); PG8_MMA(0, 1, At, B1); PG8_BAR;
            PG8_LDA(At, 1, 1); PG8_STAGE(PG8_SA(1, 0), a3, voffA);
            PG8_BAR; PG8_WAIT_L(0); PG8_MMA(1, 0, At, B0); PG8_BAR; PG8_SCHED;
            PG8_STAGE(PG8_SB(1, 1), b3 + hstep, voffB);
            PG8_WAIT_V(6); PG8_BAR; PG8_MMA(1, 1, At, B1); PG8_BAR;
            }
        }
        if constexpr (ALIGN_EPI) { if (wr == 0) PG8_BAR; }
        if constexpr (!Epi::AFTER_DRAIN) { E(acc, cur, wr, wc, fr, fq); S.done(cur); }
        if (!has_next) break;
#pragma unroll
        for (int a = 0; a < 2; ++a)
#pragma unroll
            for (int b = 0; b < 2; ++b)
#pragma unroll
                for (int m = 0; m < 4; ++m)
#pragma unroll
                    for (int n = 0; n < 2; ++n) acc[a][b][m][n] = (f32x4){0.f, 0.f, 0.f, 0.f};
        cur = nxt; cA = nA; cB = nB; ++ui;
        if constexpr (ALIGN_EPI) { if (wr == 1) PG8_BAR; }
    }
    PG8_WAIT_V(0);
    if constexpr (!ALIGN_EPI) { if (wr == 0) PG8_BAR; }
    PG8_BAR;
    if constexpr (Epi::AFTER_DRAIN) { E.fused(acc, cur, wr, wc, fr, fq, lds, wid, lane); S.done(cur); }
#undef PG8_SA
#undef PG8_SB
#undef PG8_STAGE
#undef PG8_LDA
#undef PG8_LDB
#undef PG8_MMA
#undef PG8_WAIT_V
#undef PG8_WAIT_L
#undef PG8_BAR
#undef PG8_SCHED
}
}
#define LAS __attribute__((address_space(3)))
#define XB_TMO      128
#define XB_XCNT(j)  (256  + 64 * (j))
#define XB_XSUB(j)  (1280 + 64 * (j))
#define XB_XGEN(j)  (2304 + 64 * (j))
#define XB_TOP      3328
#define XB_TOPGEN   3392
#define XCD_BAR_WORDS 3456
#define XB_SPIN_CAP (1u << 18)

__device__ __forceinline__ unsigned xb_ld(unsigned* p)              { return __hip_atomic_load(p, __ATOMIC_RELAXED, __HIP_MEMORY_SCOPE_AGENT); }
__device__ __forceinline__ unsigned xb_add(unsigned* p, unsigned v) { return __hip_atomic_fetch_add(p, v, __ATOMIC_RELAXED, __HIP_MEMORY_SCOPE_AGENT); }
__device__ __forceinline__ unsigned xb_xcc_id() { return (unsigned)__builtin_amdgcn_s_getreg((3 << 11) | 20) & 0xFu; }
#define XB_SPIN(cond, bar) do { unsigned _sp = 0; while (cond) { __builtin_amdgcn_s_sleep(1); \
    if ((++_sp & 255u) == 0u) { if (xb_ld(&(bar)[XB_TMO])) break; if (_sp > XB_SPIN_CAP) { atomicAdd(&(bar)[XB_TMO], 1u); break; } } } } while (0)

struct XcdBarrier {
    unsigned* bar; unsigned x;
    volatile LAS unsigned* st;
};

__device__ __forceinline__ XcdBarrier xcd_barrier_post(unsigned* bar, volatile LAS unsigned* st) {
    XcdBarrier b; b.bar = bar; b.x = xb_xcc_id(); b.st = st;
    if (threadIdx.x == 0) (void)xb_add(&bar[XB_XCNT(b.x)], 1u);
    return b;
}
__device__ __forceinline__ void xcd_barrier_complete(unsigned* bar, unsigned x, unsigned& nloc, unsigned& nx) {
    const unsigned G = gridDim.x * gridDim.y * gridDim.z;
    unsigned sum, cnt, mine, sp = 0u;
    for (;;) {
        sum = 0u; cnt = 0u; mine = 0u;
#pragma unroll
        for (unsigned j = 0; j < 16; ++j) { const unsigned c = xb_ld(&bar[XB_XCNT(j)]); sum += c; cnt += (c > 0u) ? 1u : 0u; mine = (j == x) ? c : mine; }
        if (sum == G) break;
        __builtin_amdgcn_s_sleep(1);
        if ((++sp & 255u) == 0u) { if (xb_ld(&bar[XB_TMO])) break; if (sp > XB_SPIN_CAP) { atomicAdd(&bar[XB_TMO], 1u); break; } }
    }
    nloc = mine > 0u ? mine : 1u; nx = cnt > 0u ? cnt : 1u;
}

__device__ __forceinline__ void xcd_barrier(const XcdBarrier& b) {
    asm volatile("s_waitcnt vmcnt(0)" ::: "memory");
    __syncthreads();
    if (threadIdx.x == 0) {
        unsigned* bar = b.bar;
        __builtin_amdgcn_s_waitcnt(0);
        unsigned nloc = b.st[0], nx = b.st[1];
        if (nloc == 0u) { xcd_barrier_complete(bar, b.x, nloc, nx); b.st[0] = nloc; b.st[1] = nx; }
        const unsigned old = xb_add(&bar[XB_XSUB(b.x)], 1u);
        const unsigned gen = old / nloc;
        if (old + 1u == (gen + 1u) * nloc) {
            __builtin_amdgcn_fence(__ATOMIC_RELEASE, "agent");
            asm volatile("s_waitcnt vmcnt(0)" ::: "memory");
            const unsigned og = xb_add(&bar[XB_TOP], 1u);
            const unsigned tg = og / nx;
            if (og + 1u == (tg + 1u) * nx) xb_add(&bar[XB_TOPGEN], 1u);
            else XB_SPIN(xb_ld(&bar[XB_TOPGEN]) == tg, bar);
            __builtin_amdgcn_fence(__ATOMIC_ACQUIRE, "agent");
            xb_add(&bar[XB_XGEN(b.x)], 1u);
            asm volatile("s_waitcnt vmcnt(0)" ::: "memory");
        } else {
            XB_SPIN(xb_ld(&bar[XB_XGEN(b.x)]) == gen, bar);
            __builtin_amdgcn_fence(__ATOMIC_ACQUIRE, "agent");
            asm volatile("s_waitcnt vmcnt(0)" ::: "memory");
        }
    }
    __syncthreads();
}
#ifdef EMU
#include <pthread.h>
#include <cstring>
#include <cstdio>
#include <cstdlib>
#include <cmath>
#include <cstdint>
#define DEV static inline
#define LAS
struct EmuDim { int x; };
static thread_local EmuDim threadIdx;
typedef short bf16x8 __attribute__((ext_vector_type(8)));
typedef short s16x4 __attribute__((ext_vector_type(4)));
typedef float f32x4 __attribute__((ext_vector_type(4)));
typedef float f32x2 __attribute__((ext_vector_type(2)));
typedef unsigned u32x4 __attribute__((ext_vector_type(4)));
typedef unsigned u32x2 __attribute__((ext_vector_type(2)));
struct WaveX { bf16x8 a[64], b[64]; float f[64]; const void* p[64]; pthread_barrier_t bar; };
static WaveX g_wx[8];
static pthread_barrier_t g_wgbar;
static inline float emu_bf2f(short v) { unsigned u = ((unsigned)(unsigned short)v) << 16; float f; memcpy(&f, &u, 4); return f; }
static inline float __uint_as_float(unsigned u) { float f; memcpy(&f, &u, 4); return f; }
static inline unsigned __float_as_uint(float f) { unsigned u; memcpy(&u, &f, 4); return u; }
DEV f32x4 mfma16(bf16x8 a, bf16x8 b, f32x4 c) {
    const int lane = threadIdx.x & 63; WaveX& W = g_wx[threadIdx.x >> 6];
    W.a[lane] = a; W.b[lane] = b; pthread_barrier_wait(&W.bar);
    f32x4 r; const int g = lane >> 4, j = lane & 15;
    for (int rr = 0; rr < 4; ++rr) { const int i = 4 * g + rr; float s = 0.f;
        for (int k = 0; k < 32; ++k) s += emu_bf2f(W.a[i + 16 * (k / 8)][k % 8]) * emu_bf2f(W.b[j + 16 * (k / 8)][k % 8]);
        r[rr] = c[rr] + s; }
    pthread_barrier_wait(&W.bar); return r;
}
DEV s16x4 tr_read(const void* p) {
    const int lane = threadIdx.x & 63; WaveX& W = g_wx[threadIdx.x >> 6];
    W.p[lane] = p; pthread_barrier_wait(&W.bar);
    s16x4 r; const int G = lane >> 4, i = lane & 15;
    for (int q = 0; q < 4; ++q) { const short* src = (const short*)W.p[16 * G + 4 * q + i / 4]; if (((uintptr_t)src) & 7) { fprintf(stderr, "tr_read: unaligned\n"); abort(); } r[q] = src[i % 4]; }
    pthread_barrier_wait(&W.bar); return r;
}
DEV void lds_wait() {}
#define tr_read_o(base, off) tr_read((const unsigned char*)(base) + (off))
DEV float shflx(float v, int m) { const int lane = threadIdx.x & 63; WaveX& W = g_wx[threadIdx.x >> 6]; W.f[lane] = v; pthread_barrier_wait(&W.bar); const float r = W.f[lane ^ m]; pthread_barrier_wait(&W.bar); return r; }
DEV void wg_sync() { pthread_barrier_wait(&g_wgbar); }
DEV void mem_fence_cc() {}
DEV float fast_exp2(float x) { return exp2f(x); }
DEV float fast_log2(float x) { return log2f(x); }
DEV float fast_rcp(float x) { return 1.0f / x; }
DEV unsigned cvt_pk_bf16(float lo, float hi) { auto f = [](float x) { unsigned u = __float_as_uint(x); return (u + 0x7fffu + ((u >> 16) & 1u)) >> 16; }; return f(lo) | (f(hi) << 16); }
#else
#define DEV __device__ __forceinline__
typedef short bf16x8 __attribute__((ext_vector_type(8)));
typedef short s16x4 __attribute__((ext_vector_type(4)));
typedef float f32x4 __attribute__((ext_vector_type(4)));
typedef float f32x2 __attribute__((ext_vector_type(2)));
typedef unsigned u32x4 __attribute__((ext_vector_type(4)));
typedef unsigned u32x2 __attribute__((ext_vector_type(2)));
DEV f32x4 mfma16(bf16x8 a, bf16x8 b, f32x4 c) { return __builtin_amdgcn_mfma_f32_16x16x32_bf16(a, b, c, 0, 0, 0); }
DEV s16x4 tr_read(const LAS void* p) { s16x4 r; asm volatile("ds_read_b64_tr_b16 %0, %1" : "=&v"(r) : "v"((unsigned)(size_t)p) : "memory"); return r; }
DEV s16x4 tr_read_o(const LAS void* p, int off) { s16x4 r; asm volatile("ds_read_b64_tr_b16 %0, %1 offset:%2" : "=&v"(r) : "v"((unsigned)(size_t)p), "i"(off) : "memory"); return r; }
DEV void lds_wait() { asm volatile("s_waitcnt lgkmcnt(0)" ::: "memory"); __builtin_amdgcn_sched_barrier(0); }
DEV float shflx(float v, int m) { return __shfl_xor(v, m); }
DEV void wg_sync() { __syncthreads(); }
DEV void mem_fence_cc() { asm volatile("" ::: "memory"); }
DEV float fast_exp2(float x) { return __builtin_amdgcn_exp2f(x); }
DEV float fast_log2(float x) { return __builtin_amdgcn_logf(x); }
DEV float fast_rcp(float x) { return __builtin_amdgcn_rcpf(x); }
DEV unsigned cvt_pk_bf16(float lo, float hi) { unsigned r; asm volatile("v_cvt_pk_bf16_f32 %0, %1, %2" : "=v"(r) : "v"(lo), "v"(hi)); return r; }
#endif
typedef unsigned short bf16;
DEV bf16x8 pack8(s16x4 lo, s16x4 hi) { return (bf16x8){lo[0], lo[1], lo[2], lo[3], hi[0], hi[1], hi[2], hi[3]}; }

namespace mk {
typedef unsigned short bf16;
typedef float f32x4 __attribute__((ext_vector_type(4)));
typedef float f32x2 __attribute__((ext_vector_type(2)));
typedef unsigned u32x4 __attribute__((ext_vector_type(4)));
typedef unsigned u32x2 __attribute__((ext_vector_type(2)));
typedef short bf16x8 __attribute__((ext_vector_type(8)));
constexpr int D = 2048, NB = 4, S = 2048, MP = NB * S, DB = 8, T = 4, MS = DB * T, MT = MP + MS, PAST = 16384;
constexpr float EPS = 1e-6f;
constexpr int A_IN = 20480, B_IN = 12288, C_IN = 6160, C_INM = 6144;
constexpr int NWG_THREADS = 512;
constexpr size_t MiB = 1u << 20;
constexpr size_t WS_CTL = 0, CTL_ZERO_BYTES = 1 * MiB;
constexpr size_t CTL_BAR = 16384;
constexpr size_t CTL_SUMSQ = 65536;
constexpr size_t WS_TABA = 1 * MiB;
constexpr size_t WS_TABB = WS_TABA + 512 * 1024;
constexpr size_t WS_WIA0 = 4 * MiB;
constexpr size_t WS_WIA1 = WS_WIA0 + (size_t)A_IN * D * 2;
constexpr size_t WS_WIB = WS_WIA1 + (size_t)A_IN * D * 2;
constexpr size_t WS_WIC = WS_WIB + (size_t)B_IN * D * 2;
constexpr size_t WS_WLR = WS_WIC + (size_t)C_INM * D * 2;
constexpr size_t WS_WOA0 = WS_WLR + (size_t)32 * D * 2;
constexpr size_t WS_WOA1 = WS_WOA0 + (size_t)D * 2048 * 2;
constexpr size_t WS_WOB = WS_WOA1 + (size_t)D * 2048 * 2;
constexpr size_t WS_WOC = WS_WOB + (size_t)D * 4096 * 2;
constexpr size_t WS_XRES = WS_WOC + (size_t)D * 2048 * 2;
constexpr size_t WS_XB = WS_XRES + (size_t)MT * D * 4;
constexpr size_t WS_Z = WS_XB + (size_t)MT * D * 2;
constexpr size_t WS_ZSRAW = WS_Z + (size_t)MT * A_IN * 2;
constexpr size_t WS_Y = WS_ZSRAW + (size_t)32 * A_IN * 4;
constexpr size_t WS_O = WS_Y + (size_t)MT * 4096 * 2;
constexpr size_t WS_LOGA = WS_O + (size_t)MT * 4096 * 4;
constexpr size_t WS_LR = WS_LOGA + (size_t)MT * 1024 * 4;
constexpr size_t WS_DVEC = WS_LR + (size_t)32 * MT * 4;
constexpr size_t WS_END = WS_DVEC + (size_t)4 * 4 * 16 * 256 * 4;
constexpr int LDS_BYTES = 147456, MISC_OFF = 131072 + 320;

struct Params {
    const float* in[19]; float* out; unsigned char* ws;
    double inv_a[16]; double inv_b[128];
    int ph_lo, ph_hi;
};

__device__ __forceinline__ float bf2f(bf16 v) { return __uint_as_float(((unsigned)v) << 16); }
__device__ __forceinline__ unsigned f2bf(float f) { unsigned u = __float_as_uint(f); return (u + 0x7fffu + ((u >> 16) & 1u)) >> 16; }
__device__ __forceinline__ unsigned pk2(float lo, float hi) { return f2bf(lo) | (f2bf(hi) << 16); }
__device__ __forceinline__ float wave_sum(float v) {
#pragma unroll
    for (int o = 32; o >= 1; o >>= 1) v += __shfl_xor(v, o);
    return v;
}
__device__ __forceinline__ float wave_max(float v) {
#pragma unroll
    for (int o = 32; o >= 1; o >>= 1) v = fmaxf(v, __shfl_xor(v, o));
    return v;
}
__device__ __forceinline__ float silu(float x) { return x / (1.f + __expf(-x)); }
__device__ __forceinline__ void sincos_d(double a, float& s, float& c) {
    const double k = rint(a * 0.63661977236758134308);
    double r = fma(-k, 1.57079632679489655800e+00, a); r = fma(-k, 6.12323399573676603587e-17, r);
    const double r2 = r * r;
    const double sp = r * (1.0 + r2 * (-1.0 / 6 + r2 * (1.0 / 120 + r2 * (-1.0 / 5040 + r2 * (1.0 / 362880 + r2 * (-1.0 / 39916800 + r2 * (1.0 / 6227020800.0)))))));
    const double cp = 1.0 + r2 * (-0.5 + r2 * (1.0 / 24 + r2 * (-1.0 / 720 + r2 * (1.0 / 40320 + r2 * (-1.0 / 3628800 + r2 * (1.0 / 479001600.0 + r2 * (-1.0 / 87178291200.0)))))));
    const int q = (int)((long long)k & 3);
    const double ss = (q == 0) ? sp : (q == 1) ? cp : (q == 2) ? -sp : -cp;
    const double cc = (q == 0) ? cp : (q == 1) ? -sp : (q == 2) ? -cp : sp;
    s = (float)ss; c = (float)cc;
}
__device__ __forceinline__ void row_info(int row, int& b, int& t, int& pi, bool& samp) {
    if (row < MP) { b = row >> 11; t = row & 2047; pi = t; samp = false; } else { const int r = row - MP; b = r >> 2; t = r & 3; pi = 2048 + t; samp = true; }
}

struct Ctx {
    LAS unsigned char* lds; int tid, lane, wave, G, wg;
    const float *x_prompt, *x_sample, *cache1, *cache2, *cache3, *state_b, *state_c, *norm_g, *final_g, *w_in_a, *w_out_a, *w_in_b, *gn_b, *w_out_b, *w_in_c, *w_gate2_c, *b_gate_c, *gn_c, *w_out_c; float* out; unsigned char* ws;
    __device__ __forceinline__ float* sumsq(int l) const { return (float*)(ws + CTL_SUMSQ) + (size_t)l * MT; }
    template <class Tp> __device__ __forceinline__ Tp* wsp(size_t off) const { return (Tp*)(ws + off); }
};

constexpr int ATT_K_OFF = 0, ATT_V_OFF = 65536;
DEV int att_off_k(int row, int ch) { return 256 * row + 16 * (ch ^ (row & 15)); }
DEV int att_off_v(int row, int ch) { return 256 * row + 16 * (ch ^ (2 * (row & 7))); }
DEV void attn_item(LAS unsigned char* lds, const bf16* z, int ldz, bf16* og, float* lse, int item, int tid) {
    const int lane = tid & 63, w = tid >> 6, G = lane >> 4, l15 = lane & 15;
    const int bh = item / 48, rem = item % 48, b = bh >> 4, h = bh & 15;
    int g, r, blk;
    if (rem < 16) { g = 0; r = 0; blk = rem; } else if (rem < 32) { g = 1; r = (rem - 16) >> 2; blk = (rem - 16) & 3; } else { g = 2; r = rem - 32; blk = 0; }
    const int dil = 1 << (2 * g);
    const int qcol = (g * 3) * 2048 + h * 128, kcol = qcol + 2048, vcol = qcol + 4096;
    const size_t tok0 = (size_t)b * 2048 + r;
#pragma unroll
    for (int j = 0; j < 8; ++j) {
        const int e = tid + 512 * j, row = e >> 4, ch = e & 15; const int p = (blk - 1) * 128 + row;
        u32x4 kv = {0u, 0u, 0u, 0u}, vv = {0u, 0u, 0u, 0u};
        if (p >= 0) { const bf16* src = z + (tok0 + (size_t)dil * p) * ldz + ch * 8; kv = *(const u32x4*)(src + kcol); vv = *(const u32x4*)(src + vcol); }
        *(LAS u32x4*)(lds + ATT_K_OFF + att_off_k(row, ch)) = kv;
        *(LAS u32x4*)(lds + ATT_V_OFF + att_off_v(row, ch)) = vv;
    }
    const int qi = 16 * w + l15; const size_t qtok = tok0 + (size_t)dil * (blk * 128 + qi);
    bf16x8 qf[4];
#pragma unroll
    for (int s = 0; s < 4; ++s) qf[s] = *(const bf16x8*)(z + qtok * ldz + qcol + 32 * s + 8 * G);
    wg_sync();
    const int m0 = w >> 1;
    f32x4 sc[10];
#pragma unroll
    for (int tt = 0; tt < 10; ++tt) {
        const int t = 2 * m0 + tt; f32x4 a = {0.f, 0.f, 0.f, 0.f};
#pragma unroll
        for (int s = 0; s < 4; ++s) { const bf16x8 kf = *(const LAS bf16x8*)(lds + ATT_K_OFF + att_off_k(16 * t + l15, 4 * s + G)); a = mfma16(kf, qf[s], a); }
        sc[tt] = a;
    }
    const float scale = 0.08838834764831845f * 1.4426950408889634f;
    float mx = -INFINITY;
#pragma unroll
    for (int tt = 0; tt < 10; ++tt)
#pragma unroll
        for (int rr = 0; rr < 4; ++rr) { const int c = 16 * (2 * m0 + tt) + 4 * G + rr; const bool ok = (c >= qi) && (c <= qi + 128) && (blk > 0 || c >= 128);
            const float v = ok ? sc[tt][rr] * scale : -INFINITY; sc[tt][rr] = v; mx = fmaxf(mx, v); }
    mx = fmaxf(mx, shflx(mx, 16)); mx = fmaxf(mx, shflx(mx, 32));
    float sum = 0.f;
#pragma unroll
    for (int tt = 0; tt < 10; ++tt)
#pragma unroll
        for (int rr = 0; rr < 4; ++rr) { const float p = fast_exp2(sc[tt][rr] - mx); sc[tt][rr] = p; sum += p; }
    sum += shflx(sum, 16); sum += shflx(sum, 32);
    f32x4 oacc[8];
#pragma unroll
    for (int dt = 0; dt < 8; ++dt) oacc[dt] = (f32x4){0.f, 0.f, 0.f, 0.f};
#pragma unroll
    for (int mm = 0; mm < 5; ++mm) {
        const f32x4 p0 = sc[2 * mm], p1 = sc[2 * mm + 1];
        u32x4 pw; pw[0] = cvt_pk_bf16(p0[0], p0[1]); pw[1] = cvt_pk_bf16(p0[2], p0[3]); pw[2] = cvt_pk_bf16(p1[0], p1[1]); pw[3] = cvt_pk_bf16(p1[2], p1[3]);
        bf16x8 pf; __builtin_memcpy(&pf, &pw, 16);
        const int krow = 32 * (m0 + mm) + 4 * G + (l15 >> 2);
#pragma unroll
        for (int dh = 0; dh < 2; ++dh) {
            s16x4 lo[4], hi[4];
#pragma unroll
            for (int d4 = 0; d4 < 4; ++d4) { const int dt = dh * 4 + d4; const int ch = 2 * dt + ((l15 >> 1) & 1);
                lo[d4] = tr_read(lds + ATT_V_OFF + att_off_v(krow, ch) + 8 * (l15 & 1)); hi[d4] = tr_read(lds + ATT_V_OFF + att_off_v(krow + 16, ch) + 8 * (l15 & 1)); }
            lds_wait();
#pragma unroll
            for (int d4 = 0; d4 < 4; ++d4) oacc[dh * 4 + d4] = mfma16(pack8(lo[d4], hi[d4]), pf, oacc[dh * 4 + d4]);
        }
    }
    const float inv = fast_rcp(sum);
    bf16* orow = og + ((size_t)g * 8192 + qtok) * 2048 + h * 128 + 4 * G;
#pragma unroll
    for (int dt = 0; dt < 8; ++dt) { u32x2 wv; wv[0] = cvt_pk_bf16(oacc[dt][0] * inv, oacc[dt][1] * inv); wv[1] = cvt_pk_bf16(oacc[dt][2] * inv, oacc[dt][3] * inv); *(u32x2*)(orow + 16 * dt) = wv; }
    if (G == 0) lse[((size_t)g * 8192 + qtok) * 16 + h] = (mx + fast_log2(sum)) * 0.6931471805599453f;
    wg_sync();
}
constexpr int SC_KP = 544, SC_K_OFF = 0, SC_V_OFF = 128 * SC_KP, SC_S_OFF = SC_V_OFF + 20480;
template <int NVT>
DEV void scan_unit(LAS unsigned char* lds, const bf16* z, int ldz, int qoff, int koff, int voff, int H, int unit, const float* dvec, float* o, int ldo, float* state_out, int tid) {
    constexpr int VS = 16 * NVT, VP = VS * 2 + 32, KP = SC_KP, NVS = 512 / VS, VCH = VS / 8, NVLD = (128 * VCH) / 512, VROWS = 512 / VCH;
    const int lane = tid & 63, w = tid >> 6, G = lane >> 4, l15 = lane & 15;
    const int vs = unit % NVS, h = (unit / NVS) % H, b = unit / (NVS * H);
    const size_t rowbase = (size_t)b * 2048;
    const bf16* zq = z + qoff + h * 256; const bf16* zk = z + koff + h * 256; const bf16* zv = z + voff + h * 512 + vs * VS;
    float gam128 = 1.f; if (!dvec) { const float gm = 1.0f - exp2f(-5.0f - (float)h); gam128 = exp2f(128.0f * log2f(gm)); }
    LAS unsigned char* const kb_row = lds + SC_K_OFF + l15 * KP + 16 * G;
    LAS unsigned char* const kb_tr = lds + SC_K_OFF + (4 * G + (l15 >> 2)) * KP + 8 * (l15 & 3) + 64 * w;
    LAS unsigned char* const vb_tr = lds + SC_V_OFF + (4 * G + (l15 >> 2)) * VP + 8 * (l15 & 3);
    LAS unsigned char* const sb_row = lds + SC_S_OFF + l15 * KP + 16 * G;
    LAS unsigned char* const sb_wr = lds + SC_S_OFF + l15 * KP + 8 * G + 64 * w;
    LAS unsigned char* const kst = lds + SC_K_OFF + (tid >> 5) * KP + (tid & 31) * 16;
    LAS unsigned char* const vst = lds + SC_V_OFF + (tid / VCH) * VP + (tid % VCH) * 16;
    const size_t kg = (size_t)(tid >> 5) * ldz + (tid & 31) * 8, vg = (size_t)(tid / VCH) * ldz + (tid % VCH) * 8;
    f32x4 sacc[2][NVT];
#pragma unroll
    for (int dd = 0; dd < 2; ++dd)
#pragma unroll
        for (int vt = 0; vt < NVT; ++vt) sacc[dd][vt] = (f32x4){0.f, 0.f, 0.f, 0.f};
    for (int e = tid; e < VS * (KP / 16); e += 512) *(LAS u32x4*)(lds + SC_S_OFF + e * 16) = (u32x4){0u, 0u, 0u, 0u};
    u32x4 kpre[8], vpre[NVLD];
    {   const bf16* kp = zk + rowbase * ldz + kg; const bf16* vp = zv + rowbase * ldz + vg;
#pragma unroll
        for (int j = 0; j < 8; ++j) kpre[j] = *(const u32x4*)(kp + (size_t)(16 * j) * ldz);
#pragma unroll
        for (int j = 0; j < NVLD; ++j) vpre[j] = *(const u32x4*)(vp + (size_t)(VROWS * j) * ldz);
#pragma unroll
        for (int j = 0; j < 8; ++j) *(LAS u32x4*)(kst + 16 * j * KP) = kpre[j];
#pragma unroll
        for (int j = 0; j < NVLD; ++j) *(LAS u32x4*)(vst + VROWS * j * VP) = vpre[j]; }
    wg_sync();
    const int qi = 16 * w + l15;
#pragma unroll 1
    for (int c = 0; c < 16; ++c) {
        const size_t crow = rowbase + (size_t)c * 128;
        const bf16* kp = zk + (crow + 128) * ldz + kg; const bf16* vp = zv + (crow + 128) * ldz + vg;
        if (c + 1 < 16) {
#pragma unroll
            for (int j = 0; j < 4; ++j) kpre[j] = *(const u32x4*)(kp + (size_t)(16 * j) * ldz);
        }
        bf16x8 qf[8];
#pragma unroll
        for (int s = 0; s < 8; ++s) qf[s] = *(const bf16x8*)(zq + (crow + qi) * ldz + 32 * s + 8 * G);
        f32x4 oacc[NVT];
#pragma unroll
        for (int vt = 0; vt < NVT; ++vt) oacc[vt] = (f32x4){0.f, 0.f, 0.f, 0.f};
#pragma unroll 1
        for (int m = 0; m <= (w >> 1); ++m) {
            f32x4 s0 = {0.f, 0.f, 0.f, 0.f}, s1 = {0.f, 0.f, 0.f, 0.f};
            LAS unsigned char* const kr = kb_row + m * (32 * KP); LAS unsigned char* const vr = vb_tr + m * (32 * VP);
#pragma unroll
            for (int s = 0; s < 8; ++s) {
                const bf16x8 k0 = *(const LAS bf16x8*)(kr + 64 * s); const bf16x8 k1 = *(const LAS bf16x8*)(kr + 16 * KP + 64 * s);
                s0 = mfma16(k0, qf[s], s0); s1 = mfma16(k1, qf[s], s1);
                if (s & 1) mem_fence_cc();
            }
#pragma unroll
            for (int rr = 0; rr < 4; ++rr) { const int j0 = 32 * m + 4 * G + rr; s0[rr] = (j0 <= qi) ? s0[rr] : 0.f; s1[rr] = (j0 + 16 <= qi) ? s1[rr] : 0.f; }
            u32x4 pw; pw[0] = cvt_pk_bf16(s0[0], s0[1]); pw[1] = cvt_pk_bf16(s0[2], s0[3]); pw[2] = cvt_pk_bf16(s1[0], s1[1]); pw[3] = cvt_pk_bf16(s1[2], s1[3]);
            bf16x8 pf; __builtin_memcpy(&pf, &pw, 16);
            s16x4 lo[NVT], hi[NVT];
#pragma unroll
            for (int vt = 0; vt < NVT; ++vt) { lo[vt] = tr_read_o(vr, 32 * vt); hi[vt] = tr_read_o(vr, 16 * VP + 32 * vt); }
            lds_wait();
#pragma unroll
            for (int vt = 0; vt < NVT; ++vt) oacc[vt] = mfma16(pack8(lo[vt], hi[vt]), pf, oacc[vt]);
        }
        if (c + 1 < 16) {
#pragma unroll
            for (int j = 4; j < 8; ++j) kpre[j] = *(const u32x4*)(kp + (size_t)(16 * j) * ldz);
        }
#pragma unroll
        for (int s = 0; s < 8; ++s)
#pragma unroll
            for (int vt = 0; vt < NVT; ++vt) { const bf16x8 sf = *(const LAS bf16x8*)(sb_row + 16 * vt * KP + 64 * s); oacc[vt] = mfma16(sf, qf[s], oacc[vt]); if (vt == NVT - 1) mem_fence_cc(); }
        {   float* orow = o + (crow + qi) * ldo + h * 512 + vs * VS + 4 * G;
#pragma unroll
            for (int vt = 0; vt < NVT; ++vt) *(f32x4*)(orow + 16 * vt) = oacc[vt]; }
        if (c + 1 < 16) {
#pragma unroll
            for (int j = 0; j < NVLD; ++j) vpre[j] = *(const u32x4*)(vp + (size_t)(VROWS * j) * ldz);
        }
#pragma unroll
        for (int ks = 0; ks < 4; ++ks) {
            s16x4 alo[2], ahi[2], blo[NVT], bhi[NVT];
#pragma unroll
            for (int dd = 0; dd < 2; ++dd) { alo[dd] = tr_read_o(kb_tr, 32 * ks * KP + 32 * dd); ahi[dd] = tr_read_o(kb_tr, (32 * ks + 16) * KP + 32 * dd); }
#pragma unroll
            for (int vt = 0; vt < NVT; ++vt) { blo[vt] = tr_read_o(vb_tr, 32 * ks * VP + 32 * vt); bhi[vt] = tr_read_o(vb_tr, (32 * ks + 16) * VP + 32 * vt); }
            lds_wait();
#pragma unroll
            for (int dd = 0; dd < 2; ++dd)
#pragma unroll
                for (int vt = 0; vt < NVT; ++vt) sacc[dd][vt] = mfma16(pack8(alo[dd], ahi[dd]), pack8(blo[vt], bhi[vt]), sacc[dd][vt]);
        }
#pragma unroll
        for (int dd = 0; dd < 2; ++dd) {
            f32x4 dv = {gam128, gam128, gam128, gam128};
            if (dvec) dv = *(const f32x4*)(dvec + ((size_t)(b * H + h) * 16 + c) * 256 + 16 * (2 * w + dd) + 4 * G);
#pragma unroll
            for (int vt = 0; vt < NVT; ++vt) sacc[dd][vt] = sacc[dd][vt] * dv;
        }
        wg_sync();
#pragma unroll
        for (int dd = 0; dd < 2; ++dd)
#pragma unroll
            for (int vt = 0; vt < NVT; ++vt) { u32x2 wv; wv[0] = cvt_pk_bf16(sacc[dd][vt][0], sacc[dd][vt][1]); wv[1] = cvt_pk_bf16(sacc[dd][vt][2], sacc[dd][vt][3]); *(LAS u32x2*)(sb_wr + 16 * vt * KP + 32 * dd) = wv; }
        if (c + 1 < 16) {
#pragma unroll
            for (int j = 0; j < 8; ++j) *(LAS u32x4*)(kst + 16 * j * KP) = kpre[j];
#pragma unroll
            for (int j = 0; j < NVLD; ++j) *(LAS u32x4*)(vst + VROWS * j * VP) = vpre[j];
        }
        wg_sync();
    }
#pragma unroll
    for (int dd = 0; dd < 2; ++dd)
#pragma unroll
        for (int vt = 0; vt < NVT; ++vt)
#pragma unroll
            for (int rr = 0; rr < 4; ++rr) state_out[(((size_t)b * H + h) * 256 + 16 * (2 * w + dd) + 4 * G + rr) * 512 + vs * VS + 16 * vt + l15] = sacc[dd][vt][rr];
}
__device__ __forceinline__ void p0_transpose_item(const float* W, int K, int ld, int ncols, const float* gain, bf16* WT, LAS float* scr, int item, int lane) {
    const int nblk = ncols / 32, kb = item / nblk, nb = item % nblk, k0 = 64 * kb, n0 = 32 * nb;
#pragma unroll 8
    for (int i = 0; i < 32; ++i) { const int kk = 2 * i + (lane >> 5); const float gk = gain ? gain[k0 + kk] : 1.0f; scr[kk * 33 + (lane & 31)] = W[(size_t)(k0 + kk) * ld + n0 + (lane & 31)] * gk; }
    asm volatile("s_waitcnt lgkmcnt(0)" ::: "memory");
    const int c = lane & 7;
#pragma unroll
    for (int j = 0; j < 4; ++j) { const int n = (lane >> 3) + 8 * j; const LAS float* s = scr + (8 * c) * 33 + n;
        u32x4 o; o.x = pk2(s[0 * 33], s[1 * 33]); o.y = pk2(s[2 * 33], s[3 * 33]); o.z = pk2(s[4 * 33], s[5 * 33]); o.w = pk2(s[6 * 33], s[7 * 33]);
        *(u32x4*)(WT + (size_t)(n0 + n) * K + k0 + 8 * c) = o; }
    asm volatile("s_waitcnt lgkmcnt(0)" ::: "memory");
}
__device__ __forceinline__ void p0_prologue(const Ctx& C, const Params& P) {
    LAS float* scr = (LAS float*)(C.lds + C.wave * 16384);
    const int gw = C.wg * 8 + C.wave, NGW = C.G * 8;
    const float* norm_g = C.norm_g;
    constexpr int I_A = (D / 64) * (A_IN / 32), I_B = (D / 64) * (B_IN / 32), I_C = (D / 64) * (C_INM / 32), I_OA = (2048 / 64) * (D / 32), I_OB = (4096 / 64) * (D / 32);
    constexpr int NITEMS = 2 * I_A + I_B + I_C + 3 * I_OA + I_OB;
    for (int it = gw; it < NITEMS; it += NGW) {
        int r = it;
        if (r < I_A) { p0_transpose_item(C.w_in_a, D, A_IN, A_IN, norm_g + 0 * D, C.wsp<bf16>(WS_WIA0), scr, r, C.lane); continue; } r -= I_A;
        if (r < I_A) { p0_transpose_item(C.w_in_a + (size_t)D * A_IN, D, A_IN, A_IN, norm_g + 3 * D, C.wsp<bf16>(WS_WIA1), scr, r, C.lane); continue; } r -= I_A;
        if (r < I_B) { p0_transpose_item(C.w_in_b, D, B_IN, B_IN, norm_g + 1 * D, C.wsp<bf16>(WS_WIB), scr, r, C.lane); continue; } r -= I_B;
        if (r < I_C) { p0_transpose_item(C.w_in_c, D, C_IN, C_INM, norm_g + 2 * D, C.wsp<bf16>(WS_WIC), scr, r, C.lane); continue; } r -= I_C;
        if (r < I_OA) { p0_transpose_item(C.w_out_a, 2048, D, D, nullptr, C.wsp<bf16>(WS_WOA0), scr, r, C.lane); continue; } r -= I_OA;
        if (r < I_OA) { p0_transpose_item(C.w_out_a + (size_t)2048 * D, 2048, D, D, nullptr, C.wsp<bf16>(WS_WOA1), scr, r, C.lane); continue; } r -= I_OA;
        if (r < I_OA) { p0_transpose_item(C.w_out_c, 2048, D, D, nullptr, C.wsp<bf16>(WS_WOC), scr, r, C.lane); continue; } r -= I_OA;
        p0_transpose_item(C.w_out_b, 4096, D, D, nullptr, C.wsp<bf16>(WS_WOB), scr, r, C.lane);
    }
    { bf16* wlr = C.wsp<bf16>(WS_WLR); const float* W = C.w_in_c; const float* g2 = norm_g + 2 * D;
      for (int e = C.wg * NWG_THREADS + C.tid; e < 32 * D; e += C.G * NWG_THREADS) { const int r = e / D, k = e % D; wlr[e] = r < 16 ? (bf16)f2bf(W[(size_t)k * C_IN + C_INM + r] * g2[k]) : (bf16)0; } }
    { float* xres = C.wsp<float>(WS_XRES); bf16* xb = C.wsp<bf16>(WS_XB); float* ss0 = C.sumsq(0);
      for (int row = gw; row < MT; row += NGW) {
          const float* src = row < MP ? C.x_prompt + (size_t)row * D : C.x_sample + (size_t)(row - MP) * D;
          float s = 0.f;
#pragma unroll
          for (int j = 0; j < 8; ++j) { const f32x4 v = *(const f32x4*)(src + 4 * C.lane + 256 * j); *(f32x4*)(xres + (size_t)row * D + 4 * C.lane + 256 * j) = v;
              u32x2 w; w.x = pk2(v[0], v[1]); w.y = pk2(v[2], v[3]); *(u32x2*)(xb + (size_t)row * D + 4 * C.lane + 256 * j) = w; s += (v[0] * v[0] + v[1] * v[1]) + (v[2] * v[2] + v[3] * v[3]); }
          s = wave_sum(s); if (C.lane == 0) ss0[row] = s; } }
    { f32x2* ta = C.wsp<f32x2>(WS_TABA); f32x2* tb = C.wsp<f32x2>(WS_TABB);
      for (int e = C.wg * NWG_THREADS + C.tid; e < 2052 * 16; e += C.G * NWG_THREADS) { const int pi = e >> 4, i = e & 15; const int pos = pi < 2048 ? pi : PAST + (pi - 2048); float s, c; sincos_d((double)pos * P.inv_a[i], s, c); ta[e] = (f32x2){c, s}; }
      for (int e = C.wg * NWG_THREADS + C.tid; e < 2052 * 128; e += C.G * NWG_THREADS) { const int pi = e >> 7, i = e & 127; const int pos = pi < 2048 ? pi : PAST + (pi - 2048); float s, c; sincos_d((double)pos * P.inv_b[i], s, c); tb[e] = (f32x2){c, s}; } }
}

template <int K, class EP>
__device__ __forceinline__ void skinny_gemm(const Ctx& C, const bf16* A, const bf16* Bt, int N, const EP& ep) {
    constexpr int KW = K / 8, NPASS = KW / 256, MAXCH = 5;
    const int fr = C.lane & 15, fq = C.lane >> 4, nch = N / 16;
    LAS float* part = (LAS float*)C.lds;
    for (int cb = C.wg; cb < nch; cb += C.G * MAXCH) {
        int ncur = 0;
#pragma unroll 1
        for (int j = 0; j < MAXCH; ++j) {
            const int ch = cb + j * C.G; if (ch >= nch) break;
            ++ncur;
            pg8::f32x4 acc0 = {0.f, 0.f, 0.f, 0.f}, acc1 = {0.f, 0.f, 0.f, 0.f};
#pragma unroll 1
            for (int ps = 0; ps < NPASS; ++ps) {
                const int kbase = C.wave * KW + ps * 256 + 8 * fq;
                const bf16* ap0 = A + (size_t)fr * K + kbase; const bf16* ap1 = A + (size_t)(16 + fr) * K + kbase; const bf16* bp = Bt + (size_t)(ch * 16 + fr) * K + kbase;
                bf16x8 a0[8], a1[8], bb[8];
#pragma unroll
                for (int s = 0; s < 8; ++s) { bb[s] = *(const bf16x8*)(bp + 32 * s); a0[s] = *(const bf16x8*)(ap0 + 32 * s); a1[s] = *(const bf16x8*)(ap1 + 32 * s); }
#pragma unroll
                for (int s = 0; s < 8; ++s) { acc0 = __builtin_amdgcn_mfma_f32_16x16x32_bf16(bb[s], a0[s], acc0, 0, 0, 0); acc1 = __builtin_amdgcn_mfma_f32_16x16x32_bf16(bb[s], a1[s], acc1, 0, 0, 0); }
            }
            LAS float* pj = part + ((size_t)(j * 8 + C.wave) * 2) * 4 * 64 + C.lane;
#pragma unroll
            for (int r = 0; r < 4; ++r) { pj[(0 * 4 + r) * 64] = acc0[r]; pj[(1 * 4 + r) * 64] = acc1[r]; }
        }
        __syncthreads();
        {
            const int l2 = C.tid & 63, mt = (C.tid >> 6) & 1, reg = C.tid >> 7;
            for (int j = 0; j < ncur; ++j) {
                float s = 0.f;
#pragma unroll
                for (int w = 0; w < 8; ++w) s += part[(((size_t)(j * 8 + w) * 2 + mt) * 4 + reg) * 64 + l2];
                const int ch = cb + j * C.G;
                ep(16 * mt + (l2 & 15), ch * 16 + 4 * (l2 >> 4) + reg, s);
            }
        }
        __syncthreads();
    }
}

__device__ __forceinline__ float rstd_of(const float* ss, int row) { return rsqrtf(ss[row] * (1.0f / 2048.0f) + EPS); }
__device__ __forceinline__ void sfix_a(const Ctx& C, int layer, int slot) {
    const float* zs = C.wsp<float>(WS_ZSRAW); bf16* z = C.wsp<bf16>(WS_Z); const float* ss = C.sumsq(layer); const f32x2* ta = C.wsp<f32x2>(WS_TABA);
    float* skv = C.out + (size_t)MP * D + (size_t)MS * D + (size_t)2 * 4 * (128 + 512 + 2048) * 4096 + (size_t)4 * 8 * 256 * 512 + (size_t)4 * 4 * 256 * 512;
    for (int e = C.wg * NWG_THREADS + C.tid; e < MS * A_IN; e += C.G * NWG_THREADS) {
        const int r = e / A_IN, c = e % A_IN, row = MP + r, b = r >> 2, t = r & 3; const float rs = rstd_of(ss, row);
        const int section = c >> 11, within = c & 2047, d = within & 127, kind = section < 9 ? section % 3 : 3, g = section / 3;
        float v = zs[e] * rs;
        if (kind < 2 && d < 32) { const int i = d & 15; const float pv = zs[d < 16 ? e + 16 : e - 16] * rs; const f32x2 cs = ta[(2048 + t) * 16 + i]; v = d < 16 ? v * cs.x - pv * cs.y : pv * cs.y + v * cs.x; }
        z[(size_t)row * A_IN + c] = (bf16)f2bf(v);
        if (kind == 1 || kind == 2) skv[(size_t)g * (2 * 8 * 4 * 4096) + ((((size_t)slot * DB + b) * T + t) * 2 + (kind - 1)) * 2048 + within] = v;
    }
}
__device__ __forceinline__ void sfix_b(const Ctx& C, int layer) {
    const float* zs = C.wsp<float>(WS_ZSRAW); bf16* z = C.wsp<bf16>(WS_Z); const float* ss = C.sumsq(layer); const f32x2* tb = C.wsp<f32x2>(WS_TABB);
    for (int e = C.wg * NWG_THREADS + C.tid; e < MS * B_IN; e += C.G * NWG_THREADS) {
        const int r = e / B_IN, c = e % B_IN, row = MP + r, t = r & 3; const float rs = rstd_of(ss, row);
        float v = zs[e] * rs;
        if (c < 4096) { const int d = c & 255, i = d & 127; const float pv = zs[d < 128 ? e + 128 : e - 128] * rs; const f32x2 cs = tb[(2048 + t) * 128 + i]; v = d < 128 ? v * cs.x - pv * cs.y : pv * cs.y + v * cs.x; if (c >= 2048) v *= 0.0625f; }
        z[(size_t)row * B_IN + c] = (bf16)f2bf(v);
    }
}
__device__ __forceinline__ void sfix_c(const Ctx& C, int layer) {
    const float* zs = C.wsp<float>(WS_ZSRAW); bf16* z = C.wsp<bf16>(WS_Z); const float* ss = C.sumsq(layer);
    for (int e = C.wg * NWG_THREADS + C.tid; e < MS * C_INM; e += C.G * NWG_THREADS) {
        const int r = e / C_INM, c = e % C_INM, row = MP + r; const float rs = rstd_of(ss, row);
        float v = zs[e] * rs; if (c < 1024) v *= 0.0625f;
        z[(size_t)row * C_INM + c] = (bf16)f2bf(v);
    }
    const float* lr = C.wsp<float>(WS_LR); float* loga = C.wsp<float>(WS_LOGA); const float* wg2 = C.w_gate2_c; const float* bg = C.b_gate_c;
    for (int e = MP * 1024 + C.wg * NWG_THREADS + C.tid; e < MT * 1024; e += C.G * NWG_THREADS) {
        const int row = e >> 10, c = e & 1023; const float rs = rstd_of(ss, row);
        float a = 0.f;
#pragma unroll
        for (int r = 0; r < 16; ++r) a += lr[(size_t)r * MT + row] * wg2[r * 1024 + c];
        a = a * rs + bg[c];
        loga[e] = (fminf(a, 0.f) - log1pf(__expf(-fabsf(a)))) * 0.0625f;
    }
}

__device__ __forceinline__ void gla_pre(const Ctx& C, int layer) {
    bf16* z = C.wsp<bf16>(WS_Z); const float* ss = C.sumsq(layer); const float* lr = C.wsp<float>(WS_LR); float* dvec = C.wsp<float>(WS_DVEC); const float* wg2 = C.w_gate2_c; const float* bg = C.b_gate_c;
    for (int u = C.wg; u < 128; u += C.G) {
        const int chunk = u >> 1, col = (u & 1) * 512 + C.tid;
        float wv[16];
#pragma unroll
        for (int r = 0; r < 16; ++r) wv[r] = wg2[r * 1024 + col];
        const float bgc = bg[col]; float bs = 0.f;
#pragma unroll 2
        for (int i = 0; i < 128; ++i) {
            const int row = chunk * 128 + i; const float rs = rstd_of(ss, row);
            float a = 0.f;
#pragma unroll
            for (int r = 0; r < 16; ++r) a += lr[(size_t)r * MT + row] * wv[r];
            a = a * rs + bgc;
            bs += (fminf(a, 0.f) - log1pf(__expf(-fabsf(a)))) * 0.0625f;
            const float eb = __expf(bs), ieb = __expf(-bs);
            bf16* zr = z + (size_t)row * C_INM;
            zr[col] = (bf16)f2bf(bf2f(zr[col]) * eb); zr[1024 + col] = (bf16)f2bf(bf2f(zr[1024 + col]) * ieb);
        }
        dvec[(((size_t)(chunk >> 4) * 4 + (col >> 8)) * 16 + (chunk & 15)) * 256 + (col & 255)] = __expf(bs);
    }
}
template <int NVT>
__device__ __forceinline__ void scan_phase(const Ctx& C, int ldz, int qoff, int koff, int voff, int H, const float* dvec, float* state_out) {
    const bf16* z = C.wsp<bf16>(WS_Z); float* o = C.wsp<float>(WS_O);
    const int nunits = NB * H * (512 / (16 * NVT));
    for (int u = C.wg; u < nunits; u += C.G) scan_unit<NVT>(C.lds, z, ldz, qoff, koff, voff, H, u, dvec, o, H * 512, state_out, C.tid);
}

__device__ __forceinline__ float dot128_bb(const bf16* q, const bf16* k) {
    float a = 0.f;
#pragma unroll 4
    for (int i = 0; i < 16; ++i) { const u32x4 x = ((const u32x4*)q)[i], y = ((const u32x4*)k)[i];
#pragma unroll
        for (int j = 0; j < 4; ++j) a += __uint_as_float(x[j] << 16) * __uint_as_float(y[j] << 16) + __uint_as_float(x[j] & 0xffff0000u) * __uint_as_float(y[j] & 0xffff0000u); }
    return a;
}
__device__ __forceinline__ float dot128_bf(const bf16* q, const float* k) {
    float a = 0.f;
#pragma unroll 4
    for (int i = 0; i < 16; ++i) { const u32x4 x = ((const u32x4*)q)[i]; const f32x4 y0 = ((const f32x4*)k)[2 * i], y1 = ((const f32x4*)k)[2 * i + 1];
        a += __uint_as_float(x[0] << 16) * y0[0] + __uint_as_float(x[0] & 0xffff0000u) * y0[1] + __uint_as_float(x[1] << 16) * y0[2] + __uint_as_float(x[1] & 0xffff0000u) * y0[3]
           + __uint_as_float(x[2] << 16) * y1[0] + __uint_as_float(x[2] & 0xffff0000u) * y1[1] + __uint_as_float(x[3] << 16) * y1[2] + __uint_as_float(x[3] & 0xffff0000u) * y1[3]; }
    return a;
}
__device__ __forceinline__ void attn_naive(const Ctx& C, int slot) {
    const bf16* z = C.wsp<bf16>(WS_Z); bf16* y = C.wsp<bf16>(WS_Y); const int lane = C.lane;
    for (int item = MP * 16 + C.wg * 8 + C.wave; item < MT * 16; item += C.G * 8) {
        const int row = item >> 4, h = item & 15; int b, t, pi; bool samp; row_info(row, b, t, pi, samp);
        const bf16* zr = z + (size_t)row * A_IN;
        float mrun = -INFINITY, wsum = 0.f, acc0 = 0.f, acc1 = 0.f;
#pragma unroll
        for (int g = 0; g < 3; ++g) {
            const int win = g == 0 ? 128 : (g == 1 ? 512 : 2048), dil = g == 0 ? 1 : (g == 1 ? 4 : 16);
            const float* cache = C.cache1; if (g == 1) cache = C.cache2; if (g == 2) cache = C.cache3;
            const int qcol = (g * 3) * 2048 + h * 128, kcol = qcol + 2048, vcol = qcol + 4096;
            float sc[3];
#pragma unroll
            for (int u = 0; u < 3; ++u) {
                const int j = lane + 64 * u; float s = -INFINITY;
                if (j <= 128) {
                    if (!samp) { const int tok = t - dil * j; if (tok >= 0) s = dot128_bb(zr + qcol, z + (size_t)(b * S + tok) * A_IN + kcol); }
                    else { const int idx = win + t - dil * j;
                        if (idx >= win) s = dot128_bb(zr + qcol, z + (size_t)(MP + b * T + (idx - win)) * A_IN + kcol);
                        else s = dot128_bf(zr + qcol, cache + ((((size_t)slot * DB + b) * win + idx) * 2) * 2048 + h * 128); }
                    s *= 0.08838834764831845f;
                }
                sc[u] = s;
            }
            const float m = wave_max(fmaxf(sc[0], fmaxf(sc[1], sc[2])));
            float p[3]; float ps = 0.f;
#pragma unroll
            for (int u = 0; u < 3; ++u) { p[u] = __expf(sc[u] - m); ps += p[u]; }
            const float den = wave_sum(ps);
            const float lse = m + __logf(den);
            float o0 = 0.f, o1 = 0.f;
#pragma unroll
            for (int u = 0; u < 3; ++u) {
                const int cnt = u < 2 ? 64 : 1;
                for (int jj = 0; jj < cnt; ++jj) {
                    const int j = jj + 64 * u;
                    const float pj = __shfl(p[u], jj);
                    if (pj == 0.f) continue;
                    if (!samp) { const int tok = t - dil * j; const unsigned w = ((const unsigned*)(z + (size_t)(b * S + tok) * A_IN + vcol))[lane]; o0 += pj * __uint_as_float(w << 16); o1 += pj * __uint_as_float(w & 0xffff0000u); }
                    else { const int idx = win + t - dil * j;
                        if (idx >= win) { const unsigned w = ((const unsigned*)(z + (size_t)(MP + b * T + (idx - win)) * A_IN + vcol))[lane]; o0 += pj * __uint_as_float(w << 16); o1 += pj * __uint_as_float(w & 0xffff0000u); }
                        else { const f32x2 w = ((const f32x2*)(cache + ((((size_t)slot * DB + b) * win + idx) * 2 + 1) * 2048 + h * 128))[lane]; o0 += pj * w.x; o1 += pj * w.y; } }
                }
            }
            o0 /= den; o1 /= den;
            const float mnew = fmaxf(mrun, lse); const float sc_old = __expf(mrun - mnew), sc_new = __expf(lse - mnew);
            acc0 = acc0 * sc_old + sc_new * o0; acc1 = acc1 * sc_old + sc_new * o1; wsum = wsum * sc_old + sc_new; mrun = mnew;
        }
        const unsigned gw = ((const unsigned*)(zr + 18432 + h * 128))[lane];
        ((unsigned*)(y + (size_t)row * 2048 + h * 128))[lane] = pk2(acc0 / wsum * silu(__uint_as_float(gw << 16)), acc1 / wsum * silu(__uint_as_float(gw & 0xffff0000u)));
    }
}
template <bool GLA>
__device__ __forceinline__ void recur_naive(const Ctx& C, int ldz, int qoff, int koff, int voff, int H, int nseq, int ntok, int row0, const float* state0, float* state_out) {
    const bf16* z = C.wsp<bf16>(WS_Z); float* o = C.wsp<float>(WS_O); const float* loga = C.wsp<float>(WS_LOGA);
    LAS float* red = (LAS float*)C.lds;
    const int d = C.tid & 255, vh = C.tid >> 8, lane = C.lane, wave = C.wave;
    for (int item = C.wg; item < nseq * H * 8; item += C.G) {
        const int vs = item & 7, h = (item >> 3) % H, seq = (item >> 3) / H;
        const int v0 = vs * 64 + vh * 32;
        float Sreg[32];
        const size_t sbase = (((size_t)seq * H + h) * 256 + d) * 512 + v0;
#pragma unroll
        for (int i = 0; i < 32; ++i) Sreg[i] = state0 ? state0[sbase + i] : 0.f;
        float gamma = 1.f; if (!GLA) gamma = 1.0f - exp2f(-5.0f - (float)h);
        for (int t = 0; t < ntok; ++t) {
            const int row = row0 + seq * ntok + t; const bf16* zr = z + (size_t)row * ldz;
            const float qd = bf2f(zr[qoff + h * 256 + d]), kd = bf2f(zr[koff + h * 256 + d]);
            float dec = gamma; if (GLA) dec = __expf(loga[(size_t)row * 1024 + h * 256 + d]);
            const unsigned* vp = (const unsigned*)(zr + voff + h * 512 + v0);
            float p[32];
#pragma unroll
            for (int i = 0; i < 16; ++i) { const unsigned w = vp[i]; const float va = __uint_as_float(w << 16), vb = __uint_as_float(w & 0xffff0000u);
                Sreg[2 * i] = dec * Sreg[2 * i] + kd * va; Sreg[2 * i + 1] = dec * Sreg[2 * i + 1] + kd * vb; p[2 * i] = qd * Sreg[2 * i]; p[2 * i + 1] = qd * Sreg[2 * i + 1]; }
#pragma unroll
            for (int i = 0; i < 32; ++i) p[i] = wave_sum(p[i]);
            float mine = 0.f;
#pragma unroll
            for (int i = 0; i < 32; ++i) if (lane == i) mine = p[i];
            if (lane < 32) red[((t & 1) * 8 + wave) * 32 + lane] = mine;
            __syncthreads();
            if (d < 32) { const LAS float* rr = red + ((t & 1) * 8 + vh * 4) * 32 + d; o[(size_t)row * (H * 512) + h * 512 + v0 + d] = rr[0] + rr[32] + rr[64] + rr[96]; }
        }
#pragma unroll
        for (int i = 0; i < 32; ++i) state_out[sbase + i] = Sreg[i];
        __syncthreads();
    }
}
template <bool MEAN>
__device__ __forceinline__ void norm_gate(const Ctx& C, int H, int ldz, int goff, const float* gn) {
    const bf16* z = C.wsp<bf16>(WS_Z); const float* o = C.wsp<float>(WS_O); bf16* y = C.wsp<bf16>(WS_Y); const int lane = C.lane;
    for (int w = C.wg * 8 + C.wave; w < MT * H; w += C.G * 8) {
        const int row = w / H, h = w % H;
        const float* orow = o + (size_t)row * (H * 512) + h * 512; const bf16* gate = z + (size_t)row * ldz + goff + h * 512;
        const f32x4 a = ((const f32x4*)orow)[2 * lane], bq = ((const f32x4*)orow)[2 * lane + 1];
        float v[8] = {a[0], a[1], a[2], a[3], bq[0], bq[1], bq[2], bq[3]};
        float s = 0.f;
#pragma unroll
        for (int i = 0; i < 8; ++i) s += v[i];
        float mu = 0.f; if (MEAN) mu = wave_sum(s) * (1.f / 512.f);
        float q = 0.f;
#pragma unroll
        for (int i = 0; i < 8; ++i) { v[i] -= mu; q += v[i] * v[i]; }
        const float r = rsqrtf(wave_sum(q) * (1.f / 512.f) + EPS);
        const u32x4 gw = ((const u32x4*)gate)[lane]; const f32x4 g0 = ((const f32x4*)(gn + h * 512))[2 * lane], g1 = ((const f32x4*)(gn + h * 512))[2 * lane + 1];
        const float gg[8] = {g0[0], g0[1], g0[2], g0[3], g1[0], g1[1], g1[2], g1[3]};
        float ov[8];
#pragma unroll
        for (int i = 0; i < 4; ++i) { ov[2 * i] = v[2 * i] * r * gg[2 * i] * silu(__uint_as_float(gw[i] << 16)); ov[2 * i + 1] = v[2 * i + 1] * r * gg[2 * i + 1] * silu(__uint_as_float(gw[i] & 0xffff0000u)); }
        u32x4 ow; ow.x = pk2(ov[0], ov[1]); ow.y = pk2(ov[2], ov[3]); ow.z = pk2(ov[4], ov[5]); ow.w = pk2(ov[6], ov[7]);
        ((u32x4*)(y + (size_t)row * (H * 512) + h * 512))[lane] = ow;
    }
}
__device__ __forceinline__ void final_norm(const Ctx& C) {
    const float* xres = C.wsp<float>(WS_XRES); const float* ss = C.sumsq(4); const float* fg = C.final_g;
    for (int row = C.wg * 8 + C.wave; row < MT; row += C.G * 8) {
        const float rs = rstd_of(ss, row);
#pragma unroll
        for (int j = 0; j < 8; ++j) { const int c = 4 * C.lane + 256 * j; const f32x4 v = *(const f32x4*)(xres + (size_t)row * D + c), g = *(const f32x4*)(fg + c); *(f32x4*)(C.out + (size_t)row * D + c) = v * rs * g; }
    }
}

__device__ __forceinline__ void attn_fast_phase(const Ctx& C) {
    const bf16* z = C.wsp<bf16>(WS_Z); bf16* og = C.wsp<bf16>(WS_O); float* lse = C.wsp<float>(WS_LOGA);
    const int per = (3072 + C.G - 1) / C.G;
    for (int j = 0; j < per; ++j) { const int item = C.wg * per + j; if (item < 3072) attn_item(C.lds, z, A_IN, og, lse, item, C.tid); }
}
__device__ __forceinline__ void attn_merge(const Ctx& C) {
    const bf16* z = C.wsp<bf16>(WS_Z); const bf16* og = C.wsp<bf16>(WS_O); const float* lse = C.wsp<float>(WS_LOGA); bf16* y = C.wsp<bf16>(WS_Y);
    for (int row = C.wg * 8 + C.wave; row < MP; row += C.G * 8) {
#pragma unroll
        for (int j = 0; j < 4; ++j) {
            const int ch = C.lane + 64 * j, col = ch * 8, h = col >> 7;
            const float l0 = lse[((size_t)0 * MP + row) * 16 + h], l1 = lse[((size_t)1 * MP + row) * 16 + h], l2 = lse[((size_t)2 * MP + row) * 16 + h];
            const float m = fmaxf(l0, fmaxf(l1, l2)); float w0 = __expf(l0 - m), w1 = __expf(l1 - m), w2 = __expf(l2 - m); const float inv = 1.0f / (w0 + w1 + w2); w0 *= inv; w1 *= inv; w2 *= inv;
            const u32x4 a = *(const u32x4*)(og + ((size_t)0 * MP + row) * 2048 + col), b = *(const u32x4*)(og + ((size_t)1 * MP + row) * 2048 + col), c = *(const u32x4*)(og + ((size_t)2 * MP + row) * 2048 + col);
            const u32x4 gt = *(const u32x4*)(z + (size_t)row * A_IN + 18432 + col);
            u32x4 o;
#pragma unroll
            for (int k = 0; k < 4; ++k) {
                const float lo = (w0 * __uint_as_float(a[k] << 16) + w1 * __uint_as_float(b[k] << 16) + w2 * __uint_as_float(c[k] << 16)) * silu(__uint_as_float(gt[k] << 16));
                const float hi = (w0 * __uint_as_float(a[k] & 0xffff0000u) + w1 * __uint_as_float(b[k] & 0xffff0000u) + w2 * __uint_as_float(c[k] & 0xffff0000u)) * silu(__uint_as_float(gt[k] & 0xffff0000u));
                o[k] = pk2(lo, hi);
            }
            *(u32x4*)(y + (size_t)row * 2048 + col) = o;
        }
    }
}

template <int MODE>
__device__ __forceinline__ void gemm_in(const Ctx& C, size_t wt_off, int N, int layer, float* kvb, int slot) {
    pg8::Gemm g{C.wsp<pg8::bf16_t>(WS_XB), C.wsp<pg8::bf16_t>(wt_off), MP, N, D}; pg8::StaticOrder So; So.init(MP, N, C.G, C.wg);
    pg8::EpiIn<MODE> E{C.wsp<pg8::bf16_t>(WS_Z), N, C.sumsq(layer), (const pg8::f32x2*)C.wsp<f32x2>(MODE == 0 ? WS_TABA : WS_TABB), kvb, slot};
    pg8::gemm_phase<pg8::EpiIn<MODE>, pg8::StaticOrder, true, true>((PG8_LAS unsigned char*)C.lds, g, So, E);
}
template <int K>
__device__ __forceinline__ void gemm_out(const Ctx& C, size_t wt_off, int layer) {
    pg8::Gemm g{C.wsp<pg8::bf16_t>(WS_Y), C.wsp<pg8::bf16_t>(wt_off), MP, D, K}; pg8::StaticOrder So; So.init(MP, D, C.G, C.wg);
    pg8::EpiOut E{C.wsp<float>(WS_XRES), C.wsp<pg8::bf16_t>(WS_XB), C.sumsq(layer + 1)};
    pg8::gemm_phase<pg8::EpiOut, pg8::StaticOrder, true, true>((PG8_LAS unsigned char*)C.lds, g, So, E);
    float* xres = C.wsp<float>(WS_XRES); bf16* xb = C.wsp<bf16>(WS_XB); float* ssn = C.sumsq(layer + 1); const int lane = C.lane;
    skinny_gemm<K>(C, C.wsp<bf16>(WS_Y) + (size_t)MP * K, C.wsp<bf16>(wt_off), D, [=](int m, int n, float v) {
        const size_t o = (size_t)(MP + m) * D + n; const float x = xres[o] + v; xres[o] = x; xb[o] = (bf16)f2bf(x);
        float s = x * x; s += __shfl_xor(s, 16); s += __shfl_xor(s, 32); if ((lane >> 4) == 0) atomicAdd(ssn + MP + m, s); });
}
__device__ __forceinline__ void skinny_in(const Ctx& C, size_t wt_off, int N) {
    float* zs = C.wsp<float>(WS_ZSRAW);
    skinny_gemm<D>(C, C.wsp<bf16>(WS_XB) + (size_t)MP * D, C.wsp<bf16>(wt_off), N, [=](int m, int n, float v) { zs[(size_t)m * N + n] = v; });
}

__global__ void __launch_bounds__(NWG_THREADS, 2) mk_fwd(Params P) {
    extern __shared__ __attribute__((aligned(16))) unsigned char lds_raw[];
    Ctx C; C.lds = (LAS unsigned char*)lds_raw; C.tid = threadIdx.x; C.lane = C.tid & 63; C.wave = __builtin_amdgcn_readfirstlane(C.tid >> 6); C.G = gridDim.x; C.wg = blockIdx.x;
    C.x_prompt = P.in[0];
    C.x_sample = P.in[1];
    C.cache1 = P.in[2];
    C.cache2 = P.in[3];
    C.cache3 = P.in[4];
    C.state_b = P.in[5];
    C.state_c = P.in[6];
    C.norm_g = P.in[7];
    C.final_g = P.in[8];
    C.w_in_a = P.in[9];
    C.w_out_a = P.in[10];
    C.w_in_b = P.in[11];
    C.gn_b = P.in[12];
    C.w_out_b = P.in[13];
    C.w_in_c = P.in[14];
    C.w_gate2_c = P.in[15];
    C.b_gate_c = P.in[16];
    C.gn_c = P.in[17];
    C.w_out_c = P.in[18];
    C.out = P.out; C.ws = P.ws;
    volatile LAS unsigned* MISC = (volatile LAS unsigned*)(C.lds + MISC_OFF);
    if (C.tid < 32) MISC[C.tid] = 0u;
    __syncthreads();
    XcdBarrier bar = xcd_barrier_post((unsigned*)(P.ws + CTL_BAR), MISC + 8);
    int ph = 0;
#define RUN (ph >= P.ph_lo && ph < P.ph_hi)
#define SEAM() do { if (ph >= P.ph_lo && ph + 1 < P.ph_hi) xcd_barrier(bar); ++ph; } while (0)
    float* out = P.out;
    float* pkv1 = out + (size_t)MP * D + (size_t)MS * D; float* pkv2 = pkv1 + (size_t)2 * 4 * 128 * 4096; float* pkv3 = pkv2 + (size_t)2 * 4 * 512 * 4096;
    float* pst_b = pkv3 + (size_t)2 * 4 * 2048 * 4096; float* pst_c = pst_b + (size_t)4 * 8 * 256 * 512;
    float* sst_b = pst_c + (size_t)4 * 4 * 256 * 512 + (size_t)3 * 2 * 8 * 4 * 4096; float* sst_c = sst_b + (size_t)8 * 8 * 256 * 512;

    if (RUN) p0_prologue(C, P);
    SEAM();
    if (RUN) { gemm_in<0>(C, WS_WIA0, A_IN, 0, pkv1, 0); skinny_in(C, WS_WIA0, A_IN); }
    SEAM();
    if (RUN) sfix_a(C, 0, 0);
    SEAM();
    if (RUN) { attn_fast_phase(C); attn_naive(C, 0); }
    SEAM();
    if (RUN) attn_merge(C);
    SEAM();
    if (RUN) gemm_out<2048>(C, WS_WOA0, 0);
    SEAM();
    if (RUN) { gemm_in<1>(C, WS_WIB, B_IN, 1, nullptr, 0); skinny_in(C, WS_WIB, B_IN); }
    SEAM();
    if (RUN) sfix_b(C, 1);
    SEAM();
    if (RUN) { scan_phase<4>(C, B_IN, 0, 2048, 4096, 8, nullptr, pst_b); recur_naive<false>(C, B_IN, 0, 2048, 4096, 8, DB, T, MP, C.state_b, sst_b); }
    SEAM();
    if (RUN) norm_gate<true>(C, 8, B_IN, 8192, C.gn_b);
    SEAM();
    if (RUN) gemm_out<4096>(C, WS_WOB, 1);
    SEAM();
    if (RUN) { gemm_in<2>(C, WS_WIC, C_INM, 2, nullptr, 0); skinny_in(C, WS_WIC, C_INM);
        float* lr = C.wsp<float>(WS_LR);
        skinny_gemm<D>(C, C.wsp<bf16>(WS_WLR), C.wsp<bf16>(WS_XB), MT, [=](int m, int n, float v) { if (m < 16) lr[(size_t)m * MT + n] = v; }); }
    SEAM();
    if (RUN) { sfix_c(C, 2); gla_pre(C, 2); }
    SEAM();
    if (RUN) { scan_phase<2>(C, C_INM, 0, 1024, 2048, 4, C.wsp<float>(WS_DVEC), pst_c); recur_naive<true>(C, C_INM, 0, 1024, 2048, 4, DB, T, MP, C.state_c, sst_c); }
    SEAM();
    if (RUN) norm_gate<false>(C, 4, C_INM, 4096, C.gn_c);
    SEAM();
    if (RUN) gemm_out<2048>(C, WS_WOC, 2);
    SEAM();
    if (RUN) { gemm_in<0>(C, WS_WIA1, A_IN, 3, pkv1, 1); skinny_in(C, WS_WIA1, A_IN); }
    SEAM();
    if (RUN) sfix_a(C, 3, 1);
    SEAM();
    if (RUN) { attn_fast_phase(C); attn_naive(C, 1); }
    SEAM();
    if (RUN) attn_merge(C);
    SEAM();
    if (RUN) gemm_out<2048>(C, WS_WOA1, 3);
    SEAM();
    if (RUN) final_norm(C);
#undef RUN
#undef SEAM
}
constexpr int NPHASES = 22;
}

#ifndef MK_LAUNCHES
#define MK_LAUNCHES 1
#endif
extern "C" void kernel_launch(void* const* d_in, const int* in_sizes, int n_in, void* d_out, int out_size, void* d_ws, size_t ws_size, hipStream_t stream) {
    using namespace mk;
    static int grid = 0;
    if (grid == 0) {
        int dev = 0, cus = 0;
        if (hipGetDevice(&dev) != hipSuccess || hipDeviceGetAttribute(&cus, hipDeviceAttributeMultiprocessorCount, dev) != hipSuccess) { fprintf(stderr, "kernel_launch: device query failed\n"); grid = -1; return; }
        if (hipFuncSetAttribute((const void*)mk_fwd, hipFuncAttributeMaxDynamicSharedMemorySize, LDS_BYTES) != hipSuccess) { fprintf(stderr, "kernel_launch: hipFuncSetAttribute failed\n"); grid = -1; return; }
        int per_cu = 0;
        if (hipOccupancyMaxActiveBlocksPerMultiprocessor(&per_cu, (const void*)mk_fwd, NWG_THREADS, LDS_BYTES) != hipSuccess || per_cu < 1) fprintf(stderr, "kernel_launch: occupancy query says %d\n", per_cu);
        (void)hipGetLastError();
        if (ws_size < WS_END) { fprintf(stderr, "kernel_launch: workspace too small (%zu < %zu)\n", ws_size, (size_t)WS_END); grid = -1; return; }
        grid = cus;
    }
    if (grid < 0) return;
    (void)hipMemsetAsync((char*)d_ws + WS_CTL, 0, CTL_ZERO_BYTES, stream);
    Params p{};
    for (int i = 0; i < 19; ++i) p.in[i] = (const float*)d_in[i];
    p.out = (float*)d_out; p.ws = (unsigned char*)d_ws;
    for (int i = 0; i < 16; ++i) p.inv_a[i] = pow(500000.0, -(double)i / 16.0);
    for (int i = 0; i < 128; ++i) p.inv_b[i] = pow(10000.0, -(double)i / 128.0);
    if (MK_LAUNCHES == 1) { p.ph_lo = 0; p.ph_hi = NPHASES; hipLaunchKernelGGL(mk_fwd, dim3(grid), dim3(NWG_THREADS), LDS_BYTES, stream, p); }
    else for (int k = 0; k < NPHASES; ++k) { p.ph_lo = k; p.ph_hi = k + 1; hipLaunchKernelGGL(mk_fwd, dim3(grid), dim3(NWG_THREADS), LDS_BYTES, stream, p); }
}
```

```cpp
#include <hip/hip_runtime.h>
#include <cstdio>
#include <cstdint>
#include <cmath>
namespace pg8 {
#define PG8_LAS __attribute__((address_space(3)))
typedef unsigned short bf16_t;
typedef short bf16x8 __attribute__((ext_vector_type(8)));
typedef float f32x4 __attribute__((ext_vector_type(4)));
typedef unsigned u32x4 __attribute__((ext_vector_type(4)));
constexpr int BM = 256, BK = 64, HALF = 128, HTB = HALF * BK * 2  , STAGE_BYTES = 8 * HTB, NXCD = 8, WGM = 8;

__host__ __device__ __forceinline__ int lds_byte(int r, int c) { const int st = (r >> 4) * 2 + (c >> 5), rr = r & 15, cc = c & 31, ob = rr * 64 + cc * 2; return st * 1024 + (ob ^ (((ob >> 9) & 1) << 5)); }
__host__ __device__ __forceinline__ void stage_rc(int b, int& R, int& C) { const int st = b / 1024, sb = b % 1024, swz = sb ^ (((sb >> 9) & 1) << 5); R = (st >> 1) * 16 + swz / 64; C = (st & 1) * 32 + (swz % 64) / 2; }
__host__ __device__ __forceinline__ int perm32(int rho) { const int n = rho >> 4, i = rho & 15; return 8 * (i >> 2) + 4 * n + (i & 3); }

struct Unit { int pm, pn; };
struct Gemm { const bf16_t* A; const bf16_t* Bt; int M, N, K; };

struct StaticOrder {
    int nM, nN, nwg, G, c;
    __host__ __device__ void init(int M, int N, int G_, int c_) { nM = M / BM; nN = N / BM; nwg = nM * nN; G = G_; c = c_; }
    __host__ __device__ bool next(int i, Unit& u) const {
        const long L = (long)i * G + c; if (L >= nwg) return false;
        int wgid = (int)L; { const int q = nwg / NXCD, r = nwg % NXCD, xcd = wgid % NXCD, off = wgid / NXCD; wgid = (xcd < r ? xcd * (q + 1) : r * (q + 1) + (xcd - r) * q) + off; }
        const int nig = WGM * nN, gid = wgid / nig, fm = gid * WGM, gsz = (nM - fm) < WGM ? (nM - fm) : WGM;
        u.pm = fm + ((wgid % nig) % gsz); u.pn = (wgid % nig) / gsz; return true;
    }
    __device__ __forceinline__ void a_ready(const Unit&) const {}
    __device__ __forceinline__ void done(const Unit&) const {}
};

__device__ __forceinline__ unsigned cvt_pk_bf16(float lo, float hi) { unsigned r; asm volatile("v_cvt_pk_bf16_f32 %0, %1, %2" : "=v"(r) : "v"(lo), "v"(hi)); return r; }
typedef float f32x2 __attribute__((ext_vector_type(2)));
typedef unsigned u32x2 __attribute__((ext_vector_type(2)));

template <int MODE> struct EpiIn {
    static constexpr bool PERM = true, AFTER_DRAIN = false;
    bf16_t* Z; int ldz; const float* sumsq; const f32x2* tab; float* kvb; int slot;
    __device__ __forceinline__ void store8(bf16_t* p, const f32x4& a, const f32x4& b) const {
        u32x4 w; w.x = cvt_pk_bf16(a[0], a[1]); w.y = cvt_pk_bf16(a[2], a[3]); w.z = cvt_pk_bf16(b[0], b[1]); w.w = cvt_pk_bf16(b[2], b[3]); *(u32x4*)p = w; }
    __device__ __forceinline__ void operator()(const f32x4 (&acc)[2][2][4][2], const Unit& u, int wr, int wc, int fr, int fq) const {
        const int row0 = u.pm * BM + wr * 64 + fr, colt = u.pn * BM;
        if constexpr (MODE == 0) {
            const int section = u.pn >> 3, kind = section < 9 ? section % 3 : 3, g = section / 3;
            const bool rot = (kind < 2) && (wc == 0);
            const int gg = g > 2 ? 2 : g, keep = 128 << (2 * gg); float* kvo = kvb + (size_t)32768 * (size_t)(128 * (((1 << (2 * gg)) - 1) / 3)) + (size_t)slot * 4 * keep * 4096;
#pragma unroll
            for (int ai = 0; ai < 2; ++ai)
#pragma unroll
                for (int m = 0; m < 4; ++m) {
                    const int row = row0 + ai * HALF + m * 16; const float rs = rsqrtf(sumsq[row] * (1.0f / 2048.0f) + 1e-6f); const int pos = row & 2047, b = row >> 11;
#pragma unroll
                    for (int bj = 0; bj < 2; ++bj) {
                        f32x4 v0 = acc[ai][bj][m][0] * rs, v1 = acc[ai][bj][m][1] * rs;
                        const int col = colt + bj * HALF + wc * 32 + 8 * fq;
                        if (rot) {
                            f32x4 p0, p1;
#pragma unroll
                            for (int j = 0; j < 4; ++j) { p0[j] = __shfl_xor(v0[j], 32); p1[j] = __shfl_xor(v1[j], 32); }
                            const f32x4* tp = (const f32x4*)(tab + pos * 16 + 8 * (fq & 1));
                            const f32x4 t0 = tp[0], t1 = tp[1], t2 = tp[2], t3 = tp[3];
                            const f32x4 c0 = {t0[0], t0[2], t1[0], t1[2]}, s0 = {t0[1], t0[3], t1[1], t1[3]}, c1 = {t2[0], t2[2], t3[0], t3[2]}, s1 = {t2[1], t2[3], t3[1], t3[3]};
                            if (fq < 2) { v0 = v0 * c0 - p0 * s0; v1 = v1 * c1 - p1 * s1; } else { v0 = p0 * s0 + v0 * c0; v1 = p1 * s1 + v1 * c1; }
                        }
                        store8(Z + (size_t)row * ldz + col, v0, v1);
                        if (kind == 1 || kind == 2) {
                            if (pos >= 2048 - keep) { float* o = kvo + (((size_t)b * keep + (pos - (2048 - keep))) * 2 + (kind - 1)) * 2048 + (col - section * 2048);
                                *(f32x4*)o = v0; *(f32x4*)(o + 4) = v1; }
                        }
                    }
                }
        } else if constexpr (MODE == 1) {
            const bool rot = u.pn < 16; const float sc = (u.pn >= 8 && u.pn < 16) ? 0.0625f : 1.0f;
            const float lg2 = log2f(1.0f - exp2f(-5.0f - (float)(u.pn & 7)));
#pragma unroll
            for (int ai = 0; ai < 2; ++ai)
#pragma unroll
                for (int m = 0; m < 4; ++m) {
                    const int row = row0 + ai * HALF + m * 16; const int pos = row & 2047;
                    float rs = rsqrtf(sumsq[row] * (1.0f / 2048.0f) + 1e-6f) * sc;
                    if (rot) { const float ee = (float)((pos & 127) + 1) * lg2; rs *= exp2f(u.pn < 8 ? ee : -ee); }
                    f32x4 x1[2], x2[2];
#pragma unroll
                    for (int n = 0; n < 2; ++n) { x1[n] = acc[ai][0][m][n] * rs; x2[n] = acc[ai][1][m][n] * rs; }
                    if (rot) {
#pragma unroll
                        for (int n = 0; n < 2; ++n) {
                            const f32x4* tp = (const f32x4*)(tab + pos * 128 + wc * 32 + 8 * fq + 4 * n);
                            const f32x4 t0 = tp[0], t1 = tp[1];
                            const f32x4 c = {t0[0], t0[2], t1[0], t1[2]}, s = {t0[1], t0[3], t1[1], t1[3]};
                            const f32x4 a = x1[n], bb = x2[n];
                            x1[n] = a * c - bb * s; x2[n] = a * s + bb * c;
                        }
                    }
                    bf16_t* zp = Z + (size_t)row * ldz + colt + wc * 32 + 8 * fq;
                    store8(zp, x1[0], x1[1]); store8(zp + HALF, x2[0], x2[1]);
                }
        } else {
            const float sc = u.pn < 4 ? 0.0625f : 1.0f;
#pragma unroll
            for (int ai = 0; ai < 2; ++ai)
#pragma unroll
                for (int m = 0; m < 4; ++m) {
                    const int row = row0 + ai * HALF + m * 16; const float rs = rsqrtf(sumsq[row] * (1.0f / 2048.0f) + 1e-6f) * sc;
                    bf16_t* zp = Z + (size_t)row * ldz + colt + wc * 32 + 8 * fq;
#pragma unroll
                    for (int bj = 0; bj < 2; ++bj) store8(zp + bj * HALF, acc[ai][bj][m][0] * rs, acc[ai][bj][m][1] * rs);
                }
        }
    }
};
struct EpiOut {
    static constexpr bool PERM = false, AFTER_DRAIN = false;
    float* xres; bf16_t* xb; float* sumsq_next;
    __device__ __forceinline__ void operator()(const f32x4 (&acc)[2][2][4][2], const Unit& u, int wr, int wc, int fr, int fq) const {
        const int row0 = u.pm * BM + wr * 64 + fr, col0 = u.pn * BM + wc * 32 + 4 * fq;
#pragma unroll
        for (int ai = 0; ai < 2; ++ai)
#pragma unroll
            for (int m = 0; m < 4; ++m) {
                const int row = row0 + ai * HALF + m * 16; float ss = 0.f;
                float* xr = xres + (size_t)row * 2048 + col0; bf16_t* br = xb + (size_t)row * 2048 + col0;
#pragma unroll
                for (int bj = 0; bj < 2; ++bj)
#pragma unroll
                    for (int n = 0; n < 2; ++n) {
                        const f32x4 v = *(const f32x4*)(xr + bj * HALF + n * 16) + acc[ai][bj][m][n];
                        *(f32x4*)(xr + bj * HALF + n * 16) = v;
                        u32x2 w; w.x = cvt_pk_bf16(v[0], v[1]); w.y = cvt_pk_bf16(v[2], v[3]); *(u32x2*)(br + bj * HALF + n * 16) = w;
                        ss += (v[0] * v[0] + v[1] * v[1]) + (v[2] * v[2] + v[3] * v[3]);
                    }
                ss += __shfl_xor(ss, 16); ss += __shfl_xor(ss, 32);
                if (fq == 0) atomicAdd(sumsq_next + row, ss);
            }
    }
};
template <class Epi, class Sched, bool ALIGN_EPI = false, bool SP2 = false>
__device__ __forceinline__ void gemm_phase(PG8_LAS unsigned char* lds, const Gemm g, const Sched& S, const Epi& E) {
    const int tid = threadIdx.x, wid = __builtin_amdgcn_readfirstlane(tid >> 6), lane = tid & 63, wr = wid >> 2, wc = wid & 3, fr = lane & 15, fq = lane >> 4;
    const int K = g.K, nt = K / BK;
    unsigned voffA[2], voffB[2];
#pragma unroll
    for (int i = 0; i < 2; ++i) { int R, C; stage_rc(tid * 16 + i * 8192, R, C); const int Rb = Epi::PERM ? ((R & ~31) + perm32(R & 31)) : R;
        voffA[i] = (unsigned)(R * K + C) * 2u; voffB[i] = (unsigned)(Rb * K + C) * 2u; }
    const size_t kstep = (size_t)(BK * 2);
    const size_t hstep = (size_t)HALF * K * 2;
    const size_t tstep = 2 * hstep;
    const unsigned ldsw = (unsigned)wid * 1024u;
    const int aoff = lds_byte(wr * 64 + fr, fq * 8), boff = lds_byte(wc * 32 + fr, fq * 8);
#define PG8_SA(b, h) (((b) * 2 + (h)) * HTB)
#define PG8_SB(b, h) ((4 + (b) * 2 + (h)) * HTB)
#define PG8_STAGE(bufoff, gbase, voff) do { _Pragma("unroll") for (int _i = 0; _i < 2; ++_i) \
        __builtin_amdgcn_global_load_lds((const unsigned*)((const char*)(gbase) + (voff)[_i]), (PG8_LAS unsigned*)(lds + (bufoff) + ldsw + _i * 8192), 16, 0, 0); } while (0)
#define PG8_LDA(dst, b, h) do { _Pragma("unroll") for (int m = 0; m < 4; ++m) _Pragma("unroll") for (int k = 0; k < 2; ++k) dst[m][k] = *(const PG8_LAS bf16x8*)(lds + PG8_SA(b, h) + aoff + m * 2048 + k * 1024); } while (0)
#define PG8_LDB(dst, b, h) do { _Pragma("unroll") for (int n = 0; n < 2; ++n) _Pragma("unroll") for (int k = 0; k < 2; ++k) dst[n][k] = *(const PG8_LAS bf16x8*)(lds + PG8_SB(b, h) + boff + n * 2048 + k * 1024); } while (0)
#define PG8_MMA(ai, bj, At, Bt) do { __builtin_amdgcn_s_setprio(1); _Pragma("unroll") for (int m = 0; m < 4; ++m) _Pragma("unroll") for (int n = 0; n < 2; ++n) _Pragma("unroll") for (int k = 0; k < 2; ++k) \
        acc[ai][bj][m][n] = __builtin_amdgcn_mfma_f32_16x16x32_bf16(Bt[n][k], At[m][k], acc[ai][bj][m][n], 0, 0, 0); __builtin_amdgcn_s_setprio(0); } while (0)
#define PG8_WAIT_V(n) asm volatile("s_waitcnt vmcnt(" #n ")" ::: "memory")
#define PG8_WAIT_L(n) asm volatile("s_waitcnt lgkmcnt(" #n ")" ::: "memory")
#define PG8_BAR __builtin_amdgcn_s_barrier()
#define PG8_SCHED __builtin_amdgcn_sched_barrier(0)
    Unit cur, nxt; int ui = 0;
    if (!S.next(0, cur)) return;
    f32x4 acc[2][2][4][2];
#pragma unroll
    for (int a = 0; a < 2; ++a)
#pragma unroll
        for (int b = 0; b < 2; ++b)
#pragma unroll
            for (int m = 0; m < 4; ++m)
#pragma unroll
                for (int n = 0; n < 2; ++n) acc[a][b][m][n] = (f32x4){0.f, 0.f, 0.f, 0.f};
    bf16x8 At[4][2], B0[2][2], B1[2][2];
    const char* cA = (const char*)g.A + (size_t)cur.pm * tstep; const char* cB = (const char*)g.Bt + (size_t)cur.pn * tstep;
    S.a_ready(cur);
    if constexpr (SP2) {
        PG8_STAGE(PG8_SB(0, 0), cB, voffB); PG8_STAGE(PG8_SB(0, 1), cB + hstep, voffB); PG8_STAGE(PG8_SA(0, 0), cA, voffA); PG8_STAGE(PG8_SA(0, 1), cA + hstep, voffA);
        if (wr == 1) PG8_BAR;
        PG8_WAIT_V(2); PG8_BAR;
        PG8_STAGE(PG8_SB(1, 0), cB + kstep, voffB); PG8_STAGE(PG8_SA(1, 0), cA + kstep, voffA); PG8_STAGE(PG8_SB(1, 1), cB + hstep + kstep, voffB);
        PG8_WAIT_V(6); PG8_BAR;
    } else {
        PG8_STAGE(PG8_SB(0, 0), cB, voffB); PG8_STAGE(PG8_SA(0, 0), cA, voffA); PG8_STAGE(PG8_SB(0, 1), cB + hstep, voffB); PG8_STAGE(PG8_SA(0, 1), cA + hstep, voffA);
        if (wr == 1) PG8_BAR;
        PG8_WAIT_V(4); PG8_BAR;
        PG8_STAGE(PG8_SB(1, 0), cB + kstep, voffB); PG8_STAGE(PG8_SA(1, 0), cA + kstep, voffA); PG8_STAGE(PG8_SB(1, 1), cB + hstep + kstep, voffB);
        PG8_WAIT_V(6); PG8_BAR;
    }
    for (;;) {
        const bool has_next = S.next(ui + 1, nxt);
        const char* nA = has_next ? (const char*)g.A + (size_t)nxt.pm * tstep : cA; const char* nB = has_next ? (const char*)g.Bt + (size_t)nxt.pn * tstep : cB;
        for (int t = 0; t < nt; t += 2) {
            const bool last = (t == nt - 2);
            const char* a1 = cA + (size_t)(t + 1) * kstep;
            const char* a2 = last ? nA : cA + (size_t)(t + 2) * kstep; const char* b2 = last ? nB : cB + (size_t)(t + 2) * kstep;
            const char* a3 = a2 + kstep; const char* b3 = b2 + kstep;
            if (last && has_next) S.a_ready(nxt);
            if constexpr (SP2) {
            PG8_LDB(B0, 0, 0); PG8_LDB(B1, 0, 1); PG8_SCHED; PG8_LDA(At, 0, 0); PG8_STAGE(PG8_SA(1, 1), a1 + hstep, voffA);
            PG8_WAIT_V(8); PG8_WAIT_L(0); PG8_BAR; PG8_MMA(0, 0, At, B0); PG8_MMA(0, 1, At, B1); PG8_BAR; PG8_SCHED;
            PG8_LDA(At, 0, 1); PG8_STAGE(PG8_SB(0, 0), b2, voffB); PG8_STAGE(PG8_SB(0, 1), b2 + hstep, voffB); PG8_STAGE(PG8_SA(0, 0), a2, voffA);
            PG8_WAIT_V(8); PG8_WAIT_L(0); PG8_BAR; PG8_MMA(1, 0, At, B0); PG8_MMA(1, 1, At, B1); PG8_BAR; PG8_SCHED;
            PG8_LDB(B0, 1, 0); PG8_LDB(B1, 1, 1); PG8_SCHED; PG8_LDA(At, 1, 0); PG8_STAGE(PG8_SA(0, 1), a2 + hstep, voffA);
            PG8_WAIT_V(8); PG8_WAIT_L(0); PG8_BAR; PG8_MMA(0, 0, At, B0); PG8_MMA(0, 1, At, B1); PG8_BAR; PG8_SCHED;
            PG8_LDA(At, 1, 1); PG8_STAGE(PG8_SB(1, 0), b3, voffB); PG8_STAGE(PG8_SB(1, 1), b3 + hstep, voffB); PG8_STAGE(PG8_SA(1, 0), a3, voffA);
            PG8_WAIT_V(8); PG8_WAIT_L(0); PG8_BAR; PG8_MMA(1, 0, At, B0); PG8_MMA(1, 1, At, B1); PG8_BAR; PG8_SCHED;
            } else {
            PG8_LDB(B0, 0, 0); PG8_SCHED; PG8_LDA(At, 0, 0); PG8_STAGE(PG8_SA(1, 1), a1 + hstep, voffA);
            PG8_WAIT_L(8); PG8_BAR; PG8_WAIT_L(0); PG8_MMA(0, 0, At, B0); PG8_BAR; PG8_SCHED;
            PG8_LDB(B1, 0, 1); PG8_STAGE(PG8_SB(0, 0), b2, voffB);
            PG8_BAR; PG8_WAIT_L(0); PG8_MMA(0, 1, At, B1); PG8_BAR;
            PG8_LDA(At, 0, 1); PG8_STAGE(PG8_SA(0, 0), a2, voffA);
            PG8_BAR; PG8_WAIT_L(0); PG8_MMA(1, 0, At, B0); PG8_BAR; PG8_SCHED;
            PG8_STAGE(PG8_SB(0, 1), b2 + hstep, voffB);
            PG8_WAIT_V(6); PG8_BAR; PG8_MMA(1, 1, At, B1); PG8_BAR;
            PG8_LDB(B0, 1, 0); PG8_SCHED; PG8_LDA(At, 1, 0); PG8_STAGE(PG8_SA(0, 1), a2 + hstep, voffA);
            PG8_WAIT_L(8); PG8_BAR; PG8_WAIT_L(0); PG8_MMA(0, 0, At, B0); PG8_BAR; PG8_SCHED;
            PG8_LDB(B1, 1, 1); PG8_STAGE(PG8_SB(1, 0), b3, voffB);
            PG8_BAR; PG8_WAIT_L(0); PG8_MMA(0, 1, At, B1); PG8_BAR;
            PG8_LDA(At, 1, 1); PG8_STAGE(PG8_SA(1, 0), a3, voffA);
            PG8_BAR; PG8_WAIT_L(0); PG8_MMA(1, 0, At, B0); PG8_BAR; PG8_SCHED;
            PG8_STAGE(PG8_SB(1, 1), b3 + hstep, voffB);
            PG8_WAIT_V(6); PG8_BAR; PG8_MMA(1, 1, At, B1); PG8_BAR;
            }
        }
        if constexpr (ALIGN_EPI) { if (wr == 0) PG8_BAR; }
        if constexpr (!Epi::AFTER_DRAIN) { E(acc, cur, wr, wc, fr, fq); S.done(cur); }
        if (!has_next) break;
#pragma unroll
        for (int a = 0; a < 2; ++a)
#pragma unroll
            for (int b = 0; b < 2; ++b)
#pragma unroll
                for (int m = 0; m < 4; ++m)
#pragma unroll
                    for (int n = 0; n < 2; ++n) acc[a][b][m][n] = (f32x4){0.f, 0.f, 0.f, 0.f};
        cur = nxt; cA = nA; cB = nB; ++ui;
        if constexpr (ALIGN_EPI) { if (wr == 1) PG8_BAR; }
    }
    PG8_WAIT_V(0);
    if constexpr (!ALIGN_EPI) { if (wr == 0) PG8_BAR; }
    PG8_BAR;
    if constexpr (Epi::AFTER_DRAIN) { E.fused(acc, cur, wr, wc, fr, fq, lds, wid, lane); S.done(cur); }
#undef PG8_SA
#undef PG8_SB
#undef PG8_STAGE
#undef PG8_LDA
#undef PG8_LDB
#undef PG8_MMA
#undef PG8_WAIT_V
#undef PG8_WAIT_L
#undef PG8_BAR
#undef PG8_SCHED
}
}
#define LAS __attribute__((address_space(3)))
#define XB_TMO      128
#define XB_XCNT(j)  (256  + 64 * (j))
#define XB_XSUB(j)  (1280 + 64 * (j))
#define XB_XGEN(j)  (2304 + 64 * (j))
#define XB_TOP      3328
#define XB_TOPGEN   3392
#define XCD_BAR_WORDS 3456
#define XB_SPIN_CAP (1u << 18)

__device__ __forceinline__ unsigned xb_ld(unsigned* p)              { return __hip_atomic_load(p, __ATOMIC_RELAXED, __HIP_MEMORY_SCOPE_AGENT); }
__device__ __forceinline__ unsigned xb_add(unsigned* p, unsigned v) { return __hip_atomic_fetch_add(p, v, __ATOMIC_RELAXED, __HIP_MEMORY_SCOPE_AGENT); }
__device__ __forceinline__ unsigned xb_xcc_id() { return (unsigned)__builtin_amdgcn_s_getreg((3 << 11) | 20) & 0xFu; }
#define XB_SPIN(cond, bar) do { unsigned _sp = 0; while (cond) { __builtin_amdgcn_s_sleep(1); \
    if ((++_sp & 255u) == 0u) { if (xb_ld(&(bar)[XB_TMO])) break; if (_sp > XB_SPIN_CAP) { atomicAdd(&(bar)[XB_TMO], 1u); break; } } } } while (0)

struct XcdBarrier {
    unsigned* bar; unsigned x;
    volatile LAS unsigned* st;
};

__device__ __forceinline__ XcdBarrier xcd_barrier_post(unsigned* bar, volatile LAS unsigned* st) {
    XcdBarrier b; b.bar = bar; b.x = xb_xcc_id(); b.st = st;
    if (threadIdx.x == 0) (void)xb_add(&bar[XB_XCNT(b.x)], 1u);
    return b;
}
__device__ __forceinline__ void xcd_barrier_complete(unsigned* bar, unsigned x, unsigned& nloc, unsigned& nx) {
    const unsigned G = gridDim.x * gridDim.y * gridDim.z;
    unsigned sum, cnt, mine, sp = 0u;
    for (;;) {
        sum = 0u; cnt = 0u; mine = 0u;
#pragma unroll
        for (unsigned j = 0; j < 16; ++j) { const unsigned c = xb_ld(&bar[XB_XCNT(j)]); sum += c; cnt += (c > 0u) ? 1u : 0u; mine = (j == x) ? c : mine; }
        if (sum == G) break;
        __builtin_amdgcn_s_sleep(1);
        if ((++sp & 255u) == 0u) { if (xb_ld(&bar[XB_TMO])) break; if (sp > XB_SPIN_CAP) { atomicAdd(&bar[XB_TMO], 1u); break; } }
    }
    nloc = mine > 0u ? mine : 1u; nx = cnt > 0u ? cnt : 1u;
}

__device__ __forceinline__ void xcd_barrier(const XcdBarrier& b) {
    asm volatile("s_waitcnt vmcnt(0)" ::: "memory");
    __syncthreads();
    if (threadIdx.x == 0) {
        unsigned* bar = b.bar;
        __builtin_amdgcn_s_waitcnt(0);
        unsigned nloc = b.st[0], nx = b.st[1];
        if (nloc == 0u) { xcd_barrier_complete(bar, b.x, nloc, nx); b.st[0] = nloc; b.st[1] = nx; }
        const unsigned old = xb_add(&bar[XB_XSUB(b.x)], 1u);
        const unsigned gen = old / nloc;
        if (old + 1u == (gen + 1u) * nloc) {
            __builtin_amdgcn_fence(__ATOMIC_RELEASE, "agent");
            asm volatile("s_waitcnt vmcnt(0)" ::: "memory");
            const unsigned og = xb_add(&bar[XB_TOP], 1u);
            const unsigned tg = og / nx;
            if (og + 1u == (tg + 1u) * nx) xb_add(&bar[XB_TOPGEN], 1u);
            else XB_SPIN(xb_ld(&bar[XB_TOPGEN]) == tg, bar);
            __builtin_amdgcn_fence(__ATOMIC_ACQUIRE, "agent");
            xb_add(&bar[XB_XGEN(b.x)], 1u);
            asm volatile("s_waitcnt vmcnt(0)" ::: "memory");
        } else {
            XB_SPIN(xb_ld(&bar[XB_XGEN(b.x)]) == gen, bar);
            __builtin_amdgcn_fence(__ATOMIC_ACQUIRE, "agent");
            asm volatile("s_waitcnt vmcnt(0)" ::: "memory");
        }
    }
    __syncthreads();
}
#ifdef EMU
#include <pthread.h>
#include <cstring>
#include <cstdio>
#include <cstdlib>
#include <cmath>
#include <cstdint>
#define DEV static inline
#define LAS
struct EmuDim { int x; };
static thread_local EmuDim threadIdx;
typedef short bf16x8 __attribute__((ext_vector_type(8)));
typedef short s16x4 __attribute__((ext_vector_type(4)));
typedef float f32x4 __attribute__((ext_vector_type(4)));
typedef float f32x2 __attribute__((ext_vector_type(2)));
typedef unsigned u32x4 __attribute__((ext_vector_type(4)));
typedef unsigned u32x2 __attribute__((ext_vector_type(2)));
struct WaveX { bf16x8 a[64], b[64]; float f[64]; const void* p[64]; pthread_barrier_t bar; };
static WaveX g_wx[8];
static pthread_barrier_t g_wgbar;
static inline float emu_bf2f(short v) { unsigned u = ((unsigned)(unsigned short)v) << 16; float f; memcpy(&f, &u, 4); return f; }
static inline float __uint_as_float(unsigned u) { float f; memcpy(&f, &u, 4); return f; }
static inline unsigned __float_as_uint(float f) { unsigned u; memcpy(&u, &f, 4); return u; }
DEV f32x4 mfma16(bf16x8 a, bf16x8 b, f32x4 c) {
    const int lane = threadIdx.x & 63; WaveX& W = g_wx[threadIdx.x >> 6];
    W.a[lane] = a; W.b[lane] = b; pthread_barrier_wait(&W.bar);
    f32x4 r; const int g = lane >> 4, j = lane & 15;
    for (int rr = 0; rr < 4; ++rr) { const int i = 4 * g + rr; float s = 0.f;
        for (int k = 0; k < 32; ++k) s += emu_bf2f(W.a[i + 16 * (k / 8)][k % 8]) * emu_bf2f(W.b[j + 16 * (k / 8)][k % 8]);
        r[rr] = c[rr] + s; }
    pthread_barrier_wait(&W.bar); return r;
}
DEV s16x4 tr_read(const void* p) {
    const int lane = threadIdx.x & 63; WaveX& W = g_wx[threadIdx.x >> 6];
    W.p[lane] = p; pthread_barrier_wait(&W.bar);
    s16x4 r; const int G = lane >> 4, i = lane & 15;
    for (int q = 0; q < 4; ++q) { const short* src = (const short*)W.p[16 * G + 4 * q + i / 4]; if (((uintptr_t)src) & 7) { fprintf(stderr, "tr_read: unaligned\n"); abort(); } r[q] = src[i % 4]; }
    pthread_barrier_wait(&W.bar); return r;
}
DEV void lds_wait() {}
#define tr_read_o(base, off) tr_read((const unsigned char*)(base) + (off))
DEV float shflx(float v, int m) { const int lane = threadIdx.x & 63; WaveX& W = g_wx[threadIdx.x >> 6]; W.f[lane] = v; pthread_barrier_wait(&W.bar); const float r = W.f[lane ^ m]; pthread_barrier_wait(&W.bar); return r; }
DEV void wg_sync() { pthread_barrier_wait(&g_wgbar); }
DEV void mem_fence_cc() {}
DEV void wave_sync() { pthread_barrier_wait(&g_wx[threadIdx.x >> 6].bar); }
DEV float fast_exp(float x) { return expf(x); }
DEV float fast_log(float x) { return logf(x); }
DEV float fast_exp2(float x) { return exp2f(x); }
DEV float fast_log2(float x) { return log2f(x); }
DEV float fast_rcp(float x) { return 1.0f / x; }
DEV unsigned cvt_pk_bf16(float lo, float hi) { auto f = [](float x) { unsigned u = __float_as_uint(x); return (u + 0x7fffu + ((u >> 16) & 1u)) >> 16; }; return f(lo) | (f(hi) << 16); }
#else
#define DEV __device__ __forceinline__
typedef short bf16x8 __attribute__((ext_vector_type(8)));
typedef short s16x4 __attribute__((ext_vector_type(4)));
typedef float f32x4 __attribute__((ext_vector_type(4)));
typedef float f32x2 __attribute__((ext_vector_type(2)));
typedef unsigned u32x4 __attribute__((ext_vector_type(4)));
typedef unsigned u32x2 __attribute__((ext_vector_type(2)));
DEV f32x4 mfma16(bf16x8 a, bf16x8 b, f32x4 c) { return __builtin_amdgcn_mfma_f32_16x16x32_bf16(a, b, c, 0, 0, 0); }
DEV s16x4 tr_read(const LAS void* p) { s16x4 r; asm volatile("ds_read_b64_tr_b16 %0, %1" : "=&v"(r) : "v"((unsigned)(size_t)p) : "memory"); return r; }
DEV s16x4 tr_read_o(const LAS void* p, int off) { s16x4 r; asm volatile("ds_read_b64_tr_b16 %0, %1 offset:%2" : "=&v"(r) : "v"((unsigned)(size_t)p), "i"(off) : "memory"); return r; }
DEV void lds_wait() { asm volatile("s_waitcnt lgkmcnt(0)" ::: "memory"); __builtin_amdgcn_sched_barrier(0); }
DEV float shflx(float v, int m) { return __shfl_xor(v, m); }
DEV void wg_sync() { __syncthreads(); }
DEV void mem_fence_cc() { asm volatile("" ::: "memory"); }
DEV void wave_sync() { asm volatile("s_waitcnt lgkmcnt(0)" ::: "memory"); }
DEV float fast_exp(float x) { return __expf(x); }
DEV float fast_log(float x) { return __logf(x); }
DEV float fast_exp2(float x) { return __builtin_amdgcn_exp2f(x); }
DEV float fast_log2(float x) { return __builtin_amdgcn_logf(x); }
DEV float fast_rcp(float x) { return __builtin_amdgcn_rcpf(x); }
DEV unsigned cvt_pk_bf16(float lo, float hi) { unsigned r; asm volatile("v_cvt_pk_bf16_f32 %0, %1, %2" : "=v"(r) : "v"(lo), "v"(hi)); return r; }
#endif
typedef unsigned short bf16;
DEV bf16x8 pack8(s16x4 lo, s16x4 hi) { return (bf16x8){lo[0], lo[1], lo[2], lo[3], hi[0], hi[1], hi[2], hi[3]}; }

namespace mk {
typedef unsigned short bf16;
typedef float f32x4 __attribute__((ext_vector_type(4)));
typedef float f32x2 __attribute__((ext_vector_type(2)));
typedef unsigned u32x4 __attribute__((ext_vector_type(4)));
typedef unsigned u32x2 __attribute__((ext_vector_type(2)));
typedef short bf16x8 __attribute__((ext_vector_type(8)));
constexpr int D = 2048, NB = 4, S = 2048, MP = NB * S, DB = 8, T = 4, MS = DB * T, MT = MP + MS, PAST = 16384;
constexpr float EPS = 1e-6f;
constexpr int A_IN = 20480, B_IN = 12288, C_IN = 6160, C_INM = 6144;
constexpr int NWG_THREADS = 512;
constexpr size_t MiB = 1u << 20;
constexpr size_t WS_CTL = 0, CTL_ZERO_BYTES = 1 * MiB;
constexpr size_t CTL_BAR = 16384;
constexpr size_t CTL_SUMSQ = 65536;
constexpr size_t WS_TABA = 1 * MiB;
constexpr size_t WS_TABB = WS_TABA + 512 * 1024;
constexpr size_t WS_WIA0 = 4 * MiB;
constexpr size_t WS_WIA1 = WS_WIA0 + (size_t)A_IN * D * 2;
constexpr size_t WS_WIB = WS_WIA1 + (size_t)A_IN * D * 2;
constexpr size_t WS_WIC = WS_WIB + (size_t)B_IN * D * 2;
constexpr size_t WS_WLR = WS_WIC + (size_t)C_INM * D * 2;
constexpr size_t WS_WOA0 = WS_WLR + (size_t)32 * D * 2;
constexpr size_t WS_WOA1 = WS_WOA0 + (size_t)D * 2048 * 2;
constexpr size_t WS_WOB = WS_WOA1 + (size_t)D * 2048 * 2;
constexpr size_t WS_WOC = WS_WOB + (size_t)D * 4096 * 2;
constexpr size_t WS_XRES = WS_WOC + (size_t)D * 2048 * 2;
constexpr size_t WS_XB = WS_XRES + (size_t)MT * D * 4;
constexpr size_t WS_Z = WS_XB + (size_t)MT * D * 2;
constexpr size_t WS_ZSRAW = WS_Z + (size_t)MT * A_IN * 2;
constexpr size_t WS_Y = WS_ZSRAW + (size_t)32 * A_IN * 4;
constexpr size_t WS_O = WS_Y + (size_t)MT * 4096 * 2;
constexpr size_t WS_LOGA = WS_O + (size_t)MT * 4096 * 4;
constexpr size_t WS_LR = WS_LOGA + (size_t)MT * 1024 * 4;
constexpr size_t WS_DVEC = WS_LR + (size_t)32 * MT * 4;
constexpr size_t WS_END = WS_DVEC + (size_t)4 * 4 * 16 * 256 * 4;
constexpr int LDS_BYTES = 147456, MISC_OFF = 131072 + 320;

struct Params {
    const float* in[19]; float* out; unsigned char* ws;
    double inv_a[16]; double inv_b[128];
    int ph_lo, ph_hi;
};

__device__ __forceinline__ float bf2f(bf16 v) { return __uint_as_float(((unsigned)v) << 16); }
__device__ __forceinline__ unsigned f2bf(float f) { unsigned u = __float_as_uint(f); return (u + 0x7fffu + ((u >> 16) & 1u)) >> 16; }
__device__ __forceinline__ unsigned pk2(float lo, float hi) { return f2bf(lo) | (f2bf(hi) << 16); }
__device__ __forceinline__ float wave_sum(float v) {
#pragma unroll
    for (int o = 32; o >= 1; o >>= 1) v += __shfl_xor(v, o);
    return v;
}
__device__ __forceinline__ float wave_max(float v) {
#pragma unroll
    for (int o = 32; o >= 1; o >>= 1) v = fmaxf(v, __shfl_xor(v, o));
    return v;
}
__device__ __forceinline__ float silu(float x) { return x / (1.f + __expf(-x)); }
__device__ __forceinline__ void sincos_d(double a, float& s, float& c) {
    const double k = rint(a * 0.63661977236758134308);
    double r = fma(-k, 1.57079632679489655800e+00, a); r = fma(-k, 6.12323399573676603587e-17, r);
    const double r2 = r * r;
    const double sp = r * (1.0 + r2 * (-1.0 / 6 + r2 * (1.0 / 120 + r2 * (-1.0 / 5040 + r2 * (1.0 / 362880 + r2 * (-1.0 / 39916800 + r2 * (1.0 / 6227020800.0)))))));
    const double cp = 1.0 + r2 * (-0.5 + r2 * (1.0 / 24 + r2 * (-1.0 / 720 + r2 * (1.0 / 40320 + r2 * (-1.0 / 3628800 + r2 * (1.0 / 479001600.0 + r2 * (-1.0 / 87178291200.0)))))));
    const int q = (int)((long long)k & 3);
    const double ss = (q == 0) ? sp : (q == 1) ? cp : (q == 2) ? -sp : -cp;
    const double cc = (q == 0) ? cp : (q == 1) ? -sp : (q == 2) ? -cp : sp;
    s = (float)ss; c = (float)cc;
}
__device__ __forceinline__ void row_info(int row, int& b, int& t, int& pi, bool& samp) {
    if (row < MP) { b = row >> 11; t = row & 2047; pi = t; samp = false; } else { const int r = row - MP; b = r >> 2; t = r & 3; pi = 2048 + t; samp = true; }
}

struct Ctx {
    LAS unsigned char* lds; int tid, lane, wave, G, wg;
    const float *x_prompt, *x_sample, *cache1, *cache2, *cache3, *state_b, *state_c, *norm_g, *final_g, *w_in_a, *w_out_a, *w_in_b, *gn_b, *w_out_b, *w_in_c, *w_gate2_c, *b_gate_c, *gn_c, *w_out_c; float* out; unsigned char* ws;
    __device__ __forceinline__ float* sumsq(int l) const { return (float*)(ws + CTL_SUMSQ) + (size_t)l * MT; }
    template <class Tp> __device__ __forceinline__ Tp* wsp(size_t off) const { return (Tp*)(ws + off); }
};

constexpr int ATT_K_OFF = 0, ATT_V_OFF = 65536, ATT_ROWS = 8192 + 32;
DEV int att_off_k(int row, int ch) { return 256 * row + 16 * (ch ^ (row & 15)); }
DEV int att_off_v(int row, int ch) { return 256 * row + 16 * (ch ^ (2 * (row & 7))); }
DEV void attn_item(LAS unsigned char* lds, const bf16* z, int ldz, bf16* og, float* lse, int item, int tid) {
    const int lane = tid & 63, w = tid >> 6, G = lane >> 4, l15 = lane & 15;
    const int bh = item / 48, rem = item % 48, b = bh >> 4, h = bh & 15;
    int g, r, blk;
    if (rem < 16) { g = 0; r = 0; blk = rem; } else if (rem < 32) { g = 1; r = (rem - 16) >> 2; blk = (rem - 16) & 3; } else { g = 2; r = rem - 32; blk = 0; }
    const int dil = 1 << (2 * g);
    const int qcol = (g * 3) * 2048 + h * 128, kcol = qcol + 2048, vcol = qcol + 4096;
    const size_t tok0 = (size_t)b * 2048 + r;
#pragma unroll
    for (int j = 0; j < 8; ++j) {
        const int e = tid + 512 * j, row = e >> 4, ch = e & 15; const int p = (blk - 1) * 128 + row;
        u32x4 kv = {0u, 0u, 0u, 0u}, vv = {0u, 0u, 0u, 0u};
        if (p >= 0) { const bf16* src = z + (tok0 + (size_t)dil * p) * ldz + ch * 8; kv = *(const u32x4*)(src + kcol); vv = *(const u32x4*)(src + vcol); }
        *(LAS u32x4*)(lds + ATT_K_OFF + att_off_k(row, ch)) = kv;
        *(LAS u32x4*)(lds + ATT_V_OFF + att_off_v(row, ch)) = vv;
    }
    const int qi = 16 * w + l15; const size_t qtok = tok0 + (size_t)dil * (blk * 128 + qi);
    bf16x8 qf[4];
#pragma unroll
    for (int s = 0; s < 4; ++s) qf[s] = *(const bf16x8*)(z + qtok * ldz + qcol + 32 * s + 8 * G);
    wg_sync();
    const int m0 = w >> 1;
    f32x4 sc[10];
#pragma unroll
    for (int tt = 0; tt < 10; ++tt) {
        const int t = 2 * m0 + tt; f32x4 a = {0.f, 0.f, 0.f, 0.f};
#pragma unroll
        for (int s = 0; s < 4; ++s) { const bf16x8 kf = *(const LAS bf16x8*)(lds + ATT_K_OFF + att_off_k(16 * t + l15, 4 * s + G)); a = mfma16(kf, qf[s], a); }
        sc[tt] = a;
    }
    const float scale = 0.08838834764831845f * 1.4426950408889634f;
    float mx = -INFINITY;
#pragma unroll
    for (int tt = 0; tt < 10; ++tt)
#pragma unroll
        for (int rr = 0; rr < 4; ++rr) { const int c = 16 * (2 * m0 + tt) + 4 * G + rr; const bool ok = (c >= qi) && (c <= qi + 128) && (blk > 0 || c >= 128);
            const float v = ok ? sc[tt][rr] * scale : -INFINITY; sc[tt][rr] = v; mx = fmaxf(mx, v); }
    mx = fmaxf(mx, shflx(mx, 16)); mx = fmaxf(mx, shflx(mx, 32));
    float sum = 0.f;
#pragma unroll
    for (int tt = 0; tt < 10; ++tt)
#pragma unroll
        for (int rr = 0; rr < 4; ++rr) { const float p = fast_exp2(sc[tt][rr] - mx); sc[tt][rr] = p; sum += p; }
    sum += shflx(sum, 16); sum += shflx(sum, 32);
    f32x4 oacc[8];
#pragma unroll
    for (int dt = 0; dt < 8; ++dt) oacc[dt] = (f32x4){0.f, 0.f, 0.f, 0.f};
#pragma unroll
    for (int mm = 0; mm < 5; ++mm) {
        const f32x4 p0 = sc[2 * mm], p1 = sc[2 * mm + 1];
        u32x4 pw; pw[0] = cvt_pk_bf16(p0[0], p0[1]); pw[1] = cvt_pk_bf16(p0[2], p0[3]); pw[2] = cvt_pk_bf16(p1[0], p1[1]); pw[3] = cvt_pk_bf16(p1[2], p1[3]);
        bf16x8 pf; __builtin_memcpy(&pf, &pw, 16);
        const int krow = 32 * (m0 + mm) + 4 * G + (l15 >> 2);
#pragma unroll
        for (int dh = 0; dh < 2; ++dh) {
            s16x4 lo[4], hi[4];
#pragma unroll
            for (int d4 = 0; d4 < 4; ++d4) { const int dt = dh * 4 + d4; const int ch = 2 * dt + ((l15 >> 1) & 1);
                lo[d4] = tr_read(lds + ATT_V_OFF + att_off_v(krow, ch) + 8 * (l15 & 1)); hi[d4] = tr_read(lds + ATT_V_OFF + att_off_v(krow + 16, ch) + 8 * (l15 & 1)); }
            lds_wait();
#pragma unroll
            for (int d4 = 0; d4 < 4; ++d4) oacc[dh * 4 + d4] = mfma16(pack8(lo[d4], hi[d4]), pf, oacc[dh * 4 + d4]);
        }
    }
    const float inv = fast_rcp(sum);
    bf16* orow = og + ((size_t)g * ATT_ROWS + qtok) * 2048 + h * 128 + 4 * G;
#pragma unroll
    for (int dt = 0; dt < 8; ++dt) { u32x2 wv; wv[0] = cvt_pk_bf16(oacc[dt][0] * inv, oacc[dt][1] * inv); wv[1] = cvt_pk_bf16(oacc[dt][2] * inv, oacc[dt][3] * inv); *(u32x2*)(orow + 16 * dt) = wv; }
    if (G == 0) lse[((size_t)g * ATT_ROWS + qtok) * 16 + h] = (mx + fast_log2(sum)) * 0.6931471805599453f;
    wg_sync();
}
constexpr int SC_KP = 544, SC_K_OFF = 0, SC_V_OFF = 128 * SC_KP, SC_S_OFF = SC_V_OFF + 20480;
template <int NVT>
DEV void scan_unit(LAS unsigned char* lds, const bf16* z, int ldz, int qoff, int koff, int voff, int H, int unit, const float* dvec, float* o, int ldo, float* state_out, int tid) {
    constexpr int VS = 16 * NVT, VP = VS * 2 + 32, KP = SC_KP, NVS = 512 / VS, VCH = VS / 8, NVLD = (128 * VCH) / 512, VROWS = 512 / VCH;
    const int lane = tid & 63, w = tid >> 6, G = lane >> 4, l15 = lane & 15;
    const int vs = unit % NVS, h = (unit / NVS) % H, b = unit / (NVS * H);
    const size_t rowbase = (size_t)b * 2048;
    const bf16* zq = z + qoff + h * 256; const bf16* zk = z + koff + h * 256; const bf16* zv = z + voff + h * 512 + vs * VS;
    float gam128 = 1.f; if (!dvec) { const float gm = 1.0f - exp2f(-5.0f - (float)h); gam128 = exp2f(128.0f * log2f(gm)); }
    LAS unsigned char* const kb_row = lds + SC_K_OFF + l15 * KP + 16 * G;
    LAS unsigned char* const kb_tr = lds + SC_K_OFF + (4 * G + (l15 >> 2)) * KP + 8 * (l15 & 3) + 64 * w;
    LAS unsigned char* const vb_tr = lds + SC_V_OFF + (4 * G + (l15 >> 2)) * VP + 8 * (l15 & 3);
    LAS unsigned char* const sb_row = lds + SC_S_OFF + l15 * KP + 16 * G;
    LAS unsigned char* const sb_wr = lds + SC_S_OFF + l15 * KP + 8 * G + 64 * w;
    LAS unsigned char* const kst = lds + SC_K_OFF + (tid >> 5) * KP + (tid & 31) * 16;
    LAS unsigned char* const vst = lds + SC_V_OFF + (tid / VCH) * VP + (tid % VCH) * 16;
    const size_t kg = (size_t)(tid >> 5) * ldz + (tid & 31) * 8, vg = (size_t)(tid / VCH) * ldz + (tid % VCH) * 8;
    f32x4 sacc[2][NVT];
#pragma unroll
    for (int dd = 0; dd < 2; ++dd)
#pragma unroll
        for (int vt = 0; vt < NVT; ++vt) sacc[dd][vt] = (f32x4){0.f, 0.f, 0.f, 0.f};
    for (int e = tid; e < VS * (KP / 16); e += 512) *(LAS u32x4*)(lds + SC_S_OFF + e * 16) = (u32x4){0u, 0u, 0u, 0u};
    u32x4 kpre[8], vpre[NVLD];
    {   const bf16* kp = zk + rowbase * ldz + kg; const bf16* vp = zv + rowbase * ldz + vg;
#pragma unroll
        for (int j = 0; j < 8; ++j) kpre[j] = *(const u32x4*)(kp + (size_t)(16 * j) * ldz);
#pragma unroll
        for (int j = 0; j < NVLD; ++j) vpre[j] = *(const u32x4*)(vp + (size_t)(VROWS * j) * ldz);
#pragma unroll
        for (int j = 0; j < 8; ++j) *(LAS u32x4*)(kst + 16 * j * KP) = kpre[j];
#pragma unroll
        for (int j = 0; j < NVLD; ++j) *(LAS u32x4*)(vst + VROWS * j * VP) = vpre[j]; }
    wg_sync();
    const int qi = 16 * w + l15;
#pragma unroll 1
    for (int c = 0; c < 16; ++c) {
        const size_t crow = rowbase + (size_t)c * 128;
        const bf16* kp = zk + (crow + 128) * ldz + kg; const bf16* vp = zv + (crow + 128) * ldz + vg;
        if (c + 1 < 16) {
#pragma unroll
            for (int j = 0; j < 4; ++j) kpre[j] = *(const u32x4*)(kp + (size_t)(16 * j) * ldz);
        }
        bf16x8 qf[8];
#pragma unroll
        for (int s = 0; s < 8; ++s) qf[s] = *(const bf16x8*)(zq + (crow + qi) * ldz + 32 * s + 8 * G);
        f32x4 oacc[NVT];
#pragma unroll
        for (int vt = 0; vt < NVT; ++vt) oacc[vt] = (f32x4){0.f, 0.f, 0.f, 0.f};
#pragma unroll 1
        for (int m = 0; m <= (w >> 1); ++m) {
            f32x4 s0 = {0.f, 0.f, 0.f, 0.f}, s1 = {0.f, 0.f, 0.f, 0.f};
            LAS unsigned char* const kr = kb_row + m * (32 * KP); LAS unsigned char* const vr = vb_tr + m * (32 * VP);
#pragma unroll
            for (int s = 0; s < 8; ++s) {
                const bf16x8 k0 = *(const LAS bf16x8*)(kr + 64 * s); const bf16x8 k1 = *(const LAS bf16x8*)(kr + 16 * KP + 64 * s);
                s0 = mfma16(k0, qf[s], s0); s1 = mfma16(k1, qf[s], s1);
                if (s & 1) mem_fence_cc();
            }
#pragma unroll
            for (int rr = 0; rr < 4; ++rr) { const int j0 = 32 * m + 4 * G + rr; s0[rr] = (j0 <= qi) ? s0[rr] : 0.f; s1[rr] = (j0 + 16 <= qi) ? s1[rr] : 0.f; }
            u32x4 pw; pw[0] = cvt_pk_bf16(s0[0], s0[1]); pw[1] = cvt_pk_bf16(s0[2], s0[3]); pw[2] = cvt_pk_bf16(s1[0], s1[1]); pw[3] = cvt_pk_bf16(s1[2], s1[3]);
            bf16x8 pf; __builtin_memcpy(&pf, &pw, 16);
            s16x4 lo[NVT], hi[NVT];
#pragma unroll
            for (int vt = 0; vt < NVT; ++vt) { lo[vt] = tr_read_o(vr, 32 * vt); hi[vt] = tr_read_o(vr, 16 * VP + 32 * vt); }
            lds_wait();
#pragma unroll
            for (int vt = 0; vt < NVT; ++vt) oacc[vt] = mfma16(pack8(lo[vt], hi[vt]), pf, oacc[vt]);
        }
        if (c + 1 < 16) {
#pragma unroll
            for (int j = 4; j < 8; ++j) kpre[j] = *(const u32x4*)(kp + (size_t)(16 * j) * ldz);
        }
#pragma unroll
        for (int s = 0; s < 8; ++s)
#pragma unroll
            for (int vt = 0; vt < NVT; ++vt) { const bf16x8 sf = *(const LAS bf16x8*)(sb_row + 16 * vt * KP + 64 * s); oacc[vt] = mfma16(sf, qf[s], oacc[vt]); if (vt == NVT - 1) mem_fence_cc(); }
        {   float* orow = o + (crow + qi) * ldo + h * 512 + vs * VS + 4 * G;
#pragma unroll
            for (int vt = 0; vt < NVT; ++vt) *(f32x4*)(orow + 16 * vt) = oacc[vt]; }
        if (c + 1 < 16) {
#pragma unroll
            for (int j = 0; j < NVLD; ++j) vpre[j] = *(const u32x4*)(vp + (size_t)(VROWS * j) * ldz);
        }
#pragma unroll
        for (int ks = 0; ks < 4; ++ks) {
            s16x4 alo[2], ahi[2], blo[NVT], bhi[NVT];
#pragma unroll
            for (int dd = 0; dd < 2; ++dd) { alo[dd] = tr_read_o(kb_tr, 32 * ks * KP + 32 * dd); ahi[dd] = tr_read_o(kb_tr, (32 * ks + 16) * KP + 32 * dd); }
#pragma unroll
            for (int vt = 0; vt < NVT; ++vt) { blo[vt] = tr_read_o(vb_tr, 32 * ks * VP + 32 * vt); bhi[vt] = tr_read_o(vb_tr, (32 * ks + 16) * VP + 32 * vt); }
            lds_wait();
#pragma unroll
            for (int dd = 0; dd < 2; ++dd)
#pragma unroll
                for (int vt = 0; vt < NVT; ++vt) sacc[dd][vt] = mfma16(pack8(alo[dd], ahi[dd]), pack8(blo[vt], bhi[vt]), sacc[dd][vt]);
        }
#pragma unroll
        for (int dd = 0; dd < 2; ++dd) {
            f32x4 dv = {gam128, gam128, gam128, gam128};
            if (dvec) dv = *(const f32x4*)(dvec + ((size_t)(b * H + h) * 16 + c) * 256 + 16 * (2 * w + dd) + 4 * G);
#pragma unroll
            for (int vt = 0; vt < NVT; ++vt) sacc[dd][vt] = sacc[dd][vt] * dv;
        }
        wg_sync();
#pragma unroll
        for (int dd = 0; dd < 2; ++dd)
#pragma unroll
            for (int vt = 0; vt < NVT; ++vt) { u32x2 wv; wv[0] = cvt_pk_bf16(sacc[dd][vt][0], sacc[dd][vt][1]); wv[1] = cvt_pk_bf16(sacc[dd][vt][2], sacc[dd][vt][3]); *(LAS u32x2*)(sb_wr + 16 * vt * KP + 32 * dd) = wv; }
        if (c + 1 < 16) {
#pragma unroll
            for (int j = 0; j < 8; ++j) *(LAS u32x4*)(kst + 16 * j * KP) = kpre[j];
#pragma unroll
            for (int j = 0; j < NVLD; ++j) *(LAS u32x4*)(vst + VROWS * j * VP) = vpre[j];
        }
        wg_sync();
    }
#pragma unroll
    for (int dd = 0; dd < 2; ++dd)
#pragma unroll
        for (int vt = 0; vt < NVT; ++vt)
#pragma unroll
            for (int rr = 0; rr < 4; ++rr) state_out[(((size_t)b * H + h) * 256 + 16 * (2 * w + dd) + 4 * G + rr) * 512 + vs * VS + 16 * vt + l15] = sacc[dd][vt][rr];
}
DEV f32x4 bf4_to_f32(u32x2 w) { return (f32x4){__uint_as_float(w[0] << 16), __uint_as_float(w[0] & 0xffff0000u), __uint_as_float(w[1] << 16), __uint_as_float(w[1] & 0xffff0000u)}; }
DEV float half_sum(float v) { v += shflx(v, 16); v += shflx(v, 8); v += shflx(v, 4); v += shflx(v, 2); v += shflx(v, 1); return v; }
DEV void sattn_unit(LAS unsigned char* lds_wave, const bf16* z, int ldz, const float* cache, int g, int b, int t, int h, bf16* og, float* lse, int lane) {
    const int lbuf = 128 << (2 * g), dil = 1 << (2 * g), hf = lane >> 5, c32 = lane & 31;
    const int row = 8192 + b * 4 + t, qcol = g * 3 * 2048 + h * 128, kcol = qcol + 2048, vcol = qcol + 4096;
    const float scale = 0.08838834764831845f;
    LAS float* sc = (LAS float*)lds_wave;
    const f32x4 q4 = bf4_to_f32(*(const u32x2*)(z + (size_t)row * ldz + qcol + 4 * c32));
    const int jn = g == 0 ? t + 1 : 1;
    for (int j = 0; j < jn; ++j) {
        const int krow = 8192 + b * 4 + (t - dil * j);
        const f32x4 k4 = bf4_to_f32(*(const u32x2*)(z + (size_t)krow * ldz + kcol + 4 * c32));
        const float s = half_sum(q4[0] * k4[0] + q4[1] * k4[1] + q4[2] * k4[2] + q4[3] * k4[3]);
        if (lane == 0) sc[j] = s * scale;
    }
    const float* kbase = cache + (size_t)b * lbuf * 4096 + h * 128 + 4 * c32;
    const int nc = 129 - jn;
#pragma unroll 1
    for (int i = 0; i < nc; i += 16) {
        f32x4 k4[8];
#pragma unroll
        for (int u = 0; u < 8; ++u) { int j = jn + i + 2 * u + hf; j = j > 128 ? 128 : j; const int idx = lbuf + t - dil * j; k4[u] = *(const f32x4*)(kbase + (size_t)idx * 4096); }
#pragma unroll
        for (int u = 0; u < 8; ++u) { const int j = jn + i + 2 * u + hf; const float s = half_sum(q4[0] * k4[u][0] + q4[1] * k4[u][1] + q4[2] * k4[u][2] + q4[3] * k4[u][3]); if (c32 == 0 && j <= 128) sc[j] = s * scale; }
    }
    wave_sync();
    float s0 = sc[lane], s1 = sc[lane + 64], s2 = lane == 0 ? sc[128] : -INFINITY;
    float m = fmaxf(s0, fmaxf(s1, s2));
    m = fmaxf(m, shflx(m, 32)); m = fmaxf(m, shflx(m, 16)); m = fmaxf(m, shflx(m, 8)); m = fmaxf(m, shflx(m, 4)); m = fmaxf(m, shflx(m, 2)); m = fmaxf(m, shflx(m, 1));
    s0 = fast_exp(s0 - m); s1 = fast_exp(s1 - m); s2 = lane == 0 ? fast_exp(s2 - m) : 0.f;
    float sum = s0 + s1 + s2; sum += shflx(sum, 32); sum = half_sum(sum);
    wave_sync();
    sc[lane] = s0; sc[lane + 64] = s1; if (lane == 0) sc[128] = s2;
    wave_sync();
    f32x4 acc = {0.f, 0.f, 0.f, 0.f};
    for (int j = 0; j < jn; ++j) {
        const int krow = 8192 + b * 4 + (t - dil * j);
        const f32x4 v4 = bf4_to_f32(*(const u32x2*)(z + (size_t)krow * ldz + vcol + 4 * c32));
        const float pj = hf == 0 ? sc[j] : 0.f; acc += v4 * pj;
    }
#pragma unroll 1
    for (int i = 0; i < nc; i += 16) {
        f32x4 v4[8];
#pragma unroll
        for (int u = 0; u < 8; ++u) { int j = jn + i + 2 * u + hf; j = j > 128 ? 128 : j; const int idx = lbuf + t - dil * j; v4[u] = *(const f32x4*)(kbase + 2048 + (size_t)idx * 4096); }
#pragma unroll
        for (int u = 0; u < 8; ++u) { const int j = jn + i + 2 * u + hf; const float pj = j <= 128 ? sc[j] : 0.f; acc += v4[u] * pj; }
    }
#pragma unroll
    for (int e = 0; e < 4; ++e) acc[e] += shflx(acc[e], 32);
    const float inv = 1.0f / sum;
    if (hf == 0) { u32x2 wv; wv[0] = cvt_pk_bf16(acc[0] * inv, acc[1] * inv); wv[1] = cvt_pk_bf16(acc[2] * inv, acc[3] * inv); *(u32x2*)(og + ((size_t)g * ATT_ROWS + row) * 2048 + h * 128 + 4 * c32) = wv; }
    if (lane == 0) lse[((size_t)g * ATT_ROWS + row) * 16 + h] = m + fast_log(sum);
}
__device__ __forceinline__ void p0_transpose_item(const float* W, int K, int ld, int ncols, const float* gain, bf16* WT, LAS float* scr, int item, int lane) {
    const int nblk = ncols / 32, kb = item / nblk, nb = item % nblk, k0 = 64 * kb, n0 = 32 * nb;
#pragma unroll 8
    for (int i = 0; i < 32; ++i) { const int kk = 2 * i + (lane >> 5); const float gk = gain ? gain[k0 + kk] : 1.0f; scr[kk * 33 + (lane & 31)] = W[(size_t)(k0 + kk) * ld + n0 + (lane & 31)] * gk; }
    asm volatile("s_waitcnt lgkmcnt(0)" ::: "memory");
    const int c = lane & 7;
#pragma unroll
    for (int j = 0; j < 4; ++j) { const int n = (lane >> 3) + 8 * j; const LAS float* s = scr + (8 * c) * 33 + n;
        u32x4 o; o.x = pk2(s[0 * 33], s[1 * 33]); o.y = pk2(s[2 * 33], s[3 * 33]); o.z = pk2(s[4 * 33], s[5 * 33]); o.w = pk2(s[6 * 33], s[7 * 33]);
        *(u32x4*)(WT + (size_t)(n0 + n) * K + k0 + 8 * c) = o; }
    asm volatile("s_waitcnt lgkmcnt(0)" ::: "memory");
}
__device__ __forceinline__ void p0_prologue(const Ctx& C, const Params& P) {
    LAS float* scr = (LAS float*)(C.lds + C.wave * 16384);
    const int gw = C.wg * 8 + C.wave, NGW = C.G * 8;
    const float* norm_g = C.norm_g;
    constexpr int I_A = (D / 64) * (A_IN / 32), I_B = (D / 64) * (B_IN / 32), I_C = (D / 64) * (C_INM / 32), I_OA = (2048 / 64) * (D / 32), I_OB = (4096 / 64) * (D / 32);
    constexpr int NITEMS = 2 * I_A + I_B + I_C + 3 * I_OA + I_OB;
    for (int it = gw; it < NITEMS; it += NGW) {
        int r = it;
        if (r < I_A) { p0_transpose_item(C.w_in_a, D, A_IN, A_IN, norm_g + 0 * D, C.wsp<bf16>(WS_WIA0), scr, r, C.lane); continue; } r -= I_A;
        if (r < I_A) { p0_transpose_item(C.w_in_a + (size_t)D * A_IN, D, A_IN, A_IN, norm_g + 3 * D, C.wsp<bf16>(WS_WIA1), scr, r, C.lane); continue; } r -= I_A;
        if (r < I_B) { p0_transpose_item(C.w_in_b, D, B_IN, B_IN, norm_g + 1 * D, C.wsp<bf16>(WS_WIB), scr, r, C.lane); continue; } r -= I_B;
        if (r < I_C) { p0_transpose_item(C.w_in_c, D, C_IN, C_INM, norm_g + 2 * D, C.wsp<bf16>(WS_WIC), scr, r, C.lane); continue; } r -= I_C;
        if (r < I_OA) { p0_transpose_item(C.w_out_a, 2048, D, D, nullptr, C.wsp<bf16>(WS_WOA0), scr, r, C.lane); continue; } r -= I_OA;
        if (r < I_OA) { p0_transpose_item(C.w_out_a + (size_t)2048 * D, 2048, D, D, nullptr, C.wsp<bf16>(WS_WOA1), scr, r, C.lane); continue; } r -= I_OA;
        if (r < I_OA) { p0_transpose_item(C.w_out_c, 2048, D, D, nullptr, C.wsp<bf16>(WS_WOC), scr, r, C.lane); continue; } r -= I_OA;
        p0_transpose_item(C.w_out_b, 4096, D, D, nullptr, C.wsp<bf16>(WS_WOB), scr, r, C.lane);
    }
    { bf16* wlr = C.wsp<bf16>(WS_WLR); const float* W = C.w_in_c; const float* g2 = norm_g + 2 * D;
      for (int e = C.wg * NWG_THREADS + C.tid; e < 32 * D; e += C.G * NWG_THREADS) { const int r = e / D, k = e % D; wlr[e] = r < 16 ? (bf16)f2bf(W[(size_t)k * C_IN + C_INM + r] * g2[k]) : (bf16)0; } }
    { float* xres = C.wsp<float>(WS_XRES); bf16* xb = C.wsp<bf16>(WS_XB); float* ss0 = C.sumsq(0);
      for (int row = gw; row < MT; row += NGW) {
          const float* src = row < MP ? C.x_prompt + (size_t)row * D : C.x_sample + (size_t)(row - MP) * D;
          float s = 0.f;
#pragma unroll
          for (int j = 0; j < 8; ++j) { const f32x4 v = *(const f32x4*)(src + 4 * C.lane + 256 * j); *(f32x4*)(xres + (size_t)row * D + 4 * C.lane + 256 * j) = v;
              u32x2 w; w.x = pk2(v[0], v[1]); w.y = pk2(v[2], v[3]); *(u32x2*)(xb + (size_t)row * D + 4 * C.lane + 256 * j) = w; s += (v[0] * v[0] + v[1] * v[1]) + (v[2] * v[2] + v[3] * v[3]); }
          s = wave_sum(s); if (C.lane == 0) ss0[row] = s; } }
    { f32x2* ta = C.wsp<f32x2>(WS_TABA); f32x2* tb = C.wsp<f32x2>(WS_TABB);
      for (int e = C.wg * NWG_THREADS + C.tid; e < 2052 * 16; e += C.G * NWG_THREADS) { const int pi = e >> 4, i = e & 15; const int pos = pi < 2048 ? pi : PAST + (pi - 2048); float s, c; sincos_d((double)pos * P.inv_a[i], s, c); ta[e] = (f32x2){c, s}; }
      for (int e = C.wg * NWG_THREADS + C.tid; e < 2052 * 128; e += C.G * NWG_THREADS) { const int pi = e >> 7, i = e & 127; const int pos = pi < 2048 ? pi : PAST + (pi - 2048); float s, c; sincos_d((double)pos * P.inv_b[i], s, c); tb[e] = (f32x2){c, s}; } }
}

template <int K, class EP>
__device__ __forceinline__ void skinny_gemm(const Ctx& C, const bf16* A, const bf16* Bt, int N, const EP& ep) {
    constexpr int KW = K / 8, NPASS = KW / 256, MAXCH = 5;
    const int fr = C.lane & 15, fq = C.lane >> 4, nch = N / 16;
    LAS float* part = (LAS float*)C.lds;
    for (int cb = C.wg; cb < nch; cb += C.G * MAXCH) {
        int ncur = 0;
#pragma unroll 1
        for (int j = 0; j < MAXCH; ++j) {
            const int ch = cb + j * C.G; if (ch >= nch) break;
            ++ncur;
            pg8::f32x4 acc0 = {0.f, 0.f, 0.f, 0.f}, acc1 = {0.f, 0.f, 0.f, 0.f};
#pragma unroll 1
            for (int ps = 0; ps < NPASS; ++ps) {
                const int kbase = C.wave * KW + ps * 256 + 8 * fq;
                const bf16* ap0 = A + (size_t)fr * K + kbase; const bf16* ap1 = A + (size_t)(16 + fr) * K + kbase; const bf16* bp = Bt + (size_t)(ch * 16 + fr) * K + kbase;
                bf16x8 a0[8], a1[8], bb[8];
#pragma unroll
                for (int s = 0; s < 8; ++s) { bb[s] = *(const bf16x8*)(bp + 32 * s); a0[s] = *(const bf16x8*)(ap0 + 32 * s); a1[s] = *(const bf16x8*)(ap1 + 32 * s); }
#pragma unroll
                for (int s = 0; s < 8; ++s) { acc0 = __builtin_amdgcn_mfma_f32_16x16x32_bf16(bb[s], a0[s], acc0, 0, 0, 0); acc1 = __builtin_amdgcn_mfma_f32_16x16x32_bf16(bb[s], a1[s], acc1, 0, 0, 0); }
            }
            LAS float* pj = part + ((size_t)(j * 8 + C.wave) * 2) * 4 * 64 + C.lane;
#pragma unroll
            for (int r = 0; r < 4; ++r) { pj[(0 * 4 + r) * 64] = acc0[r]; pj[(1 * 4 + r) * 64] = acc1[r]; }
        }
        __syncthreads();
        {
            const int l2 = C.tid & 63, mt = (C.tid >> 6) & 1, reg = C.tid >> 7;
            for (int j = 0; j < ncur; ++j) {
                float s = 0.f;
#pragma unroll
                for (int w = 0; w < 8; ++w) s += part[(((size_t)(j * 8 + w) * 2 + mt) * 4 + reg) * 64 + l2];
                const int ch = cb + j * C.G;
                ep(16 * mt + (l2 & 15), ch * 16 + 4 * (l2 >> 4) + reg, s);
            }
        }
        __syncthreads();
    }
}

__device__ __forceinline__ float rstd_of(const float* ss, int row) { return rsqrtf(ss[row] * (1.0f / 2048.0f) + EPS); }
__device__ __forceinline__ void sfix_a(const Ctx& C, int layer, int slot) {
    const float* zs = C.wsp<float>(WS_ZSRAW); bf16* z = C.wsp<bf16>(WS_Z); const float* ss = C.sumsq(layer); const f32x2* ta = C.wsp<f32x2>(WS_TABA);
    float* skv = C.out + (size_t)MP * D + (size_t)MS * D + (size_t)2 * 4 * (128 + 512 + 2048) * 4096 + (size_t)4 * 8 * 256 * 512 + (size_t)4 * 4 * 256 * 512;
    for (int e = C.wg * NWG_THREADS + C.tid; e < MS * A_IN; e += C.G * NWG_THREADS) {
        const int r = e / A_IN, c = e % A_IN, row = MP + r, b = r >> 2, t = r & 3; const float rs = rstd_of(ss, row);
        const int section = c >> 11, within = c & 2047, d = within & 127, kind = section < 9 ? section % 3 : 3, g = section / 3;
        float v = zs[e] * rs;
        if (kind < 2 && d < 32) { const int i = d & 15; const float pv = zs[d < 16 ? e + 16 : e - 16] * rs; const f32x2 cs = ta[(2048 + t) * 16 + i]; v = d < 16 ? v * cs.x - pv * cs.y : pv * cs.y + v * cs.x; }
        z[(size_t)row * A_IN + c] = (bf16)f2bf(v);
        if (kind == 1 || kind == 2) skv[(size_t)g * (2 * 8 * 4 * 4096) + ((((size_t)slot * DB + b) * T + t) * 2 + (kind - 1)) * 2048 + within] = v;
    }
}
__device__ __forceinline__ void sfix_b(const Ctx& C, int layer) {
    const float* zs = C.wsp<float>(WS_ZSRAW); bf16* z = C.wsp<bf16>(WS_Z); const float* ss = C.sumsq(layer); const f32x2* tb = C.wsp<f32x2>(WS_TABB);
    for (int e = C.wg * NWG_THREADS + C.tid; e < MS * B_IN; e += C.G * NWG_THREADS) {
        const int r = e / B_IN, c = e % B_IN, row = MP + r, t = r & 3; const float rs = rstd_of(ss, row);
        float v = zs[e] * rs;
        if (c < 4096) { const int d = c & 255, i = d & 127; const float pv = zs[d < 128 ? e + 128 : e - 128] * rs; const f32x2 cs = tb[(2048 + t) * 128 + i]; v = d < 128 ? v * cs.x - pv * cs.y : pv * cs.y + v * cs.x; if (c >= 2048) v *= 0.0625f; }
        z[(size_t)row * B_IN + c] = (bf16)f2bf(v);
    }
}
__device__ __forceinline__ void sfix_c(const Ctx& C, int layer) {
    const float* zs = C.wsp<float>(WS_ZSRAW); bf16* z = C.wsp<bf16>(WS_Z); const float* ss = C.sumsq(layer);
    for (int e = C.wg * NWG_THREADS + C.tid; e < MS * C_INM; e += C.G * NWG_THREADS) {
        const int r = e / C_INM, c = e % C_INM, row = MP + r; const float rs = rstd_of(ss, row);
        float v = zs[e] * rs; if (c < 1024) v *= 0.0625f;
        z[(size_t)row * C_INM + c] = (bf16)f2bf(v);
    }
    const float* lr = C.wsp<float>(WS_LR); float* loga = C.wsp<float>(WS_LOGA); const float* wg2 = C.w_gate2_c; const float* bg = C.b_gate_c;
    for (int e = MP * 1024 + C.wg * NWG_THREADS + C.tid; e < MT * 1024; e += C.G * NWG_THREADS) {
        const int row = e >> 10, c = e & 1023; const float rs = rstd_of(ss, row);
        float a = 0.f;
#pragma unroll
        for (int r = 0; r < 16; ++r) a += lr[(size_t)r * MT + row] * wg2[r * 1024 + c];
        a = a * rs + bg[c];
        loga[e] = (fminf(a, 0.f) - log1pf(__expf(-fabsf(a)))) * 0.0625f;
    }
}

__device__ __forceinline__ void gla_pre(const Ctx& C, int layer) {
    bf16* z = C.wsp<bf16>(WS_Z); const float* ss = C.sumsq(layer); const float* lr = C.wsp<float>(WS_LR); float* dvec = C.wsp<float>(WS_DVEC); const float* wg2 = C.w_gate2_c; const float* bg = C.b_gate_c;
    for (int u = C.wg; u < 128; u += C.G) {
        const int chunk = u >> 1, col = (u & 1) * 512 + C.tid;
        float wv[16];
#pragma unroll
        for (int r = 0; r < 16; ++r) wv[r] = wg2[r * 1024 + col];
        const float bgc = bg[col]; float bs = 0.f;
#pragma unroll 2
        for (int i = 0; i < 128; ++i) {
            const int row = chunk * 128 + i; const float rs = rstd_of(ss, row);
            float a = 0.f;
#pragma unroll
            for (int r = 0; r < 16; ++r) a += lr[(size_t)r * MT + row] * wv[r];
            a = a * rs + bgc;
            bs += (fminf(a, 0.f) - log1pf(__expf(-fabsf(a)))) * 0.0625f;
            const float eb = __expf(bs), ieb = __expf(-bs);
            bf16* zr = z + (size_t)row * C_INM;
            zr[col] = (bf16)f2bf(bf2f(zr[col]) * eb); zr[1024 + col] = (bf16)f2bf(bf2f(zr[1024 + col]) * ieb);
        }
        dvec[(((size_t)(chunk >> 4) * 4 + (col >> 8)) * 16 + (chunk & 15)) * 256 + (col & 255)] = __expf(bs);
    }
}
template <int NVT>
__device__ __forceinline__ void scan_phase(const Ctx& C, int ldz, int qoff, int koff, int voff, int H, const float* dvec, float* state_out) {
    const bf16* z = C.wsp<bf16>(WS_Z); float* o = C.wsp<float>(WS_O);
    const int nunits = NB * H * (512 / (16 * NVT));
    for (int u = C.wg; u < nunits; u += C.G) scan_unit<NVT>(C.lds, z, ldz, qoff, koff, voff, H, u, dvec, o, H * 512, state_out, C.tid);
}

__device__ __forceinline__ float dot128_bb(const bf16* q, const bf16* k) {
    float a = 0.f;
#pragma unroll 4
    for (int i = 0; i < 16; ++i) { const u32x4 x = ((const u32x4*)q)[i], y = ((const u32x4*)k)[i];
#pragma unroll
        for (int j = 0; j < 4; ++j) a += __uint_as_float(x[j] << 16) * __uint_as_float(y[j] << 16) + __uint_as_float(x[j] & 0xffff0000u) * __uint_as_float(y[j] & 0xffff0000u); }
    return a;
}
__device__ __forceinline__ float dot128_bf(const bf16* q, const float* k) {
    float a = 0.f;
#pragma unroll 4
    for (int i = 0; i < 16; ++i) { const u32x4 x = ((const u32x4*)q)[i]; const f32x4 y0 = ((const f32x4*)k)[2 * i], y1 = ((const f32x4*)k)[2 * i + 1];
        a += __uint_as_float(x[0] << 16) * y0[0] + __uint_as_float(x[0] & 0xffff0000u) * y0[1] + __uint_as_float(x[1] << 16) * y0[2] + __uint_as_float(x[1] & 0xffff0000u) * y0[3]
           + __uint_as_float(x[2] << 16) * y1[0] + __uint_as_float(x[2] & 0xffff0000u) * y1[1] + __uint_as_float(x[3] << 16) * y1[2] + __uint_as_float(x[3] & 0xffff0000u) * y1[3]; }
    return a;
}
template <bool GLA>
__device__ __forceinline__ void recur_naive(const Ctx& C, int ldz, int qoff, int koff, int voff, int H, int nseq, int ntok, int row0, const float* state0, float* state_out) {
    const bf16* z = C.wsp<bf16>(WS_Z); float* o = C.wsp<float>(WS_O); const float* loga = C.wsp<float>(WS_LOGA);
    LAS float* red = (LAS float*)C.lds;
    const int d = C.tid & 255, vh = C.tid >> 8, lane = C.lane, wave = C.wave;
    for (int item = C.wg; item < nseq * H * 8; item += C.G) {
        const int vs = item & 7, h = (item >> 3) % H, seq = (item >> 3) / H;
        const int v0 = vs * 64 + vh * 32;
        float Sreg[32];
        const size_t sbase = (((size_t)seq * H + h) * 256 + d) * 512 + v0;
#pragma unroll
        for (int i = 0; i < 32; ++i) Sreg[i] = state0 ? state0[sbase + i] : 0.f;
        float gamma = 1.f; if (!GLA) gamma = 1.0f - exp2f(-5.0f - (float)h);
        for (int t = 0; t < ntok; ++t) {
            const int row = row0 + seq * ntok + t; const bf16* zr = z + (size_t)row * ldz;
            const float qd = bf2f(zr[qoff + h * 256 + d]), kd = bf2f(zr[koff + h * 256 + d]);
            float dec = gamma; if (GLA) dec = __expf(loga[(size_t)row * 1024 + h * 256 + d]);
            const unsigned* vp = (const unsigned*)(zr + voff + h * 512 + v0);
            float p[32];
#pragma unroll
            for (int i = 0; i < 16; ++i) { const unsigned w = vp[i]; const float va = __uint_as_float(w << 16), vb = __uint_as_float(w & 0xffff0000u);
                Sreg[2 * i] = dec * Sreg[2 * i] + kd * va; Sreg[2 * i + 1] = dec * Sreg[2 * i + 1] + kd * vb; p[2 * i] = qd * Sreg[2 * i]; p[2 * i + 1] = qd * Sreg[2 * i + 1]; }
#pragma unroll
            for (int i = 0; i < 32; ++i) p[i] = wave_sum(p[i]);
            float mine = 0.f;
#pragma unroll
            for (int i = 0; i < 32; ++i) if (lane == i) mine = p[i];
            if (lane < 32) red[((t & 1) * 8 + wave) * 32 + lane] = mine;
            __syncthreads();
            if (d < 32) { const LAS float* rr = red + ((t & 1) * 8 + vh * 4) * 32 + d; o[(size_t)row * (H * 512) + h * 512 + v0 + d] = rr[0] + rr[32] + rr[64] + rr[96]; }
        }
#pragma unroll
        for (int i = 0; i < 32; ++i) state_out[sbase + i] = Sreg[i];
        __syncthreads();
    }
}
template <bool MEAN>
__device__ __forceinline__ void norm_gate(const Ctx& C, int H, int ldz, int goff, const float* gn) {
    const bf16* z = C.wsp<bf16>(WS_Z); const float* o = C.wsp<float>(WS_O); bf16* y = C.wsp<bf16>(WS_Y); const int lane = C.lane;
    for (int w = C.wg * 8 + C.wave; w < MT * H; w += C.G * 8) {
        const int row = w / H, h = w % H;
        const float* orow = o + (size_t)row * (H * 512) + h * 512; const bf16* gate = z + (size_t)row * ldz + goff + h * 512;
        const f32x4 a = ((const f32x4*)orow)[2 * lane], bq = ((const f32x4*)orow)[2 * lane + 1];
        float v[8] = {a[0], a[1], a[2], a[3], bq[0], bq[1], bq[2], bq[3]};
        float s = 0.f;
#pragma unroll
        for (int i = 0; i < 8; ++i) s += v[i];
        float mu = 0.f; if (MEAN) mu = wave_sum(s) * (1.f / 512.f);
        float q = 0.f;
#pragma unroll
        for (int i = 0; i < 8; ++i) { v[i] -= mu; q += v[i] * v[i]; }
        const float r = rsqrtf(wave_sum(q) * (1.f / 512.f) + EPS);
        const u32x4 gw = ((const u32x4*)gate)[lane]; const f32x4 g0 = ((const f32x4*)(gn + h * 512))[2 * lane], g1 = ((const f32x4*)(gn + h * 512))[2 * lane + 1];
        const float gg[8] = {g0[0], g0[1], g0[2], g0[3], g1[0], g1[1], g1[2], g1[3]};
        float ov[8];
#pragma unroll
        for (int i = 0; i < 4; ++i) { ov[2 * i] = v[2 * i] * r * gg[2 * i] * silu(__uint_as_float(gw[i] << 16)); ov[2 * i + 1] = v[2 * i + 1] * r * gg[2 * i + 1] * silu(__uint_as_float(gw[i] & 0xffff0000u)); }
        u32x4 ow; ow.x = pk2(ov[0], ov[1]); ow.y = pk2(ov[2], ov[3]); ow.z = pk2(ov[4], ov[5]); ow.w = pk2(ov[6], ov[7]);
        ((u32x4*)(y + (size_t)row * (H * 512) + h * 512))[lane] = ow;
    }
}
__device__ __forceinline__ void final_norm(const Ctx& C) {
    const float* xres = C.wsp<float>(WS_XRES); const float* ss = C.sumsq(4); const float* fg = C.final_g;
    for (int row = C.wg * 8 + C.wave; row < MT; row += C.G * 8) {
        const float rs = rstd_of(ss, row);
#pragma unroll
        for (int j = 0; j < 8; ++j) { const int c = 4 * C.lane + 256 * j; const f32x4 v = *(const f32x4*)(xres + (size_t)row * D + c), g = *(const f32x4*)(fg + c); *(f32x4*)(C.out + (size_t)row * D + c) = v * rs * g; }
    }
}

__device__ __forceinline__ void attn_fast_phase(const Ctx& C) {
    const bf16* z = C.wsp<bf16>(WS_Z); bf16* og = C.wsp<bf16>(WS_O); float* lse = C.wsp<float>(WS_LOGA);
    const int per = (3072 + C.G - 1) / C.G;
    for (int j = 0; j < per; ++j) { const int item = C.wg * per + j; if (item < 3072) attn_item(C.lds, z, A_IN, og, lse, item, C.tid); }
}
__device__ __forceinline__ void sattn_phase(const Ctx& C, int slot, const float* c1, const float* c2, const float* c3) {
    const bf16* z = C.wsp<bf16>(WS_Z); bf16* og = C.wsp<bf16>(WS_O); float* lse = C.wsp<float>(WS_LOGA);
    for (int u0 = C.wg * 6; u0 < 1536; u0 += C.G * 6) {
        const int u = u0 + C.wave;
        if (C.wave < 6 && u < 1536) {
            const int t = u & 3, h = (u >> 2) & 15, b = (u >> 6) & 7, g = u >> 9;
            const float* cache = c1; if (g == 1) cache = c2; if (g == 2) cache = c3;
            sattn_unit(C.lds + C.wave * 1024, z, A_IN, cache + (size_t)slot * 8 * (128 << (2 * g)) * 4096, g, b, t, h, og, lse, C.lane);
        }
    }
}
__device__ __forceinline__ void attn_merge(const Ctx& C) {
    const bf16* z = C.wsp<bf16>(WS_Z); const bf16* og = C.wsp<bf16>(WS_O); const float* lse = C.wsp<float>(WS_LOGA); bf16* y = C.wsp<bf16>(WS_Y);
    for (int row = C.wg * 8 + C.wave; row < MT; row += C.G * 8) {
#pragma unroll
        for (int j = 0; j < 4; ++j) {
            const int ch = C.lane + 64 * j, col = ch * 8, h = col >> 7;
            const float l0 = lse[((size_t)0 * MT + row) * 16 + h], l1 = lse[((size_t)1 * MT + row) * 16 + h], l2 = lse[((size_t)2 * MT + row) * 16 + h];
            const float m = fmaxf(l0, fmaxf(l1, l2)); float w0 = __expf(l0 - m), w1 = __expf(l1 - m), w2 = __expf(l2 - m); const float inv = 1.0f / (w0 + w1 + w2); w0 *= inv; w1 *= inv; w2 *= inv;
            const u32x4 a = *(const u32x4*)(og + ((size_t)0 * MT + row) * 2048 + col), b = *(const u32x4*)(og + ((size_t)1 * MT + row) * 2048 + col), c = *(const u32x4*)(og + ((size_t)2 * MT + row) * 2048 + col);
            const u32x4 gt = *(const u32x4*)(z + (size_t)row * A_IN + 18432 + col);
            u32x4 o;
#pragma unroll
            for (int k = 0; k < 4; ++k) {
                const float lo = (w0 * __uint_as_float(a[k] << 16) + w1 * __uint_as_float(b[k] << 16) + w2 * __uint_as_float(c[k] << 16)) * silu(__uint_as_float(gt[k] << 16));
                const float hi = (w0 * __uint_as_float(a[k] & 0xffff0000u) + w1 * __uint_as_float(b[k] & 0xffff0000u) + w2 * __uint_as_float(c[k] & 0xffff0000u)) * silu(__uint_as_float(gt[k] & 0xffff0000u));
                o[k] = pk2(lo, hi);
            }
            *(u32x4*)(y + (size_t)row * 2048 + col) = o;
        }
    }
}

template <int MODE>
__device__ __forceinline__ void gemm_in(const Ctx& C, size_t wt_off, int N, int layer, float* kvb, int slot) {
    pg8::Gemm g{C.wsp<pg8::bf16_t>(WS_XB), C.wsp<pg8::bf16_t>(wt_off), MP, N, D}; pg8::StaticOrder So; So.init(MP, N, C.G, C.wg);
    pg8::EpiIn<MODE> E{C.wsp<pg8::bf16_t>(WS_Z), N, C.sumsq(layer), (const pg8::f32x2*)C.wsp<f32x2>(MODE == 0 ? WS_TABA : WS_TABB), kvb, slot};
    pg8::gemm_phase<pg8::EpiIn<MODE>, pg8::StaticOrder, true, true>((PG8_LAS unsigned char*)C.lds, g, So, E);
}
template <int K>
__device__ __forceinline__ void gemm_out(const Ctx& C, size_t wt_off, int layer) {
    pg8::Gemm g{C.wsp<pg8::bf16_t>(WS_Y), C.wsp<pg8::bf16_t>(wt_off), MP, D, K}; pg8::StaticOrder So; So.init(MP, D, C.G, C.wg);
    pg8::EpiOut E{C.wsp<float>(WS_XRES), C.wsp<pg8::bf16_t>(WS_XB), C.sumsq(layer + 1)};
    pg8::gemm_phase<pg8::EpiOut, pg8::StaticOrder, true, true>((PG8_LAS unsigned char*)C.lds, g, So, E);
    float* xres = C.wsp<float>(WS_XRES); bf16* xb = C.wsp<bf16>(WS_XB); float* ssn = C.sumsq(layer + 1); const int lane = C.lane;
    skinny_gemm<K>(C, C.wsp<bf16>(WS_Y) + (size_t)MP * K, C.wsp<bf16>(wt_off), D, [=](int m, int n, float v) {
        const size_t o = (size_t)(MP + m) * D + n; const float x = xres[o] + v; xres[o] = x; xb[o] = (bf16)f2bf(x);
        float s = x * x; s += __shfl_xor(s, 16); s += __shfl_xor(s, 32); if ((lane >> 4) == 0) atomicAdd(ssn + MP + m, s); });
}
__device__ __forceinline__ void skinny_in(const Ctx& C, size_t wt_off, int N) {
    float* zs = C.wsp<float>(WS_ZSRAW);
    skinny_gemm<D>(C, C.wsp<bf16>(WS_XB) + (size_t)MP * D, C.wsp<bf16>(wt_off), N, [=](int m, int n, float v) { zs[(size_t)m * N + n] = v; });
}

__global__ void __launch_bounds__(NWG_THREADS, 2) mk_fwd(Params P) {
    extern __shared__ __attribute__((aligned(16))) unsigned char lds_raw[];
    Ctx C; C.lds = (LAS unsigned char*)lds_raw; C.tid = threadIdx.x; C.lane = C.tid & 63; C.wave = __builtin_amdgcn_readfirstlane(C.tid >> 6); C.G = gridDim.x; C.wg = blockIdx.x;
    C.x_prompt = P.in[0];
    C.x_sample = P.in[1];
    C.cache1 = P.in[2];
    C.cache2 = P.in[3];
    C.cache3 = P.in[4];
    C.state_b = P.in[5];
    C.state_c = P.in[6];
    C.norm_g = P.in[7];
    C.final_g = P.in[8];
    C.w_in_a = P.in[9];
    C.w_out_a = P.in[10];
    C.w_in_b = P.in[11];
    C.gn_b = P.in[12];
    C.w_out_b = P.in[13];
    C.w_in_c = P.in[14];
    C.w_gate2_c = P.in[15];
    C.b_gate_c = P.in[16];
    C.gn_c = P.in[17];
    C.w_out_c = P.in[18];
    C.out = P.out; C.ws = P.ws;
    volatile LAS unsigned* MISC = (volatile LAS unsigned*)(C.lds + MISC_OFF);
    if (C.tid < 32) MISC[C.tid] = 0u;
    __syncthreads();
    XcdBarrier bar = xcd_barrier_post((unsigned*)(P.ws + CTL_BAR), MISC + 8);
    int ph = 0;
#define RUN (ph >= P.ph_lo && ph < P.ph_hi)
#define SEAM() do { if (ph >= P.ph_lo && ph + 1 < P.ph_hi) xcd_barrier(bar); ++ph; } while (0)
    float* out = P.out;
    float* pkv1 = out + (size_t)MP * D + (size_t)MS * D; float* pkv2 = pkv1 + (size_t)2 * 4 * 128 * 4096; float* pkv3 = pkv2 + (size_t)2 * 4 * 512 * 4096;
    float* pst_b = pkv3 + (size_t)2 * 4 * 2048 * 4096; float* pst_c = pst_b + (size_t)4 * 8 * 256 * 512;
    float* sst_b = pst_c + (size_t)4 * 4 * 256 * 512 + (size_t)3 * 2 * 8 * 4 * 4096; float* sst_c = sst_b + (size_t)8 * 8 * 256 * 512;

    if (RUN) p0_prologue(C, P);
    SEAM();
    if (RUN) { gemm_in<0>(C, WS_WIA0, A_IN, 0, pkv1, 0); skinny_in(C, WS_WIA0, A_IN); }
    SEAM();
    if (RUN) sfix_a(C, 0, 0);
    SEAM();
    if (RUN) { attn_fast_phase(C); sattn_phase(C, 0, P.in[2], P.in[3], P.in[4]); }
    SEAM();
    if (RUN) attn_merge(C);
    SEAM();
    if (RUN) gemm_out<2048>(C, WS_WOA0, 0);
    SEAM();
    if (RUN) { gemm_in<1>(C, WS_WIB, B_IN, 1, nullptr, 0); skinny_in(C, WS_WIB, B_IN); }
    SEAM();
    if (RUN) sfix_b(C, 1);
    SEAM();
    if (RUN) { scan_phase<4>(C, B_IN, 0, 2048, 4096, 8, nullptr, pst_b); recur_naive<false>(C, B_IN, 0, 2048, 4096, 8, DB, T, MP, C.state_b, sst_b); }
    SEAM();
    if (RUN) norm_gate<true>(C, 8, B_IN, 8192, C.gn_b);
    SEAM();
    if (RUN) gemm_out<4096>(C, WS_WOB, 1);
    SEAM();
    if (RUN) { gemm_in<2>(C, WS_WIC, C_INM, 2, nullptr, 0); skinny_in(C, WS_WIC, C_INM);
        float* lr = C.wsp<float>(WS_LR);
        skinny_gemm<D>(C, C.wsp<bf16>(WS_WLR), C.wsp<bf16>(WS_XB), MT, [=](int m, int n, float v) { if (m < 16) lr[(size_t)m * MT + n] = v; }); }
    SEAM();
    if (RUN) { sfix_c(C, 2); gla_pre(C, 2); }
    SEAM();
    if (RUN) { scan_phase<2>(C, C_INM, 0, 1024, 2048, 4, C.wsp<float>(WS_DVEC), pst_c); recur_naive<true>(C, C_INM, 0, 1024, 2048, 4, DB, T, MP, C.state_c, sst_c); }
    SEAM();
    if (RUN) norm_gate<false>(C, 4, C_INM, 4096, C.gn_c);
    SEAM();
    if (RUN) gemm_out<2048>(C, WS_WOC, 2);
    SEAM();
    if (RUN) { gemm_in<0>(C, WS_WIA1, A_IN, 3, pkv1, 1); skinny_in(C, WS_WIA1, A_IN); }
    SEAM();
    if (RUN) sfix_a(C, 3, 1);
    SEAM();
    if (RUN) { attn_fast_phase(C); sattn_phase(C, 1, P.in[2], P.in[3], P.in[4]); }
    SEAM();
    if (RUN) attn_merge(C);
    SEAM();
    if (RUN) gemm_out<2048>(C, WS_WOA1, 3);
    SEAM();
    if (RUN) final_norm(C);
#undef RUN
#undef SEAM
}
constexpr int NPHASES = 22;
}

#ifndef MK_LAUNCHES
#define MK_LAUNCHES 1
#endif
extern "C" void kernel_launch(void* const* d_in, const int* in_sizes, int n_in, void* d_out, int out_size, void* d_ws, size_t ws_size, hipStream_t stream) {
    using namespace mk;
    static int grid = 0;
    if (grid == 0) {
        int dev = 0, cus = 0;
        if (hipGetDevice(&dev) != hipSuccess || hipDeviceGetAttribute(&cus, hipDeviceAttributeMultiprocessorCount, dev) != hipSuccess) { fprintf(stderr, "kernel_launch: device query failed\n"); grid = -1; return; }
        if (hipFuncSetAttribute((const void*)mk_fwd, hipFuncAttributeMaxDynamicSharedMemorySize, LDS_BYTES) != hipSuccess) { fprintf(stderr, "kernel_launch: hipFuncSetAttribute failed\n"); grid = -1; return; }
        int per_cu = 0;
        if (hipOccupancyMaxActiveBlocksPerMultiprocessor(&per_cu, (const void*)mk_fwd, NWG_THREADS, LDS_BYTES) != hipSuccess || per_cu < 1) fprintf(stderr, "kernel_launch: occupancy query says %d\n", per_cu);
        (void)hipGetLastError();
        if (ws_size < WS_END) { fprintf(stderr, "kernel_launch: workspace too small (%zu < %zu)\n", ws_size, (size_t)WS_END); grid = -1; return; }
        grid = cus;
    }
    if (grid < 0) return;
    (void)hipMemsetAsync((char*)d_ws + WS_CTL, 0, CTL_ZERO_BYTES, stream);
    Params p{};
    for (int i = 0; i < 19; ++i) p.in[i] = (const float*)d_in[i];
    p.out = (float*)d_out; p.ws = (unsigned char*)d_ws;
    for (int i = 0; i < 16; ++i) p.inv_a[i] = pow(500000.0, -(double)i / 16.0);
    for (int i = 0; i < 128; ++i) p.inv_b[i] = pow(10000.0, -(double)i / 128.0);
    if (MK_LAUNCHES == 1) { p.ph_lo = 0; p.ph_hi = NPHASES; hipLaunchKernelGGL(mk_fwd, dim3(grid), dim3(NWG_THREADS), LDS_BYTES, stream, p); }
    else for (int k = 0; k < NPHASES; ++k) { p.ph_lo = k; p.ph_hi = k + 1; hipLaunchKernelGGL(mk_fwd, dim3(grid), dim3(NWG_THREADS), LDS_BYTES, stream, p); }
}
```

```cpp
#include <hip/hip_runtime.h>
#include <cstdio>
#include <cstdint>
#include <cmath>
namespace pg8 {
#define PG8_LAS __attribute__((address_space(3)))
typedef unsigned short bf16_t;
typedef short bf16x8 __attribute__((ext_vector_type(8)));
typedef float f32x4 __attribute__((ext_vector_type(4)));
typedef unsigned u32x4 __attribute__((ext_vector_type(4)));
constexpr int BM = 256, BK = 64, HALF = 128, HTB = HALF * BK * 2  , STAGE_BYTES = 8 * HTB, NXCD = 8, WGM = 8;

__host__ __device__ __forceinline__ int lds_byte(int r, int c) { const int st = (r >> 4) * 2 + (c >> 5), rr = r & 15, cc = c & 31, ob = rr * 64 + cc * 2; return st * 1024 + (ob ^ (((ob >> 9) & 1) << 5)); }
__host__ __device__ __forceinline__ void stage_rc(int b, int& R, int& C) { const int st = b / 1024, sb = b % 1024, swz = sb ^ (((sb >> 9) & 1) << 5); R = (st >> 1) * 16 + swz / 64; C = (st & 1) * 32 + (swz % 64) / 2; }
__host__ __device__ __forceinline__ int perm32(int rho) { const int n = rho >> 4, i = rho & 15; return 8 * (i >> 2) + 4 * n + (i & 3); }

struct Unit { int pm, pn; };
struct Gemm { const bf16_t* A; const bf16_t* Bt; int M, N, K; };

struct StaticOrder {
    int nM, nN, nwg, G, c;
    __host__ __device__ void init(int M, int N, int G_, int c_) { nM = M / BM; nN = N / BM; nwg = nM * nN; G = G_; c = c_; }
    __host__ __device__ bool next(int i, Unit& u) const {
        const long L = (long)i * G + c; if (L >= nwg) return false;
        int wgid = (int)L; { const int q = nwg / NXCD, r = nwg % NXCD, xcd = wgid % NXCD, off = wgid / NXCD; wgid = (xcd < r ? xcd * (q + 1) : r * (q + 1) + (xcd - r) * q) + off; }
        const int nig = WGM * nN, gid = wgid / nig, fm = gid * WGM, gsz = (nM - fm) < WGM ? (nM - fm) : WGM;
        u.pm = fm + ((wgid % nig) % gsz); u.pn = (wgid % nig) / gsz; return true;
    }
    __device__ __forceinline__ void a_ready(const Unit&) const {}
    __device__ __forceinline__ void done(const Unit&) const {}
};

__device__ __forceinline__ unsigned cvt_pk_bf16(float lo, float hi) { unsigned r; asm volatile("v_cvt_pk_bf16_f32 %0, %1, %2" : "=v"(r) : "v"(lo), "v"(hi)); return r; }
typedef float f32x2 __attribute__((ext_vector_type(2)));
typedef unsigned u32x2 __attribute__((ext_vector_type(2)));

template <int MODE> struct EpiIn {
    static constexpr bool PERM = true, AFTER_DRAIN = false;
    bf16_t* Z; int ldz; const float* sumsq; const f32x2* tab; float* kvb; int slot;
    __device__ __forceinline__ void store8(bf16_t* p, const f32x4& a, const f32x4& b) const {
        u32x4 w; w.x = cvt_pk_bf16(a[0], a[1]); w.y = cvt_pk_bf16(a[2], a[3]); w.z = cvt_pk_bf16(b[0], b[1]); w.w = cvt_pk_bf16(b[2], b[3]); *(u32x4*)p = w; }
    __device__ __forceinline__ void operator()(const f32x4 (&acc)[2][2][4][2], const Unit& u, int wr, int wc, int fr, int fq) const {
        const int row0 = u.pm * BM + wr * 64 + fr, colt = u.pn * BM;
        if constexpr (MODE == 0) {
            const int section = u.pn >> 3, kind = section < 9 ? section % 3 : 3, g = section / 3;
            const bool rot = (kind < 2) && (wc == 0);
            const int gg = g > 2 ? 2 : g, keep = 128 << (2 * gg); float* kvo = kvb + (size_t)32768 * (size_t)(128 * (((1 << (2 * gg)) - 1) / 3)) + (size_t)slot * 4 * keep * 4096;
#pragma unroll
            for (int ai = 0; ai < 2; ++ai)
#pragma unroll
                for (int m = 0; m < 4; ++m) {
                    const int row = row0 + ai * HALF + m * 16; const float rs = rsqrtf(sumsq[row] * (1.0f / 2048.0f) + 1e-6f); const int pos = row & 2047, b = row >> 11;
#pragma unroll
                    for (int bj = 0; bj < 2; ++bj) {
                        f32x4 v0 = acc[ai][bj][m][0] * rs, v1 = acc[ai][bj][m][1] * rs;
                        const int col = colt + bj * HALF + wc * 32 + 8 * fq;
                        if (rot) {
                            f32x4 p0, p1;
#pragma unroll
                            for (int j = 0; j < 4; ++j) { p0[j] = __shfl_xor(v0[j], 32); p1[j] = __shfl_xor(v1[j], 32); }
                            const f32x4* tp = (const f32x4*)(tab + pos * 16 + 8 * (fq & 1));
                            const f32x4 t0 = tp[0], t1 = tp[1], t2 = tp[2], t3 = tp[3];
                            const f32x4 c0 = {t0[0], t0[2], t1[0], t1[2]}, s0 = {t0[1], t0[3], t1[1], t1[3]}, c1 = {t2[0], t2[2], t3[0], t3[2]}, s1 = {t2[1], t2[3], t3[1], t3[3]};
                            if (fq < 2) { v0 = v0 * c0 - p0 * s0; v1 = v1 * c1 - p1 * s1; } else { v0 = p0 * s0 + v0 * c0; v1 = p1 * s1 + v1 * c1; }
                        }
                        store8(Z + (size_t)row * ldz + col, v0, v1);
                        if (kind == 1 || kind == 2) {
                            if (pos >= 2048 - keep) { float* o = kvo + (((size_t)b * keep + (pos - (2048 - keep))) * 2 + (kind - 1)) * 2048 + (col - section * 2048);
                                *(f32x4*)o = v0; *(f32x4*)(o + 4) = v1; }
                        }
                    }
                }
        } else if constexpr (MODE == 1) {
            const bool rot = u.pn < 16; const float sc = (u.pn >= 8 && u.pn < 16) ? 0.0625f : 1.0f;
            const float lg2 = log2f(1.0f - exp2f(-5.0f - (float)(u.pn & 7)));
#pragma unroll
            for (int ai = 0; ai < 2; ++ai)
#pragma unroll
                for (int m = 0; m < 4; ++m) {
                    const int row = row0 + ai * HALF + m * 16; const int pos = row & 2047;
                    float rs = rsqrtf(sumsq[row] * (1.0f / 2048.0f) + 1e-6f) * sc;
                    if (rot) { const float ee = (float)((pos & 127) + 1) * lg2; rs *= exp2f(u.pn < 8 ? ee : -ee); }
                    f32x4 x1[2], x2[2];
#pragma unroll
                    for (int n = 0; n < 2; ++n) { x1[n] = acc[ai][0][m][n] * rs; x2[n] = acc[ai][1][m][n] * rs; }
                    if (rot) {
#pragma unroll
                        for (int n = 0; n < 2; ++n) {
                            const f32x4* tp = (const f32x4*)(tab + pos * 128 + wc * 32 + 8 * fq + 4 * n);
                            const f32x4 t0 = tp[0], t1 = tp[1];
                            const f32x4 c = {t0[0], t0[2], t1[0], t1[2]}, s = {t0[1], t0[3], t1[1], t1[3]};
                            const f32x4 a = x1[n], bb = x2[n];
                            x1[n] = a * c - bb * s; x2[n] = a * s + bb * c;
                        }
                    }
                    bf16_t* zp = Z + (size_t)row * ldz + colt + wc * 32 + 8 * fq;
                    store8(zp, x1[0], x1[1]); store8(zp + HALF, x2[0], x2[1]);
                }
        } else {
            const float sc = u.pn < 4 ? 0.0625f : 1.0f;
#pragma unroll
            for (int ai = 0; ai < 2; ++ai)
#pragma unroll
                for (int m = 0; m < 4; ++m) {
                    const int row = row0 + ai * HALF + m * 16; const float rs = rsqrtf(sumsq[row] * (1.0f / 2048.0f) + 1e-6f) * sc;
                    bf16_t* zp = Z + (size_t)row * ldz + colt + wc * 32 + 8 * fq;
#pragma unroll
                    for (int bj = 0; bj < 2; ++bj) store8(zp + bj * HALF, acc[ai][bj][m][0] * rs, acc[ai][bj][m][1] * rs);
                }
        }
    }
};
struct EpiOut {
    static constexpr bool PERM = false, AFTER_DRAIN = false;
    float* xres; bf16_t* xb; float* sumsq_next;
    __device__ __forceinline__ void operator()(const f32x4 (&acc)[2][2][4][2], const Unit& u, int wr, int wc, int fr, int fq) const {
        const int row0 = u.pm * BM + wr * 64 + fr, col0 = u.pn * BM + wc * 32 + 4 * fq;
#pragma unroll
        for (int ai = 0; ai < 2; ++ai)
#pragma unroll
            for (int m = 0; m < 4; ++m) {
                const int row = row0 + ai * HALF + m * 16; float ss = 0.f;
                float* xr = xres + (size_t)row * 2048 + col0; bf16_t* br = xb + (size_t)row * 2048 + col0;
#pragma unroll
                for (int bj = 0; bj < 2; ++bj)
#pragma unroll
                    for (int n = 0; n < 2; ++n) {
                        const f32x4 v = *(const f32x4*)(xr + bj * HALF + n * 16) + acc[ai][bj][m][n];
                        *(f32x4*)(xr + bj * HALF + n * 16) = v;
                        u32x2 w; w.x = cvt_pk_bf16(v[0], v[1]); w.y = cvt_pk_bf16(v[2], v[3]); *(u32x2*)(br + bj * HALF + n * 16) = w;
                        ss += (v[0] * v[0] + v[1] * v[1]) + (v[2] * v[2] + v[3] * v[3]);
                    }
                ss += __shfl_xor(ss, 16); ss += __shfl_xor(ss, 32);
                if (fq == 0) atomicAdd(sumsq_next + row, ss);
            }
    }
};
template <class Epi, class Sched, bool ALIGN_EPI = false, bool SP2 = false>
__device__ __forceinline__ void gemm_phase(PG8_LAS unsigned char* lds, const Gemm g, const Sched& S, const Epi& E) {
    const int tid = threadIdx.x, wid = __builtin_amdgcn_readfirstlane(tid >> 6), lane = tid & 63, wr = wid >> 2, wc = wid & 3, fr = lane & 15, fq = lane >> 4;
    const int K = g.K, nt = K / BK;
    unsigned voffA[2], voffB[2];
#pragma unroll
    for (int i = 0; i < 2; ++i) { int R, C; stage_rc(tid * 16 + i * 8192, R, C); const int Rb = Epi::PERM ? ((R & ~31) + perm32(R & 31)) : R;
        voffA[i] = (unsigned)(R * K + C) * 2u; voffB[i] = (unsigned)(Rb * K + C) * 2u; }
    const size_t kstep = (size_t)(BK * 2);
    const size_t hstep = (size_t)HALF * K * 2;
    const size_t tstep = 2 * hstep;
    const unsigned ldsw = (unsigned)wid * 1024u;
    const int aoff = lds_byte(wr * 64 + fr, fq * 8), boff = lds_byte(wc * 32 + fr, fq * 8);
#define PG8_SA(b, h) (((b) * 2 + (h)) * HTB)
#define PG8_SB(b, h) ((4 + (b) * 2 + (h)) * HTB)
#define PG8_STAGE(bufoff, gbase, voff) do { _Pragma("unroll") for (int _i = 0; _i < 2; ++_i) \
        __builtin_amdgcn_global_load_lds((const unsigned*)((const char*)(gbase) + (voff)[_i]), (PG8_LAS unsigned*)(lds + (bufoff) + ldsw + _i * 8192), 16, 0, 0); } while (0)
#define PG8_LDA(dst, b, h) do { _Pragma("unroll") for (int m = 0; m < 4; ++m) _Pragma("unroll") for (int k = 0; k < 2; ++k) dst[m][k] = *(const PG8_LAS bf16x8*)(lds + PG8_SA(b, h) + aoff + m * 2048 + k * 1024); } while (0)
#define PG8_LDB(dst, b, h) do { _Pragma("unroll") for (int n = 0; n < 2; ++n) _Pragma("unroll") for (int k = 0; k < 2; ++k) dst[n][k] = *(const PG8_LAS bf16x8*)(lds + PG8_SB(b, h) + boff + n * 2048 + k * 1024); } while (0)
#define PG8_MMA(ai, bj, At, Bt) do { __builtin_amdgcn_s_setprio(1); _Pragma("unroll") for (int m = 0; m < 4; ++m) _Pragma("unroll") for (int n = 0; n < 2; ++n) _Pragma("unroll") for (int k = 0; k < 2; ++k) \
        acc[ai][bj][m][n] = __builtin_amdgcn_mfma_f32_16x16x32_bf16(Bt[n][k], At[m][k], acc[ai][bj][m][n], 0, 0, 0); __builtin_amdgcn_s_setprio(0); } while (0)
#define PG8_WAIT_V(n) asm volatile("s_waitcnt vmcnt(" #n ")" ::: "memory")
#define PG8_WAIT_L(n) asm volatile("s_waitcnt lgkmcnt(" #n ")" ::: "memory")
#define PG8_BAR __builtin_amdgcn_s_barrier()
#define PG8_SCHED __builtin_amdgcn_sched_barrier(0)
    Unit cur, nxt; int ui = 0;
    if (!S.next(0, cur)) return;
    f32x4 acc[2][2][4][2];
#pragma unroll
    for (int a = 0; a < 2; ++a)
#pragma unroll
        for (int b = 0; b < 2; ++b)
#pragma unroll
            for (int m = 0; m < 4; ++m)
#pragma unroll
                for (int n = 0; n < 2; ++n) acc[a][b][m][n] = (f32x4){0.f, 0.f, 0.f, 0.f};
    bf16x8 At[4][2], B0[2][2], B1[2][2];
    const char* cA = (const char*)g.A + (size_t)cur.pm * tstep; const char* cB = (const char*)g.Bt + (size_t)cur.pn * tstep;
    S.a_ready(cur);
    if constexpr (SP2) {
        PG8_STAGE(PG8_SB(0, 0), cB, voffB); PG8_STAGE(PG8_SB(0, 1), cB + hstep, voffB); PG8_STAGE(PG8_SA(0, 0), cA, voffA); PG8_STAGE(PG8_SA(0, 1), cA + hstep, voffA);
        if (wr == 1) PG8_BAR;
        PG8_WAIT_V(2); PG8_BAR;
        PG8_STAGE(PG8_SB(1, 0), cB + kstep, voffB); PG8_STAGE(PG8_SA(1, 0), cA + kstep, voffA); PG8_STAGE(PG8_SB(1, 1), cB + hstep + kstep, voffB);
        PG8_WAIT_V(6); PG8_BAR;
    } else {
        PG8_STAGE(PG8_SB(0, 0), cB, voffB); PG8_STAGE(PG8_SA(0, 0), cA, voffA); PG8_STAGE(PG8_SB(0, 1), cB + hstep, voffB); PG8_STAGE(PG8_SA(0, 1), cA + hstep, voffA);
        if (wr == 1) PG8_BAR;
        PG8_WAIT_V(4); PG8_BAR;
        PG8_STAGE(PG8_SB(1, 0), cB + kstep, voffB); PG8_STAGE(PG8_SA(1, 0), cA + kstep, voffA); PG8_STAGE(PG8_SB(1, 1), cB + hstep + kstep, voffB);
        PG8_WAIT_V(6); PG8_BAR;
    }
    for (;;) {
        const bool has_next = S.next(ui + 1, nxt);
        const char* nA = has_next ? (const char*)g.A + (size_t)nxt.pm * tstep : cA; const char* nB = has_next ? (const char*)g.Bt + (size_t)nxt.pn * tstep : cB;
        for (int t = 0; t < nt; t += 2) {
            const bool last = (t == nt - 2);
            const char* a1 = cA + (size_t)(t + 1) * kstep;
            const char* a2 = last ? nA : cA + (size_t)(t + 2) * kstep; const char* b2 = last ? nB : cB + (size_t)(t + 2) * kstep;
            const char* a3 = a2 + kstep; const char* b3 = b2 + kstep;
            if (last && has_next) S.a_ready(nxt);
            if constexpr (SP2) {
            PG8_LDB(B0, 0, 0); PG8_LDB(B1, 0, 1); PG8_SCHED; PG8_LDA(At, 0, 0); PG8_STAGE(PG8_SA(1, 1), a1 + hstep, voffA);
            PG8_WAIT_V(8); PG8_WAIT_L(0); PG8_BAR; PG8_MMA(0, 0, At, B0); PG8_MMA(0, 1, At, B1); PG8_BAR; PG8_SCHED;
            PG8_LDA(At, 0, 1); PG8_STAGE(PG8_SB(0, 0), b2, voffB); PG8_STAGE(PG8_SB(0, 1), b2 + hstep, voffB); PG8_STAGE(PG8_SA(0, 0), a2, voffA);
            PG8_WAIT_V(8); PG8_WAIT_L(0); PG8_BAR; PG8_MMA(1, 0, At, B0); PG8_MMA(1, 1, At, B1); PG8_BAR; PG8_SCHED;
            PG8_LDB(B0, 1, 0); PG8_LDB(B1, 1, 1); PG8_SCHED; PG8_LDA(At, 1, 0); PG8_STAGE(PG8_SA(0, 1), a2 + hstep, voffA);
            PG8_WAIT_V(8); PG8_WAIT_L(0); PG8_BAR; PG8_MMA(0, 0, At, B0); PG8_MMA(0, 1, At, B1); PG8_BAR; PG8_SCHED;
            PG8_LDA(At, 1, 1); PG8_STAGE(PG8_SB(1, 0), b3, voffB); PG8_STAGE(PG8_SB(1, 1), b3 + hstep, voffB); PG8_STAGE(PG8_SA(1, 0), a3, voffA);
            PG8_WAIT_V(8); PG8_WAIT_L(0); PG8_BAR; PG8_MMA(1, 0, At, B0); PG8_MMA(1, 1, At, B1); PG8_BAR; PG8_SCHED;
            } else {
            PG8_LDB(B0, 0, 0); PG8_SCHED; PG8_LDA(At, 0, 0); PG8_STAGE(PG8_SA(1, 1), a1 + hstep, voffA);
            PG8_WAIT_L(8); PG8_BAR; PG8_WAIT_L(0); PG8_MMA(0, 0, At, B0); PG8_BAR; PG8_SCHED;
            PG8_LDB(B1, 0, 1); PG8_STAGE(PG8_SB(0, 0), b2, voffB);
            PG8_BAR; PG8_WAIT_L(0); PG8_MMA(0, 1, At, B1); PG8_BAR;
            PG8_LDA(At, 0, 1); PG8_STAGE(PG8_SA(0, 0), a2, voffA);
            PG8_BAR; PG8_WAIT_L(0); PG8_MMA(1, 0, At, B0); PG8_BAR; PG8_SCHED;
            PG8_STAGE(PG8_SB(0, 1), b2 + hstep, voffB);
            PG8_WAIT_V(6); PG8_BAR; PG8_MMA(1, 1, At, B1); PG8_BAR;
            PG8_LDB(B0, 1, 0); PG8_SCHED; PG8_LDA(At, 1, 0); PG8_STAGE(PG8_SA(0, 1), a2 + hstep, voffA);
            PG8_WAIT_L(8); PG8_BAR; PG8_WAIT_L(0); PG8_MMA(0, 0, At, B0); PG8_BAR; PG8_SCHED;
            PG8_LDB(B1, 1, 1); PG8_STAGE(PG8_SB(1, 0), b3, voffB);
            PG8_BAR; PG8_WAIT_L(0); PG8_MMA(0, 1, At, B1); PG8_BAR;
            PG8_LDA(At, 1, 1); PG8_STAGE(PG8_SA(1, 0), a3, voffA);
            PG8_BAR; PG8_WAIT_L(0); PG8_MMA(1, 0, At, B0); PG8_BAR; PG8_SCHED;
            PG8_STAGE(PG8_SB(1, 1), b3 + hstep, voffB);
            PG8_WAIT_V(6); PG8_BAR; PG8_MMA(1, 1, At, B1); PG8_BAR;
            }
        }
        if constexpr (ALIGN_EPI) { if (wr == 0) PG8_BAR; }
        if constexpr (!Epi::AFTER_DRAIN) { E(acc, cur, wr, wc, fr, fq); S.done(cur); }
        if (!has_next) break;
#pragma unroll
        for (int a = 0; a < 2; ++a)
#pragma unroll
            for (int b = 0; b < 2; ++b)
#pragma unroll
                for (int m = 0; m < 4; ++m)
#pragma unroll
                    for (int n = 0; n < 2; ++n) acc[a][b][m][n] = (f32x4){0.f, 0.f, 0.f, 0.f};
        cur = nxt; cA = nA; cB = nB; ++ui;
        if constexpr (ALIGN_EPI) { if (wr == 1) PG8_BAR; }
    }
    PG8_WAIT_V(0);
    if constexpr (!ALIGN_EPI) { if (wr == 0) PG8_BAR; }
    PG8_BAR;
    if constexpr (Epi::AFTER_DRAIN) { E.fused(acc, cur, wr, wc, fr, fq, lds, wid, lane); S.done(cur); }
#undef PG8_SA
#undef PG8_SB
#undef PG8_STAGE
#undef PG8_LDA
#undef PG8_LDB
#undef PG8_MMA
#undef PG8_WAIT_V
#undef PG8_WAIT_L
#undef PG8_BAR
#undef PG8_SCHED
}
}
#define LAS __attribute__((address_space(3)))
#define XB_TMO      128
#define XB_XCNT(j)  (256  + 64 * (j))
#define XB_XSUB(j)  (1280 + 64 * (j))
#define XB_XGEN(j)  (2304 + 64 * (j))
#define XB_TOP      3328
#define XB_TOPGEN   3392
#define XCD_BAR_WORDS 3456
#define XB_SPIN_CAP (1u << 18)

__device__ __forceinline__ unsigned xb_ld(unsigned* p)              { return __hip_atomic_load(p, __ATOMIC_RELAXED, __HIP_MEMORY_SCOPE_AGENT); }
__device__ __forceinline__ unsigned xb_add(unsigned* p, unsigned v) { return __hip_atomic_fetch_add(p, v, __ATOMIC_RELAXED, __HIP_MEMORY_SCOPE_AGENT); }
__device__ __forceinline__ unsigned xb_xcc_id() { return (unsigned)__builtin_amdgcn_s_getreg((3 << 11) | 20) & 0xFu; }
#define XB_SPIN(cond, bar) do { unsigned _sp = 0; while (cond) { __builtin_amdgcn_s_sleep(1); \
    if ((++_sp & 255u) == 0u) { if (xb_ld(&(bar)[XB_TMO])) break; if (_sp > XB_SPIN_CAP) { atomicAdd(&(bar)[XB_TMO], 1u); break; } } } } while (0)

struct XcdBarrier {
    unsigned* bar; unsigned x;
    volatile LAS unsigned* st;
};

__device__ __forceinline__ XcdBarrier xcd_barrier_post(unsigned* bar, volatile LAS unsigned* st) {
    XcdBarrier b; b.bar = bar; b.x = xb_xcc_id(); b.st = st;
    if (threadIdx.x == 0) (void)xb_add(&bar[XB_XCNT(b.x)], 1u);
    return b;
}
__device__ __forceinline__ void xcd_barrier_complete(unsigned* bar, unsigned x, unsigned& nloc, unsigned& nx) {
    const unsigned G = gridDim.x * gridDim.y * gridDim.z;
    unsigned sum, cnt, mine, sp = 0u;
    for (;;) {
        sum = 0u; cnt = 0u; mine = 0u;
#pragma unroll
        for (unsigned j = 0; j < 16; ++j) { const unsigned c = xb_ld(&bar[XB_XCNT(j)]); sum += c; cnt += (c > 0u) ? 1u : 0u; mine = (j == x) ? c : mine; }
        if (sum == G) break;
        __builtin_amdgcn_s_sleep(1);
        if ((++sp & 255u) == 0u) { if (xb_ld(&bar[XB_TMO])) break; if (sp > XB_SPIN_CAP) { atomicAdd(&bar[XB_TMO], 1u); break; } }
    }
    nloc = mine > 0u ? mine : 1u; nx = cnt > 0u ? cnt : 1u;
}

__device__ __forceinline__ void xcd_barrier(const XcdBarrier& b) {
    asm volatile("s_waitcnt vmcnt(0)" ::: "memory");
    __syncthreads();
    if (threadIdx.x == 0) {
        unsigned* bar = b.bar;
        __builtin_amdgcn_s_waitcnt(0);
        unsigned nloc = b.st[0], nx = b.st[1];
        if (nloc == 0u) { xcd_barrier_complete(bar, b.x, nloc, nx); b.st[0] = nloc; b.st[1] = nx; }
        const unsigned old = xb_add(&bar[XB_XSUB(b.x)], 1u);
        const unsigned gen = old / nloc;
        if (old + 1u == (gen + 1u) * nloc) {
            __builtin_amdgcn_fence(__ATOMIC_RELEASE, "agent");
            asm volatile("s_waitcnt vmcnt(0)" ::: "memory");
            const unsigned og = xb_add(&bar[XB_TOP], 1u);
            const unsigned tg = og / nx;
            if (og + 1u == (tg + 1u) * nx) xb_add(&bar[XB_TOPGEN], 1u);
            else XB_SPIN(xb_ld(&bar[XB_TOPGEN]) == tg, bar);
            __builtin_amdgcn_fence(__ATOMIC_ACQUIRE, "agent");
            xb_add(&bar[XB_XGEN(b.x)], 1u);
            asm volatile("s_waitcnt vmcnt(0)" ::: "memory");
        } else {
            XB_SPIN(xb_ld(&bar[XB_XGEN(b.x)]) == gen, bar);
            __builtin_amdgcn_fence(__ATOMIC_ACQUIRE, "agent");
            asm volatile("s_waitcnt vmcnt(0)" ::: "memory");
        }
    }
    __syncthreads();
}
#ifdef EMU
#include <pthread.h>
#include <cstring>
#include <cstdio>
#include <cstdlib>
#include <cmath>
#include <cstdint>
#define DEV static inline
#define LAS
struct EmuDim { int x; };
static thread_local EmuDim threadIdx;
typedef short bf16x8 __attribute__((ext_vector_type(8)));
typedef short s16x4 __attribute__((ext_vector_type(4)));
typedef float f32x4 __attribute__((ext_vector_type(4)));
typedef float f32x2 __attribute__((ext_vector_type(2)));
typedef unsigned u32x4 __attribute__((ext_vector_type(4)));
typedef unsigned u32x2 __attribute__((ext_vector_type(2)));
struct WaveX { bf16x8 a[64], b[64]; float f[64]; const void* p[64]; pthread_barrier_t bar; };
static WaveX g_wx[8];
static pthread_barrier_t g_wgbar;
static inline float emu_bf2f(short v) { unsigned u = ((unsigned)(unsigned short)v) << 16; float f; memcpy(&f, &u, 4); return f; }
static inline float __uint_as_float(unsigned u) { float f; memcpy(&f, &u, 4); return f; }
static inline unsigned __float_as_uint(float f) { unsigned u; memcpy(&u, &f, 4); return u; }
DEV f32x4 mfma16(bf16x8 a, bf16x8 b, f32x4 c) {
    const int lane = threadIdx.x & 63; WaveX& W = g_wx[threadIdx.x >> 6];
    W.a[lane] = a; W.b[lane] = b; pthread_barrier_wait(&W.bar);
    f32x4 r; const int g = lane >> 4, j = lane & 15;
    for (int rr = 0; rr < 4; ++rr) { const int i = 4 * g + rr; float s = 0.f;
        for (int k = 0; k < 32; ++k) s += emu_bf2f(W.a[i + 16 * (k / 8)][k % 8]) * emu_bf2f(W.b[j + 16 * (k / 8)][k % 8]);
        r[rr] = c[rr] + s; }
    pthread_barrier_wait(&W.bar); return r;
}
DEV s16x4 tr_read(const void* p) {
    const int lane = threadIdx.x & 63; WaveX& W = g_wx[threadIdx.x >> 6];
    W.p[lane] = p; pthread_barrier_wait(&W.bar);
    s16x4 r; const int G = lane >> 4, i = lane & 15;
    for (int q = 0; q < 4; ++q) { const short* src = (const short*)W.p[16 * G + 4 * q + i / 4]; if (((uintptr_t)src) & 7) { fprintf(stderr, "tr_read: unaligned\n"); abort(); } r[q] = src[i % 4]; }
    pthread_barrier_wait(&W.bar); return r;
}
DEV void lds_wait() {}
#define tr_read_o(base, off) tr_read((const unsigned char*)(base) + (off))
DEV float shflx(float v, int m) { const int lane = threadIdx.x & 63; WaveX& W = g_wx[threadIdx.x >> 6]; W.f[lane] = v; pthread_barrier_wait(&W.bar); const float r = W.f[lane ^ m]; pthread_barrier_wait(&W.bar); return r; }
DEV void wg_sync() { pthread_barrier_wait(&g_wgbar); }
DEV void mem_fence_cc() {}
DEV void wave_sync() { pthread_barrier_wait(&g_wx[threadIdx.x >> 6].bar); }
DEV float fast_exp(float x) { return expf(x); }
DEV float fast_log(float x) { return logf(x); }
DEV float fast_exp2(float x) { return exp2f(x); }
DEV float fast_log2(float x) { return log2f(x); }
DEV float fast_rcp(float x) { return 1.0f / x; }
DEV unsigned cvt_pk_bf16(float lo, float hi) { auto f = [](float x) { unsigned u = __float_as_uint(x); return (u + 0x7fffu + ((u >> 16) & 1u)) >> 16; }; return f(lo) | (f(hi) << 16); }
#else
#define DEV __device__ __forceinline__
typedef short bf16x8 __attribute__((ext_vector_type(8)));
typedef short s16x4 __attribute__((ext_vector_type(4)));
typedef float f32x4 __attribute__((ext_vector_type(4)));
typedef float f32x2 __attribute__((ext_vector_type(2)));
typedef unsigned u32x4 __attribute__((ext_vector_type(4)));
typedef unsigned u32x2 __attribute__((ext_vector_type(2)));
DEV f32x4 mfma16(bf16x8 a, bf16x8 b, f32x4 c) { return __builtin_amdgcn_mfma_f32_16x16x32_bf16(a, b, c, 0, 0, 0); }
DEV s16x4 tr_read(const LAS void* p) { s16x4 r; asm volatile("ds_read_b64_tr_b16 %0, %1" : "=&v"(r) : "v"((unsigned)(size_t)p) : "memory"); return r; }
DEV s16x4 tr_read_o(const LAS void* p, int off) { s16x4 r; asm volatile("ds_read_b64_tr_b16 %0, %1 offset:%2" : "=&v"(r) : "v"((unsigned)(size_t)p), "i"(off) : "memory"); return r; }
DEV void lds_wait() { asm volatile("s_waitcnt lgkmcnt(0)" ::: "memory"); __builtin_amdgcn_sched_barrier(0); }
DEV float shflx(float v, int m) { return __shfl_xor(v, m); }
DEV void wg_sync() { __syncthreads(); }
DEV void mem_fence_cc() { asm volatile("" ::: "memory"); }
DEV void wave_sync() { asm volatile("s_waitcnt lgkmcnt(0)" ::: "memory"); }
DEV float fast_exp(float x) { return __expf(x); }
DEV float fast_log(float x) { return __logf(x); }
DEV float fast_exp2(float x) { return __builtin_amdgcn_exp2f(x); }
DEV float fast_log2(float x) { return __builtin_amdgcn_logf(x); }
DEV float fast_rcp(float x) { return __builtin_amdgcn_rcpf(x); }
DEV unsigned cvt_pk_bf16(float lo, float hi) { unsigned r; asm volatile("v_cvt_pk_bf16_f32 %0, %1, %2" : "=v"(r) : "v"(lo), "v"(hi)); return r; }
#endif
typedef unsigned short bf16;
DEV bf16x8 pack8(s16x4 lo, s16x4 hi) { return (bf16x8){lo[0], lo[1], lo[2], lo[3], hi[0], hi[1], hi[2], hi[3]}; }

namespace mk {
typedef unsigned short bf16;
typedef float f32x4 __attribute__((ext_vector_type(4)));
typedef float f32x2 __attribute__((ext_vector_type(2)));
typedef unsigned u32x4 __attribute__((ext_vector_type(4)));
typedef unsigned u32x2 __attribute__((ext_vector_type(2)));
typedef short bf16x8 __attribute__((ext_vector_type(8)));
constexpr int D = 2048, NB = 4, S = 2048, MP = NB * S, DB = 8, T = 4, MS = DB * T, MT = MP + MS, PAST = 16384;
constexpr float EPS = 1e-6f;
constexpr int A_IN = 20480, B_IN = 12288, C_IN = 6160, C_INM = 6144;
constexpr int NWG_THREADS = 512;
constexpr size_t MiB = 1u << 20;
constexpr size_t WS_CTL = 0, CTL_ZERO_BYTES = 1 * MiB;
constexpr size_t CTL_BAR = 16384;
constexpr size_t CTL_SUMSQ = 65536;
constexpr size_t WS_TABA = 1 * MiB;
constexpr size_t WS_TABB = WS_TABA + 512 * 1024;
constexpr size_t WS_WIA0 = 4 * MiB;
constexpr size_t WS_WIA1 = WS_WIA0 + (size_t)A_IN * D * 2;
constexpr size_t WS_WIB = WS_WIA1 + (size_t)A_IN * D * 2;
constexpr size_t WS_WIC = WS_WIB + (size_t)B_IN * D * 2;
constexpr size_t WS_WLR = WS_WIC + (size_t)C_INM * D * 2;
constexpr size_t WS_WOA0 = WS_WLR + (size_t)32 * D * 2;
constexpr size_t WS_WOA1 = WS_WOA0 + (size_t)D * 2048 * 2;
constexpr size_t WS_WOB = WS_WOA1 + (size_t)D * 2048 * 2;
constexpr size_t WS_WOC = WS_WOB + (size_t)D * 4096 * 2;
constexpr size_t WS_XRES = WS_WOC + (size_t)D * 2048 * 2;
constexpr size_t WS_XB = WS_XRES + (size_t)MT * D * 4;
constexpr size_t WS_Z = WS_XB + (size_t)MT * D * 2;
constexpr size_t WS_ZSRAW = WS_Z + (size_t)MT * A_IN * 2;
constexpr size_t WS_Y = WS_ZSRAW + (size_t)32 * A_IN * 4;
constexpr size_t WS_O = WS_Y + (size_t)MT * 4096 * 2;
constexpr size_t WS_LOGA = WS_O + (size_t)MT * 4096 * 4;
constexpr size_t WS_LR = WS_LOGA + (size_t)MT * 1024 * 4;
constexpr size_t WS_DVEC = WS_LR + (size_t)32 * MT * 4;
constexpr size_t WS_END = WS_DVEC + (size_t)4 * 4 * 16 * 256 * 4;
constexpr int LDS_BYTES = 147456, MISC_OFF = 147456 - 256;

struct Params {
    const float* in[19]; float* out; unsigned char* ws;
    double inv_a[16]; double inv_b[128];
    int ph_lo, ph_hi;
};

__device__ __forceinline__ float bf2f(bf16 v) { return __uint_as_float(((unsigned)v) << 16); }
__device__ __forceinline__ unsigned f2bf(float f) { unsigned u = __float_as_uint(f); return (u + 0x7fffu + ((u >> 16) & 1u)) >> 16; }
__device__ __forceinline__ unsigned pk2(float lo, float hi) { return f2bf(lo) | (f2bf(hi) << 16); }
__device__ __forceinline__ float wave_sum(float v) {
#pragma unroll
    for (int o = 32; o >= 1; o >>= 1) v += __shfl_xor(v, o);
    return v;
}
__device__ __forceinline__ float wave_max(float v) {
#pragma unroll
    for (int o = 32; o >= 1; o >>= 1) v = fmaxf(v, __shfl_xor(v, o));
    return v;
}
__device__ __forceinline__ float silu(float x) { return x / (1.f + __expf(-x)); }
__device__ __forceinline__ void sincos_d(double a, float& s, float& c) {
    const double k = rint(a * 0.63661977236758134308);
    double r = fma(-k, 1.57079632679489655800e+00, a); r = fma(-k, 6.12323399573676603587e-17, r);
    const double r2 = r * r;
    const double sp = r * (1.0 + r2 * (-1.0 / 6 + r2 * (1.0 / 120 + r2 * (-1.0 / 5040 + r2 * (1.0 / 362880 + r2 * (-1.0 / 39916800 + r2 * (1.0 / 6227020800.0)))))));
    const double cp = 1.0 + r2 * (-0.5 + r2 * (1.0 / 24 + r2 * (-1.0 / 720 + r2 * (1.0 / 40320 + r2 * (-1.0 / 3628800 + r2 * (1.0 / 479001600.0 + r2 * (-1.0 / 87178291200.0)))))));
    const int q = (int)((long long)k & 3);
    const double ss = (q == 0) ? sp : (q == 1) ? cp : (q == 2) ? -sp : -cp;
    const double cc = (q == 0) ? cp : (q == 1) ? -sp : (q == 2) ? -cp : sp;
    s = (float)ss; c = (float)cc;
}
__device__ __forceinline__ void row_info(int row, int& b, int& t, int& pi, bool& samp) {
    if (row < MP) { b = row >> 11; t = row & 2047; pi = t; samp = false; } else { const int r = row - MP; b = r >> 2; t = r & 3; pi = 2048 + t; samp = true; }
}

struct Ctx {
    LAS unsigned char* lds; int tid, lane, wave, G, wg;
    const float *x_prompt, *x_sample, *cache1, *cache2, *cache3, *state_b, *state_c, *norm_g, *final_g, *w_in_a, *w_out_a, *w_in_b, *gn_b, *w_out_b, *w_in_c, *w_gate2_c, *b_gate_c, *gn_c, *w_out_c; float* out; unsigned char* ws;
    __device__ __forceinline__ float* sumsq(int l) const { return (float*)(ws + CTL_SUMSQ) + (size_t)l * MT; }
    template <class Tp> __device__ __forceinline__ Tp* wsp(size_t off) const { return (Tp*)(ws + off); }
};

constexpr int ATT_K_OFF = 0, ATT_V_OFF = 65536, ATT_ROWS = 8192 + 32;
DEV int att_off_k(int row, int ch) { return 256 * row + 16 * (ch ^ (row & 15)); }
DEV int att_off_v(int row, int ch) { return 256 * row + 16 * (ch ^ (2 * (row & 7))); }
DEV void attn_item(LAS unsigned char* lds, const bf16* z, int ldz, bf16* og, float* lse, int item, int tid) {
    const int lane = tid & 63, w = tid >> 6, G = lane >> 4, l15 = lane & 15;
    const int bh = item / 48, rem = item % 48, b = bh >> 4, h = bh & 15;
    int g, r, blk;
    if (rem < 16) { g = 0; r = 0; blk = rem; } else if (rem < 32) { g = 1; r = (rem - 16) >> 2; blk = (rem - 16) & 3; } else { g = 2; r = rem - 32; blk = 0; }
    const int dil = 1 << (2 * g);
    const int qcol = (g * 3) * 2048 + h * 128, kcol = qcol + 2048, vcol = qcol + 4096;
    const size_t tok0 = (size_t)b * 2048 + r;
#pragma unroll
    for (int j = 0; j < 8; ++j) {
        const int e = tid + 512 * j, row = e >> 4, ch = e & 15; const int p = (blk - 1) * 128 + row;
        u32x4 kv = {0u, 0u, 0u, 0u}, vv = {0u, 0u, 0u, 0u};
        if (p >= 0) { const bf16* src = z + (tok0 + (size_t)dil * p) * ldz + ch * 8; kv = *(const u32x4*)(src + kcol); vv = *(const u32x4*)(src + vcol); }
        *(LAS u32x4*)(lds + ATT_K_OFF + att_off_k(row, ch)) = kv;
        *(LAS u32x4*)(lds + ATT_V_OFF + att_off_v(row, ch)) = vv;
    }
    const int qi = 16 * w + l15; const size_t qtok = tok0 + (size_t)dil * (blk * 128 + qi);
    bf16x8 qf[4];
#pragma unroll
    for (int s = 0; s < 4; ++s) qf[s] = *(const bf16x8*)(z + qtok * ldz + qcol + 32 * s + 8 * G);
    wg_sync();
    const int m0 = w >> 1;
    f32x4 sc[10];
#pragma unroll
    for (int tt = 0; tt < 10; ++tt) {
        const int t = 2 * m0 + tt; f32x4 a = {0.f, 0.f, 0.f, 0.f};
#pragma unroll
        for (int s = 0; s < 4; ++s) { const bf16x8 kf = *(const LAS bf16x8*)(lds + ATT_K_OFF + att_off_k(16 * t + l15, 4 * s + G)); a = mfma16(kf, qf[s], a); }
        sc[tt] = a;
    }
    const float scale = 0.08838834764831845f * 1.4426950408889634f;
    float mx = -INFINITY;
#pragma unroll
    for (int tt = 0; tt < 10; ++tt)
#pragma unroll
        for (int rr = 0; rr < 4; ++rr) { const int c = 16 * (2 * m0 + tt) + 4 * G + rr; const bool ok = (c >= qi) && (c <= qi + 128) && (blk > 0 || c >= 128);
            const float v = ok ? sc[tt][rr] * scale : -INFINITY; sc[tt][rr] = v; mx = fmaxf(mx, v); }
    mx = fmaxf(mx, shflx(mx, 16)); mx = fmaxf(mx, shflx(mx, 32));
    float sum = 0.f;
#pragma unroll
    for (int tt = 0; tt < 10; ++tt)
#pragma unroll
        for (int rr = 0; rr < 4; ++rr) { const float p = fast_exp2(sc[tt][rr] - mx); sc[tt][rr] = p; sum += p; }
    sum += shflx(sum, 16); sum += shflx(sum, 32);
    f32x4 oacc[8];
#pragma unroll
    for (int dt = 0; dt < 8; ++dt) oacc[dt] = (f32x4){0.f, 0.f, 0.f, 0.f};
#pragma unroll
    for (int mm = 0; mm < 5; ++mm) {
        const f32x4 p0 = sc[2 * mm], p1 = sc[2 * mm + 1];
        u32x4 pw; pw[0] = cvt_pk_bf16(p0[0], p0[1]); pw[1] = cvt_pk_bf16(p0[2], p0[3]); pw[2] = cvt_pk_bf16(p1[0], p1[1]); pw[3] = cvt_pk_bf16(p1[2], p1[3]);
        bf16x8 pf; __builtin_memcpy(&pf, &pw, 16);
        const int krow = 32 * (m0 + mm) + 4 * G + (l15 >> 2);
#pragma unroll
        for (int dh = 0; dh < 2; ++dh) {
            s16x4 lo[4], hi[4];
#pragma unroll
            for (int d4 = 0; d4 < 4; ++d4) { const int dt = dh * 4 + d4; const int ch = 2 * dt + ((l15 >> 1) & 1);
                lo[d4] = tr_read(lds + ATT_V_OFF + att_off_v(krow, ch) + 8 * (l15 & 1)); hi[d4] = tr_read(lds + ATT_V_OFF + att_off_v(krow + 16, ch) + 8 * (l15 & 1)); }
            lds_wait();
#pragma unroll
            for (int d4 = 0; d4 < 4; ++d4) oacc[dh * 4 + d4] = mfma16(pack8(lo[d4], hi[d4]), pf, oacc[dh * 4 + d4]);
        }
    }
    const float inv = fast_rcp(sum);
    bf16* orow = og + ((size_t)g * ATT_ROWS + qtok) * 2048 + h * 128 + 4 * G;
#pragma unroll
    for (int dt = 0; dt < 8; ++dt) { u32x2 wv; wv[0] = cvt_pk_bf16(oacc[dt][0] * inv, oacc[dt][1] * inv); wv[1] = cvt_pk_bf16(oacc[dt][2] * inv, oacc[dt][3] * inv); *(u32x2*)(orow + 16 * dt) = wv; }
    if (G == 0) lse[((size_t)g * ATT_ROWS + qtok) * 16 + h] = (mx + fast_log2(sum)) * 0.6931471805599453f;
    wg_sync();
}
constexpr int SC_KP = 544, SC_K_OFF = 0, SC_V_OFF = 128 * SC_KP, SC_S_OFF = SC_V_OFF + 20480;
template <int NVT>
DEV void scan_unit(LAS unsigned char* lds, const bf16* z, int ldz, int qoff, int koff, int voff, int H, int unit, const float* dvec, float* o, int ldo, float* state_out, int tid) {
    constexpr int VS = 16 * NVT, VP = VS * 2 + 32, KP = SC_KP, NVS = 512 / VS, VCH = VS / 8, NVLD = (128 * VCH) / 512, VROWS = 512 / VCH;
    const int lane = tid & 63, w = tid >> 6, G = lane >> 4, l15 = lane & 15;
    const int vs = unit % NVS, h = (unit / NVS) % H, b = unit / (NVS * H);
    const size_t rowbase = (size_t)b * 2048;
    const bf16* zq = z + qoff + h * 256; const bf16* zk = z + koff + h * 256; const bf16* zv = z + voff + h * 512 + vs * VS;
    float gam128 = 1.f; if (!dvec) { const float gm = 1.0f - exp2f(-5.0f - (float)h); gam128 = exp2f(128.0f * log2f(gm)); }
    LAS unsigned char* const kb_row = lds + SC_K_OFF + l15 * KP + 16 * G;
    LAS unsigned char* const kb_tr = lds + SC_K_OFF + (4 * G + (l15 >> 2)) * KP + 8 * (l15 & 3) + 64 * w;
    LAS unsigned char* const vb_tr = lds + SC_V_OFF + (4 * G + (l15 >> 2)) * VP + 8 * (l15 & 3);
    LAS unsigned char* const sb_row = lds + SC_S_OFF + l15 * KP + 16 * G;
    LAS unsigned char* const sb_wr = lds + SC_S_OFF + l15 * KP + 8 * G + 64 * w;
    LAS unsigned char* const kst = lds + SC_K_OFF + (tid >> 5) * KP + (tid & 31) * 16;
    LAS unsigned char* const vst = lds + SC_V_OFF + (tid / VCH) * VP + (tid % VCH) * 16;
    const size_t kg = (size_t)(tid >> 5) * ldz + (tid & 31) * 8, vg = (size_t)(tid / VCH) * ldz + (tid % VCH) * 8;
    f32x4 sacc[2][NVT];
#pragma unroll
    for (int dd = 0; dd < 2; ++dd)
#pragma unroll
        for (int vt = 0; vt < NVT; ++vt) sacc[dd][vt] = (f32x4){0.f, 0.f, 0.f, 0.f};
    for (int e = tid; e < VS * (KP / 16); e += 512) *(LAS u32x4*)(lds + SC_S_OFF + e * 16) = (u32x4){0u, 0u, 0u, 0u};
    u32x4 kpre[8], vpre[NVLD];
    {   const bf16* kp = zk + rowbase * ldz + kg; const bf16* vp = zv + rowbase * ldz + vg;
#pragma unroll
        for (int j = 0; j < 8; ++j) kpre[j] = *(const u32x4*)(kp + (size_t)(16 * j) * ldz);
#pragma unroll
        for (int j = 0; j < NVLD; ++j) vpre[j] = *(const u32x4*)(vp + (size_t)(VROWS * j) * ldz);
#pragma unroll
        for (int j = 0; j < 8; ++j) *(LAS u32x4*)(kst + 16 * j * KP) = kpre[j];
#pragma unroll
        for (int j = 0; j < NVLD; ++j) *(LAS u32x4*)(vst + VROWS * j * VP) = vpre[j]; }
    wg_sync();
    const int qi = 16 * w + l15;
#pragma unroll 1
    for (int c = 0; c < 16; ++c) {
        const size_t crow = rowbase + (size_t)c * 128;
        const bf16* kp = zk + (crow + 128) * ldz + kg; const bf16* vp = zv + (crow + 128) * ldz + vg;
        if (c + 1 < 16) {
#pragma unroll
            for (int j = 0; j < 4; ++j) kpre[j] = *(const u32x4*)(kp + (size_t)(16 * j) * ldz);
        }
        bf16x8 qf[8];
#pragma unroll
        for (int s = 0; s < 8; ++s) qf[s] = *(const bf16x8*)(zq + (crow + qi) * ldz + 32 * s + 8 * G);
        f32x4 oacc[NVT];
#pragma unroll
        for (int vt = 0; vt < NVT; ++vt) oacc[vt] = (f32x4){0.f, 0.f, 0.f, 0.f};
#pragma unroll 1
        for (int m = 0; m <= (w >> 1); ++m) {
            f32x4 s0 = {0.f, 0.f, 0.f, 0.f}, s1 = {0.f, 0.f, 0.f, 0.f};
            LAS unsigned char* const kr = kb_row + m * (32 * KP); LAS unsigned char* const vr = vb_tr + m * (32 * VP);
#pragma unroll
            for (int s = 0; s < 8; ++s) {
                const bf16x8 k0 = *(const LAS bf16x8*)(kr + 64 * s); const bf16x8 k1 = *(const LAS bf16x8*)(kr + 16 * KP + 64 * s);
                s0 = mfma16(k0, qf[s], s0); s1 = mfma16(k1, qf[s], s1);
                if (s & 1) mem_fence_cc();
            }
#pragma unroll
            for (int rr = 0; rr < 4; ++rr) { const int j0 = 32 * m + 4 * G + rr; s0[rr] = (j0 <= qi) ? s0[rr] : 0.f; s1[rr] = (j0 + 16 <= qi) ? s1[rr] : 0.f; }
            u32x4 pw; pw[0] = cvt_pk_bf16(s0[0], s0[1]); pw[1] = cvt_pk_bf16(s0[2], s0[3]); pw[2] = cvt_pk_bf16(s1[0], s1[1]); pw[3] = cvt_pk_bf16(s1[2], s1[3]);
            bf16x8 pf; __builtin_memcpy(&pf, &pw, 16);
            s16x4 lo[NVT], hi[NVT];
#pragma unroll
            for (int vt = 0; vt < NVT; ++vt) { lo[vt] = tr_read_o(vr, 32 * vt); hi[vt] = tr_read_o(vr, 16 * VP + 32 * vt); }
            lds_wait();
#pragma unroll
            for (int vt = 0; vt < NVT; ++vt) oacc[vt] = mfma16(pack8(lo[vt], hi[vt]), pf, oacc[vt]);
        }
        if (c + 1 < 16) {
#pragma unroll
            for (int j = 4; j < 8; ++j) kpre[j] = *(const u32x4*)(kp + (size_t)(16 * j) * ldz);
        }
#pragma unroll
        for (int s = 0; s < 8; ++s)
#pragma unroll
            for (int vt = 0; vt < NVT; ++vt) { const bf16x8 sf = *(const LAS bf16x8*)(sb_row + 16 * vt * KP + 64 * s); oacc[vt] = mfma16(sf, qf[s], oacc[vt]); if (vt == NVT - 1) mem_fence_cc(); }
        {   float* orow = o + (crow + qi) * ldo + h * 512 + vs * VS + 4 * G;
#pragma unroll
            for (int vt = 0; vt < NVT; ++vt) *(f32x4*)(orow + 16 * vt) = oacc[vt]; }
        if (c + 1 < 16) {
#pragma unroll
            for (int j = 0; j < NVLD; ++j) vpre[j] = *(const u32x4*)(vp + (size_t)(VROWS * j) * ldz);
        }
#pragma unroll
        for (int ks = 0; ks < 4; ++ks) {
            s16x4 alo[2], ahi[2], blo[NVT], bhi[NVT];
#pragma unroll
            for (int dd = 0; dd < 2; ++dd) { alo[dd] = tr_read_o(kb_tr, 32 * ks * KP + 32 * dd); ahi[dd] = tr_read_o(kb_tr, (32 * ks + 16) * KP + 32 * dd); }
#pragma unroll
            for (int vt = 0; vt < NVT; ++vt) { blo[vt] = tr_read_o(vb_tr, 32 * ks * VP + 32 * vt); bhi[vt] = tr_read_o(vb_tr, (32 * ks + 16) * VP + 32 * vt); }
            lds_wait();
#pragma unroll
            for (int dd = 0; dd < 2; ++dd)
#pragma unroll
                for (int vt = 0; vt < NVT; ++vt) sacc[dd][vt] = mfma16(pack8(alo[dd], ahi[dd]), pack8(blo[vt], bhi[vt]), sacc[dd][vt]);
        }
#pragma unroll
        for (int dd = 0; dd < 2; ++dd) {
            f32x4 dv = {gam128, gam128, gam128, gam128};
            if (dvec) dv = *(const f32x4*)(dvec + ((size_t)(b * H + h) * 16 + c) * 256 + 16 * (2 * w + dd) + 4 * G);
#pragma unroll
            for (int vt = 0; vt < NVT; ++vt) sacc[dd][vt] = sacc[dd][vt] * dv;
        }
        wg_sync();
#pragma unroll
        for (int dd = 0; dd < 2; ++dd)
#pragma unroll
            for (int vt = 0; vt < NVT; ++vt) { u32x2 wv; wv[0] = cvt_pk_bf16(sacc[dd][vt][0], sacc[dd][vt][1]); wv[1] = cvt_pk_bf16(sacc[dd][vt][2], sacc[dd][vt][3]); *(LAS u32x2*)(sb_wr + 16 * vt * KP + 32 * dd) = wv; }
        if (c + 1 < 16) {
#pragma unroll
            for (int j = 0; j < 8; ++j) *(LAS u32x4*)(kst + 16 * j * KP) = kpre[j];
#pragma unroll
            for (int j = 0; j < NVLD; ++j) *(LAS u32x4*)(vst + VROWS * j * VP) = vpre[j];
        }
        wg_sync();
    }
#pragma unroll
    for (int dd = 0; dd < 2; ++dd)
#pragma unroll
        for (int vt = 0; vt < NVT; ++vt)
#pragma unroll
            for (int rr = 0; rr < 4; ++rr) state_out[(((size_t)b * H + h) * 256 + 16 * (2 * w + dd) + 4 * G + rr) * 512 + vs * VS + 16 * vt + l15] = sacc[dd][vt][rr];
}
DEV f32x4 bf4_to_f32(u32x2 w) { return (f32x4){__uint_as_float(w[0] << 16), __uint_as_float(w[0] & 0xffff0000u), __uint_as_float(w[1] << 16), __uint_as_float(w[1] & 0xffff0000u)}; }
DEV float half_sum(float v) { v += shflx(v, 16); v += shflx(v, 8); v += shflx(v, 4); v += shflx(v, 2); v += shflx(v, 1); return v; }
DEV void sattn_unit(LAS unsigned char* lds_wave, const bf16* z, int ldz, const float* cache, int g, int b, int t, int h, bf16* og, float* lse, int lane) {
    const int lbuf = 128 << (2 * g), dil = 1 << (2 * g), hf = lane >> 5, c32 = lane & 31;
    const int row = 8192 + b * 4 + t, qcol = g * 3 * 2048 + h * 128, kcol = qcol + 2048, vcol = qcol + 4096;
    const float scale = 0.08838834764831845f;
    LAS float* sc = (LAS float*)lds_wave;
    const f32x4 q4 = bf4_to_f32(*(const u32x2*)(z + (size_t)row * ldz + qcol + 4 * c32));
    const int jn = g == 0 ? t + 1 : 1;
    for (int j = 0; j < jn; ++j) {
        const int krow = 8192 + b * 4 + (t - dil * j);
        const f32x4 k4 = bf4_to_f32(*(const u32x2*)(z + (size_t)krow * ldz + kcol + 4 * c32));
        const float s = half_sum(q4[0] * k4[0] + q4[1] * k4[1] + q4[2] * k4[2] + q4[3] * k4[3]);
        if (lane == 0) sc[j] = s * scale;
    }
    const float* kbase = cache + (size_t)b * lbuf * 4096 + h * 128 + 4 * c32;
    const int nc = 129 - jn;
#pragma unroll 1
    for (int i = 0; i < nc; i += 16) {
        f32x4 k4[8];
#pragma unroll
        for (int u = 0; u < 8; ++u) { int j = jn + i + 2 * u + hf; j = j > 128 ? 128 : j; const int idx = lbuf + t - dil * j; k4[u] = *(const f32x4*)(kbase + (size_t)idx * 4096); }
#pragma unroll
        for (int u = 0; u < 8; ++u) { const int j = jn + i + 2 * u + hf; const float s = half_sum(q4[0] * k4[u][0] + q4[1] * k4[u][1] + q4[2] * k4[u][2] + q4[3] * k4[u][3]); if (c32 == 0 && j <= 128) sc[j] = s * scale; }
    }
    wave_sync();
    float s0 = sc[lane], s1 = sc[lane + 64], s2 = lane == 0 ? sc[128] : -INFINITY;
    float m = fmaxf(s0, fmaxf(s1, s2));
    m = fmaxf(m, shflx(m, 32)); m = fmaxf(m, shflx(m, 16)); m = fmaxf(m, shflx(m, 8)); m = fmaxf(m, shflx(m, 4)); m = fmaxf(m, shflx(m, 2)); m = fmaxf(m, shflx(m, 1));
    s0 = fast_exp(s0 - m); s1 = fast_exp(s1 - m); s2 = lane == 0 ? fast_exp(s2 - m) : 0.f;
    float sum = s0 + s1 + s2; sum += shflx(sum, 32); sum = half_sum(sum);
    wave_sync();
    sc[lane] = s0; sc[lane + 64] = s1; if (lane == 0) sc[128] = s2;
    wave_sync();
    f32x4 acc = {0.f, 0.f, 0.f, 0.f};
    for (int j = 0; j < jn; ++j) {
        const int krow = 8192 + b * 4 + (t - dil * j);
        const f32x4 v4 = bf4_to_f32(*(const u32x2*)(z + (size_t)krow * ldz + vcol + 4 * c32));
        const float pj = hf == 0 ? sc[j] : 0.f; acc += v4 * pj;
    }
#pragma unroll 1
    for (int i = 0; i < nc; i += 16) {
        f32x4 v4[8];
#pragma unroll
        for (int u = 0; u < 8; ++u) { int j = jn + i + 2 * u + hf; j = j > 128 ? 128 : j; const int idx = lbuf + t - dil * j; v4[u] = *(const f32x4*)(kbase + 2048 + (size_t)idx * 4096); }
#pragma unroll
        for (int u = 0; u < 8; ++u) { const int j = jn + i + 2 * u + hf; const float pj = j <= 128 ? sc[j] : 0.f; acc += v4[u] * pj; }
    }
#pragma unroll
    for (int e = 0; e < 4; ++e) acc[e] += shflx(acc[e], 32);
    const float inv = 1.0f / sum;
    if (hf == 0) { u32x2 wv; wv[0] = cvt_pk_bf16(acc[0] * inv, acc[1] * inv); wv[1] = cvt_pk_bf16(acc[2] * inv, acc[3] * inv); *(u32x2*)(og + ((size_t)g * ATT_ROWS + row) * 2048 + h * 128 + 4 * c32) = wv; }
    if (lane == 0) lse[((size_t)g * ATT_ROWS + row) * 16 + h] = m + fast_log(sum);
}
__device__ __forceinline__ void p0_transpose_item(const float* W, int K, int ld, int ncols, const float* gain, bf16* WT, LAS float* scr, int item, int lane) {
    const int nblk = ncols / 128, kb = item / nblk, nb = item % nblk, k0 = 32 * kb, n0 = 128 * nb;
    f32x4 v[16];
#pragma unroll
    for (int i = 0; i < 16; ++i) { const int kk = 2 * i + (lane >> 5); v[i] = *(const f32x4*)(W + (size_t)(k0 + kk) * ld + n0 + 4 * (lane & 31)); }
#pragma unroll
    for (int i = 0; i < 16; ++i) { const int kk = 2 * i + (lane >> 5); const float gk = gain ? gain[k0 + kk] : 1.0f; LAS float* d = scr + kk * 129 + 4 * (lane & 31);
        d[0] = v[i][0] * gk; d[1] = v[i][1] * gk; d[2] = v[i][2] * gk; d[3] = v[i][3] * gk; }
    asm volatile("s_waitcnt lgkmcnt(0)" ::: "memory");
    const int c = lane & 3;
#pragma unroll
    for (int j = 0; j < 8; ++j) { const int n = (lane >> 2) + 16 * j; const LAS float* s = scr + (8 * c) * 129 + n;
        u32x4 o; o.x = pk2(s[0 * 129], s[1 * 129]); o.y = pk2(s[2 * 129], s[3 * 129]); o.z = pk2(s[4 * 129], s[5 * 129]); o.w = pk2(s[6 * 129], s[7 * 129]);
        *(u32x4*)(WT + (size_t)(n0 + n) * K + k0 + 8 * c) = o; }
    asm volatile("s_waitcnt lgkmcnt(0)" ::: "memory");
}
__device__ __forceinline__ void p0_prologue(const Ctx& C, const Params& P) {
    LAS float* scr = (LAS float*)(C.lds + C.wave * 16640);
    const int gw = C.wg * 8 + C.wave, NGW = C.G * 8;
    const float* norm_g = C.norm_g;
    constexpr int I_A = (D / 32) * (A_IN / 128), I_B = (D / 32) * (B_IN / 128), I_C = (D / 32) * (C_INM / 128), I_OA = (2048 / 32) * (D / 128), I_OB = (4096 / 32) * (D / 128);
    constexpr int NITEMS = 2 * I_A + I_B + I_C + 3 * I_OA + I_OB;
    for (int it = gw; it < NITEMS; it += NGW) {
        int r = it;
        if (r < I_A) { p0_transpose_item(C.w_in_a, D, A_IN, A_IN, norm_g + 0 * D, C.wsp<bf16>(WS_WIA0), scr, r, C.lane); continue; } r -= I_A;
        if (r < I_A) { p0_transpose_item(C.w_in_a + (size_t)D * A_IN, D, A_IN, A_IN, norm_g + 3 * D, C.wsp<bf16>(WS_WIA1), scr, r, C.lane); continue; } r -= I_A;
        if (r < I_B) { p0_transpose_item(C.w_in_b, D, B_IN, B_IN, norm_g + 1 * D, C.wsp<bf16>(WS_WIB), scr, r, C.lane); continue; } r -= I_B;
        if (r < I_C) { p0_transpose_item(C.w_in_c, D, C_IN, C_INM, norm_g + 2 * D, C.wsp<bf16>(WS_WIC), scr, r, C.lane); continue; } r -= I_C;
        if (r < I_OA) { p0_transpose_item(C.w_out_a, 2048, D, D, nullptr, C.wsp<bf16>(WS_WOA0), scr, r, C.lane); continue; } r -= I_OA;
        if (r < I_OA) { p0_transpose_item(C.w_out_a + (size_t)2048 * D, 2048, D, D, nullptr, C.wsp<bf16>(WS_WOA1), scr, r, C.lane); continue; } r -= I_OA;
        if (r < I_OA) { p0_transpose_item(C.w_out_c, 2048, D, D, nullptr, C.wsp<bf16>(WS_WOC), scr, r, C.lane); continue; } r -= I_OA;
        p0_transpose_item(C.w_out_b, 4096, D, D, nullptr, C.wsp<bf16>(WS_WOB), scr, r, C.lane);
    }
    { bf16* wlr = C.wsp<bf16>(WS_WLR); const float* W = C.w_in_c; const float* g2 = norm_g + 2 * D;
      for (int e = C.wg * NWG_THREADS + C.tid; e < 32 * D; e += C.G * NWG_THREADS) { const int r = e / D, k = e % D; wlr[e] = r < 16 ? (bf16)f2bf(W[(size_t)k * C_IN + C_INM + r] * g2[k]) : (bf16)0; } }
    { float* xres = C.wsp<float>(WS_XRES); bf16* xb = C.wsp<bf16>(WS_XB); float* ss0 = C.sumsq(0);
      for (int row = gw; row < MT; row += NGW) {
          const float* src = row < MP ? C.x_prompt + (size_t)row * D : C.x_sample + (size_t)(row - MP) * D;
          float s = 0.f;
#pragma unroll
          for (int j = 0; j < 8; ++j) { const f32x4 v = *(const f32x4*)(src + 4 * C.lane + 256 * j); *(f32x4*)(xres + (size_t)row * D + 4 * C.lane + 256 * j) = v;
              u32x2 w; w.x = pk2(v[0], v[1]); w.y = pk2(v[2], v[3]); *(u32x2*)(xb + (size_t)row * D + 4 * C.lane + 256 * j) = w; s += (v[0] * v[0] + v[1] * v[1]) + (v[2] * v[2] + v[3] * v[3]); }
          s = wave_sum(s); if (C.lane == 0) ss0[row] = s; } }
    { f32x2* ta = C.wsp<f32x2>(WS_TABA); f32x2* tb = C.wsp<f32x2>(WS_TABB);
      for (int e = C.wg * NWG_THREADS + C.tid; e < 2052 * 16; e += C.G * NWG_THREADS) { const int pi = e >> 4, i = e & 15; const int pos = pi < 2048 ? pi : PAST + (pi - 2048); float s, c; sincos_d((double)pos * P.inv_a[i], s, c); ta[e] = (f32x2){c, s}; }
      for (int e = C.wg * NWG_THREADS + C.tid; e < 2052 * 128; e += C.G * NWG_THREADS) { const int pi = e >> 7, i = e & 127; const int pos = pi < 2048 ? pi : PAST + (pi - 2048); float s, c; sincos_d((double)pos * P.inv_b[i], s, c); tb[e] = (f32x2){c, s}; } }
}

template <int K, class EP>
__device__ __forceinline__ void skinny_gemm(const Ctx& C, const bf16* A, const bf16* Bt, int N, const EP& ep) {
    constexpr int KW = K / 8, NPASS = KW / 256, MAXCH = 5;
    const int fr = C.lane & 15, fq = C.lane >> 4, nch = N / 16;
    LAS float* part = (LAS float*)C.lds;
    for (int cb = C.wg; cb < nch; cb += C.G * MAXCH) {
        int ncur = 0;
#pragma unroll 1
        for (int j = 0; j < MAXCH; ++j) {
            const int ch = cb + j * C.G; if (ch >= nch) break;
            ++ncur;
            pg8::f32x4 acc0 = {0.f, 0.f, 0.f, 0.f}, acc1 = {0.f, 0.f, 0.f, 0.f};
#pragma unroll 1
            for (int ps = 0; ps < NPASS; ++ps) {
                const int kbase = C.wave * KW + ps * 256 + 8 * fq;
                const bf16* ap0 = A + (size_t)fr * K + kbase; const bf16* ap1 = A + (size_t)(16 + fr) * K + kbase; const bf16* bp = Bt + (size_t)(ch * 16 + fr) * K + kbase;
                bf16x8 a0[8], a1[8], bb[8];
#pragma unroll
                for (int s = 0; s < 8; ++s) { bb[s] = *(const bf16x8*)(bp + 32 * s); a0[s] = *(const bf16x8*)(ap0 + 32 * s); a1[s] = *(const bf16x8*)(ap1 + 32 * s); }
#pragma unroll
                for (int s = 0; s < 8; ++s) { acc0 = __builtin_amdgcn_mfma_f32_16x16x32_bf16(bb[s], a0[s], acc0, 0, 0, 0); acc1 = __builtin_amdgcn_mfma_f32_16x16x32_bf16(bb[s], a1[s], acc1, 0, 0, 0); }
            }
            LAS float* pj = part + ((size_t)(j * 8 + C.wave) * 2) * 4 * 64 + C.lane;
#pragma unroll
            for (int r = 0; r < 4; ++r) { pj[(0 * 4 + r) * 64] = acc0[r]; pj[(1 * 4 + r) * 64] = acc1[r]; }
        }
        __syncthreads();
        {
            const int l2 = C.tid & 63, mt = (C.tid >> 6) & 1, reg = C.tid >> 7;
            for (int j = 0; j < ncur; ++j) {
                float s = 0.f;
#pragma unroll
                for (int w = 0; w < 8; ++w) s += part[(((size_t)(j * 8 + w) * 2 + mt) * 4 + reg) * 64 + l2];
                const int ch = cb + j * C.G;
                ep(16 * mt + (l2 & 15), ch * 16 + 4 * (l2 >> 4) + reg, s);
            }
        }
        __syncthreads();
    }
}

__device__ __forceinline__ float rstd_of(const float* ss, int row) { return rsqrtf(ss[row] * (1.0f / 2048.0f) + EPS); }
__device__ __forceinline__ void sfix_a(const Ctx& C, int layer, int slot) {
    const float* zs = C.wsp<float>(WS_ZSRAW); bf16* z = C.wsp<bf16>(WS_Z); const float* ss = C.sumsq(layer); const f32x2* ta = C.wsp<f32x2>(WS_TABA);
    float* skv = C.out + (size_t)MP * D + (size_t)MS * D + (size_t)2 * 4 * (128 + 512 + 2048) * 4096 + (size_t)4 * 8 * 256 * 512 + (size_t)4 * 4 * 256 * 512;
    for (int e = C.wg * NWG_THREADS + C.tid; e < MS * A_IN; e += C.G * NWG_THREADS) {
        const int r = e / A_IN, c = e % A_IN, row = MP + r, b = r >> 2, t = r & 3; const float rs = rstd_of(ss, row);
        const int section = c >> 11, within = c & 2047, d = within & 127, kind = section < 9 ? section % 3 : 3, g = section / 3;
        float v = zs[e] * rs;
        if (kind < 2 && d < 32) { const int i = d & 15; const float pv = zs[d < 16 ? e + 16 : e - 16] * rs; const f32x2 cs = ta[(2048 + t) * 16 + i]; v = d < 16 ? v * cs.x - pv * cs.y : pv * cs.y + v * cs.x; }
        z[(size_t)row * A_IN + c] = (bf16)f2bf(v);
        if (kind == 1 || kind == 2) skv[(size_t)g * (2 * 8 * 4 * 4096) + ((((size_t)slot * DB + b) * T + t) * 2 + (kind - 1)) * 2048 + within] = v;
    }
}
__device__ __forceinline__ void sfix_b(const Ctx& C, int layer) {
    const float* zs = C.wsp<float>(WS_ZSRAW); bf16* z = C.wsp<bf16>(WS_Z); const float* ss = C.sumsq(layer); const f32x2* tb = C.wsp<f32x2>(WS_TABB);
    for (int e = C.wg * NWG_THREADS + C.tid; e < MS * B_IN; e += C.G * NWG_THREADS) {
        const int r = e / B_IN, c = e % B_IN, row = MP + r, t = r & 3; const float rs = rstd_of(ss, row);
        float v = zs[e] * rs;
        if (c < 4096) { const int d = c & 255, i = d & 127; const float pv = zs[d < 128 ? e + 128 : e - 128] * rs; const f32x2 cs = tb[(2048 + t) * 128 + i]; v = d < 128 ? v * cs.x - pv * cs.y : pv * cs.y + v * cs.x; if (c >= 2048) v *= 0.0625f; }
        z[(size_t)row * B_IN + c] = (bf16)f2bf(v);
    }
}
__device__ __forceinline__ void sfix_c(const Ctx& C, int layer) {
    const float* zs = C.wsp<float>(WS_ZSRAW); bf16* z = C.wsp<bf16>(WS_Z); const float* ss = C.sumsq(layer);
    for (int e = C.wg * NWG_THREADS + C.tid; e < MS * C_INM; e += C.G * NWG_THREADS) {
        const int r = e / C_INM, c = e % C_INM, row = MP + r; const float rs = rstd_of(ss, row);
        float v = zs[e] * rs; if (c < 1024) v *= 0.0625f;
        z[(size_t)row * C_INM + c] = (bf16)f2bf(v);
    }
    const float* lr = C.wsp<float>(WS_LR); float* loga = C.wsp<float>(WS_LOGA); const float* wg2 = C.w_gate2_c; const float* bg = C.b_gate_c;
    for (int e = MP * 1024 + C.wg * NWG_THREADS + C.tid; e < MT * 1024; e += C.G * NWG_THREADS) {
        const int row = e >> 10, c = e & 1023; const float rs = rstd_of(ss, row);
        float a = 0.f;
#pragma unroll
        for (int r = 0; r < 16; ++r) a += lr[(size_t)row * 16 + r] * wg2[r * 1024 + c];
        a = a * rs + bg[c];
        loga[e] = (fminf(a, 0.f) - log1pf(__expf(-fabsf(a)))) * 0.0625f;
    }
}

__device__ __forceinline__ void gla_pre(const Ctx& C, int layer) {
    bf16* z = C.wsp<bf16>(WS_Z); const float* ss = C.sumsq(layer); const float* lr = C.wsp<float>(WS_LR); float* dvec = C.wsp<float>(WS_DVEC); const float* wg2 = C.w_gate2_c; const float* bg = C.b_gate_c;
    LAS float* lrs = (LAS float*)C.lds; LAS float* tot = lrs + 128 * 16; LAS bf16* ebs = (LAS bf16*)(C.lds + 16384);
    for (int u = C.wg; u < 256; u += C.G) {
        const int chunk = u >> 2, cq = u & 3, cl = C.tid & 255, col = cq * 256 + cl, ih = C.tid >> 8;
        { const int row = chunk * 128 + (C.tid >> 2); const f32x4 v = *(const f32x4*)(lr + (size_t)row * 16 + (C.tid & 3) * 4); *(LAS f32x4*)(lrs + C.tid * 4) = v * rstd_of(ss, row); }
        float wv[16];
#pragma unroll
        for (int r = 0; r < 16; ++r) wv[r] = wg2[r * 1024 + col];
        const float bgc = bg[col];
        __syncthreads();
        float la[64]; float run = 0.f;
#pragma unroll
        for (int j = 0; j < 64; ++j) {
            const LAS f32x4* lp = (const LAS f32x4*)(lrs + (ih * 64 + j) * 16);
            const f32x4 l0 = lp[0], l1 = lp[1], l2 = lp[2], l3 = lp[3];
            float a = bgc + l0[0] * wv[0] + l0[1] * wv[1] + l0[2] * wv[2] + l0[3] * wv[3] + l1[0] * wv[4] + l1[1] * wv[5] + l1[2] * wv[6] + l1[3] * wv[7]
                    + l2[0] * wv[8] + l2[1] * wv[9] + l2[2] * wv[10] + l2[3] * wv[11] + l3[0] * wv[12] + l3[1] * wv[13] + l3[2] * wv[14] + l3[3] * wv[15];
            run += (fminf(a, 0.f) - __logf(1.0f + __expf(-fabsf(a)))) * 0.0625f; la[j] = run;
        }
        if (ih == 0) tot[cl] = run;
        __syncthreads();
        const float off = ih ? tot[cl] : 0.f;
#pragma unroll
        for (int j = 0; j < 64; ++j) ebs[(ih * 64 + j) * 256 + cl] = (bf16)f2bf(__expf(la[j] + off));
        if (ih) dvec[(((size_t)(chunk >> 4) * 4 + (col >> 8)) * 16 + (chunk & 15)) * 256 + (col & 255)] = __expf(la[63] + off);
        __syncthreads();
#pragma unroll
        for (int j = 0; j < 8; ++j) {
            const int pc = C.tid + 512 * j, tk = pc >> 5, cg = pc & 31;
            bf16* zq = z + (size_t)(chunk * 128 + tk) * C_INM + cq * 256 + cg * 8;
            const u32x4 qv = *(const u32x4*)zq, kv = *(const u32x4*)(zq + 1024); const u32x4 ev = *(const LAS u32x4*)(ebs + tk * 256 + cg * 8);
            u32x4 qo, ko;
#pragma unroll
            for (int k = 0; k < 4; ++k) { const float e0 = __uint_as_float(ev[k] << 16), e1 = __uint_as_float(ev[k] & 0xffff0000u); const float i0 = 1.0f / e0, i1 = 1.0f / e1;
                qo[k] = pk2(__uint_as_float(qv[k] << 16) * e0, __uint_as_float(qv[k] & 0xffff0000u) * e1); ko[k] = pk2(__uint_as_float(kv[k] << 16) * i0, __uint_as_float(kv[k] & 0xffff0000u) * i1); }
            *(u32x4*)zq = qo; *(u32x4*)(zq + 1024) = ko;
        }
        __syncthreads();
    }
}
template <int NVT>
__device__ __forceinline__ void scan_phase(const Ctx& C, int ldz, int qoff, int koff, int voff, int H, const float* dvec, float* state_out) {
    const bf16* z = C.wsp<bf16>(WS_Z); float* o = C.wsp<float>(WS_O);
    const int nunits = NB * H * (512 / (16 * NVT));
    for (int u = C.wg; u < nunits; u += C.G) scan_unit<NVT>(C.lds, z, ldz, qoff, koff, voff, H, u, dvec, o, H * 512, state_out, C.tid);
}

__device__ __forceinline__ float dot128_bb(const bf16* q, const bf16* k) {
    float a = 0.f;
#pragma unroll 4
    for (int i = 0; i < 16; ++i) { const u32x4 x = ((const u32x4*)q)[i], y = ((const u32x4*)k)[i];
#pragma unroll
        for (int j = 0; j < 4; ++j) a += __uint_as_float(x[j] << 16) * __uint_as_float(y[j] << 16) + __uint_as_float(x[j] & 0xffff0000u) * __uint_as_float(y[j] & 0xffff0000u); }
    return a;
}
__device__ __forceinline__ float dot128_bf(const bf16* q, const float* k) {
    float a = 0.f;
#pragma unroll 4
    for (int i = 0; i < 16; ++i) { const u32x4 x = ((const u32x4*)q)[i]; const f32x4 y0 = ((const f32x4*)k)[2 * i], y1 = ((const f32x4*)k)[2 * i + 1];
        a += __uint_as_float(x[0] << 16) * y0[0] + __uint_as_float(x[0] & 0xffff0000u) * y0[1] + __uint_as_float(x[1] << 16) * y0[2] + __uint_as_float(x[1] & 0xffff0000u) * y0[3]
           + __uint_as_float(x[2] << 16) * y1[0] + __uint_as_float(x[2] & 0xffff0000u) * y1[1] + __uint_as_float(x[3] << 16) * y1[2] + __uint_as_float(x[3] & 0xffff0000u) * y1[3]; }
    return a;
}
template <bool GLA>
__device__ __forceinline__ void recur_naive(const Ctx& C, int ldz, int qoff, int koff, int voff, int H, int nseq, int ntok, int row0, const float* state0, float* state_out) {
    const bf16* z = C.wsp<bf16>(WS_Z); float* o = C.wsp<float>(WS_O); const float* loga = C.wsp<float>(WS_LOGA);
    LAS float* red = (LAS float*)C.lds;
    const int d = C.tid & 255, vh = C.tid >> 8, lane = C.lane, wave = C.wave;
    for (int item = C.wg; item < nseq * H * 8; item += C.G) {
        const int vs = item & 7, h = (item >> 3) % H, seq = (item >> 3) / H;
        const int v0 = vs * 64 + vh * 32;
        float Sreg[32];
        const size_t sbase = (((size_t)seq * H + h) * 256 + d) * 512 + v0;
#pragma unroll
        for (int i = 0; i < 32; ++i) Sreg[i] = state0 ? state0[sbase + i] : 0.f;
        float gamma = 1.f; if (!GLA) gamma = 1.0f - exp2f(-5.0f - (float)h);
        for (int t = 0; t < ntok; ++t) {
            const int row = row0 + seq * ntok + t; const bf16* zr = z + (size_t)row * ldz;
            const float qd = bf2f(zr[qoff + h * 256 + d]), kd = bf2f(zr[koff + h * 256 + d]);
            float dec = gamma; if (GLA) dec = __expf(loga[(size_t)row * 1024 + h * 256 + d]);
            const unsigned* vp = (const unsigned*)(zr + voff + h * 512 + v0);
            float p[32];
#pragma unroll
            for (int i = 0; i < 16; ++i) { const unsigned w = vp[i]; const float va = __uint_as_float(w << 16), vb = __uint_as_float(w & 0xffff0000u);
                Sreg[2 * i] = dec * Sreg[2 * i] + kd * va; Sreg[2 * i + 1] = dec * Sreg[2 * i + 1] + kd * vb; p[2 * i] = qd * Sreg[2 * i]; p[2 * i + 1] = qd * Sreg[2 * i + 1]; }
#pragma unroll
            for (int i = 0; i < 32; ++i) p[i] = wave_sum(p[i]);
            float mine = 0.f;
#pragma unroll
            for (int i = 0; i < 32; ++i) if (lane == i) mine = p[i];
            if (lane < 32) red[((t & 1) * 8 + wave) * 32 + lane] = mine;
            __syncthreads();
            if (d < 32) { const LAS float* rr = red + ((t & 1) * 8 + vh * 4) * 32 + d; o[(size_t)row * (H * 512) + h * 512 + v0 + d] = rr[0] + rr[32] + rr[64] + rr[96]; }
        }
#pragma unroll
        for (int i = 0; i < 32; ++i) state_out[sbase + i] = Sreg[i];
        __syncthreads();
    }
}
template <bool MEAN>
__device__ __forceinline__ void norm_gate(const Ctx& C, int H, int ldz, int goff, const float* gn) {
    const bf16* z = C.wsp<bf16>(WS_Z); const float* o = C.wsp<float>(WS_O); bf16* y = C.wsp<bf16>(WS_Y); const int lane = C.lane;
    for (int w0 = (C.wg * 8 + C.wave) * 4; w0 < MT * H; w0 += C.G * 8 * 4) {
        f32x4 a[4], bq[4]; u32x4 gw[4]; f32x4 g0[4], g1[4];
#pragma unroll
        for (int k = 0; k < 4; ++k) { const int w = w0 + k, row = w / H, h = w % H; const float* orow = o + (size_t)row * (H * 512) + h * 512;
            a[k] = ((const f32x4*)orow)[2 * lane]; bq[k] = ((const f32x4*)orow)[2 * lane + 1]; gw[k] = ((const u32x4*)(z + (size_t)row * ldz + goff + h * 512))[lane];
            g0[k] = ((const f32x4*)(gn + h * 512))[2 * lane]; g1[k] = ((const f32x4*)(gn + h * 512))[2 * lane + 1]; }
#pragma unroll
        for (int k = 0; k < 4; ++k) {
            const int w = w0 + k, row = w / H, h = w % H;
            float v[8] = {a[k][0], a[k][1], a[k][2], a[k][3], bq[k][0], bq[k][1], bq[k][2], bq[k][3]};
            float s = 0.f;
#pragma unroll
            for (int i = 0; i < 8; ++i) s += v[i];
            float mu = 0.f; if (MEAN) mu = wave_sum(s) * (1.f / 512.f);
            float q = 0.f;
#pragma unroll
            for (int i = 0; i < 8; ++i) { v[i] -= mu; q += v[i] * v[i]; }
            const float r = rsqrtf(wave_sum(q) * (1.f / 512.f) + EPS);
            const float gg[8] = {g0[k][0], g0[k][1], g0[k][2], g0[k][3], g1[k][0], g1[k][1], g1[k][2], g1[k][3]};
            float ov[8];
#pragma unroll
            for (int i = 0; i < 4; ++i) { ov[2 * i] = v[2 * i] * r * gg[2 * i] * silu(__uint_as_float(gw[k][i] << 16)); ov[2 * i + 1] = v[2 * i + 1] * r * gg[2 * i + 1] * silu(__uint_as_float(gw[k][i] & 0xffff0000u)); }
            u32x4 ow; ow.x = pk2(ov[0], ov[1]); ow.y = pk2(ov[2], ov[3]); ow.z = pk2(ov[4], ov[5]); ow.w = pk2(ov[6], ov[7]);
            ((u32x4*)(y + (size_t)row * (H * 512) + h * 512))[lane] = ow;
        }
    }
}
__device__ __forceinline__ void final_norm(const Ctx& C) {
    const float* xres = C.wsp<float>(WS_XRES); const float* ss = C.sumsq(4); const float* fg = C.final_g;
    for (int row = C.wg * 8 + C.wave; row < MT; row += C.G * 8) {
        const float rs = rstd_of(ss, row);
#pragma unroll
        for (int j = 0; j < 8; ++j) { const int c = 4 * C.lane + 256 * j; const f32x4 v = *(const f32x4*)(xres + (size_t)row * D + c), g = *(const f32x4*)(fg + c); *(f32x4*)(C.out + (size_t)row * D + c) = v * rs * g; }
    }
}

__device__ __forceinline__ void attn_fast_phase(const Ctx& C) {
    const bf16* z = C.wsp<bf16>(WS_Z); bf16* og = C.wsp<bf16>(WS_O); float* lse = C.wsp<float>(WS_LOGA);
    const int per = (3072 + C.G - 1) / C.G;
    for (int j = 0; j < per; ++j) { const int item = C.wg * per + j; if (item < 3072) attn_item(C.lds, z, A_IN, og, lse, item, C.tid); }
}
__device__ __forceinline__ void sattn_phase(const Ctx& C, int slot, const float* c1, const float* c2, const float* c3) {
    const bf16* z = C.wsp<bf16>(WS_Z); bf16* og = C.wsp<bf16>(WS_O); float* lse = C.wsp<float>(WS_LOGA);
    for (int u0 = C.wg * 6; u0 < 1536; u0 += C.G * 6) {
        const int u = u0 + C.wave;
        if (C.wave < 6 && u < 1536) {
            const int t = u & 3, h = (u >> 2) & 15, b = (u >> 6) & 7, g = u >> 9;
            const float* cache = c1; if (g == 1) cache = c2; if (g == 2) cache = c3;
            sattn_unit(C.lds + C.wave * 1024, z, A_IN, cache + (size_t)slot * 8 * (128 << (2 * g)) * 4096, g, b, t, h, og, lse, C.lane);
        }
    }
}
__device__ __forceinline__ void attn_merge(const Ctx& C) {
    const bf16* z = C.wsp<bf16>(WS_Z); const bf16* og = C.wsp<bf16>(WS_O); const float* lse = C.wsp<float>(WS_LOGA); bf16* y = C.wsp<bf16>(WS_Y);
    for (int row = C.wg * 8 + C.wave; row < MT; row += C.G * 8) {
#pragma unroll
        for (int j = 0; j < 4; ++j) {
            const int ch = C.lane + 64 * j, col = ch * 8, h = col >> 7;
            const float l0 = lse[((size_t)0 * MT + row) * 16 + h], l1 = lse[((size_t)1 * MT + row) * 16 + h], l2 = lse[((size_t)2 * MT + row) * 16 + h];
            const float m = fmaxf(l0, fmaxf(l1, l2)); float w0 = __expf(l0 - m), w1 = __expf(l1 - m), w2 = __expf(l2 - m); const float inv = 1.0f / (w0 + w1 + w2); w0 *= inv; w1 *= inv; w2 *= inv;
            const u32x4 a = *(const u32x4*)(og + ((size_t)0 * MT + row) * 2048 + col), b = *(const u32x4*)(og + ((size_t)1 * MT + row) * 2048 + col), c = *(const u32x4*)(og + ((size_t)2 * MT + row) * 2048 + col);
            const u32x4 gt = *(const u32x4*)(z + (size_t)row * A_IN + 18432 + col);
            u32x4 o;
#pragma unroll
            for (int k = 0; k < 4; ++k) {
                const float lo = (w0 * __uint_as_float(a[k] << 16) + w1 * __uint_as_float(b[k] << 16) + w2 * __uint_as_float(c[k] << 16)) * silu(__uint_as_float(gt[k] << 16));
                const float hi = (w0 * __uint_as_float(a[k] & 0xffff0000u) + w1 * __uint_as_float(b[k] & 0xffff0000u) + w2 * __uint_as_float(c[k] & 0xffff0000u)) * silu(__uint_as_float(gt[k] & 0xffff0000u));
                o[k] = pk2(lo, hi);
            }
            *(u32x4*)(y + (size_t)row * 2048 + col) = o;
        }
    }
}

template <int MODE>
__device__ __forceinline__ void gemm_in(const Ctx& C, size_t wt_off, int N, int layer, float* kvb, int slot) {
    pg8::Gemm g{C.wsp<pg8::bf16_t>(WS_XB), C.wsp<pg8::bf16_t>(wt_off), MP, N, D}; pg8::StaticOrder So; So.init(MP, N, C.G, C.wg);
    pg8::EpiIn<MODE> E{C.wsp<pg8::bf16_t>(WS_Z), N, C.sumsq(layer), (const pg8::f32x2*)C.wsp<f32x2>(MODE == 0 ? WS_TABA : WS_TABB), kvb, slot};
    pg8::gemm_phase<pg8::EpiIn<MODE>, pg8::StaticOrder, true, true>((PG8_LAS unsigned char*)C.lds, g, So, E);
}
template <int K>
__device__ __forceinline__ void gemm_out(const Ctx& C, size_t wt_off, int layer) {
    pg8::Gemm g{C.wsp<pg8::bf16_t>(WS_Y), C.wsp<pg8::bf16_t>(wt_off), MP, D, K}; pg8::StaticOrder So; So.init(MP, D, C.G, C.wg);
    pg8::EpiOut E{C.wsp<float>(WS_XRES), C.wsp<pg8::bf16_t>(WS_XB), C.sumsq(layer + 1)};
    pg8::gemm_phase<pg8::EpiOut, pg8::StaticOrder, true, true>((PG8_LAS unsigned char*)C.lds, g, So, E);
    float* xres = C.wsp<float>(WS_XRES); bf16* xb = C.wsp<bf16>(WS_XB); float* ssn = C.sumsq(layer + 1); const int lane = C.lane;
    skinny_gemm<K>(C, C.wsp<bf16>(WS_Y) + (size_t)MP * K, C.wsp<bf16>(wt_off), D, [=](int m, int n, float v) {
        const size_t o = (size_t)(MP + m) * D + n; const float x = xres[o] + v; xres[o] = x; xb[o] = (bf16)f2bf(x);
        float s = x * x; s += __shfl_xor(s, 16); s += __shfl_xor(s, 32); if ((lane >> 4) == 0) atomicAdd(ssn + MP + m, s); });
}
__device__ __forceinline__ void skinny_in(const Ctx& C, size_t wt_off, int N) {
    float* zs = C.wsp<float>(WS_ZSRAW);
    skinny_gemm<D>(C, C.wsp<bf16>(WS_XB) + (size_t)MP * D, C.wsp<bf16>(wt_off), N, [=](int m, int n, float v) { zs[(size_t)m * N + n] = v; });
}

__global__ void __launch_bounds__(NWG_THREADS, 2) mk_fwd(Params P) {
    extern __shared__ __attribute__((aligned(16))) unsigned char lds_raw[];
    Ctx C; C.lds = (LAS unsigned char*)lds_raw; C.tid = threadIdx.x; C.lane = C.tid & 63; C.wave = __builtin_amdgcn_readfirstlane(C.tid >> 6); C.G = gridDim.x; C.wg = blockIdx.x;
    C.x_prompt = P.in[0];
    C.x_sample = P.in[1];
    C.cache1 = P.in[2];
    C.cache2 = P.in[3];
    C.cache3 = P.in[4];
    C.state_b = P.in[5];
    C.state_c = P.in[6];
    C.norm_g = P.in[7];
    C.final_g = P.in[8];
    C.w_in_a = P.in[9];
    C.w_out_a = P.in[10];
    C.w_in_b = P.in[11];
    C.gn_b = P.in[12];
    C.w_out_b = P.in[13];
    C.w_in_c = P.in[14];
    C.w_gate2_c = P.in[15];
    C.b_gate_c = P.in[16];
    C.gn_c = P.in[17];
    C.w_out_c = P.in[18];
    C.out = P.out; C.ws = P.ws;
    volatile LAS unsigned* MISC = (volatile LAS unsigned*)(C.lds + MISC_OFF);
    if (C.tid < 32) MISC[C.tid] = 0u;
    __syncthreads();
    XcdBarrier bar = xcd_barrier_post((unsigned*)(P.ws + CTL_BAR), MISC + 8);
    int ph = 0;
#define RUN (ph >= P.ph_lo && ph < P.ph_hi)
#define SEAM() do { if (ph >= P.ph_lo && ph + 1 < P.ph_hi) xcd_barrier(bar); ++ph; } while (0)
    float* out = P.out;
    float* pkv1 = out + (size_t)MP * D + (size_t)MS * D; float* pkv2 = pkv1 + (size_t)2 * 4 * 128 * 4096; float* pkv3 = pkv2 + (size_t)2 * 4 * 512 * 4096;
    float* pst_b = pkv3 + (size_t)2 * 4 * 2048 * 4096; float* pst_c = pst_b + (size_t)4 * 8 * 256 * 512;
    float* sst_b = pst_c + (size_t)4 * 4 * 256 * 512 + (size_t)3 * 2 * 8 * 4 * 4096; float* sst_c = sst_b + (size_t)8 * 8 * 256 * 512;

    if (RUN) p0_prologue(C, P);
    SEAM();
    if (RUN) { gemm_in<0>(C, WS_WIA0, A_IN, 0, pkv1, 0); skinny_in(C, WS_WIA0, A_IN); }
    SEAM();
    if (RUN) sfix_a(C, 0, 0);
    SEAM();
    if (RUN) { attn_fast_phase(C); sattn_phase(C, 0, P.in[2], P.in[3], P.in[4]); }
    SEAM();
    if (RUN) attn_merge(C);
    SEAM();
    if (RUN) gemm_out<2048>(C, WS_WOA0, 0);
    SEAM();
    if (RUN) { gemm_in<1>(C, WS_WIB, B_IN, 1, nullptr, 0); skinny_in(C, WS_WIB, B_IN); }
    SEAM();
    if (RUN) sfix_b(C, 1);
    SEAM();
    if (RUN) { scan_phase<4>(C, B_IN, 0, 2048, 4096, 8, nullptr, pst_b); recur_naive<false>(C, B_IN, 0, 2048, 4096, 8, DB, T, MP, C.state_b, sst_b); }
    SEAM();
    if (RUN) norm_gate<true>(C, 8, B_IN, 8192, C.gn_b);
    SEAM();
    if (RUN) gemm_out<4096>(C, WS_WOB, 1);
    SEAM();
    if (RUN) { gemm_in<2>(C, WS_WIC, C_INM, 2, nullptr, 0); skinny_in(C, WS_WIC, C_INM);
        float* lr = C.wsp<float>(WS_LR);
        skinny_gemm<D>(C, C.wsp<bf16>(WS_WLR), C.wsp<bf16>(WS_XB), MT, [=](int m, int n, float v) { if (m < 16) lr[(size_t)n * 16 + m] = v; }); }
    SEAM();
    if (RUN) { sfix_c(C, 2); gla_pre(C, 2); }
    SEAM();
    if (RUN) { scan_phase<2>(C, C_INM, 0, 1024, 2048, 4, C.wsp<float>(WS_DVEC), pst_c); recur_naive<true>(C, C_INM, 0, 1024, 2048, 4, DB, T, MP, C.state_c, sst_c); }
    SEAM();
    if (RUN) norm_gate<false>(C, 4, C_INM, 4096, C.gn_c);
    SEAM();
    if (RUN) gemm_out<2048>(C, WS_WOC, 2);
    SEAM();
    if (RUN) { gemm_in<0>(C, WS_WIA1, A_IN, 3, pkv1, 1); skinny_in(C, WS_WIA1, A_IN); }
    SEAM();
    if (RUN) sfix_a(C, 3, 1);
    SEAM();
    if (RUN) { attn_fast_phase(C); sattn_phase(C, 1, P.in[2], P.in[3], P.in[4]); }
    SEAM();
    if (RUN) attn_merge(C);
    SEAM();
    if (RUN) gemm_out<2048>(C, WS_WOA1, 3);
    SEAM();
    if (RUN) final_norm(C);
#undef RUN
#undef SEAM
}
constexpr int NPHASES = 22;
}

#ifndef MK_PRE
#define MK_PRE -1
#endif
#ifndef MK_LAUNCHES
#define MK_LAUNCHES 1
#endif
extern "C" void kernel_launch(void* const* d_in, const int* in_sizes, int n_in, void* d_out, int out_size, void* d_ws, size_t ws_size, hipStream_t stream) {
    using namespace mk;
    static int grid = 0;
    if (grid == 0) {
        int dev = 0, cus = 0;
        if (hipGetDevice(&dev) != hipSuccess || hipDeviceGetAttribute(&cus, hipDeviceAttributeMultiprocessorCount, dev) != hipSuccess) { fprintf(stderr, "kernel_launch: device query failed\n"); grid = -1; return; }
        if (hipFuncSetAttribute((const void*)mk_fwd, hipFuncAttributeMaxDynamicSharedMemorySize, LDS_BYTES) != hipSuccess) { fprintf(stderr, "kernel_launch: hipFuncSetAttribute failed\n"); grid = -1; return; }
        int per_cu = 0;
        if (hipOccupancyMaxActiveBlocksPerMultiprocessor(&per_cu, (const void*)mk_fwd, NWG_THREADS, LDS_BYTES) != hipSuccess || per_cu < 1) fprintf(stderr, "kernel_launch: occupancy query says %d\n", per_cu);
        (void)hipGetLastError();
        if (ws_size < WS_END) { fprintf(stderr, "kernel_launch: workspace too small (%zu < %zu)\n", ws_size, (size_t)WS_END); grid = -1; return; }
        grid = cus;
    }
    if (grid < 0) return;
    (void)hipMemsetAsync((char*)d_ws + WS_CTL, 0, CTL_ZERO_BYTES, stream);
    Params p{};
    for (int i = 0; i < 19; ++i) p.in[i] = (const float*)d_in[i];
    p.out = (float*)d_out; p.ws = (unsigned char*)d_ws;
    for (int i = 0; i < 16; ++i) p.inv_a[i] = pow(500000.0, -(double)i / 16.0);
    for (int i = 0; i < 128; ++i) p.inv_b[i] = pow(10000.0, -(double)i / 128.0);
    if (MK_PRE >= 0) { p.ph_lo = MK_PRE; p.ph_hi = MK_PRE + 1; hipLaunchKernelGGL(mk_fwd, dim3(grid), dim3(NWG_THREADS), LDS_BYTES, stream, p); (void)hipMemsetAsync((char*)d_ws + WS_CTL, 0, CTL_ZERO_BYTES, stream); }
    if (MK_LAUNCHES == 1) { p.ph_lo = 0; p.ph_hi = NPHASES; hipLaunchKernelGGL(mk_fwd, dim3(grid), dim3(NWG_THREADS), LDS_BYTES, stream, p); }
    else for (int k = 0; k < NPHASES; ++k) { p.ph_lo = k; p.ph_hi = k + 1; hipLaunchKernelGGL(mk_fwd, dim3(grid), dim3(NWG_THREADS), LDS_BYTES, stream, p); }
}
```

```cpp
#include <hip/hip_runtime.h>
#include <cstdio>
#include <cstdint>
#include <cmath>
namespace pg8 {
#define PG8_LAS __attribute__((address_space(3)))
typedef unsigned short bf16_t;
typedef short bf16x8 __attribute__((ext_vector_type(8)));
typedef float f32x4 __attribute__((ext_vector_type(4)));
typedef unsigned u32x4 __attribute__((ext_vector_type(4)));
constexpr int BM = 256, BK = 64, HALF = 128, HTB = HALF * BK * 2  , STAGE_BYTES = 8 * HTB, NXCD = 8, WGM = 8;

__host__ __device__ __forceinline__ int lds_byte(int r, int c) { const int st = (r >> 4) * 2 + (c >> 5), rr = r & 15, cc = c & 31, ob = rr * 64 + cc * 2; return st * 1024 + (ob ^ (((ob >> 9) & 1) << 5)); }
__host__ __device__ __forceinline__ void stage_rc(int b, int& R, int& C) { const int st = b / 1024, sb = b % 1024, swz = sb ^ (((sb >> 9) & 1) << 5); R = (st >> 1) * 16 + swz / 64; C = (st & 1) * 32 + (swz % 64) / 2; }
__host__ __device__ __forceinline__ int perm32(int rho) { const int n = rho >> 4, i = rho & 15; return 8 * (i >> 2) + 4 * n + (i & 3); }

struct Unit { int pm, pn; };
struct Gemm { const bf16_t* A; const bf16_t* Bt; int M, N, K; };

struct StaticOrder {
    int nM, nN, nwg, G, c;
    __host__ __device__ void init(int M, int N, int G_, int c_) { nM = M / BM; nN = N / BM; nwg = nM * nN; G = G_; c = c_; }
    __host__ __device__ bool next(int i, Unit& u) const {
        const long L = (long)i * G + c; if (L >= nwg) return false;
        int wgid = (int)L; { const int q = nwg / NXCD, r = nwg % NXCD, xcd = wgid % NXCD, off = wgid / NXCD; wgid = (xcd < r ? xcd * (q + 1) : r * (q + 1) + (xcd - r) * q) + off; }
        const int nig = WGM * nN, gid = wgid / nig, fm = gid * WGM, gsz = (nM - fm) < WGM ? (nM - fm) : WGM;
        u.pm = fm + ((wgid % nig) % gsz); u.pn = (wgid % nig) / gsz; return true;
    }
    __device__ __forceinline__ void a_ready(const Unit&) const {}
    __device__ __forceinline__ void done(const Unit&) const {}
};

__device__ __forceinline__ unsigned cvt_pk_bf16(float lo, float hi) { unsigned r; asm volatile("v_cvt_pk_bf16_f32 %0, %1, %2" : "=v"(r) : "v"(lo), "v"(hi)); return r; }
typedef float f32x2 __attribute__((ext_vector_type(2)));
typedef unsigned u32x2 __attribute__((ext_vector_type(2)));

template <int MODE> struct EpiIn {
    static constexpr bool PERM = true, AFTER_DRAIN = false;
    bf16_t* Z; int ldz; const float* sumsq; const f32x2* tab; float* kvb; int slot;
    __device__ __forceinline__ void store8(bf16_t* p, const f32x4& a, const f32x4& b) const {
        u32x4 w; w.x = cvt_pk_bf16(a[0], a[1]); w.y = cvt_pk_bf16(a[2], a[3]); w.z = cvt_pk_bf16(b[0], b[1]); w.w = cvt_pk_bf16(b[2], b[3]); *(u32x4*)p = w; }
    __device__ __forceinline__ void operator()(const f32x4 (&acc)[2][2][4][2], const Unit& u, int wr, int wc, int fr, int fq) const {
        const int row0 = u.pm * BM + wr * 64 + fr, colt = u.pn * BM;
        if constexpr (MODE == 0) {
            const int section = u.pn >> 3, kind = section < 9 ? section % 3 : 3, g = section / 3;
            const bool rot = (kind < 2) && (wc == 0);
            const int gg = g > 2 ? 2 : g, keep = 128 << (2 * gg); float* kvo = kvb + (size_t)32768 * (size_t)(128 * (((1 << (2 * gg)) - 1) / 3)) + (size_t)slot * 4 * keep * 4096;
#pragma unroll
            for (int ai = 0; ai < 2; ++ai)
#pragma unroll
                for (int m = 0; m < 4; ++m) {
                    const int row = row0 + ai * HALF + m * 16; const float rs = rsqrtf(sumsq[row] * (1.0f / 2048.0f) + 1e-6f); const int pos = row & 2047, b = row >> 11;
#pragma unroll
                    for (int bj = 0; bj < 2; ++bj) {
                        f32x4 v0 = acc[ai][bj][m][0] * rs, v1 = acc[ai][bj][m][1] * rs;
                        const int col = colt + bj * HALF + wc * 32 + 8 * fq;
                        if (rot) {
                            f32x4 p0, p1;
#pragma unroll
                            for (int j = 0; j < 4; ++j) { p0[j] = __shfl_xor(v0[j], 32); p1[j] = __shfl_xor(v1[j], 32); }
                            const f32x4* tp = (const f32x4*)(tab + pos * 16 + 8 * (fq & 1));
                            const f32x4 t0 = tp[0], t1 = tp[1], t2 = tp[2], t3 = tp[3];
                            const f32x4 c0 = {t0[0], t0[2], t1[0], t1[2]}, s0 = {t0[1], t0[3], t1[1], t1[3]}, c1 = {t2[0], t2[2], t3[0], t3[2]}, s1 = {t2[1], t2[3], t3[1], t3[3]};
                            if (fq < 2) { v0 = v0 * c0 - p0 * s0; v1 = v1 * c1 - p1 * s1; } else { v0 = p0 * s0 + v0 * c0; v1 = p1 * s1 + v1 * c1; }
                        }
                        store8(Z + (size_t)row * ldz + col, v0, v1);
                        if (kind == 1 || kind == 2) {
                            if (pos >= 2048 - keep) { float* o = kvo + (((size_t)b * keep + (pos - (2048 - keep))) * 2 + (kind - 1)) * 2048 + (col - section * 2048);
                                *(f32x4*)o = v0; *(f32x4*)(o + 4) = v1; }
                        }
                    }
                }
        } else if constexpr (MODE == 1) {
            const bool rot = u.pn < 16; const float sc = (u.pn >= 8 && u.pn < 16) ? 0.0625f : 1.0f;
            const float lg2 = log2f(1.0f - exp2f(-5.0f - (float)(u.pn & 7)));
#pragma unroll
            for (int ai = 0; ai < 2; ++ai)
#pragma unroll
                for (int m = 0; m < 4; ++m) {
                    const int row = row0 + ai * HALF + m * 16; const int pos = row & 2047;
                    float rs = rsqrtf(sumsq[row] * (1.0f / 2048.0f) + 1e-6f) * sc;
                    if (rot) { const float ee = (float)((pos & 127) + 1) * lg2; rs *= exp2f(u.pn < 8 ? ee : -ee); }
                    f32x4 x1[2], x2[2];
#pragma unroll
                    for (int n = 0; n < 2; ++n) { x1[n] = acc[ai][0][m][n] * rs; x2[n] = acc[ai][1][m][n] * rs; }
                    if (rot) {
#pragma unroll
                        for (int n = 0; n < 2; ++n) {
                            const f32x4* tp = (const f32x4*)(tab + pos * 128 + wc * 32 + 8 * fq + 4 * n);
                            const f32x4 t0 = tp[0], t1 = tp[1];
                            const f32x4 c = {t0[0], t0[2], t1[0], t1[2]}, s = {t0[1], t0[3], t1[1], t1[3]};
                            const f32x4 a = x1[n], bb = x2[n];
                            x1[n] = a * c - bb * s; x2[n] = a * s + bb * c;
                        }
                    }
                    bf16_t* zp = Z + (size_t)row * ldz + colt + wc * 32 + 8 * fq;
                    store8(zp, x1[0], x1[1]); store8(zp + HALF, x2[0], x2[1]);
                }
        } else {
            const float sc = u.pn < 4 ? 0.0625f : 1.0f;
#pragma unroll
            for (int ai = 0; ai < 2; ++ai)
#pragma unroll
                for (int m = 0; m < 4; ++m) {
                    const int row = row0 + ai * HALF + m * 16; const float rs = rsqrtf(sumsq[row] * (1.0f / 2048.0f) + 1e-6f) * sc;
                    bf16_t* zp = Z + (size_t)row * ldz + colt + wc * 32 + 8 * fq;
#pragma unroll
                    for (int bj = 0; bj < 2; ++bj) store8(zp + bj * HALF, acc[ai][bj][m][0] * rs, acc[ai][bj][m][1] * rs);
                }
        }
    }
};
struct EpiOut {
    static constexpr bool PERM = false, AFTER_DRAIN = false;
    float* xres; bf16_t* xb; float* sumsq_next;
    __device__ __forceinline__ void operator()(const f32x4 (&acc)[2][2][4][2], const Unit& u, int wr, int wc, int fr, int fq) const {
        const int row0 = u.pm * BM + wr * 64 + fr, col0 = u.pn * BM + wc * 32 + 4 * fq;
#pragma unroll
        for (int ai = 0; ai < 2; ++ai)
#pragma unroll
            for (int m = 0; m < 4; ++m) {
                const int row = row0 + ai * HALF + m * 16; float ss = 0.f;
                float* xr = xres + (size_t)row * 2048 + col0; bf16_t* br = xb + (size_t)row * 2048 + col0;
#pragma unroll
                for (int bj = 0; bj < 2; ++bj)
#pragma unroll
                    for (int n = 0; n < 2; ++n) {
                        const f32x4 v = *(const f32x4*)(xr + bj * HALF + n * 16) + acc[ai][bj][m][n];
                        *(f32x4*)(xr + bj * HALF + n * 16) = v;
                        u32x2 w; w.x = cvt_pk_bf16(v[0], v[1]); w.y = cvt_pk_bf16(v[2], v[3]); *(u32x2*)(br + bj * HALF + n * 16) = w;
                        ss += (v[0] * v[0] + v[1] * v[1]) + (v[2] * v[2] + v[3] * v[3]);
                    }
                ss += __shfl_xor(ss, 16); ss += __shfl_xor(ss, 32);
                if (fq == 0) atomicAdd(sumsq_next + row, ss);
            }
    }
};
template <class Epi, class Sched, bool ALIGN_EPI = false, bool SP2 = false>
__device__ __forceinline__ void gemm_phase(PG8_LAS unsigned char* lds, const Gemm g, const Sched& S, const Epi& E) {
    const int tid = threadIdx.x, wid = __builtin_amdgcn_readfirstlane(tid >> 6), lane = tid & 63, wr = wid >> 2, wc = wid & 3, fr = lane & 15, fq = lane >> 4;
    const int K = g.K, nt = K / BK;
    unsigned voffA[2], voffB[2];
#pragma unroll
    for (int i = 0; i < 2; ++i) { int R, C; stage_rc(tid * 16 + i * 8192, R, C); const int Rb = Epi::PERM ? ((R & ~31) + perm32(R & 31)) : R;
        voffA[i] = (unsigned)(R * K + C) * 2u; voffB[i] = (unsigned)(Rb * K + C) * 2u; }
    const size_t kstep = (size_t)(BK * 2);
    const size_t hstep = (size_t)HALF * K * 2;
    const size_t tstep = 2 * hstep;
    const unsigned ldsw = (unsigned)wid * 1024u;
    const int aoff = lds_byte(wr * 64 + fr, fq * 8), boff = lds_byte(wc * 32 + fr, fq * 8);
#define PG8_SA(b, h) (((b) * 2 + (h)) * HTB)
#define PG8_SB(b, h) ((4 + (b) * 2 + (h)) * HTB)
#define PG8_STAGE(bufoff, gbase, voff) do { _Pragma("unroll") for (int _i = 0; _i < 2; ++_i) \
        __builtin_amdgcn_global_load_lds((const unsigned*)((const char*)(gbase) + (voff)[_i]), (PG8_LAS unsigned*)(lds + (bufoff) + ldsw + _i * 8192), 16, 0, 0); } while (0)
#define PG8_LDA(dst, b, h) do { _Pragma("unroll") for (int m = 0; m < 4; ++m) _Pragma("unroll") for (int k = 0; k < 2; ++k) dst[m][k] = *(const PG8_LAS bf16x8*)(lds + PG8_SA(b, h) + aoff + m * 2048 + k * 1024); } while (0)
#define PG8_LDB(dst, b, h) do { _Pragma("unroll") for (int n = 0; n < 2; ++n) _Pragma("unroll") for (int k = 0; k < 2; ++k) dst[n][k] = *(const PG8_LAS bf16x8*)(lds + PG8_SB(b, h) + boff + n * 2048 + k * 1024); } while (0)
#define PG8_MMA(ai, bj, At, Bt) do { __builtin_amdgcn_s_setprio(1); _Pragma("unroll") for (int m = 0; m < 4; ++m) _Pragma("unroll") for (int n = 0; n < 2; ++n) _Pragma("unroll") for (int k = 0; k < 2; ++k) \
        acc[ai][bj][m][n] = __builtin_amdgcn_mfma_f32_16x16x32_bf16(Bt[n][k], At[m][k], acc[ai][bj][m][n], 0, 0, 0); __builtin_amdgcn_s_setprio(0); } while (0)
#define PG8_WAIT_V(n) asm volatile("s_waitcnt vmcnt(" #n ")" ::: "memory")
#define PG8_WAIT_L(n) asm volatile("s_waitcnt lgkmcnt(" #n ")" ::: "memory")
#define PG8_BAR __builtin_amdgcn_s_barrier()
#define PG8_SCHED __builtin_amdgcn_sched_barrier(0)
    Unit cur, nxt; int ui = 0;
    if (!S.next(0, cur)) return;
    f32x4 acc[2][2][4][2];
#pragma unroll
    for (int a = 0; a < 2; ++a)
#pragma unroll
        for (int b = 0; b < 2; ++b)
#pragma unroll
            for (int m = 0; m < 4; ++m)
#pragma unroll
                for (int n = 0; n < 2; ++n) acc[a][b][m][n] = (f32x4){0.f, 0.f, 0.f, 0.f};
    bf16x8 At[4][2], B0[2][2], B1[2][2];
    const char* cA = (const char*)g.A + (size_t)cur.pm * tstep; const char* cB = (const char*)g.Bt + (size_t)cur.pn * tstep;
    S.a_ready(cur);
    if constexpr (SP2) {
        PG8_STAGE(PG8_SB(0, 0), cB, voffB); PG8_STAGE(PG8_SB(0, 1), cB + hstep, voffB); PG8_STAGE(PG8_SA(0, 0), cA, voffA); PG8_STAGE(PG8_SA(0, 1), cA + hstep, voffA);
        if (wr == 1) PG8_BAR;
        PG8_WAIT_V(2); PG8_BAR;
        PG8_STAGE(PG8_SB(1, 0), cB + kstep, voffB); PG8_STAGE(PG8_SA(1, 0), cA + kstep, voffA); PG8_STAGE(PG8_SB(1, 1), cB + hstep + kstep, voffB);
        PG8_WAIT_V(6); PG8_BAR;
    } else {
        PG8_STAGE(PG8_SB(0, 0), cB, voffB); PG8_STAGE(PG8_SA(0, 0), cA, voffA); PG8_STAGE(PG8_SB(0, 1), cB + hstep, voffB); PG8_STAGE(PG8_SA(0, 1), cA + hstep, voffA);
        if (wr == 1) PG8_BAR;
        PG8_WAIT_V(4); PG8_BAR;
        PG8_STAGE(PG8_SB(1, 0), cB + kstep, voffB); PG8_STAGE(PG8_SA(1, 0), cA + kstep, voffA); PG8_STAGE(PG8_SB(1, 1), cB + hstep + kstep, voffB);
        PG8_WAIT_V(6); PG8_BAR;
    }
    for (;;) {
        const bool has_next = S.next(ui + 1, nxt);
        const char* nA = has_next ? (const char*)g.A + (size_t)nxt.pm * tstep : cA; const char* nB = has_next ? (const char*)g.Bt + (size_t)nxt.pn * tstep : cB;
        for (int t = 0; t < nt; t += 2) {
            const bool last = (t == nt - 2);
            const char* a1 = cA + (size_t)(t + 1) * kstep;
            const char* a2 = last ? nA : cA + (size_t)(t + 2) * kstep; const char* b2 = last ? nB : cB + (size_t)(t + 2) * kstep;
            const char* a3 = a2 + kstep; const char* b3 = b2 + kstep;
            if (last && has_next) S.a_ready(nxt);
            if constexpr (SP2) {
            PG8_LDB(B0, 0, 0); PG8_LDB(B1, 0, 1); PG8_SCHED; PG8_LDA(At, 0, 0); PG8_STAGE(PG8_SA(1, 1), a1 + hstep, voffA);
            PG8_WAIT_V(8); PG8_WAIT_L(0); PG8_BAR; PG8_MMA(0, 0, At, B0); PG8_MMA(0, 1, At, B1); PG8_BAR; PG8_SCHED;
            PG8_LDA(At, 0, 1); PG8_STAGE(PG8_SB(0, 0), b2, voffB); PG8_STAGE(PG8_SB(0, 1), b2 + hstep, voffB); PG8_STAGE(PG8_SA(0, 0), a2, voffA);
            PG8_WAIT_V(8); PG8_WAIT_L(0); PG8_BAR; PG8_MMA(1, 0, At, B0); PG8_MMA(1, 1, At, B1); PG8_BAR; PG8_SCHED;
            PG8_LDB(B0, 1, 0); PG8_LDB(B1, 1, 1); PG8_SCHED; PG8_LDA(At, 1, 0); PG8_STAGE(PG8_SA(0, 1), a2 + hstep, voffA);
            PG8_WAIT_V(8); PG8_WAIT_L(0); PG8_BAR; PG8_MMA(0, 0, At, B0); PG8_MMA(0, 1, At, B1); PG8_BAR; PG8_SCHED;
            PG8_LDA(At, 1, 1); PG8_STAGE(PG8_SB(1, 0), b3, voffB); PG8_STAGE(PG8_SB(1, 1), b3 + hstep, voffB); PG8_STAGE(PG8_SA(1, 0), a3, voffA);
            PG8_WAIT_V(8); PG8_WAIT_L(0); PG8_BAR; PG8_MMA(1, 0, At, B0); PG8_MMA(1, 1, At, B1); PG8_BAR; PG8_SCHED;
            } else {
            PG8_LDB(B0, 0, 0); PG8_SCHED; PG8_LDA(At, 0, 0); PG8_STAGE(PG8_SA(1, 1), a1 + hstep, voffA);
            PG8_WAIT_L(8); PG8_BAR; PG8_WAIT_L(0); PG8_MMA(0, 0, At, B0); PG8_BAR; PG8_SCHED;
            PG8_LDB(B1, 0, 1); PG8_STAGE(PG8_SB(0, 0), b2, voffB);
            PG8_BAR; PG8_WAIT_L(0); PG8_MMA(0, 1, At, B1); PG8_BAR;
            PG8_LDA(At, 0, 1); PG8_STAGE(PG8_SA(0, 0), a2, voffA);
            PG8_BAR; PG8_WAIT_L(0); PG8_MMA(1, 0, At, B0); PG8_BAR; PG8_SCHED;
            PG8_STAGE(PG8_SB(0, 1), b2 + hstep, voffB);
            PG8_WAIT_V(6); PG8_BAR; PG8_MMA(1, 1, At, B1); PG8_BAR;
            PG8_LDB(B0, 1, 0); PG8_SCHED; PG8_LDA(At, 1, 0); PG8_STAGE(PG8_SA(0, 1), a2 + hstep, voffA);
            PG8_WAIT_L(8); PG8_BAR; PG8_WAIT_L(0); PG8_MMA(0, 0, At, B0); PG8_BAR; PG8_SCHED;
            PG8_LDB(B1, 1, 1); PG8_STAGE(PG8_SB(1, 0), b3, voffB);
            PG8_BAR; PG8_WAIT_L(0); PG8_MMA(0, 1, At, B1); PG8_BAR;
            PG8_LDA(At, 1, 1); PG8_STAGE(PG8_SA(1, 0), a3, voffA);
            PG8_BAR; PG8_WAIT_L(0); PG8_MMA(1, 0, At, B0); PG8_BAR; PG8_SCHED;
            PG8_STAGE(PG8_SB(1, 1), b3 + hstep, voffB);
            PG8_WAIT_V(6); PG8_BAR; PG8_MMA(1, 1, At, B1); PG8_BAR;
            }
        }
        if constexpr (ALIGN_EPI) { if (wr == 0) PG8_BAR; }
        if constexpr (!Epi::AFTER_DRAIN) { E(acc, cur, wr, wc, fr, fq); S.done(cur); }
        if (!has_next) break;
#pragma unroll
        for (int a = 0; a < 2; ++a)
#pragma unroll
            for (int b = 0; b < 2; ++b)
#pragma unroll
                for (int m = 0; m < 4; ++m)
#pragma unroll
                    for (int n = 0; n < 2; ++n) acc[a][b][m][n] = (f32x4){0.f, 0.f, 0.f, 0.f};
        cur = nxt; cA = nA; cB = nB; ++ui;
        if constexpr (ALIGN_EPI) { if (wr == 1) PG8_BAR; }
    }
    PG8_WAIT_V(0);
    if constexpr (!ALIGN_EPI) { if (wr == 0) PG8_BAR; }
    PG8_BAR;
    if constexpr (Epi::AFTER_DRAIN) { E.fused(acc, cur, wr, wc, fr, fq, lds, wid, lane); S.done(cur); }
#undef PG8_SA
#undef PG8_SB
#undef PG8_STAGE
#undef PG8_LDA
#undef PG8_LDB
#undef PG8_MMA
#undef PG8_WAIT_V
#undef PG8_WAIT_L
#undef PG8_BAR
#undef PG8_SCHED
}
}
#define LAS __attribute__((address_space(3)))
#define XB_TMO      128
#define XB_XCNT(j)  (256  + 64 * (j))
#define XB_XSUB(j)  (1280 + 64 * (j))
#define XB_XGEN(j)  (2304 + 64 * (j))
#define XB_TOP      3328
#define XB_TOPGEN   3392
#define XCD_BAR_WORDS 3456
#define XB_SPIN_CAP (1u << 18)

__device__ __forceinline__ unsigned xb_ld(unsigned* p)              { return __hip_atomic_load(p, __ATOMIC_RELAXED, __HIP_MEMORY_SCOPE_AGENT); }
__device__ __forceinline__ unsigned xb_add(unsigned* p, unsigned v) { return __hip_atomic_fetch_add(p, v, __ATOMIC_RELAXED, __HIP_MEMORY_SCOPE_AGENT); }
__device__ __forceinline__ unsigned xb_xcc_id() { return (unsigned)__builtin_amdgcn_s_getreg((3 << 11) | 20) & 0xFu; }
#define XB_SPIN(cond, bar) do { unsigned _sp = 0; while (cond) { __builtin_amdgcn_s_sleep(1); \
    if ((++_sp & 255u) == 0u) { if (xb_ld(&(bar)[XB_TMO])) break; if (_sp > XB_SPIN_CAP) { atomicAdd(&(bar)[XB_TMO], 1u); break; } } } } while (0)

struct XcdBarrier {
    unsigned* bar; unsigned x;
    volatile LAS unsigned* st;
};

__device__ __forceinline__ XcdBarrier xcd_barrier_post(unsigned* bar, volatile LAS unsigned* st) {
    XcdBarrier b; b.bar = bar; b.x = xb_xcc_id(); b.st = st;
    if (threadIdx.x == 0) (void)xb_add(&bar[XB_XCNT(b.x)], 1u);
    return b;
}
__device__ __forceinline__ void xcd_barrier_complete(unsigned* bar, unsigned x, unsigned& nloc, unsigned& nx) {
    const unsigned G = gridDim.x * gridDim.y * gridDim.z;
    unsigned sum, cnt, mine, sp = 0u;
    for (;;) {
        sum = 0u; cnt = 0u; mine = 0u;
#pragma unroll
        for (unsigned j = 0; j < 16; ++j) { const unsigned c = xb_ld(&bar[XB_XCNT(j)]); sum += c; cnt += (c > 0u) ? 1u : 0u; mine = (j == x) ? c : mine; }
        if (sum == G) break;
        __builtin_amdgcn_s_sleep(1);
        if ((++sp & 255u) == 0u) { if (xb_ld(&bar[XB_TMO])) break; if (sp > XB_SPIN_CAP) { atomicAdd(&bar[XB_TMO], 1u); break; } }
    }
    nloc = mine > 0u ? mine : 1u; nx = cnt > 0u ? cnt : 1u;
}

__device__ __forceinline__ void xcd_barrier(const XcdBarrier& b) {
    asm volatile("s_waitcnt vmcnt(0)" ::: "memory");
    __syncthreads();
    if (threadIdx.x == 0) {
        unsigned* bar = b.bar;
        __builtin_amdgcn_s_waitcnt(0);
        unsigned nloc = b.st[0], nx = b.st[1];
        if (nloc == 0u) { xcd_barrier_complete(bar, b.x, nloc, nx); b.st[0] = nloc; b.st[1] = nx; }
        const unsigned old = xb_add(&bar[XB_XSUB(b.x)], 1u);
        const unsigned gen = old / nloc;
        if (old + 1u == (gen + 1u) * nloc) {
            __builtin_amdgcn_fence(__ATOMIC_RELEASE, "agent");
            asm volatile("s_waitcnt vmcnt(0)" ::: "memory");
            const unsigned og = xb_add(&bar[XB_TOP], 1u);
            const unsigned tg = og / nx;
            if (og + 1u == (tg + 1u) * nx) xb_add(&bar[XB_TOPGEN], 1u);
            else XB_SPIN(xb_ld(&bar[XB_TOPGEN]) == tg, bar);
            __builtin_amdgcn_fence(__ATOMIC_ACQUIRE, "agent");
            xb_add(&bar[XB_XGEN(b.x)], 1u);
            asm volatile("s_waitcnt vmcnt(0)" ::: "memory");
        } else {
            XB_SPIN(xb_ld(&bar[XB_XGEN(b.x)]) == gen, bar);
            __builtin_amdgcn_fence(__ATOMIC_ACQUIRE, "agent");
            asm volatile("s_waitcnt vmcnt(0)" ::: "memory");
        }
    }
    __syncthreads();
}
#ifdef EMU
#include <pthread.h>
#include <cstring>
#include <cstdio>
#include <cstdlib>
#include <cmath>
#include <cstdint>
#define DEV static inline
#define LAS
struct EmuDim { int x; };
static thread_local EmuDim threadIdx;
typedef short bf16x8 __attribute__((ext_vector_type(8)));
typedef short s16x4 __attribute__((ext_vector_type(4)));
typedef float f32x4 __attribute__((ext_vector_type(4)));
typedef float f32x2 __attribute__((ext_vector_type(2)));
typedef unsigned u32x4 __attribute__((ext_vector_type(4)));
typedef unsigned u32x2 __attribute__((ext_vector_type(2)));
struct WaveX { bf16x8 a[64], b[64]; float f[64]; const void* p[64]; pthread_barrier_t bar; };
static WaveX g_wx[8];
static pthread_barrier_t g_wgbar;
static inline float emu_bf2f(short v) { unsigned u = ((unsigned)(unsigned short)v) << 16; float f; memcpy(&f, &u, 4); return f; }
static inline float __uint_as_float(unsigned u) { float f; memcpy(&f, &u, 4); return f; }
static inline unsigned __float_as_uint(float f) { unsigned u; memcpy(&u, &f, 4); return u; }
DEV f32x4 mfma16(bf16x8 a, bf16x8 b, f32x4 c) {
    const int lane = threadIdx.x & 63; WaveX& W = g_wx[threadIdx.x >> 6];
    W.a[lane] = a; W.b[lane] = b; pthread_barrier_wait(&W.bar);
    f32x4 r; const int g = lane >> 4, j = lane & 15;
    for (int rr = 0; rr < 4; ++rr) { const int i = 4 * g + rr; float s = 0.f;
        for (int k = 0; k < 32; ++k) s += emu_bf2f(W.a[i + 16 * (k / 8)][k % 8]) * emu_bf2f(W.b[j + 16 * (k / 8)][k % 8]);
        r[rr] = c[rr] + s; }
    pthread_barrier_wait(&W.bar); return r;
}
DEV s16x4 tr_read(const void* p) {
    const int lane = threadIdx.x & 63; WaveX& W = g_wx[threadIdx.x >> 6];
    W.p[lane] = p; pthread_barrier_wait(&W.bar);
    s16x4 r; const int G = lane >> 4, i = lane & 15;
    for (int q = 0; q < 4; ++q) { const short* src = (const short*)W.p[16 * G + 4 * q + i / 4]; if (((uintptr_t)src) & 7) { fprintf(stderr, "tr_read: unaligned\n"); abort(); } r[q] = src[i % 4]; }
    pthread_barrier_wait(&W.bar); return r;
}
DEV void lds_wait() {}
#define tr_read_o(base, off) tr_read((const unsigned char*)(base) + (off))
DEV float shflx(float v, int m) { const int lane = threadIdx.x & 63; WaveX& W = g_wx[threadIdx.x >> 6]; W.f[lane] = v; pthread_barrier_wait(&W.bar); const float r = W.f[lane ^ m]; pthread_barrier_wait(&W.bar); return r; }
DEV void wg_sync() { pthread_barrier_wait(&g_wgbar); }
DEV void mem_fence_cc() {}
DEV void wave_sync() { pthread_barrier_wait(&g_wx[threadIdx.x >> 6].bar); }
DEV float fast_exp(float x) { return expf(x); }
DEV float fast_log(float x) { return logf(x); }
DEV float fast_exp2(float x) { return exp2f(x); }
DEV float fast_log2(float x) { return log2f(x); }
DEV float fast_rcp(float x) { return 1.0f / x; }
DEV unsigned cvt_pk_bf16(float lo, float hi) { auto f = [](float x) { unsigned u = __float_as_uint(x); return (u + 0x7fffu + ((u >> 16) & 1u)) >> 16; }; return f(lo) | (f(hi) << 16); }
#else
#define DEV __device__ __forceinline__
typedef short bf16x8 __attribute__((ext_vector_type(8)));
typedef short s16x4 __attribute__((ext_vector_type(4)));
typedef float f32x4 __attribute__((ext_vector_type(4)));
typedef float f32x2 __attribute__((ext_vector_type(2)));
typedef unsigned u32x4 __attribute__((ext_vector_type(4)));
typedef unsigned u32x2 __attribute__((ext_vector_type(2)));
DEV f32x4 mfma16(bf16x8 a, bf16x8 b, f32x4 c) { return __builtin_amdgcn_mfma_f32_16x16x32_bf16(a, b, c, 0, 0, 0); }
DEV s16x4 tr_read(const LAS void* p) { s16x4 r; asm volatile("ds_read_b64_tr_b16 %0, %1" : "=&v"(r) : "v"((unsigned)(size_t)p) : "memory"); return r; }
DEV s16x4 tr_read_o(const LAS void* p, int off) { s16x4 r; asm volatile("ds_read_b64_tr_b16 %0, %1 offset:%2" : "=&v"(r) : "v"((unsigned)(size_t)p), "i"(off) : "memory"); return r; }
DEV void lds_wait() { asm volatile("s_waitcnt lgkmcnt(0)" ::: "memory"); __builtin_amdgcn_sched_barrier(0); }
DEV float shflx(float v, int m) { return __shfl_xor(v, m); }
DEV void wg_sync() { __syncthreads(); }
DEV void mem_fence_cc() { asm volatile("" ::: "memory"); }
DEV void wave_sync() { asm volatile("s_waitcnt lgkmcnt(0)" ::: "memory"); }
DEV float fast_exp(float x) { return __expf(x); }
DEV float fast_log(float x) { return __logf(x); }
DEV float fast_exp2(float x) { return __builtin_amdgcn_exp2f(x); }
DEV float fast_log2(float x) { return __builtin_amdgcn_logf(x); }
DEV float fast_rcp(float x) { return __builtin_amdgcn_rcpf(x); }
DEV unsigned cvt_pk_bf16(float lo, float hi) { unsigned r; asm volatile("v_cvt_pk_bf16_f32 %0, %1, %2" : "=v"(r) : "v"(lo), "v"(hi)); return r; }
#endif
typedef unsigned short bf16;
DEV bf16x8 pack8(s16x4 lo, s16x4 hi) { return (bf16x8){lo[0], lo[1], lo[2], lo[3], hi[0], hi[1], hi[2], hi[3]}; }

namespace mk {
typedef unsigned short bf16;
typedef float f32x4 __attribute__((ext_vector_type(4)));
typedef float f32x2 __attribute__((ext_vector_type(2)));
typedef unsigned u32x4 __attribute__((ext_vector_type(4)));
typedef unsigned u32x2 __attribute__((ext_vector_type(2)));
typedef short bf16x8 __attribute__((ext_vector_type(8)));
constexpr int D = 2048, NB = 4, S = 2048, MP = NB * S, DB = 8, T = 4, MS = DB * T, MT = MP + MS, PAST = 16384;
constexpr float EPS = 1e-6f;
constexpr int A_IN = 20480, B_IN = 12288, C_IN = 6160, C_INM = 6144;
constexpr int NWG_THREADS = 512;
constexpr size_t MiB = 1u << 20;
constexpr size_t WS_CTL = 0, CTL_ZERO_BYTES = 1 * MiB;
constexpr size_t CTL_BAR = 16384;
constexpr size_t CTL_SUMSQ = 65536;
constexpr size_t WS_TABA = 1 * MiB;
constexpr size_t WS_TABB = WS_TABA + 512 * 1024;
constexpr size_t WS_WIA0 = 4 * MiB;
constexpr size_t WS_WIA1 = WS_WIA0 + (size_t)A_IN * D * 2;
constexpr size_t WS_WIB = WS_WIA1 + (size_t)A_IN * D * 2;
constexpr size_t WS_WIC = WS_WIB + (size_t)B_IN * D * 2;
constexpr size_t WS_WLR = WS_WIC + (size_t)C_INM * D * 2;
constexpr size_t WS_WOA0 = WS_WLR + (size_t)32 * D * 2;
constexpr size_t WS_WOA1 = WS_WOA0 + (size_t)D * 2048 * 2;
constexpr size_t WS_WOB = WS_WOA1 + (size_t)D * 2048 * 2;
constexpr size_t WS_WOC = WS_WOB + (size_t)D * 4096 * 2;
constexpr size_t WS_XRES = WS_WOC + (size_t)D * 2048 * 2;
constexpr size_t WS_XB = WS_XRES + (size_t)MT * D * 4;
constexpr size_t WS_Z = WS_XB + (size_t)MT * D * 2;
constexpr size_t WS_ZSRAW = WS_Z + (size_t)MT * A_IN * 2;
constexpr size_t WS_Y = WS_ZSRAW + (size_t)32 * A_IN * 4;
constexpr size_t WS_O = WS_Y + (size_t)MT * 4096 * 2;
constexpr size_t WS_LOGA = WS_O + (size_t)MT * 4096 * 4;
constexpr size_t WS_LR = WS_LOGA + (size_t)MT * 1024 * 4;
constexpr size_t WS_DVEC = WS_LR + (size_t)32 * MT * 4;
constexpr size_t WS_END = WS_DVEC + (size_t)4 * 4 * 16 * 256 * 4;
constexpr int LDS_BYTES = 147456, MISC_OFF = 147456 - 256;

struct Params {
    const float* in[19]; float* out; unsigned char* ws;
    double inv_a[16]; double inv_b[128];
    int ph_lo, ph_hi;
};

__device__ __forceinline__ float bf2f(bf16 v) { return __uint_as_float(((unsigned)v) << 16); }
__device__ __forceinline__ unsigned f2bf(float f) { unsigned u = __float_as_uint(f); return (u + 0x7fffu + ((u >> 16) & 1u)) >> 16; }
__device__ __forceinline__ unsigned pk2(float lo, float hi) { return f2bf(lo) | (f2bf(hi) << 16); }
__device__ __forceinline__ float wave_sum(float v) {
#pragma unroll
    for (int o = 32; o >= 1; o >>= 1) v += __shfl_xor(v, o);
    return v;
}
__device__ __forceinline__ float wave_max(float v) {
#pragma unroll
    for (int o = 32; o >= 1; o >>= 1) v = fmaxf(v, __shfl_xor(v, o));
    return v;
}
__device__ __forceinline__ float silu(float x) { return x / (1.f + __expf(-x)); }
__device__ __forceinline__ void sincos_d(double a, float& s, float& c) {
    const double k = rint(a * 0.63661977236758134308);
    double r = fma(-k, 1.57079632679489655800e+00, a); r = fma(-k, 6.12323399573676603587e-17, r);
    const double r2 = r * r;
    const double sp = r * (1.0 + r2 * (-1.0 / 6 + r2 * (1.0 / 120 + r2 * (-1.0 / 5040 + r2 * (1.0 / 362880 + r2 * (-1.0 / 39916800 + r2 * (1.0 / 6227020800.0)))))));
    const double cp = 1.0 + r2 * (-0.5 + r2 * (1.0 / 24 + r2 * (-1.0 / 720 + r2 * (1.0 / 40320 + r2 * (-1.0 / 3628800 + r2 * (1.0 / 479001600.0 + r2 * (-1.0 / 87178291200.0)))))));
    const int q = (int)((long long)k & 3);
    const double ss = (q == 0) ? sp : (q == 1) ? cp : (q == 2) ? -sp : -cp;
    const double cc = (q == 0) ? cp : (q == 1) ? -sp : (q == 2) ? -cp : sp;
    s = (float)ss; c = (float)cc;
}
__device__ __forceinline__ void row_info(int row, int& b, int& t, int& pi, bool& samp) {
    if (row < MP) { b = row >> 11; t = row & 2047; pi = t; samp = false; } else { const int r = row - MP; b = r >> 2; t = r & 3; pi = 2048 + t; samp = true; }
}

struct Ctx {
    LAS unsigned char* lds; int tid, lane, wave, G, wg;
    const float *x_prompt, *x_sample, *cache1, *cache2, *cache3, *state_b, *state_c, *norm_g, *final_g, *w_in_a, *w_out_a, *w_in_b, *gn_b, *w_out_b, *w_in_c, *w_gate2_c, *b_gate_c, *gn_c, *w_out_c; float* out; unsigned char* ws;
    __device__ __forceinline__ float* sumsq(int l) const { return (float*)(ws + CTL_SUMSQ) + (size_t)l * MT; }
    template <class Tp> __device__ __forceinline__ Tp* wsp(size_t off) const { return (Tp*)(ws + off); }
};

constexpr int ATT_K_OFF = 0, ATT_V_OFF = 65536, ATT_ROWS = 8192 + 32;
DEV int att_off_k(int row, int ch) { return 256 * row + 16 * (ch ^ (row & 15)); }
DEV int att_off_v(int row, int ch) { return 256 * row + 16 * (ch ^ (2 * (row & 7))); }
DEV void attn_item(LAS unsigned char* lds, const bf16* z, int ldz, bf16* og, float* lse, int item, int tid) {
    const int lane = tid & 63, w = tid >> 6, G = lane >> 4, l15 = lane & 15;
    const int bh = item / 48, rem = item % 48, b = bh >> 4, h = bh & 15;
    int g, r, blk;
    if (rem < 16) { g = 0; r = 0; blk = rem; } else if (rem < 32) { g = 1; r = (rem - 16) >> 2; blk = (rem - 16) & 3; } else { g = 2; r = rem - 32; blk = 0; }
    const int dil = 1 << (2 * g);
    const int qcol = (g * 3) * 2048 + h * 128, kcol = qcol + 2048, vcol = qcol + 4096;
    const size_t tok0 = (size_t)b * 2048 + r;
#pragma unroll
    for (int j = 0; j < 8; ++j) {
        const int e = tid + 512 * j, row = e >> 4, ch = e & 15; const int p = (blk - 1) * 128 + row;
        u32x4 kv = {0u, 0u, 0u, 0u}, vv = {0u, 0u, 0u, 0u};
        if (p >= 0) { const bf16* src = z + (tok0 + (size_t)dil * p) * ldz + ch * 8; kv = *(const u32x4*)(src + kcol); vv = *(const u32x4*)(src + vcol); }
        *(LAS u32x4*)(lds + ATT_K_OFF + att_off_k(row, ch)) = kv;
        *(LAS u32x4*)(lds + ATT_V_OFF + att_off_v(row, ch)) = vv;
    }
    const int qi = 16 * w + l15; const size_t qtok = tok0 + (size_t)dil * (blk * 128 + qi);
    bf16x8 qf[4];
#pragma unroll
    for (int s = 0; s < 4; ++s) qf[s] = *(const bf16x8*)(z + qtok * ldz + qcol + 32 * s + 8 * G);
    wg_sync();
    const int m0 = w >> 1;
    f32x4 sc[10];
#pragma unroll
    for (int tt = 0; tt < 10; ++tt) {
        const int t = 2 * m0 + tt; f32x4 a = {0.f, 0.f, 0.f, 0.f};
#pragma unroll
        for (int s = 0; s < 4; ++s) { const bf16x8 kf = *(const LAS bf16x8*)(lds + ATT_K_OFF + att_off_k(16 * t + l15, 4 * s + G)); a = mfma16(kf, qf[s], a); }
        sc[tt] = a;
    }
    const float scale = 0.08838834764831845f * 1.4426950408889634f;
    float mx = -INFINITY;
#pragma unroll
    for (int tt = 0; tt < 10; ++tt)
#pragma unroll
        for (int rr = 0; rr < 4; ++rr) { const int c = 16 * (2 * m0 + tt) + 4 * G + rr; const bool ok = (c >= qi) && (c <= qi + 128) && (blk > 0 || c >= 128);
            const float v = ok ? sc[tt][rr] * scale : -INFINITY; sc[tt][rr] = v; mx = fmaxf(mx, v); }
    mx = fmaxf(mx, shflx(mx, 16)); mx = fmaxf(mx, shflx(mx, 32));
    float sum = 0.f;
#pragma unroll
    for (int tt = 0; tt < 10; ++tt)
#pragma unroll
        for (int rr = 0; rr < 4; ++rr) { const float p = fast_exp2(sc[tt][rr] - mx); sc[tt][rr] = p; sum += p; }
    sum += shflx(sum, 16); sum += shflx(sum, 32);
    f32x4 oacc[8];
#pragma unroll
    for (int dt = 0; dt < 8; ++dt) oacc[dt] = (f32x4){0.f, 0.f, 0.f, 0.f};
#pragma unroll
    for (int mm = 0; mm < 5; ++mm) {
        const f32x4 p0 = sc[2 * mm], p1 = sc[2 * mm + 1];
        u32x4 pw; pw[0] = cvt_pk_bf16(p0[0], p0[1]); pw[1] = cvt_pk_bf16(p0[2], p0[3]); pw[2] = cvt_pk_bf16(p1[0], p1[1]); pw[3] = cvt_pk_bf16(p1[2], p1[3]);
        bf16x8 pf; __builtin_memcpy(&pf, &pw, 16);
        const int krow = 32 * (m0 + mm) + 4 * G + (l15 >> 2);
#pragma unroll
        for (int dh = 0; dh < 2; ++dh) {
            s16x4 lo[4], hi[4];
#pragma unroll
            for (int d4 = 0; d4 < 4; ++d4) { const int dt = dh * 4 + d4; const int ch = 2 * dt + ((l15 >> 1) & 1);
                lo[d4] = tr_read(lds + ATT_V_OFF + att_off_v(krow, ch) + 8 * (l15 & 1)); hi[d4] = tr_read(lds + ATT_V_OFF + att_off_v(krow + 16, ch) + 8 * (l15 & 1)); }
            lds_wait();
#pragma unroll
            for (int d4 = 0; d4 < 4; ++d4) oacc[dh * 4 + d4] = mfma16(pack8(lo[d4], hi[d4]), pf, oacc[dh * 4 + d4]);
        }
    }
    const float inv = fast_rcp(sum);
    bf16* orow = og + ((size_t)g * ATT_ROWS + qtok) * 2048 + h * 128 + 4 * G;
#pragma unroll
    for (int dt = 0; dt < 8; ++dt) { u32x2 wv; wv[0] = cvt_pk_bf16(oacc[dt][0] * inv, oacc[dt][1] * inv); wv[1] = cvt_pk_bf16(oacc[dt][2] * inv, oacc[dt][3] * inv); *(u32x2*)(orow + 16 * dt) = wv; }
    if (G == 0) lse[((size_t)g * ATT_ROWS + qtok) * 16 + h] = (mx + fast_log2(sum)) * 0.6931471805599453f;
    wg_sync();
}
struct AttItem { int b, h, g, r, blk; };
DEV AttItem att_decode(int item) { AttItem a; const int bh = item / 48, rem = item % 48; a.b = bh >> 4; a.h = bh & 15;
    if (rem < 16) { a.g = 0; a.r = 0; a.blk = rem; } else if (rem < 32) { a.g = 1; a.r = (rem - 16) >> 2; a.blk = (rem - 16) & 3; } else { a.g = 2; a.r = rem - 32; a.blk = 0; } return a; }
DEV bool att_continues(int item) { const int rem = item % 48; return rem < 15 || (rem >= 16 && rem < 32 && ((rem - 16) & 3) < 3); }
DEV void att_load_half(const bf16* z, int ldz, const AttItem& a, int pblk, int tid, u32x4 (&kr)[4], u32x4 (&vr)[4]) {
    const int dil = 1 << (2 * a.g), qcol = (a.g * 3) * 2048 + a.h * 128; const size_t tok0 = (size_t)a.b * 2048 + a.r;
#pragma unroll
    for (int j = 0; j < 4; ++j) { const int e = tid + 512 * j, row = e >> 4, ch = e & 15;
        kr[j] = (u32x4){0u, 0u, 0u, 0u}; vr[j] = (u32x4){0u, 0u, 0u, 0u};
        if (pblk >= 0) { const bf16* src = z + (tok0 + (size_t)dil * (pblk * 128 + row)) * ldz + qcol + ch * 8; kr[j] = *(const u32x4*)(src + 2048); vr[j] = *(const u32x4*)(src + 4096); } }
}
DEV void att_store_half(LAS unsigned char* lds, int half, int tid, const u32x4 (&kr)[4], const u32x4 (&vr)[4]) {
#pragma unroll
    for (int j = 0; j < 4; ++j) { const int e = tid + 512 * j, prow = half * 128 + (e >> 4), ch = e & 15;
        *(LAS u32x4*)(lds + ATT_K_OFF + 256 * prow + 16 * (ch ^ (prow & 15))) = kr[j]; *(LAS u32x4*)(lds + ATT_V_OFF + 256 * prow + 16 * (ch ^ (2 * (prow & 7)))) = vr[j]; }
}
DEV void att_load_q(const bf16* z, int ldz, const AttItem& a, int w, int l15, int G, bf16x8 (&qf)[4]) {
    const int dil = 1 << (2 * a.g); const size_t qtok = (size_t)a.b * 2048 + a.r + (size_t)dil * (a.blk * 128 + 16 * w + l15);
#pragma unroll
    for (int s = 0; s < 4; ++s) qf[s] = *(const bf16x8*)(z + qtok * ldz + (a.g * 3) * 2048 + a.h * 128 + 32 * s + 8 * G);
}
DEV void attn_run(LAS unsigned char* lds, const bf16* z, int ldz, bf16* og, float* lse, int item0, int nitems, int tid) {
    const int lane = tid & 63, w = tid >> 6, G = lane >> 4, l15 = lane & 15;
    int kb[4], vb[8];
#pragma unroll
    for (int s = 0; s < 4; ++s) kb[s] = ATT_K_OFF + 256 * l15 + 16 * ((4 * s + G) ^ l15);
    { const int r7 = 4 * (G & 1) + (l15 >> 2);
#pragma unroll
      for (int dt = 0; dt < 8; ++dt) vb[dt] = ATT_V_OFF + 256 * (4 * G + (l15 >> 2)) + 16 * ((2 * dt + ((l15 >> 1) & 1)) ^ (2 * r7)) + 8 * (l15 & 1); }
    int par = 0;
    AttItem cur = att_decode(item0);
    bf16x8 qf[4];
    {   u32x4 kA[4], vA[4], kB[4], vB[4];
        att_load_half(z, ldz, cur, cur.blk - 1, tid, kA, vA); att_load_half(z, ldz, cur, cur.blk, tid, kB, vB); att_load_q(z, ldz, cur, w, l15, G, qf);
        att_store_half(lds, 0, tid, kA, vA); att_store_half(lds, 1, tid, kB, vB); }
#pragma unroll 1
    for (int it = 0; it < nitems; ++it) {
        wg_sync();
        const bool has_next = it + 1 < nitems; const bool cont = has_next && att_continues(item0 + it);
        AttItem nxt = cur; if (has_next) nxt = att_decode(item0 + it + 1);
        u32x4 kA[4], vA[4], kB[4], vB[4]; bf16x8 qn[4];
        if (has_next) { if (!cont) att_load_half(z, ldz, nxt, nxt.blk - 1, tid, kA, vA); att_load_half(z, ldz, nxt, nxt.blk, tid, kB, vB); att_load_q(z, ldz, nxt, w, l15, G, qn); }
        const int m0 = w >> 1, qi = 16 * w + l15;
        f32x4 sc[10];
#pragma unroll
        for (int tt = 0; tt < 10; ++tt) {
            const int pt = (2 * m0 + tt) ^ (8 * par); f32x4 a = {0.f, 0.f, 0.f, 0.f};
#pragma unroll
            for (int s = 0; s < 4; ++s) { const bf16x8 kf = *(const LAS bf16x8*)(lds + kb[s] + 4096 * pt); a = mfma16(kf, qf[s], a); }
            sc[tt] = a;
        }
        const float scale = 0.08838834764831845f * 1.4426950408889634f;
        float mx = -INFINITY;
#pragma unroll
        for (int tt = 0; tt < 10; ++tt)
#pragma unroll
            for (int rr = 0; rr < 4; ++rr) { const int c = 16 * (2 * m0 + tt) + 4 * G + rr; const bool ok = (c >= qi) && (c <= qi + 128) && (cur.blk > 0 || c >= 128);
                const float v = ok ? sc[tt][rr] * scale : -INFINITY; sc[tt][rr] = v; mx = fmaxf(mx, v); }
        mx = fmaxf(mx, shflx(mx, 16)); mx = fmaxf(mx, shflx(mx, 32));
        float sum = 0.f;
#pragma unroll
        for (int tt = 0; tt < 10; ++tt)
#pragma unroll
            for (int rr = 0; rr < 4; ++rr) { const float p = fast_exp2(sc[tt][rr] - mx); sc[tt][rr] = p; sum += p; }
        sum += shflx(sum, 16); sum += shflx(sum, 32);
        f32x4 oacc[8];
#pragma unroll
        for (int dt = 0; dt < 8; ++dt) oacc[dt] = (f32x4){0.f, 0.f, 0.f, 0.f};
#pragma unroll
        for (int mm = 0; mm < 5; ++mm) {
            const f32x4 p0 = sc[2 * mm], p1 = sc[2 * mm + 1];
            u32x4 pw; pw[0] = cvt_pk_bf16(p0[0], p0[1]); pw[1] = cvt_pk_bf16(p0[2], p0[3]); pw[2] = cvt_pk_bf16(p1[0], p1[1]); pw[3] = cvt_pk_bf16(p1[2], p1[3]);
            bf16x8 pf; __builtin_memcpy(&pf, &pw, 16);
            const int prow = 8192 * ((m0 + mm) ^ (4 * par));
#pragma unroll
            for (int dh = 0; dh < 2; ++dh) {
                s16x4 lo[4], hi[4];
#pragma unroll
                for (int d4 = 0; d4 < 4; ++d4) { lo[d4] = tr_read_o(lds + vb[dh * 4 + d4] + prow, 0); hi[d4] = tr_read_o(lds + vb[dh * 4 + d4] + prow, 4096); }
                lds_wait();
#pragma unroll
                for (int d4 = 0; d4 < 4; ++d4) oacc[dh * 4 + d4] = mfma16(pack8(lo[d4], hi[d4]), pf, oacc[dh * 4 + d4]);
            }
        }
        {   const float inv = fast_rcp(sum); const int dil = 1 << (2 * cur.g); const size_t qtok = (size_t)cur.b * 2048 + cur.r + (size_t)dil * (cur.blk * 128 + qi);
            bf16* orow = og + ((size_t)cur.g * ATT_ROWS + qtok) * 2048 + cur.h * 128 + 4 * G;
#pragma unroll
            for (int dt = 0; dt < 8; ++dt) { u32x2 wv; wv[0] = cvt_pk_bf16(oacc[dt][0] * inv, oacc[dt][1] * inv); wv[1] = cvt_pk_bf16(oacc[dt][2] * inv, oacc[dt][3] * inv); *(u32x2*)(orow + 16 * dt) = wv; }
            if (G == 0) lse[((size_t)cur.g * ATT_ROWS + qtok) * 16 + cur.h] = (mx + fast_log2(sum)) * 0.6931471805599453f; }
        wg_sync();
        if (has_next) {
            if (cont) { att_store_half(lds, par, tid, kB, vB); par ^= 1; }
            else { att_store_half(lds, 0, tid, kA, vA); att_store_half(lds, 1, tid, kB, vB); par = 0; }
#pragma unroll
            for (int s = 0; s < 4; ++s) qf[s] = qn[s];
            cur = nxt;
        }
    }
    wg_sync();
}
constexpr int SC_KP = 544, SC_K_OFF = 0, SC_V_OFF = 128 * SC_KP, SC_S_OFF = SC_V_OFF + 20480;
template <int NVT, class OT>
DEV void scan_unit(LAS unsigned char* lds, const bf16* z, int ldz, int qoff, int koff, int voff, int H, int unit, const float* dvec, OT* o, int ldo, float* state_out, int tid) {
    constexpr int VS = 16 * NVT, VP = VS * 2 + 32, KP = SC_KP, NVS = 512 / VS, VCH = VS / 8, NVLD = (128 * VCH) / 512, VROWS = 512 / VCH;
    const int lane = tid & 63, w = tid >> 6, G = lane >> 4, l15 = lane & 15;
    const int vs = unit % NVS, h = (unit / NVS) % H, b = unit / (NVS * H);
    const size_t rowbase = (size_t)b * 2048;
    const bf16* zq = z + qoff + h * 256; const bf16* zk = z + koff + h * 256; const bf16* zv = z + voff + h * 512 + vs * VS;
    float gam128 = 1.f; if (!dvec) { const float gm = 1.0f - exp2f(-5.0f - (float)h); gam128 = exp2f(128.0f * log2f(gm)); }
    LAS unsigned char* const kb_row = lds + SC_K_OFF + l15 * KP + 16 * G;
    LAS unsigned char* const kb_tr = lds + SC_K_OFF + (4 * G + (l15 >> 2)) * KP + 8 * (l15 & 3) + 64 * w;
    LAS unsigned char* const vb_tr = lds + SC_V_OFF + (4 * G + (l15 >> 2)) * VP + 8 * (l15 & 3);
    LAS unsigned char* const sb_row = lds + SC_S_OFF + l15 * KP + 16 * G;
    LAS unsigned char* const sb_wr = lds + SC_S_OFF + l15 * KP + 8 * G + 64 * w;
    LAS unsigned char* const kst = lds + SC_K_OFF + (tid >> 5) * KP + (tid & 31) * 16;
    LAS unsigned char* const vst = lds + SC_V_OFF + (tid / VCH) * VP + (tid % VCH) * 16;
    const size_t kg = (size_t)(tid >> 5) * ldz + (tid & 31) * 8, vg = (size_t)(tid / VCH) * ldz + (tid % VCH) * 8;
    f32x4 sacc[2][NVT];
#pragma unroll
    for (int dd = 0; dd < 2; ++dd)
#pragma unroll
        for (int vt = 0; vt < NVT; ++vt) sacc[dd][vt] = (f32x4){0.f, 0.f, 0.f, 0.f};
    for (int e = tid; e < VS * (KP / 16); e += 512) *(LAS u32x4*)(lds + SC_S_OFF + e * 16) = (u32x4){0u, 0u, 0u, 0u};
    u32x4 kpre[8], vpre[NVLD];
    {   const bf16* kp = zk + rowbase * ldz + kg; const bf16* vp = zv + rowbase * ldz + vg;
#pragma unroll
        for (int j = 0; j < 8; ++j) kpre[j] = *(const u32x4*)(kp + (size_t)(16 * j) * ldz);
#pragma unroll
        for (int j = 0; j < NVLD; ++j) vpre[j] = *(const u32x4*)(vp + (size_t)(VROWS * j) * ldz);
#pragma unroll
        for (int j = 0; j < 8; ++j) *(LAS u32x4*)(kst + 16 * j * KP) = kpre[j];
#pragma unroll
        for (int j = 0; j < NVLD; ++j) *(LAS u32x4*)(vst + VROWS * j * VP) = vpre[j]; }
    wg_sync();
    const int qi = 16 * w + l15;
#pragma unroll 1
    for (int c = 0; c < 16; ++c) {
        const size_t crow = rowbase + (size_t)c * 128;
        const bf16* kp = zk + (crow + 128) * ldz + kg; const bf16* vp = zv + (crow + 128) * ldz + vg;
        if (c + 1 < 16) {
#pragma unroll
            for (int j = 0; j < 4; ++j) kpre[j] = *(const u32x4*)(kp + (size_t)(16 * j) * ldz);
        }
        bf16x8 qf[8];
#pragma unroll
        for (int s = 0; s < 8; ++s) qf[s] = *(const bf16x8*)(zq + (crow + qi) * ldz + 32 * s + 8 * G);
        f32x4 oacc[NVT];
#pragma unroll
        for (int vt = 0; vt < NVT; ++vt) oacc[vt] = (f32x4){0.f, 0.f, 0.f, 0.f};
#pragma unroll 1
        for (int m = 0; m <= (w >> 1); ++m) {
            f32x4 s0 = {0.f, 0.f, 0.f, 0.f}, s1 = {0.f, 0.f, 0.f, 0.f};
            LAS unsigned char* const kr = kb_row + m * (32 * KP); LAS unsigned char* const vr = vb_tr + m * (32 * VP);
#pragma unroll
            for (int s = 0; s < 8; ++s) {
                const bf16x8 k0 = *(const LAS bf16x8*)(kr + 64 * s); const bf16x8 k1 = *(const LAS bf16x8*)(kr + 16 * KP + 64 * s);
                s0 = mfma16(k0, qf[s], s0); s1 = mfma16(k1, qf[s], s1);
                if (s & 1) mem_fence_cc();
            }
#pragma unroll
            for (int rr = 0; rr < 4; ++rr) { const int j0 = 32 * m + 4 * G + rr; s0[rr] = (j0 <= qi) ? s0[rr] : 0.f; s1[rr] = (j0 + 16 <= qi) ? s1[rr] : 0.f; }
            u32x4 pw; pw[0] = cvt_pk_bf16(s0[0], s0[1]); pw[1] = cvt_pk_bf16(s0[2], s0[3]); pw[2] = cvt_pk_bf16(s1[0], s1[1]); pw[3] = cvt_pk_bf16(s1[2], s1[3]);
            bf16x8 pf; __builtin_memcpy(&pf, &pw, 16);
            s16x4 lo[NVT], hi[NVT];
#pragma unroll
            for (int vt = 0; vt < NVT; ++vt) { lo[vt] = tr_read_o(vr, 32 * vt); hi[vt] = tr_read_o(vr, 16 * VP + 32 * vt); }
            lds_wait();
#pragma unroll
            for (int vt = 0; vt < NVT; ++vt) oacc[vt] = mfma16(pack8(lo[vt], hi[vt]), pf, oacc[vt]);
        }
        if (c + 1 < 16) {
#pragma unroll
            for (int j = 4; j < 8; ++j) kpre[j] = *(const u32x4*)(kp + (size_t)(16 * j) * ldz);
        }
#pragma unroll
        for (int s = 0; s < 8; ++s)
#pragma unroll
            for (int vt = 0; vt < NVT; ++vt) { const bf16x8 sf = *(const LAS bf16x8*)(sb_row + 16 * vt * KP + 64 * s); oacc[vt] = mfma16(sf, qf[s], oacc[vt]); if (vt == NVT - 1) mem_fence_cc(); }
        {   OT* orow = o + (crow + qi) * ldo + h * 512 + vs * VS + 4 * G;
#pragma unroll
            for (int vt = 0; vt < NVT; ++vt) {
                if constexpr (sizeof(OT) == 2) { u32x2 wv; wv[0] = cvt_pk_bf16(oacc[vt][0], oacc[vt][1]); wv[1] = cvt_pk_bf16(oacc[vt][2], oacc[vt][3]); *(u32x2*)(orow + 16 * vt) = wv; }
                else *(f32x4*)(orow + 16 * vt) = oacc[vt]; } }
        if (c + 1 < 16) {
#pragma unroll
            for (int j = 0; j < NVLD; ++j) vpre[j] = *(const u32x4*)(vp + (size_t)(VROWS * j) * ldz);
        }
#pragma unroll
        for (int ks = 0; ks < 4; ++ks) {
            s16x4 alo[2], ahi[2], blo[NVT], bhi[NVT];
#pragma unroll
            for (int dd = 0; dd < 2; ++dd) { alo[dd] = tr_read_o(kb_tr, 32 * ks * KP + 32 * dd); ahi[dd] = tr_read_o(kb_tr, (32 * ks + 16) * KP + 32 * dd); }
#pragma unroll
            for (int vt = 0; vt < NVT; ++vt) { blo[vt] = tr_read_o(vb_tr, 32 * ks * VP + 32 * vt); bhi[vt] = tr_read_o(vb_tr, (32 * ks + 16) * VP + 32 * vt); }
            lds_wait();
#pragma unroll
            for (int dd = 0; dd < 2; ++dd)
#pragma unroll
                for (int vt = 0; vt < NVT; ++vt) sacc[dd][vt] = mfma16(pack8(alo[dd], ahi[dd]), pack8(blo[vt], bhi[vt]), sacc[dd][vt]);
        }
#pragma unroll
        for (int dd = 0; dd < 2; ++dd) {
            f32x4 dv = {gam128, gam128, gam128, gam128};
            if (dvec) dv = *(const f32x4*)(dvec + ((size_t)(b * H + h) * 16 + c) * 256 + 16 * (2 * w + dd) + 4 * G);
#pragma unroll
            for (int vt = 0; vt < NVT; ++vt) sacc[dd][vt] = sacc[dd][vt] * dv;
        }
        wg_sync();
#pragma unroll
        for (int dd = 0; dd < 2; ++dd)
#pragma unroll
            for (int vt = 0; vt < NVT; ++vt) { u32x2 wv; wv[0] = cvt_pk_bf16(sacc[dd][vt][0], sacc[dd][vt][1]); wv[1] = cvt_pk_bf16(sacc[dd][vt][2], sacc[dd][vt][3]); *(LAS u32x2*)(sb_wr + 16 * vt * KP + 32 * dd) = wv; }
        if (c + 1 < 16) {
#pragma unroll
            for (int j = 0; j < 8; ++j) *(LAS u32x4*)(kst + 16 * j * KP) = kpre[j];
#pragma unroll
            for (int j = 0; j < NVLD; ++j) *(LAS u32x4*)(vst + VROWS * j * VP) = vpre[j];
        }
        wg_sync();
    }
#pragma unroll
    for (int dd = 0; dd < 2; ++dd)
#pragma unroll
        for (int vt = 0; vt < NVT; ++vt)
#pragma unroll
            for (int rr = 0; rr < 4; ++rr) state_out[(((size_t)b * H + h) * 256 + 16 * (2 * w + dd) + 4 * G + rr) * 512 + vs * VS + 16 * vt + l15] = sacc[dd][vt][rr];
}
DEV f32x4 bf4_to_f32(u32x2 w) { return (f32x4){__uint_as_float(w[0] << 16), __uint_as_float(w[0] & 0xffff0000u), __uint_as_float(w[1] << 16), __uint_as_float(w[1] & 0xffff0000u)}; }
DEV float half_sum(float v) { v += shflx(v, 16); v += shflx(v, 8); v += shflx(v, 4); v += shflx(v, 2); v += shflx(v, 1); return v; }
DEV void sattn_unit(LAS unsigned char* lds_wave, const bf16* z, int ldz, const float* cache, int g, int b, int t, int h, bf16* og, float* lse, int lane) {
    const int lbuf = 128 << (2 * g), dil = 1 << (2 * g), hf = lane >> 5, c32 = lane & 31;
    const int row = 8192 + b * 4 + t, qcol = g * 3 * 2048 + h * 128, kcol = qcol + 2048, vcol = qcol + 4096;
    const float scale = 0.08838834764831845f;
    LAS float* sc = (LAS float*)lds_wave;
    const f32x4 q4 = bf4_to_f32(*(const u32x2*)(z + (size_t)row * ldz + qcol + 4 * c32));
    const int jn = g == 0 ? t + 1 : 1;
    for (int j = 0; j < jn; ++j) {
        const int krow = 8192 + b * 4 + (t - dil * j);
        const f32x4 k4 = bf4_to_f32(*(const u32x2*)(z + (size_t)krow * ldz + kcol + 4 * c32));
        const float s = half_sum(q4[0] * k4[0] + q4[1] * k4[1] + q4[2] * k4[2] + q4[3] * k4[3]);
        if (lane == 0) sc[j] = s * scale;
    }
    const float* kbase = cache + (size_t)b * lbuf * 4096 + h * 128 + 4 * c32;
    const int nc = 129 - jn;
#pragma unroll 1
    for (int i = 0; i < nc; i += 16) {
        f32x4 k4[8];
#pragma unroll
        for (int u = 0; u < 8; ++u) { int j = jn + i + 2 * u + hf; j = j > 128 ? 128 : j; const int idx = lbuf + t - dil * j; k4[u] = *(const f32x4*)(kbase + (size_t)idx * 4096); }
#pragma unroll
        for (int u = 0; u < 8; ++u) { const int j = jn + i + 2 * u + hf; const float s = half_sum(q4[0] * k4[u][0] + q4[1] * k4[u][1] + q4[2] * k4[u][2] + q4[3] * k4[u][3]); if (c32 == 0 && j <= 128) sc[j] = s * scale; }
    }
    wave_sync();
    float s0 = sc[lane], s1 = sc[lane + 64], s2 = lane == 0 ? sc[128] : -INFINITY;
    float m = fmaxf(s0, fmaxf(s1, s2));
    m = fmaxf(m, shflx(m, 32)); m = fmaxf(m, shflx(m, 16)); m = fmaxf(m, shflx(m, 8)); m = fmaxf(m, shflx(m, 4)); m = fmaxf(m, shflx(m, 2)); m = fmaxf(m, shflx(m, 1));
    s0 = fast_exp(s0 - m); s1 = fast_exp(s1 - m); s2 = lane == 0 ? fast_exp(s2 - m) : 0.f;
    float sum = s0 + s1 + s2; sum += shflx(sum, 32); sum = half_sum(sum);
    wave_sync();
    sc[lane] = s0; sc[lane + 64] = s1; if (lane == 0) sc[128] = s2;
    wave_sync();
    f32x4 acc = {0.f, 0.f, 0.f, 0.f};
    for (int j = 0; j < jn; ++j) {
        const int krow = 8192 + b * 4 + (t - dil * j);
        const f32x4 v4 = bf4_to_f32(*(const u32x2*)(z + (size_t)krow * ldz + vcol + 4 * c32));
        const float pj = hf == 0 ? sc[j] : 0.f; acc += v4 * pj;
    }
#pragma unroll 1
    for (int i = 0; i < nc; i += 16) {
        f32x4 v4[8];
#pragma unroll
        for (int u = 0; u < 8; ++u) { int j = jn + i + 2 * u + hf; j = j > 128 ? 128 : j; const int idx = lbuf + t - dil * j; v4[u] = *(const f32x4*)(kbase + 2048 + (size_t)idx * 4096); }
#pragma unroll
        for (int u = 0; u < 8; ++u) { const int j = jn + i + 2 * u + hf; const float pj = j <= 128 ? sc[j] : 0.f; acc += v4[u] * pj; }
    }
#pragma unroll
    for (int e = 0; e < 4; ++e) acc[e] += shflx(acc[e], 32);
    const float inv = 1.0f / sum;
    if (hf == 0) { u32x2 wv; wv[0] = cvt_pk_bf16(acc[0] * inv, acc[1] * inv); wv[1] = cvt_pk_bf16(acc[2] * inv, acc[3] * inv); *(u32x2*)(og + ((size_t)g * ATT_ROWS + row) * 2048 + h * 128 + 4 * c32) = wv; }
    if (lane == 0) lse[((size_t)g * ATT_ROWS + row) * 16 + h] = m + fast_log(sum);
}
__device__ __forceinline__ void p0_transpose_item(const float* W, int K, int ld, int ncols, const float* gain, bf16* WT, LAS float* scr, int item, int lane) {
    const int nblk = ncols / 128, kb = item / nblk, nb = item % nblk, k0 = 32 * kb, n0 = 128 * nb;
    f32x4 v[16];
#pragma unroll
    for (int i = 0; i < 16; ++i) { const int kk = 2 * i + (lane >> 5); v[i] = *(const f32x4*)(W + (size_t)(k0 + kk) * ld + n0 + 4 * (lane & 31)); }
#pragma unroll
    for (int i = 0; i < 16; ++i) { const int kk = 2 * i + (lane >> 5); const float gk = gain ? gain[k0 + kk] : 1.0f; LAS float* d = scr + kk * 129 + 4 * (lane & 31);
        d[0] = v[i][0] * gk; d[1] = v[i][1] * gk; d[2] = v[i][2] * gk; d[3] = v[i][3] * gk; }
    asm volatile("s_waitcnt lgkmcnt(0)" ::: "memory");
    const int c = lane & 3;
#pragma unroll
    for (int j = 0; j < 8; ++j) { const int n = (lane >> 2) + 16 * j; const LAS float* s = scr + (8 * c) * 129 + n;
        u32x4 o; o.x = pk2(s[0 * 129], s[1 * 129]); o.y = pk2(s[2 * 129], s[3 * 129]); o.z = pk2(s[4 * 129], s[5 * 129]); o.w = pk2(s[6 * 129], s[7 * 129]);
        *(u32x4*)(WT + (size_t)(n0 + n) * K + k0 + 8 * c) = o; }
    asm volatile("s_waitcnt lgkmcnt(0)" ::: "memory");
}
__device__ __forceinline__ void p0_prologue(const Ctx& C, const Params& P) {
    LAS float* scr = (LAS float*)(C.lds + C.wave * 16640);
    const int gw = C.wg * 8 + C.wave, NGW = C.G * 8;
    const float* norm_g = C.norm_g;
    constexpr int I_A = (D / 32) * (A_IN / 128), I_B = (D / 32) * (B_IN / 128), I_C = (D / 32) * (C_INM / 128), I_OA = (2048 / 32) * (D / 128), I_OB = (4096 / 32) * (D / 128);
    constexpr int NITEMS = 2 * I_A + I_B + I_C + 3 * I_OA + I_OB;
    for (int it = gw; it < NITEMS; it += NGW) {
        int r = it;
        if (r < I_A) { p0_transpose_item(C.w_in_a, D, A_IN, A_IN, norm_g + 0 * D, C.wsp<bf16>(WS_WIA0), scr, r, C.lane); continue; } r -= I_A;
        if (r < I_A) { p0_transpose_item(C.w_in_a + (size_t)D * A_IN, D, A_IN, A_IN, norm_g + 3 * D, C.wsp<bf16>(WS_WIA1), scr, r, C.lane); continue; } r -= I_A;
        if (r < I_B) { p0_transpose_item(C.w_in_b, D, B_IN, B_IN, norm_g + 1 * D, C.wsp<bf16>(WS_WIB), scr, r, C.lane); continue; } r -= I_B;
        if (r < I_C) { p0_transpose_item(C.w_in_c, D, C_IN, C_INM, norm_g + 2 * D, C.wsp<bf16>(WS_WIC), scr, r, C.lane); continue; } r -= I_C;
        if (r < I_OA) { p0_transpose_item(C.w_out_a, 2048, D, D, nullptr, C.wsp<bf16>(WS_WOA0), scr, r, C.lane); continue; } r -= I_OA;
        if (r < I_OA) { p0_transpose_item(C.w_out_a + (size_t)2048 * D, 2048, D, D, nullptr, C.wsp<bf16>(WS_WOA1), scr, r, C.lane); continue; } r -= I_OA;
        if (r < I_OA) { p0_transpose_item(C.w_out_c, 2048, D, D, nullptr, C.wsp<bf16>(WS_WOC), scr, r, C.lane); continue; } r -= I_OA;
        p0_transpose_item(C.w_out_b, 4096, D, D, nullptr, C.wsp<bf16>(WS_WOB), scr, r, C.lane);
    }
    { bf16* wlr = C.wsp<bf16>(WS_WLR); const float* W = C.w_in_c; const float* g2 = norm_g + 2 * D;
      for (int e = C.wg * NWG_THREADS + C.tid; e < 32 * D; e += C.G * NWG_THREADS) { const int r = e / D, k = e % D; wlr[e] = r < 16 ? (bf16)f2bf(W[(size_t)k * C_IN + C_INM + r] * g2[k]) : (bf16)0; } }
    { float* xres = C.wsp<float>(WS_XRES); bf16* xb = C.wsp<bf16>(WS_XB); float* ss0 = C.sumsq(0);
      for (int row = gw; row < MT; row += NGW) {
          const float* src = row < MP ? C.x_prompt + (size_t)row * D : C.x_sample + (size_t)(row - MP) * D;
          float s = 0.f;
#pragma unroll
          for (int j = 0; j < 8; ++j) { const f32x4 v = *(const f32x4*)(src + 4 * C.lane + 256 * j); *(f32x4*)(xres + (size_t)row * D + 4 * C.lane + 256 * j) = v;
              u32x2 w; w.x = pk2(v[0], v[1]); w.y = pk2(v[2], v[3]); *(u32x2*)(xb + (size_t)row * D + 4 * C.lane + 256 * j) = w; s += (v[0] * v[0] + v[1] * v[1]) + (v[2] * v[2] + v[3] * v[3]); }
          s = wave_sum(s); if (C.lane == 0) ss0[row] = s; } }
    { f32x2* ta = C.wsp<f32x2>(WS_TABA); f32x2* tb = C.wsp<f32x2>(WS_TABB);
      for (int e = C.wg * NWG_THREADS + C.tid; e < 2052 * 16; e += C.G * NWG_THREADS) { const int pi = e >> 4, i = e & 15; const int pos = pi < 2048 ? pi : PAST + (pi - 2048); float s, c; sincos_d((double)pos * P.inv_a[i], s, c); ta[e] = (f32x2){c, s}; }
      for (int e = C.wg * NWG_THREADS + C.tid; e < 2052 * 128; e += C.G * NWG_THREADS) { const int pi = e >> 7, i = e & 127; const int pos = pi < 2048 ? pi : PAST + (pi - 2048); float s, c; sincos_d((double)pos * P.inv_b[i], s, c); tb[e] = (f32x2){c, s}; } }
}

template <int K, class EP>
__device__ __forceinline__ void skinny_gemm(const Ctx& C, const bf16* A, const bf16* Bt, int N, const EP& ep) {
    constexpr int KW = K / 8, NPASS = KW / 256, MAXCH = 5;
    const int fr = C.lane & 15, fq = C.lane >> 4, nch = N / 16;
    LAS float* part = (LAS float*)C.lds;
    for (int cb = C.wg; cb < nch; cb += C.G * MAXCH) {
        int ncur = 0;
#pragma unroll 1
        for (int j = 0; j < MAXCH; ++j) {
            const int ch = cb + j * C.G; if (ch >= nch) break;
            ++ncur;
            pg8::f32x4 acc0 = {0.f, 0.f, 0.f, 0.f}, acc1 = {0.f, 0.f, 0.f, 0.f};
#pragma unroll 1
            for (int ps = 0; ps < NPASS; ++ps) {
                const int kbase = C.wave * KW + ps * 256 + 8 * fq;
                const bf16* ap0 = A + (size_t)fr * K + kbase; const bf16* ap1 = A + (size_t)(16 + fr) * K + kbase; const bf16* bp = Bt + (size_t)(ch * 16 + fr) * K + kbase;
                bf16x8 a0[8], a1[8], bb[8];
#pragma unroll
                for (int s = 0; s < 8; ++s) { bb[s] = *(const bf16x8*)(bp + 32 * s); a0[s] = *(const bf16x8*)(ap0 + 32 * s); a1[s] = *(const bf16x8*)(ap1 + 32 * s); }
#pragma unroll
                for (int s = 0; s < 8; ++s) { acc0 = __builtin_amdgcn_mfma_f32_16x16x32_bf16(bb[s], a0[s], acc0, 0, 0, 0); acc1 = __builtin_amdgcn_mfma_f32_16x16x32_bf16(bb[s], a1[s], acc1, 0, 0, 0); }
            }
            LAS float* pj = part + ((size_t)(j * 8 + C.wave) * 2) * 4 * 64 + C.lane;
#pragma unroll
            for (int r = 0; r < 4; ++r) { pj[(0 * 4 + r) * 64] = acc0[r]; pj[(1 * 4 + r) * 64] = acc1[r]; }
        }
        __syncthreads();
        {
            const int l2 = C.tid & 63, mt = (C.tid >> 6) & 1, reg = C.tid >> 7;
            for (int j = 0; j < ncur; ++j) {
                float s = 0.f;
#pragma unroll
                for (int w = 0; w < 8; ++w) s += part[(((size_t)(j * 8 + w) * 2 + mt) * 4 + reg) * 64 + l2];
                const int ch = cb + j * C.G;
                ep(16 * mt + (l2 & 15), ch * 16 + 4 * (l2 >> 4) + reg, s);
            }
        }
        __syncthreads();
    }
}
#ifndef MK_ATTN_RUN
#define MK_ATTN_RUN 1
#endif

__device__ __forceinline__ float rstd_of(const float* ss, int row) { return rsqrtf(ss[row] * (1.0f / 2048.0f) + EPS); }
__device__ __forceinline__ void sfix_a(const Ctx& C, int layer, int slot) {
    const float* zs = C.wsp<float>(WS_ZSRAW); bf16* z = C.wsp<bf16>(WS_Z); const float* ss = C.sumsq(layer); const f32x2* ta = C.wsp<f32x2>(WS_TABA);
    float* skv = C.out + (size_t)MP * D + (size_t)MS * D + (size_t)2 * 4 * (128 + 512 + 2048) * 4096 + (size_t)4 * 8 * 256 * 512 + (size_t)4 * 4 * 256 * 512;
    for (int e = C.wg * NWG_THREADS + C.tid; e < MS * A_IN; e += C.G * NWG_THREADS) {
        const int r = e / A_IN, c = e % A_IN, row = MP + r, b = r >> 2, t = r & 3; const float rs = rstd_of(ss, row);
        const int section = c >> 11, within = c & 2047, d = within & 127, kind = section < 9 ? section % 3 : 3, g = section / 3;
        float v = zs[e] * rs;
        if (kind < 2 && d < 32) { const int i = d & 15; const float pv = zs[d < 16 ? e + 16 : e - 16] * rs; const f32x2 cs = ta[(2048 + t) * 16 + i]; v = d < 16 ? v * cs.x - pv * cs.y : pv * cs.y + v * cs.x; }
        z[(size_t)row * A_IN + c] = (bf16)f2bf(v);
        if (kind == 1 || kind == 2) skv[(size_t)g * (2 * 8 * 4 * 4096) + ((((size_t)slot * DB + b) * T + t) * 2 + (kind - 1)) * 2048 + within] = v;
    }
}
__device__ __forceinline__ void sfix_b(const Ctx& C, int layer) {
    const float* zs = C.wsp<float>(WS_ZSRAW); bf16* z = C.wsp<bf16>(WS_Z); const float* ss = C.sumsq(layer); const f32x2* tb = C.wsp<f32x2>(WS_TABB);
    for (int e = C.wg * NWG_THREADS + C.tid; e < MS * B_IN; e += C.G * NWG_THREADS) {
        const int r = e / B_IN, c = e % B_IN, row = MP + r, t = r & 3; const float rs = rstd_of(ss, row);
        float v = zs[e] * rs;
        if (c < 4096) { const int d = c & 255, i = d & 127; const float pv = zs[d < 128 ? e + 128 : e - 128] * rs; const f32x2 cs = tb[(2048 + t) * 128 + i]; v = d < 128 ? v * cs.x - pv * cs.y : pv * cs.y + v * cs.x; if (c >= 2048) v *= 0.0625f; }
        z[(size_t)row * B_IN + c] = (bf16)f2bf(v);
    }
}
__device__ __forceinline__ void sfix_c(const Ctx& C, int layer) {
    const float* zs = C.wsp<float>(WS_ZSRAW); bf16* z = C.wsp<bf16>(WS_Z); const float* ss = C.sumsq(layer);
    for (int e = C.wg * NWG_THREADS + C.tid; e < MS * C_INM; e += C.G * NWG_THREADS) {
        const int r = e / C_INM, c = e % C_INM, row = MP + r; const float rs = rstd_of(ss, row);
        float v = zs[e] * rs; if (c < 1024) v *= 0.0625f;
        z[(size_t)row * C_INM + c] = (bf16)f2bf(v);
    }
    const float* lr = C.wsp<float>(WS_LR); float* loga = C.wsp<float>(WS_LOGA); const float* wg2 = C.w_gate2_c; const float* bg = C.b_gate_c;
    for (int e = MP * 1024 + C.wg * NWG_THREADS + C.tid; e < MT * 1024; e += C.G * NWG_THREADS) {
        const int row = e >> 10, c = e & 1023; const float rs = rstd_of(ss, row);
        float a = 0.f;
#pragma unroll
        for (int r = 0; r < 16; ++r) a += lr[(size_t)row * 16 + r] * wg2[r * 1024 + c];
        a = a * rs + bg[c];
        loga[e] = (fminf(a, 0.f) - log1pf(__expf(-fabsf(a)))) * 0.0625f;
    }
}

__device__ __forceinline__ void gla_pre(const Ctx& C, int layer) {
    bf16* z = C.wsp<bf16>(WS_Z); const float* ss = C.sumsq(layer); const float* lr = C.wsp<float>(WS_LR); float* dvec = C.wsp<float>(WS_DVEC); const float* wg2 = C.w_gate2_c; const float* bg = C.b_gate_c;
    LAS float* lrs = (LAS float*)C.lds; LAS float* tot = lrs + 128 * 16; LAS bf16* ebs = (LAS bf16*)(C.lds + 16384);
    for (int u = C.wg; u < 256; u += C.G) {
        const int chunk = u >> 2, cq = u & 3, cl = C.tid & 255, col = cq * 256 + cl, ih = C.tid >> 8;
        { const int row = chunk * 128 + (C.tid >> 2); const f32x4 v = *(const f32x4*)(lr + (size_t)row * 16 + (C.tid & 3) * 4); *(LAS f32x4*)(lrs + C.tid * 4) = v * rstd_of(ss, row); }
        float wv[16];
#pragma unroll
        for (int r = 0; r < 16; ++r) wv[r] = wg2[r * 1024 + col];
        const float bgc = bg[col];
        __syncthreads();
        float la[64]; float run = 0.f;
#pragma unroll
        for (int j = 0; j < 64; ++j) {
            const LAS f32x4* lp = (const LAS f32x4*)(lrs + (ih * 64 + j) * 16);
            const f32x4 l0 = lp[0], l1 = lp[1], l2 = lp[2], l3 = lp[3];
            float a = bgc + l0[0] * wv[0] + l0[1] * wv[1] + l0[2] * wv[2] + l0[3] * wv[3] + l1[0] * wv[4] + l1[1] * wv[5] + l1[2] * wv[6] + l1[3] * wv[7]
                    + l2[0] * wv[8] + l2[1] * wv[9] + l2[2] * wv[10] + l2[3] * wv[11] + l3[0] * wv[12] + l3[1] * wv[13] + l3[2] * wv[14] + l3[3] * wv[15];
            run += (fminf(a, 0.f) - __logf(1.0f + __expf(-fabsf(a)))) * 0.0625f; la[j] = run;
        }
        if (ih == 0) tot[cl] = run;
        __syncthreads();
        const float off = ih ? tot[cl] : 0.f;
#pragma unroll
        for (int j = 0; j < 64; ++j) ebs[(ih * 64 + j) * 256 + cl] = (bf16)f2bf(__expf(la[j] + off));
        if (ih) dvec[(((size_t)(chunk >> 4) * 4 + (col >> 8)) * 16 + (chunk & 15)) * 256 + (col & 255)] = __expf(la[63] + off);
        __syncthreads();
#pragma unroll
        for (int j = 0; j < 8; ++j) {
            const int pc = C.tid + 512 * j, tk = pc >> 5, cg = pc & 31;
            bf16* zq = z + (size_t)(chunk * 128 + tk) * C_INM + cq * 256 + cg * 8;
            const u32x4 qv = *(const u32x4*)zq, kv = *(const u32x4*)(zq + 1024); const u32x4 ev = *(const LAS u32x4*)(ebs + tk * 256 + cg * 8);
            u32x4 qo, ko;
#pragma unroll
            for (int k = 0; k < 4; ++k) { const float e0 = __uint_as_float(ev[k] << 16), e1 = __uint_as_float(ev[k] & 0xffff0000u); const float i0 = 1.0f / e0, i1 = 1.0f / e1;
                qo[k] = pk2(__uint_as_float(qv[k] << 16) * e0, __uint_as_float(qv[k] & 0xffff0000u) * e1); ko[k] = pk2(__uint_as_float(kv[k] << 16) * i0, __uint_as_float(kv[k] & 0xffff0000u) * i1); }
            *(u32x4*)zq = qo; *(u32x4*)(zq + 1024) = ko;
        }
        __syncthreads();
    }
}
template <int NVT, class OT>
__device__ __forceinline__ void scan_phase(const Ctx& C, int ldz, int qoff, int koff, int voff, int H, const float* dvec, float* state_out) {
    const bf16* z = C.wsp<bf16>(WS_Z); OT* o = C.wsp<OT>(WS_O);
    const int nunits = NB * H * (512 / (16 * NVT));
    for (int u = C.wg; u < nunits; u += C.G) scan_unit<NVT, OT>(C.lds, z, ldz, qoff, koff, voff, H, u, dvec, o, H * 512, state_out, C.tid);
}

__device__ __forceinline__ float dot128_bb(const bf16* q, const bf16* k) {
    float a = 0.f;
#pragma unroll 4
    for (int i = 0; i < 16; ++i) { const u32x4 x = ((const u32x4*)q)[i], y = ((const u32x4*)k)[i];
#pragma unroll
        for (int j = 0; j < 4; ++j) a += __uint_as_float(x[j] << 16) * __uint_as_float(y[j] << 16) + __uint_as_float(x[j] & 0xffff0000u) * __uint_as_float(y[j] & 0xffff0000u); }
    return a;
}
__device__ __forceinline__ float dot128_bf(const bf16* q, const float* k) {
    float a = 0.f;
#pragma unroll 4
    for (int i = 0; i < 16; ++i) { const u32x4 x = ((const u32x4*)q)[i]; const f32x4 y0 = ((const f32x4*)k)[2 * i], y1 = ((const f32x4*)k)[2 * i + 1];
        a += __uint_as_float(x[0] << 16) * y0[0] + __uint_as_float(x[0] & 0xffff0000u) * y0[1] + __uint_as_float(x[1] << 16) * y0[2] + __uint_as_float(x[1] & 0xffff0000u) * y0[3]
           + __uint_as_float(x[2] << 16) * y1[0] + __uint_as_float(x[2] & 0xffff0000u) * y1[1] + __uint_as_float(x[3] << 16) * y1[2] + __uint_as_float(x[3] & 0xffff0000u) * y1[3]; }
    return a;
}
template <bool GLA, class OT>
__device__ __forceinline__ void recur_naive(const Ctx& C, int ldz, int qoff, int koff, int voff, int H, int nseq, int ntok, int row0, const float* state0, float* state_out) {
    const bf16* z = C.wsp<bf16>(WS_Z); OT* o = C.wsp<OT>(WS_O); const float* loga = C.wsp<float>(WS_LOGA);
    LAS float* red = (LAS float*)C.lds;
    const int d = C.tid & 255, vh = C.tid >> 8, lane = C.lane, wave = C.wave;
    for (int item = C.wg; item < nseq * H * 8; item += C.G) {
        const int vs = item & 7, h = (item >> 3) % H, seq = (item >> 3) / H;
        const int v0 = vs * 64 + vh * 32;
        float Sreg[32];
        const size_t sbase = (((size_t)seq * H + h) * 256 + d) * 512 + v0;
#pragma unroll
        for (int i = 0; i < 32; ++i) Sreg[i] = state0 ? state0[sbase + i] : 0.f;
        float gamma = 1.f; if (!GLA) gamma = 1.0f - exp2f(-5.0f - (float)h);
        for (int t = 0; t < ntok; ++t) {
            const int row = row0 + seq * ntok + t; const bf16* zr = z + (size_t)row * ldz;
            const float qd = bf2f(zr[qoff + h * 256 + d]), kd = bf2f(zr[koff + h * 256 + d]);
            float dec = gamma; if (GLA) dec = __expf(loga[(size_t)row * 1024 + h * 256 + d]);
            const unsigned* vp = (const unsigned*)(zr + voff + h * 512 + v0);
            float p[32];
#pragma unroll
            for (int i = 0; i < 16; ++i) { const unsigned w = vp[i]; const float va = __uint_as_float(w << 16), vb = __uint_as_float(w & 0xffff0000u);
                Sreg[2 * i] = dec * Sreg[2 * i] + kd * va; Sreg[2 * i + 1] = dec * Sreg[2 * i + 1] + kd * vb; p[2 * i] = qd * Sreg[2 * i]; p[2 * i + 1] = qd * Sreg[2 * i + 1]; }
#pragma unroll
            for (int i = 0; i < 32; ++i) p[i] = wave_sum(p[i]);
            float mine = 0.f;
#pragma unroll
            for (int i = 0; i < 32; ++i) if (lane == i) mine = p[i];
            if (lane < 32) red[((t & 1) * 8 + wave) * 32 + lane] = mine;
            __syncthreads();
            if (d < 32) { const LAS float* rr = red + ((t & 1) * 8 + vh * 4) * 32 + d; const float ov = rr[0] + rr[32] + rr[64] + rr[96]; if constexpr (sizeof(OT) == 2) o[(size_t)row * (H * 512) + h * 512 + v0 + d] = (OT)f2bf(ov); else o[(size_t)row * (H * 512) + h * 512 + v0 + d] = ov; }
        }
#pragma unroll
        for (int i = 0; i < 32; ++i) state_out[sbase + i] = Sreg[i];
        __syncthreads();
    }
}
template <bool MEAN, class OT>
__device__ __forceinline__ void norm_gate(const Ctx& C, int H, int ldz, int goff, const float* gn) {
    const bf16* z = C.wsp<bf16>(WS_Z); const OT* o = C.wsp<OT>(WS_O); bf16* y = C.wsp<bf16>(WS_Y); const int lane = C.lane;
    for (int w0 = (C.wg * 8 + C.wave) * 4; w0 < MT * H; w0 += C.G * 8 * 4) {
        u32x4 ov4[4]; f32x4 oa[4], ob[4]; u32x4 gw[4]; f32x4 g0[4], g1[4];
#pragma unroll
        for (int k = 0; k < 4; ++k) { const int w = w0 + k, row = w / H, h = w % H; const OT* orow = o + (size_t)row * (H * 512) + h * 512;
            if constexpr (sizeof(OT) == 2) ov4[k] = ((const u32x4*)orow)[lane]; else { oa[k] = ((const f32x4*)orow)[2 * lane]; ob[k] = ((const f32x4*)orow)[2 * lane + 1]; }
            gw[k] = ((const u32x4*)(z + (size_t)row * ldz + goff + h * 512))[lane];
            g0[k] = ((const f32x4*)(gn + h * 512))[2 * lane]; g1[k] = ((const f32x4*)(gn + h * 512))[2 * lane + 1]; }
#pragma unroll
        for (int k = 0; k < 4; ++k) {
            const int w = w0 + k, row = w / H, h = w % H;
            float v[8];
            if constexpr (sizeof(OT) != 2) { v[0] = oa[k][0]; v[1] = oa[k][1]; v[2] = oa[k][2]; v[3] = oa[k][3]; v[4] = ob[k][0]; v[5] = ob[k][1]; v[6] = ob[k][2]; v[7] = ob[k][3]; }
            else { const float vv[8] = {__uint_as_float(ov4[k][0] << 16), __uint_as_float(ov4[k][0] & 0xffff0000u), __uint_as_float(ov4[k][1] << 16), __uint_as_float(ov4[k][1] & 0xffff0000u),
                          __uint_as_float(ov4[k][2] << 16), __uint_as_float(ov4[k][2] & 0xffff0000u), __uint_as_float(ov4[k][3] << 16), __uint_as_float(ov4[k][3] & 0xffff0000u)};
#pragma unroll
                for (int i = 0; i < 8; ++i) v[i] = vv[i]; }
            float s = 0.f;
#pragma unroll
            for (int i = 0; i < 8; ++i) s += v[i];
            float mu = 0.f; if (MEAN) mu = wave_sum(s) * (1.f / 512.f);
            float q = 0.f;
#pragma unroll
            for (int i = 0; i < 8; ++i) { v[i] -= mu; q += v[i] * v[i]; }
            const float r = rsqrtf(wave_sum(q) * (1.f / 512.f) + EPS);
            const float gg[8] = {g0[k][0], g0[k][1], g0[k][2], g0[k][3], g1[k][0], g1[k][1], g1[k][2], g1[k][3]};
            float ov[8];
#pragma unroll
            for (int i = 0; i < 4; ++i) { ov[2 * i] = v[2 * i] * r * gg[2 * i] * silu(__uint_as_float(gw[k][i] << 16)); ov[2 * i + 1] = v[2 * i + 1] * r * gg[2 * i + 1] * silu(__uint_as_float(gw[k][i] & 0xffff0000u)); }
            u32x4 ow; ow.x = pk2(ov[0], ov[1]); ow.y = pk2(ov[2], ov[3]); ow.z = pk2(ov[4], ov[5]); ow.w = pk2(ov[6], ov[7]);
            ((u32x4*)(y + (size_t)row * (H * 512) + h * 512))[lane] = ow;
        }
    }
}
__device__ __forceinline__ void final_norm(const Ctx& C) {
    const float* xres = C.wsp<float>(WS_XRES); const float* ss = C.sumsq(4); const float* fg = C.final_g;
    for (int row = C.wg * 8 + C.wave; row < MT; row += C.G * 8) {
        const float rs = rstd_of(ss, row);
#pragma unroll
        for (int j = 0; j < 8; ++j) { const int c = 4 * C.lane + 256 * j; const f32x4 v = *(const f32x4*)(xres + (size_t)row * D + c), g = *(const f32x4*)(fg + c); *(f32x4*)(C.out + (size_t)row * D + c) = v * rs * g; }
    }
}

__device__ __forceinline__ void attn_fast_phase(const Ctx& C) {
    const bf16* z = C.wsp<bf16>(WS_Z); bf16* og = C.wsp<bf16>(WS_O); float* lse = C.wsp<float>(WS_LOGA);
    const int per = (3072 + C.G - 1) / C.G;
    const int i0 = C.wg * per; int n = 3072 - i0; n = n > per ? per : n;
#if MK_ATTN_RUN
    if (n > 0) attn_run(C.lds, z, A_IN, og, lse, i0, n, C.tid);
#else
    for (int j = 0; j < n; ++j) attn_item(C.lds, z, A_IN, og, lse, i0 + j, C.tid);
#endif
}
__device__ __forceinline__ void sattn_phase(const Ctx& C, int slot, const float* c1, const float* c2, const float* c3) {
    const bf16* z = C.wsp<bf16>(WS_Z); bf16* og = C.wsp<bf16>(WS_O); float* lse = C.wsp<float>(WS_LOGA);
    for (int u0 = C.wg * 6; u0 < 1536; u0 += C.G * 6) {
        const int u = u0 + C.wave;
        if (C.wave < 6 && u < 1536) {
            const int t = u & 3, h = (u >> 2) & 15, b = (u >> 6) & 7, g = u >> 9;
            const float* cache = c1; if (g == 1) cache = c2; if (g == 2) cache = c3;
            sattn_unit(C.lds + C.wave * 1024, z, A_IN, cache + (size_t)slot * 8 * (128 << (2 * g)) * 4096, g, b, t, h, og, lse, C.lane);
        }
    }
}
__device__ __forceinline__ void attn_merge(const Ctx& C) {
    const bf16* z = C.wsp<bf16>(WS_Z); const bf16* og = C.wsp<bf16>(WS_O); const float* lse = C.wsp<float>(WS_LOGA); bf16* y = C.wsp<bf16>(WS_Y);
    for (int row = C.wg * 8 + C.wave; row < MT; row += C.G * 8) {
#pragma unroll
        for (int j = 0; j < 4; ++j) {
            const int ch = C.lane + 64 * j, col = ch * 8, h = col >> 7;
            const float l0 = lse[((size_t)0 * MT + row) * 16 + h], l1 = lse[((size_t)1 * MT + row) * 16 + h], l2 = lse[((size_t)2 * MT + row) * 16 + h];
            const float m = fmaxf(l0, fmaxf(l1, l2)); float w0 = __expf(l0 - m), w1 = __expf(l1 - m), w2 = __expf(l2 - m); const float inv = 1.0f / (w0 + w1 + w2); w0 *= inv; w1 *= inv; w2 *= inv;
            const u32x4 a = *(const u32x4*)(og + ((size_t)0 * MT + row) * 2048 + col), b = *(const u32x4*)(og + ((size_t)1 * MT + row) * 2048 + col), c = *(const u32x4*)(og + ((size_t)2 * MT + row) * 2048 + col);
            const u32x4 gt = *(const u32x4*)(z + (size_t)row * A_IN + 18432 + col);
            u32x4 o;
#pragma unroll
            for (int k = 0; k < 4; ++k) {
                const float lo = (w0 * __uint_as_float(a[k] << 16) + w1 * __uint_as_float(b[k] << 16) + w2 * __uint_as_float(c[k] << 16)) * silu(__uint_as_float(gt[k] << 16));
                const float hi = (w0 * __uint_as_float(a[k] & 0xffff0000u) + w1 * __uint_as_float(b[k] & 0xffff0000u) + w2 * __uint_as_float(c[k] & 0xffff0000u)) * silu(__uint_as_float(gt[k] & 0xffff0000u));
                o[k] = pk2(lo, hi);
            }
            *(u32x4*)(y + (size_t)row * 2048 + col) = o;
        }
    }
}

template <int MODE>
__device__ __forceinline__ void gemm_in(const Ctx& C, size_t wt_off, int N, int layer, float* kvb, int slot) {
    pg8::Gemm g{C.wsp<pg8::bf16_t>(WS_XB), C.wsp<pg8::bf16_t>(wt_off), MP, N, D}; pg8::StaticOrder So; So.init(MP, N, C.G, C.wg);
    pg8::EpiIn<MODE> E{C.wsp<pg8::bf16_t>(WS_Z), N, C.sumsq(layer), (const pg8::f32x2*)C.wsp<f32x2>(MODE == 0 ? WS_TABA : WS_TABB), kvb, slot};
    pg8::gemm_phase<pg8::EpiIn<MODE>, pg8::StaticOrder, true, true>((PG8_LAS unsigned char*)C.lds, g, So, E);
}
template <int K>
__device__ __forceinline__ void gemm_out(const Ctx& C, size_t wt_off, int layer) {
    pg8::Gemm g{C.wsp<pg8::bf16_t>(WS_Y), C.wsp<pg8::bf16_t>(wt_off), MP, D, K}; pg8::StaticOrder So; So.init(MP, D, C.G, C.wg);
    pg8::EpiOut E{C.wsp<float>(WS_XRES), C.wsp<pg8::bf16_t>(WS_XB), C.sumsq(layer + 1)};
    pg8::gemm_phase<pg8::EpiOut, pg8::StaticOrder, true, true>((PG8_LAS unsigned char*)C.lds, g, So, E);
    float* xres = C.wsp<float>(WS_XRES); bf16* xb = C.wsp<bf16>(WS_XB); float* ssn = C.sumsq(layer + 1); const int lane = C.lane;
    skinny_gemm<K>(C, C.wsp<bf16>(WS_Y) + (size_t)MP * K, C.wsp<bf16>(wt_off), D, [=](int m, int n, float v) {
        const size_t o = (size_t)(MP + m) * D + n; const float x = xres[o] + v; xres[o] = x; xb[o] = (bf16)f2bf(x);
        float s = x * x; s += __shfl_xor(s, 16); s += __shfl_xor(s, 32); if ((lane >> 4) == 0) atomicAdd(ssn + MP + m, s); });
}
__device__ __forceinline__ void skinny_in(const Ctx& C, size_t wt_off, int N) {
    float* zs = C.wsp<float>(WS_ZSRAW);
    skinny_gemm<D>(C, C.wsp<bf16>(WS_XB) + (size_t)MP * D, C.wsp<bf16>(wt_off), N, [=](int m, int n, float v) { zs[(size_t)m * N + n] = v; });
}

__global__ void __launch_bounds__(NWG_THREADS, 2) mk_fwd(Params P) {
    extern __shared__ __attribute__((aligned(16))) unsigned char lds_raw[];
    Ctx C; C.lds = (LAS unsigned char*)lds_raw; C.tid = threadIdx.x; C.lane = C.tid & 63; C.wave = __builtin_amdgcn_readfirstlane(C.tid >> 6); C.G = gridDim.x; C.wg = blockIdx.x;
    C.x_prompt = P.in[0];
    C.x_sample = P.in[1];
    C.cache1 = P.in[2];
    C.cache2 = P.in[3];
    C.cache3 = P.in[4];
    C.state_b = P.in[5];
    C.state_c = P.in[6];
    C.norm_g = P.in[7];
    C.final_g = P.in[8];
    C.w_in_a = P.in[9];
    C.w_out_a = P.in[10];
    C.w_in_b = P.in[11];
    C.gn_b = P.in[12];
    C.w_out_b = P.in[13];
    C.w_in_c = P.in[14];
    C.w_gate2_c = P.in[15];
    C.b_gate_c = P.in[16];
    C.gn_c = P.in[17];
    C.w_out_c = P.in[18];
    C.out = P.out; C.ws = P.ws;
    volatile LAS unsigned* MISC = (volatile LAS unsigned*)(C.lds + MISC_OFF);
    if (C.tid < 32) MISC[C.tid] = 0u;
    __syncthreads();
    XcdBarrier bar = xcd_barrier_post((unsigned*)(P.ws + CTL_BAR), MISC + 8);
    int ph = 0;
#define RUN (ph >= P.ph_lo && ph < P.ph_hi)
#define SEAM() do { if (ph >= P.ph_lo && ph + 1 < P.ph_hi) xcd_barrier(bar); ++ph; } while (0)
    float* out = P.out;
    float* pkv1 = out + (size_t)MP * D + (size_t)MS * D; float* pkv2 = pkv1 + (size_t)2 * 4 * 128 * 4096; float* pkv3 = pkv2 + (size_t)2 * 4 * 512 * 4096;
    float* pst_b = pkv3 + (size_t)2 * 4 * 2048 * 4096; float* pst_c = pst_b + (size_t)4 * 8 * 256 * 512;
    float* sst_b = pst_c + (size_t)4 * 4 * 256 * 512 + (size_t)3 * 2 * 8 * 4 * 4096; float* sst_c = sst_b + (size_t)8 * 8 * 256 * 512;

    if (RUN) p0_prologue(C, P);
    SEAM();
    if (RUN) { gemm_in<0>(C, WS_WIA0, A_IN, 0, pkv1, 0); skinny_in(C, WS_WIA0, A_IN); }
    SEAM();
    if (RUN) sfix_a(C, 0, 0);
    SEAM();
    if (RUN) { attn_fast_phase(C); sattn_phase(C, 0, P.in[2], P.in[3], P.in[4]); }
    SEAM();
    if (RUN) attn_merge(C);
    SEAM();
    if (RUN) gemm_out<2048>(C, WS_WOA0, 0);
    SEAM();
    if (RUN) { gemm_in<1>(C, WS_WIB, B_IN, 1, nullptr, 0); skinny_in(C, WS_WIB, B_IN); }
    SEAM();
    if (RUN) sfix_b(C, 1);
    SEAM();
    if (RUN) { scan_phase<4, float>(C, B_IN, 0, 2048, 4096, 8, nullptr, pst_b); recur_naive<false, float>(C, B_IN, 0, 2048, 4096, 8, DB, T, MP, C.state_b, sst_b); }
    SEAM();
    if (RUN) norm_gate<true, float>(C, 8, B_IN, 8192, C.gn_b);
    SEAM();
    if (RUN) gemm_out<4096>(C, WS_WOB, 1);
    SEAM();
    if (RUN) { gemm_in<2>(C, WS_WIC, C_INM, 2, nullptr, 0); skinny_in(C, WS_WIC, C_INM);
        float* lr = C.wsp<float>(WS_LR);
        skinny_gemm<D>(C, C.wsp<bf16>(WS_WLR), C.wsp<bf16>(WS_XB), MT, [=](int m, int n, float v) { if (m < 16) lr[(size_t)n * 16 + m] = v; }); }
    SEAM();
    if (RUN) { sfix_c(C, 2); gla_pre(C, 2); }
    SEAM();
    if (RUN) { scan_phase<2, float>(C, C_INM, 0, 1024, 2048, 4, C.wsp<float>(WS_DVEC), pst_c); recur_naive<true, float>(C, C_INM, 0, 1024, 2048, 4, DB, T, MP, C.state_c, sst_c); }
    SEAM();
    if (RUN) norm_gate<false, float>(C, 4, C_INM, 4096, C.gn_c);
    SEAM();
    if (RUN) gemm_out<2048>(C, WS_WOC, 2);
    SEAM();
    if (RUN) { gemm_in<0>(C, WS_WIA1, A_IN, 3, pkv1, 1); skinny_in(C, WS_WIA1, A_IN); }
    SEAM();
    if (RUN) sfix_a(C, 3, 1);
    SEAM();
    if (RUN) { attn_fast_phase(C); sattn_phase(C, 1, P.in[2], P.in[3], P.in[4]); }
    SEAM();
    if (RUN) attn_merge(C);
    SEAM();
    if (RUN) gemm_out<2048>(C, WS_WOA1, 3);
    SEAM();
    if (RUN) final_norm(C);
#undef RUN
#undef SEAM
}
constexpr int NPHASES = 22;
}

#ifndef MK_PRE
#define MK_PRE -1
#endif
#ifndef MK_LAUNCHES
#define MK_LAUNCHES 1
#endif
extern "C" void kernel_launch(void* const* d_in, const int* in_sizes, int n_in, void* d_out, int out_size, void* d_ws, size_t ws_size, hipStream_t stream) {
    using namespace mk;
    static int grid = 0;
    if (grid == 0) {
        int dev = 0, cus = 0;
        if (hipGetDevice(&dev) != hipSuccess || hipDeviceGetAttribute(&cus, hipDeviceAttributeMultiprocessorCount, dev) != hipSuccess) { fprintf(stderr, "kernel_launch: device query failed\n"); grid = -1; return; }
        if (hipFuncSetAttribute((const void*)mk_fwd, hipFuncAttributeMaxDynamicSharedMemorySize, LDS_BYTES) != hipSuccess) { fprintf(stderr, "kernel_launch: hipFuncSetAttribute failed\n"); grid = -1; return; }
        int per_cu = 0;
        if (hipOccupancyMaxActiveBlocksPerMultiprocessor(&per_cu, (const void*)mk_fwd, NWG_THREADS, LDS_BYTES) != hipSuccess || per_cu < 1) fprintf(stderr, "kernel_launch: occupancy query says %d\n", per_cu);
        (void)hipGetLastError();
        if (ws_size < WS_END) { fprintf(stderr, "kernel_launch: workspace too small (%zu < %zu)\n", ws_size, (size_t)WS_END); grid = -1; return; }
        grid = cus;
    }
    if (grid < 0) return;
    (void)hipMemsetAsync((char*)d_ws + WS_CTL, 0, CTL_ZERO_BYTES, stream);
    Params p{};
    for (int i = 0; i < 19; ++i) p.in[i] = (const float*)d_in[i];
    p.out = (float*)d_out; p.ws = (unsigned char*)d_ws;
    for (int i = 0; i < 16; ++i) p.inv_a[i] = pow(500000.0, -(double)i / 16.0);
    for (int i = 0; i < 128; ++i) p.inv_b[i] = pow(10000.0, -(double)i / 128.0);
    if (MK_PRE >= 0) { p.ph_lo = MK_PRE; p.ph_hi = MK_PRE + 1; hipLaunchKernelGGL(mk_fwd, dim3(grid), dim3(NWG_THREADS), LDS_BYTES, stream, p); (void)hipMemsetAsync((char*)d_ws + WS_CTL, 0, CTL_ZERO_BYTES, stream); }
    if (MK_LAUNCHES == 1) { p.ph_lo = 0; p.ph_hi = NPHASES; hipLaunchKernelGGL(mk_fwd, dim3(grid), dim3(NWG_THREADS), LDS_BYTES, stream, p); }
    else for (int k = 0; k < NPHASES; ++k) { p.ph_lo = k; p.ph_hi = k + 1; hipLaunchKernelGGL(mk_fwd, dim3(grid), dim3(NWG_THREADS), LDS_BYTES, stream, p); }
}
```

```cpp
#include <hip/hip_runtime.h>
#include <cstdio>
#include <cstdint>
#include <cmath>
namespace pg8 {
#define PG8_LAS __attribute__((address_space(3)))
typedef unsigned short bf16_t;
typedef short bf16x8 __attribute__((ext_vector_type(8)));
typedef float f32x4 __attribute__((ext_vector_type(4)));
typedef unsigned u32x4 __attribute__((ext_vector_type(4)));
constexpr int BM = 256, BK = 64, HALF = 128, HTB = HALF * BK * 2  , STAGE_BYTES = 8 * HTB, NXCD = 8, WGM = 8;

__host__ __device__ __forceinline__ int lds_byte(int r, int c) { const int st = (r >> 4) * 2 + (c >> 5), rr = r & 15, cc = c & 31, ob = rr * 64 + cc * 2; return st * 1024 + (ob ^ (((ob >> 9) & 1) << 5)); }
__host__ __device__ __forceinline__ void stage_rc(int b, int& R, int& C) { const int st = b / 1024, sb = b % 1024, swz = sb ^ (((sb >> 9) & 1) << 5); R = (st >> 1) * 16 + swz / 64; C = (st & 1) * 32 + (swz % 64) / 2; }
__host__ __device__ __forceinline__ int perm32(int rho) { const int n = rho >> 4, i = rho & 15; return 8 * (i >> 2) + 4 * n + (i & 3); }

struct Unit { int pm, pn; };
struct Gemm { const bf16_t* A; const bf16_t* Bt; int M, N, K; };

struct StaticOrder {
    int nM, nN, nwg, G, c;
    __host__ __device__ void init(int M, int N, int G_, int c_) { nM = M / BM; nN = N / BM; nwg = nM * nN; G = G_; c = c_; }
    __host__ __device__ bool next(int i, Unit& u) const {
        const long L = (long)i * G + c; if (L >= nwg) return false;
        int wgid = (int)L; { const int q = nwg / NXCD, r = nwg % NXCD, xcd = wgid % NXCD, off = wgid / NXCD; wgid = (xcd < r ? xcd * (q + 1) : r * (q + 1) + (xcd - r) * q) + off; }
        const int nig = WGM * nN, gid = wgid / nig, fm = gid * WGM, gsz = (nM - fm) < WGM ? (nM - fm) : WGM;
        u.pm = fm + ((wgid % nig) % gsz); u.pn = (wgid % nig) / gsz; return true;
    }
    __device__ __forceinline__ void a_ready(const Unit&) const {}
    __device__ __forceinline__ void done(const Unit&) const {}
};

__device__ __forceinline__ unsigned cvt_pk_bf16(float lo, float hi) { unsigned r; asm volatile("v_cvt_pk_bf16_f32 %0, %1, %2" : "=v"(r) : "v"(lo), "v"(hi)); return r; }
typedef float f32x2 __attribute__((ext_vector_type(2)));
typedef unsigned u32x2 __attribute__((ext_vector_type(2)));

__device__ __forceinline__ float rstd32(const float* part, int row) { const f32x4* p = (const f32x4*)(part + (size_t)row * 32); f32x4 s = p[0];
#pragma unroll
    for (int i = 1; i < 8; ++i) s += p[i];
    return rsqrtf(((s[0] + s[1]) + (s[2] + s[3])) * (1.0f / 2048.0f) + 1e-6f); }
template <int MODE> struct EpiIn {
    static constexpr bool PERM = true, AFTER_DRAIN = false;
    bf16_t* Z; int ldz; const float* sumsq; const f32x2* tab; float* kvb; int slot; const PG8_LAS float* rs_lds; int pm0;
    __device__ __forceinline__ float rs_of(const Unit& u, int row) const { return u.pm == pm0 ? rs_lds[row & 255] : rstd32(sumsq, row); }
    __device__ __forceinline__ void store8(bf16_t* p, const f32x4& a, const f32x4& b) const {
        u32x4 w; w.x = cvt_pk_bf16(a[0], a[1]); w.y = cvt_pk_bf16(a[2], a[3]); w.z = cvt_pk_bf16(b[0], b[1]); w.w = cvt_pk_bf16(b[2], b[3]); *(u32x4*)p = w; }
    __device__ __forceinline__ void operator()(const f32x4 (&acc)[2][2][4][2], const Unit& u, int wr, int wc, int fr, int fq) const {
        const int row0 = u.pm * BM + wr * 64 + fr, colt = u.pn * BM;
        if constexpr (MODE == 0) {
            const int section = u.pn >> 3, kind = section < 9 ? section % 3 : 3, g = section / 3;
            const bool rot = (kind < 2) && (wc == 0);
            const int gg = g > 2 ? 2 : g, keep = 128 << (2 * gg); float* kvo = kvb + (size_t)32768 * (size_t)(128 * (((1 << (2 * gg)) - 1) / 3)) + (size_t)slot * 4 * keep * 4096;
#pragma unroll
            for (int ai = 0; ai < 2; ++ai)
#pragma unroll
                for (int m = 0; m < 4; ++m) {
                    const int row = row0 + ai * HALF + m * 16; const float rs = rs_of(u, row); const int pos = row & 2047, b = row >> 11;
#pragma unroll
                    for (int bj = 0; bj < 2; ++bj) {
                        f32x4 v0 = acc[ai][bj][m][0] * rs, v1 = acc[ai][bj][m][1] * rs;
                        const int col = colt + bj * HALF + wc * 32 + 8 * fq;
                        if (rot) {
                            f32x4 p0, p1;
#pragma unroll
                            for (int j = 0; j < 4; ++j) { p0[j] = __shfl_xor(v0[j], 32); p1[j] = __shfl_xor(v1[j], 32); }
                            const f32x4* tp = (const f32x4*)(tab + pos * 16 + 8 * (fq & 1));
                            const f32x4 t0 = tp[0], t1 = tp[1], t2 = tp[2], t3 = tp[3];
                            const f32x4 c0 = {t0[0], t0[2], t1[0], t1[2]}, s0 = {t0[1], t0[3], t1[1], t1[3]}, c1 = {t2[0], t2[2], t3[0], t3[2]}, s1 = {t2[1], t2[3], t3[1], t3[3]};
                            if (fq < 2) { v0 = v0 * c0 - p0 * s0; v1 = v1 * c1 - p1 * s1; } else { v0 = p0 * s0 + v0 * c0; v1 = p1 * s1 + v1 * c1; }
                        }
                        store8(Z + ((size_t)(col >> 7) * 8224 + row) * 128 + (col & 127), v0, v1);
                        if (kind == 1 || kind == 2) {
                            if (pos >= 2048 - keep) { float* o = kvo + (((size_t)b * keep + (pos - (2048 - keep))) * 2 + (kind - 1)) * 2048 + (col - section * 2048);
                                *(f32x4*)o = v0; *(f32x4*)(o + 4) = v1; }
                        }
                    }
                }
        } else if constexpr (MODE == 1) {
            const bool rot = u.pn < 16; const float sc = (u.pn >= 8 && u.pn < 16) ? 0.0625f : 1.0f;
            const float lg2 = log2f(1.0f - exp2f(-5.0f - (float)(u.pn & 7)));
#pragma unroll
            for (int ai = 0; ai < 2; ++ai)
#pragma unroll
                for (int m = 0; m < 4; ++m) {
                    const int row = row0 + ai * HALF + m * 16; const int pos = row & 2047;
                    float rs = rs_of(u, row) * sc;
                    if (rot) { const float ee = (float)((pos & 127) + 1) * lg2; rs *= exp2f(u.pn < 8 ? ee : -ee); }
                    f32x4 x1[2], x2[2];
#pragma unroll
                    for (int n = 0; n < 2; ++n) { x1[n] = acc[ai][0][m][n] * rs; x2[n] = acc[ai][1][m][n] * rs; }
                    if (rot) {
#pragma unroll
                        for (int n = 0; n < 2; ++n) {
                            const f32x4* tp = (const f32x4*)(tab + pos * 128 + wc * 32 + 8 * fq + 4 * n);
                            const f32x4 t0 = tp[0], t1 = tp[1];
                            const f32x4 c = {t0[0], t0[2], t1[0], t1[2]}, s = {t0[1], t0[3], t1[1], t1[3]};
                            const f32x4 a = x1[n], bb = x2[n];
                            x1[n] = a * c - bb * s; x2[n] = a * s + bb * c;
                        }
                    }
                    bf16_t* zp = Z + (size_t)row * ldz + colt + wc * 32 + 8 * fq;
                    store8(zp, x1[0], x1[1]); store8(zp + HALF, x2[0], x2[1]);
                }
        } else {
            const float sc = u.pn < 4 ? 0.0625f : 1.0f;
#pragma unroll
            for (int ai = 0; ai < 2; ++ai)
#pragma unroll
                for (int m = 0; m < 4; ++m) {
                    const int row = row0 + ai * HALF + m * 16; const float rs = rs_of(u, row) * sc;
                    bf16_t* zp = Z + (size_t)row * ldz + colt + wc * 32 + 8 * fq;
#pragma unroll
                    for (int bj = 0; bj < 2; ++bj) store8(zp + bj * HALF, acc[ai][bj][m][0] * rs, acc[ai][bj][m][1] * rs);
                }
        }
    }
};
struct EpiOut {
    static constexpr bool PERM = false, AFTER_DRAIN = false;
    bf16_t* xb; float* sumsq_next;
    __device__ __forceinline__ void operator()(const f32x4 (&acc)[2][2][4][2], const Unit& u, int wr, int wc, int fr, int fq) const {
        const int row0 = u.pm * BM + wr * 64 + fr, col0 = u.pn * BM + wc * 32 + 4 * fq;
#pragma unroll
        for (int ai = 0; ai < 2; ++ai)
#pragma unroll
            for (int m = 0; m < 4; ++m) {
                const int row = row0 + ai * HALF + m * 16; float ss = 0.f;
                bf16_t* br = xb + (size_t)row * 2048 + col0;
                u32x2 old[2][2];
#pragma unroll
                for (int bj = 0; bj < 2; ++bj)
#pragma unroll
                    for (int n = 0; n < 2; ++n) old[bj][n] = *(const u32x2*)(br + bj * HALF + n * 16);
#pragma unroll
                for (int bj = 0; bj < 2; ++bj)
#pragma unroll
                    for (int n = 0; n < 2; ++n) {
                        const u32x2 o = old[bj][n];
                        const f32x4 xo = {__uint_as_float(o.x << 16), __uint_as_float(o.x & 0xffff0000u), __uint_as_float(o.y << 16), __uint_as_float(o.y & 0xffff0000u)};
                        const f32x4 v = xo + acc[ai][bj][m][n];
                        u32x2 w; w.x = cvt_pk_bf16(v[0], v[1]); w.y = cvt_pk_bf16(v[2], v[3]); *(u32x2*)(br + bj * HALF + n * 16) = w;
                        ss += (v[0] * v[0] + v[1] * v[1]) + (v[2] * v[2] + v[3] * v[3]);
                    }
                ss += __shfl_xor(ss, 16); ss += __shfl_xor(ss, 32);
                if (fq == 0) sumsq_next[(size_t)row * 32 + u.pn * 4 + wc] = ss;
            }
    }
};
template <class Epi, class Sched, bool ALIGN_EPI = false, bool SP2 = false>
__device__ __forceinline__ void gemm_phase(PG8_LAS unsigned char* lds, const Gemm g, const Sched& S, const Epi& E) {
    const int tid = threadIdx.x, wid = __builtin_amdgcn_readfirstlane(tid >> 6), lane = tid & 63, wr = wid >> 2, wc = wid & 3, fr = lane & 15, fq = lane >> 4;
    const int K = g.K, nt = K / BK;
    unsigned voffA[2], voffB[2];
#pragma unroll
    for (int i = 0; i < 2; ++i) { int R, C; stage_rc(tid * 16 + i * 8192, R, C); const int Rb = Epi::PERM ? ((R & ~31) + perm32(R & 31)) : R;
        voffA[i] = (unsigned)(R * K + C) * 2u; voffB[i] = (unsigned)(Rb * 64 + C) * 2u; }
    const size_t kstep = (size_t)(BK * 2);
    const size_t hstep = (size_t)HALF * K * 2;
    const size_t tstep = 2 * hstep;
    const size_t kstepB = (size_t)g.N * 64 * 2, hstepB = (size_t)HALF * 64 * 2, tstepB = 2 * hstepB;
    const unsigned ldsw = (unsigned)wid * 1024u;
    const int aoff = lds_byte(wr * 64 + fr, fq * 8), boff = lds_byte(wc * 32 + fr, fq * 8);
#define PG8_SA(b, h) (((b) * 2 + (h)) * HTB)
#define PG8_SB(b, h) ((4 + (b) * 2 + (h)) * HTB)
#define PG8_STAGE(bufoff, gbase, voff) do { _Pragma("unroll") for (int _i = 0; _i < 2; ++_i) \
        __builtin_amdgcn_global_load_lds((const unsigned*)((const char*)(gbase) + (voff)[_i]), (PG8_LAS unsigned*)(lds + (bufoff) + ldsw + _i * 8192), 16, 0, 0); } while (0)
#define PG8_LDA(dst, b, h) do { _Pragma("unroll") for (int m = 0; m < 4; ++m) _Pragma("unroll") for (int k = 0; k < 2; ++k) dst[m][k] = *(const PG8_LAS bf16x8*)(lds + PG8_SA(b, h) + aoff + m * 2048 + k * 1024); } while (0)
#define PG8_LDB(dst, b, h) do { _Pragma("unroll") for (int n = 0; n < 2; ++n) _Pragma("unroll") for (int k = 0; k < 2; ++k) dst[n][k] = *(const PG8_LAS bf16x8*)(lds + PG8_SB(b, h) + boff + n * 2048 + k * 1024); } while (0)
#define PG8_MMA(ai, bj, At, Bt) do { __builtin_amdgcn_s_setprio(1); _Pragma("unroll") for (int m = 0; m < 4; ++m) _Pragma("unroll") for (int n = 0; n < 2; ++n) _Pragma("unroll") for (int k = 0; k < 2; ++k) \
        acc[ai][bj][m][n] = __builtin_amdgcn_mfma_f32_16x16x32_bf16(Bt[n][k], At[m][k], acc[ai][bj][m][n], 0, 0, 0); __builtin_amdgcn_s_setprio(0); } while (0)
#define PG8_WAIT_V(n) asm volatile("s_waitcnt vmcnt(" #n ")" ::: "memory")
#define PG8_WAIT_L(n) asm volatile("s_waitcnt lgkmcnt(" #n ")" ::: "memory")
#define PG8_BAR __builtin_amdgcn_s_barrier()
#define PG8_SCHED __builtin_amdgcn_sched_barrier(0)
    Unit cur, nxt; int ui = 0;
    if (!S.next(0, cur)) return;
    f32x4 acc[2][2][4][2];
#pragma unroll
    for (int a = 0; a < 2; ++a)
#pragma unroll
        for (int b = 0; b < 2; ++b)
#pragma unroll
            for (int m = 0; m < 4; ++m)
#pragma unroll
                for (int n = 0; n < 2; ++n) acc[a][b][m][n] = (f32x4){0.f, 0.f, 0.f, 0.f};
    bf16x8 At[4][2], B0[2][2], B1[2][2];
    const char* cA = (const char*)g.A + (size_t)cur.pm * tstep; const char* cB = (const char*)g.Bt + (size_t)cur.pn * tstepB;
    S.a_ready(cur);
    if constexpr (SP2) {
        PG8_STAGE(PG8_SB(0, 0), cB, voffB); PG8_STAGE(PG8_SB(0, 1), cB + hstepB, voffB); PG8_STAGE(PG8_SA(0, 0), cA, voffA); PG8_STAGE(PG8_SA(0, 1), cA + hstep, voffA);
        if (wr == 1) PG8_BAR;
        PG8_WAIT_V(2); PG8_BAR;
        PG8_STAGE(PG8_SB(1, 0), cB + kstepB, voffB); PG8_STAGE(PG8_SA(1, 0), cA + kstep, voffA); PG8_STAGE(PG8_SB(1, 1), cB + hstepB + kstepB, voffB);
        PG8_WAIT_V(6); PG8_BAR;
    } else {
        PG8_STAGE(PG8_SB(0, 0), cB, voffB); PG8_STAGE(PG8_SA(0, 0), cA, voffA); PG8_STAGE(PG8_SB(0, 1), cB + hstepB, voffB); PG8_STAGE(PG8_SA(0, 1), cA + hstep, voffA);
        if (wr == 1) PG8_BAR;
        PG8_WAIT_V(4); PG8_BAR;
        PG8_STAGE(PG8_SB(1, 0), cB + kstepB, voffB); PG8_STAGE(PG8_SA(1, 0), cA + kstep, voffA); PG8_STAGE(PG8_SB(1, 1), cB + hstepB + kstepB, voffB);
        PG8_WAIT_V(6); PG8_BAR;
    }
    for (;;) {
        const bool has_next = S.next(ui + 1, nxt);
        const char* nA = has_next ? (const char*)g.A + (size_t)nxt.pm * tstep : cA; const char* nB = has_next ? (const char*)g.Bt + (size_t)nxt.pn * tstepB : cB;
        for (int t = 0; t < nt; t += 2) {
            const bool last = (t == nt - 2);
            const char* a1 = cA + (size_t)(t + 1) * kstep;
            const char* a2 = last ? nA : cA + (size_t)(t + 2) * kstep; const char* b2 = last ? nB : cB + (size_t)(t + 2) * kstepB;
            const char* a3 = a2 + kstep; const char* b3 = b2 + kstepB;
            if (last && has_next) S.a_ready(nxt);
            if constexpr (SP2) {
            PG8_LDB(B0, 0, 0); PG8_LDB(B1, 0, 1); PG8_SCHED; PG8_LDA(At, 0, 0); PG8_STAGE(PG8_SA(1, 1), a1 + hstep, voffA);
            PG8_WAIT_V(8); PG8_WAIT_L(0); PG8_BAR; PG8_MMA(0, 0, At, B0); PG8_MMA(0, 1, At, B1); PG8_BAR; PG8_SCHED;
            PG8_LDA(At, 0, 1); PG8_STAGE(PG8_SB(0, 0), b2, voffB); PG8_STAGE(PG8_SB(0, 1), b2 + hstepB, voffB); PG8_STAGE(PG8_SA(0, 0), a2, voffA);
            PG8_WAIT_V(8); PG8_WAIT_L(0); PG8_BAR; PG8_MMA(1, 0, At, B0); PG8_MMA(1, 1, At, B1); PG8_BAR; PG8_SCHED;
            PG8_LDB(B0, 1, 0); PG8_LDB(B1, 1, 1); PG8_SCHED; PG8_LDA(At, 1, 0); PG8_STAGE(PG8_SA(0, 1), a2 + hstep, voffA);
            PG8_WAIT_V(8); PG8_WAIT_L(0); PG8_BAR; PG8_MMA(0, 0, At, B0); PG8_MMA(0, 1, At, B1); PG8_BAR; PG8_SCHED;
            PG8_LDA(At, 1, 1); PG8_STAGE(PG8_SB(1, 0), b3, voffB); PG8_STAGE(PG8_SB(1, 1), b3 + hstepB, voffB); PG8_STAGE(PG8_SA(1, 0), a3, voffA);
            PG8_WAIT_V(8); PG8_WAIT_L(0); PG8_BAR; PG8_MMA(1, 0, At, B0); PG8_MMA(1, 1, At, B1); PG8_BAR; PG8_SCHED;
            } else {
            PG8_LDB(B0, 0, 0); PG8_SCHED; PG8_LDA(At, 0, 0); PG8_STAGE(PG8_SA(1, 1), a1 + hstep, voffA);
            PG8_WAIT_L(8); PG8_BAR; PG8_WAIT_L(0); PG8_MMA(0, 0, At, B0); PG8_BAR; PG8_SCHED;
            PG8_LDB(B1, 0, 1); PG8_STAGE(PG8_SB(0, 0), b2, voffB);
            PG8_BAR; PG8_WAIT_L(0); PG8_MMA(0, 1, At, B1); PG8_BAR;
            PG8_LDA(At, 0, 1); PG8_STAGE(PG8_SA(0, 0), a2, voffA);
            PG8_BAR; PG8_WAIT_L(0); PG8_MMA(1, 0, At, B0); PG8_BAR; PG8_SCHED;
            PG8_STAGE(PG8_SB(0, 1), b2 + hstepB, voffB);
            PG8_WAIT_V(6); PG8_BAR; PG8_MMA(1, 1, At, B1); PG8_BAR;
            PG8_LDB(B0, 1, 0); PG8_SCHED; PG8_LDA(At, 1, 0); PG8_STAGE(PG8_SA(0, 1), a2 + hstep, voffA);
            PG8_WAIT_L(8); PG8_BAR; PG8_WAIT_L(0); PG8_MMA(0, 0, At, B0); PG8_BAR; PG8_SCHED;
            PG8_LDB(B1, 1, 1); PG8_STAGE(PG8_SB(1, 0), b3, voffB);
            PG8_BAR; PG8_WAIT_L(0); PG8_MMA(0, 1, At, B1); PG8_BAR;
            PG8_LDA(At, 1, 1); PG8_STAGE(PG8_SA(1, 0), a3, voffA);
            PG8_BAR; PG8_WAIT_L(0); PG8_MMA(1, 0, At, B0); PG8_BAR; PG8_SCHED;
            PG8_STAGE(PG8_SB(1, 1), b3 + hstepB, voffB);
            PG8_WAIT_V(6); PG8_BAR; PG8_MMA(1, 1, At, B1); PG8_BAR;
            }
        }
        if constexpr (ALIGN_EPI) { if (wr == 0) PG8_BAR; }
        if constexpr (!Epi::AFTER_DRAIN) { E(acc, cur, wr, wc, fr, fq); S.done(cur); }
        if (!has_next) break;
#pragma unroll
        for (int a = 0; a < 2; ++a)
#pragma unroll
            for (int b = 0; b < 2; ++b)
#pragma unroll
                for (int m = 0; m < 4; ++m)
#pragma unroll
                    for (int n = 0; n < 2; ++n) acc[a][b][m][n] = (f32x4){0.f, 0.f, 0.f, 0.f};
        cur = nxt; cA = nA; cB = nB; ++ui;
        if constexpr (ALIGN_EPI) { if (wr == 1) PG8_BAR; }
    }
    PG8_WAIT_V(0);
    if constexpr (!ALIGN_EPI) { if (wr == 0) PG8_BAR; }
    PG8_BAR;
    if constexpr (Epi::AFTER_DRAIN) { E.fused(acc, cur, wr, wc, fr, fq, lds, wid, lane); S.done(cur); }
#undef PG8_SA
#undef PG8_SB
#undef PG8_STAGE
#undef PG8_LDA
#undef PG8_LDB
#undef PG8_MMA
#undef PG8_WAIT_V
#undef PG8_WAIT_L
#undef PG8_BAR
#undef PG8_SCHED
}
}
#define LAS __attribute__((address_space(3)))
#define XB_TMO      128
#define XB_XCNT(j)  (256  + 64 * (j))
#define XB_XSUB(j)  (1280 + 64 * (j))
#define XB_XGEN(j)  (2304 + 64 * (j))
#define XB_TOP      3328
#define XB_TOPGEN   3392
#define XCD_BAR_WORDS 3456
#define XB_SPIN_CAP (1u << 18)

__device__ __forceinline__ unsigned xb_ld(unsigned* p)              { return __hip_atomic_load(p, __ATOMIC_RELAXED, __HIP_MEMORY_SCOPE_AGENT); }
__device__ __forceinline__ unsigned xb_add(unsigned* p, unsigned v) { return __hip_atomic_fetch_add(p, v, __ATOMIC_RELAXED, __HIP_MEMORY_SCOPE_AGENT); }
__device__ __forceinline__ unsigned xb_xcc_id() { return (unsigned)__builtin_amdgcn_s_getreg((3 << 11) | 20) & 0xFu; }
#define XB_SPIN(cond, bar) do { unsigned _sp = 0; while (cond) { __builtin_amdgcn_s_sleep(1); \
    if ((++_sp & 255u) == 0u) { if (xb_ld(&(bar)[XB_TMO])) break; if (_sp > XB_SPIN_CAP) { atomicAdd(&(bar)[XB_TMO], 1u); break; } } } } while (0)

struct XcdBarrier {
    unsigned* bar; unsigned x;
    volatile LAS unsigned* st;
};

__device__ __forceinline__ XcdBarrier xcd_barrier_post(unsigned* bar, volatile LAS unsigned* st) {
    XcdBarrier b; b.bar = bar; b.x = xb_xcc_id(); b.st = st;
    if (threadIdx.x == 0) (void)xb_add(&bar[XB_XCNT(b.x)], 1u);
    return b;
}
__device__ __forceinline__ void xcd_barrier_complete(unsigned* bar, unsigned x, unsigned& nloc, unsigned& nx) {
    const unsigned G = gridDim.x * gridDim.y * gridDim.z;
    unsigned sum, cnt, mine, sp = 0u;
    for (;;) {
        sum = 0u; cnt = 0u; mine = 0u;
#pragma unroll
        for (unsigned j = 0; j < 16; ++j) { const unsigned c = xb_ld(&bar[XB_XCNT(j)]); sum += c; cnt += (c > 0u) ? 1u : 0u; mine = (j == x) ? c : mine; }
        if (sum == G) break;
        __builtin_amdgcn_s_sleep(1);
        if ((++sp & 255u) == 0u) { if (xb_ld(&bar[XB_TMO])) break; if (sp > XB_SPIN_CAP) { atomicAdd(&bar[XB_TMO], 1u); break; } }
    }
    nloc = mine > 0u ? mine : 1u; nx = cnt > 0u ? cnt : 1u;
}

__device__ __forceinline__ void xcd_barrier(const XcdBarrier& b) {
    asm volatile("s_waitcnt vmcnt(0)" ::: "memory");
    __syncthreads();
    if (threadIdx.x == 0) {
        unsigned* bar = b.bar;
        __builtin_amdgcn_s_waitcnt(0);
        unsigned nloc = b.st[0], nx = b.st[1];
        if (nloc == 0u) { xcd_barrier_complete(bar, b.x, nloc, nx); b.st[0] = nloc; b.st[1] = nx; }
        const unsigned old = xb_add(&bar[XB_XSUB(b.x)], 1u);
        const unsigned gen = old / nloc;
        if (old + 1u == (gen + 1u) * nloc) {
            __builtin_amdgcn_fence(__ATOMIC_RELEASE, "agent");
            asm volatile("s_waitcnt vmcnt(0)" ::: "memory");
            const unsigned og = xb_add(&bar[XB_TOP], 1u);
            const unsigned tg = og / nx;
            if (og + 1u == (tg + 1u) * nx) xb_add(&bar[XB_TOPGEN], 1u);
            else XB_SPIN(xb_ld(&bar[XB_TOPGEN]) == tg, bar);
            __builtin_amdgcn_fence(__ATOMIC_ACQUIRE, "agent");
            xb_add(&bar[XB_XGEN(b.x)], 1u);
            asm volatile("s_waitcnt vmcnt(0)" ::: "memory");
        } else {
            XB_SPIN(xb_ld(&bar[XB_XGEN(b.x)]) == gen, bar);
            __builtin_amdgcn_fence(__ATOMIC_ACQUIRE, "agent");
            asm volatile("s_waitcnt vmcnt(0)" ::: "memory");
        }
    }
    __syncthreads();
}
#ifdef EMU
#include <pthread.h>
#include <cstring>
#include <cstdio>
#include <cstdlib>
#include <cmath>
#include <cstdint>
#define DEV static inline
#define LAS
struct EmuDim { int x; };
static thread_local EmuDim threadIdx;
typedef short bf16x8 __attribute__((ext_vector_type(8)));
typedef short s16x4 __attribute__((ext_vector_type(4)));
typedef float f32x4 __attribute__((ext_vector_type(4)));
typedef float f32x2 __attribute__((ext_vector_type(2)));
typedef unsigned u32x4 __attribute__((ext_vector_type(4)));
typedef unsigned u32x2 __attribute__((ext_vector_type(2)));
struct WaveX { bf16x8 a[64], b[64]; float f[64]; const void* p[64]; pthread_barrier_t bar; };
static WaveX g_wx[8];
static pthread_barrier_t g_wgbar;
static inline float emu_bf2f(short v) { unsigned u = ((unsigned)(unsigned short)v) << 16; float f; memcpy(&f, &u, 4); return f; }
static inline float __uint_as_float(unsigned u) { float f; memcpy(&f, &u, 4); return f; }
static inline unsigned __float_as_uint(float f) { unsigned u; memcpy(&u, &f, 4); return u; }
DEV f32x4 mfma16(bf16x8 a, bf16x8 b, f32x4 c) {
    const int lane = threadIdx.x & 63; WaveX& W = g_wx[threadIdx.x >> 6];
    W.a[lane] = a; W.b[lane] = b; pthread_barrier_wait(&W.bar);
    f32x4 r; const int g = lane >> 4, j = lane & 15;
    for (int rr = 0; rr < 4; ++rr) { const int i = 4 * g + rr; float s = 0.f;
        for (int k = 0; k < 32; ++k) s += emu_bf2f(W.a[i + 16 * (k / 8)][k % 8]) * emu_bf2f(W.b[j + 16 * (k / 8)][k % 8]);
        r[rr] = c[rr] + s; }
    pthread_barrier_wait(&W.bar); return r;
}
DEV s16x4 tr_read(const void* p) {
    const int lane = threadIdx.x & 63; WaveX& W = g_wx[threadIdx.x >> 6];
    W.p[lane] = p; pthread_barrier_wait(&W.bar);
    s16x4 r; const int G = lane >> 4, i = lane & 15;
    for (int q = 0; q < 4; ++q) { const short* src = (const short*)W.p[16 * G + 4 * q + i / 4]; if (((uintptr_t)src) & 7) { fprintf(stderr, "tr_read: unaligned\n"); abort(); } r[q] = src[i % 4]; }
    pthread_barrier_wait(&W.bar); return r;
}
DEV void lds_wait() {}
#define tr_read_o(base, off) tr_read((const unsigned char*)(base) + (off))
DEV float shflx(float v, int m) { const int lane = threadIdx.x & 63; WaveX& W = g_wx[threadIdx.x >> 6]; W.f[lane] = v; pthread_barrier_wait(&W.bar); const float r = W.f[lane ^ m]; pthread_barrier_wait(&W.bar); return r; }
DEV void wg_sync() { pthread_barrier_wait(&g_wgbar); }
DEV void wg_sync_lds() { pthread_barrier_wait(&g_wgbar); }
DEV void mem_fence_cc() {}
DEV void wave_sync() { pthread_barrier_wait(&g_wx[threadIdx.x >> 6].bar); }
DEV float fast_exp(float x) { return expf(x); }
DEV float fast_log(float x) { return logf(x); }
DEV float fast_exp2(float x) { return exp2f(x); }
DEV float fast_log2(float x) { return log2f(x); }
DEV float fast_rcp(float x) { return 1.0f / x; }
DEV unsigned cvt_pk_bf16(float lo, float hi) { auto f = [](float x) { unsigned u = __float_as_uint(x); return (u + 0x7fffu + ((u >> 16) & 1u)) >> 16; }; return f(lo) | (f(hi) << 16); }
#else
#define DEV __device__ __forceinline__
typedef short bf16x8 __attribute__((ext_vector_type(8)));
typedef short s16x4 __attribute__((ext_vector_type(4)));
typedef float f32x4 __attribute__((ext_vector_type(4)));
typedef float f32x2 __attribute__((ext_vector_type(2)));
typedef unsigned u32x4 __attribute__((ext_vector_type(4)));
typedef unsigned u32x2 __attribute__((ext_vector_type(2)));
DEV f32x4 mfma16(bf16x8 a, bf16x8 b, f32x4 c) { return __builtin_amdgcn_mfma_f32_16x16x32_bf16(a, b, c, 0, 0, 0); }
DEV s16x4 tr_read(const LAS void* p) { s16x4 r; asm volatile("ds_read_b64_tr_b16 %0, %1" : "=&v"(r) : "v"((unsigned)(size_t)p) : "memory"); return r; }
DEV s16x4 tr_read_o(const LAS void* p, int off) { s16x4 r; asm volatile("ds_read_b64_tr_b16 %0, %1 offset:%2" : "=&v"(r) : "v"((unsigned)(size_t)p), "i"(off) : "memory"); return r; }
DEV void lds_wait() { asm volatile("s_waitcnt lgkmcnt(0)" ::: "memory"); __builtin_amdgcn_sched_barrier(0); }
DEV float shflx(float v, int m) { return __shfl_xor(v, m); }
DEV void wg_sync() { __syncthreads(); }
DEV void wg_sync_lds() { asm volatile("s_waitcnt lgkmcnt(0)" ::: "memory"); __builtin_amdgcn_s_barrier(); asm volatile("" ::: "memory"); }
DEV void mem_fence_cc() { asm volatile("" ::: "memory"); }
DEV void wave_sync() { asm volatile("s_waitcnt lgkmcnt(0)" ::: "memory"); }
DEV float fast_exp(float x) { return __expf(x); }
DEV float fast_log(float x) { return __logf(x); }
DEV float fast_exp2(float x) { return __builtin_amdgcn_exp2f(x); }
DEV float fast_log2(float x) { return __builtin_amdgcn_logf(x); }
DEV float fast_rcp(float x) { return __builtin_amdgcn_rcpf(x); }
DEV unsigned cvt_pk_bf16(float lo, float hi) { unsigned r; asm volatile("v_cvt_pk_bf16_f32 %0, %1, %2" : "=v"(r) : "v"(lo), "v"(hi)); return r; }
#endif
typedef unsigned short bf16;
DEV bf16x8 pack8(s16x4 lo, s16x4 hi) { return (bf16x8){lo[0], lo[1], lo[2], lo[3], hi[0], hi[1], hi[2], hi[3]}; }

namespace mk {
typedef unsigned short bf16;
typedef float f32x4 __attribute__((ext_vector_type(4)));
typedef float f32x2 __attribute__((ext_vector_type(2)));
typedef unsigned u32x4 __attribute__((ext_vector_type(4)));
typedef unsigned u32x2 __attribute__((ext_vector_type(2)));
typedef short bf16x8 __attribute__((ext_vector_type(8)));
constexpr int D = 2048, NB = 4, S = 2048, MP = NB * S, DB = 8, T = 4, MS = DB * T, MT = MP + MS, PAST = 16384;
constexpr float EPS = 1e-6f;
constexpr int A_IN = 20480, B_IN = 12288, C_IN = 6160, C_INM = 6144;
constexpr int NWG_THREADS = 512;
constexpr size_t MiB = 1u << 20;
constexpr size_t WS_CTL = 0, CTL_ZERO_BYTES = 1 * MiB;
constexpr size_t CTL_BAR = 16384;
constexpr size_t CTL_SUMSQ = 65536;
constexpr size_t WS_TABA = 1 * MiB;
constexpr size_t WS_TABB = WS_TABA + 512 * 1024;
constexpr size_t WS_WIA0 = 4 * MiB;
constexpr size_t WS_WIA1 = WS_WIA0 + (size_t)A_IN * D * 2;
constexpr size_t WS_WIB = WS_WIA1 + (size_t)A_IN * D * 2;
constexpr size_t WS_WIC = WS_WIB + (size_t)B_IN * D * 2;
constexpr size_t WS_WLR = WS_WIC + (size_t)C_INM * D * 2;
constexpr size_t WS_WOA0 = WS_WLR + (size_t)32 * D * 2;
constexpr size_t WS_WOA1 = WS_WOA0 + (size_t)D * 2048 * 2;
constexpr size_t WS_WOB = WS_WOA1 + (size_t)D * 2048 * 2;
constexpr size_t WS_WOC = WS_WOB + (size_t)D * 4096 * 2;
constexpr size_t WS_XRES = WS_WOC + (size_t)D * 2048 * 2;
constexpr size_t WS_XB = WS_XRES + (size_t)MT * D * 4;
constexpr size_t WS_Z = WS_XB + (size_t)MT * D * 2;
constexpr size_t WS_ZSRAW = WS_Z + (size_t)MT * A_IN * 2;
constexpr size_t WS_Y = WS_ZSRAW + (size_t)32 * A_IN * 4;
constexpr size_t WS_O = WS_Y + (size_t)MT * 4096 * 2;
constexpr size_t WS_LOGA = WS_O + (size_t)MT * 4096 * 4;
constexpr size_t WS_LR = WS_LOGA + (size_t)MT * 1024 * 4;
constexpr size_t WS_DVEC = WS_LR + (size_t)32 * MT * 4;
constexpr size_t WS_SSP = WS_DVEC + (size_t)4 * 4 * 16 * 256 * 4;
constexpr size_t WS_END = WS_SSP + (size_t)4 * MP * 32 * 4;
constexpr int LDS_BYTES = 147456, MISC_OFF = 147456 - 256;

struct Params {
    const float* in[19]; float* out; unsigned char* ws;
    double inv_a[16]; double inv_b[128];
    int ph_lo, ph_hi;
};

__device__ __forceinline__ float bf2f(bf16 v) { return __uint_as_float(((unsigned)v) << 16); }
__device__ __forceinline__ unsigned f2bf(float f) { unsigned u = __float_as_uint(f); return (u + 0x7fffu + ((u >> 16) & 1u)) >> 16; }
__device__ __forceinline__ unsigned pk2(float lo, float hi) { return f2bf(lo) | (f2bf(hi) << 16); }
__device__ __forceinline__ float wave_sum(float v) {
#pragma unroll
    for (int o = 32; o >= 1; o >>= 1) v += __shfl_xor(v, o);
    return v;
}
__device__ __forceinline__ float wave_max(float v) {
#pragma unroll
    for (int o = 32; o >= 1; o >>= 1) v = fmaxf(v, __shfl_xor(v, o));
    return v;
}
__device__ __forceinline__ float silu(float x) { return x / (1.f + __expf(-x)); }
__device__ __forceinline__ void sincos_d(double a, float& s, float& c) {
    const double k = rint(a * 0.63661977236758134308);
    double r = fma(-k, 1.57079632679489655800e+00, a); r = fma(-k, 6.12323399573676603587e-17, r);
    const double r2 = r * r;
    const double sp = r * (1.0 + r2 * (-1.0 / 6 + r2 * (1.0 / 120 + r2 * (-1.0 / 5040 + r2 * (1.0 / 362880 + r2 * (-1.0 / 39916800 + r2 * (1.0 / 6227020800.0)))))));
    const double cp = 1.0 + r2 * (-0.5 + r2 * (1.0 / 24 + r2 * (-1.0 / 720 + r2 * (1.0 / 40320 + r2 * (-1.0 / 3628800 + r2 * (1.0 / 479001600.0 + r2 * (-1.0 / 87178291200.0)))))));
    const int q = (int)((long long)k & 3);
    const double ss = (q == 0) ? sp : (q == 1) ? cp : (q == 2) ? -sp : -cp;
    const double cc = (q == 0) ? cp : (q == 1) ? -sp : (q == 2) ? -cp : sp;
    s = (float)ss; c = (float)cc;
}
__device__ __forceinline__ void row_info(int row, int& b, int& t, int& pi, bool& samp) {
    if (row < MP) { b = row >> 11; t = row & 2047; pi = t; samp = false; } else { const int r = row - MP; b = r >> 2; t = r & 3; pi = 2048 + t; samp = true; }
}

struct Ctx {
    LAS unsigned char* lds; int tid, lane, wave, G, wg;
    const Params* P; float* out; unsigned char* ws;
    __device__ __forceinline__ const float* in(int i) const { return P->in[i]; }
    __device__ __forceinline__ float* sumsq(int l) const { return (float*)(ws + WS_SSP) + (size_t)l * MP * 32; }
    template <class Tp> __device__ __forceinline__ Tp* wsp(size_t off) const { return (Tp*)(ws + off); }
};

constexpr int ATT_K_OFF = 0, ATT_V_OFF = 65536, ATT_ROWS = 8192 + 32;
DEV int att_off_k(int row, int ch) { return 256 * row + 16 * (ch ^ (row & 15)); }
DEV int att_off_v(int row, int ch) { return 256 * row + 16 * (ch ^ (2 * (row & 7))); }
DEV void attn_item(LAS unsigned char* lds, const bf16* z, int ldz, bf16* og, float* lse, int item, int tid) {
    const int lane = tid & 63, w = tid >> 6, G = lane >> 4, l15 = lane & 15;
    const int bh = item / 48, rem = item % 48, b = bh >> 4, h = bh & 15;
    int g, r, blk;
    if (rem < 16) { g = 0; r = 0; blk = rem; } else if (rem < 32) { g = 1; r = (rem - 16) >> 2; blk = (rem - 16) & 3; } else { g = 2; r = rem - 32; blk = 0; }
    const int dil = 1 << (2 * g);
    const int qcol = (g * 3) * 2048 + h * 128, kcol = qcol + 2048, vcol = qcol + 4096;
    const size_t tok0 = (size_t)b * 2048 + r;
#pragma unroll
    for (int j = 0; j < 8; ++j) {
        const int e = tid + 512 * j, row = e >> 4, ch = e & 15; const int p = (blk - 1) * 128 + row;
        u32x4 kv = {0u, 0u, 0u, 0u}, vv = {0u, 0u, 0u, 0u};
        if (p >= 0) { const bf16* src = z + (tok0 + (size_t)dil * p) * ldz + ch * 8; kv = *(const u32x4*)(src + kcol); vv = *(const u32x4*)(src + vcol); }
        *(LAS u32x4*)(lds + ATT_K_OFF + att_off_k(row, ch)) = kv;
        *(LAS u32x4*)(lds + ATT_V_OFF + att_off_v(row, ch)) = vv;
    }
    const int qi = 16 * w + l15; const size_t qtok = tok0 + (size_t)dil * (blk * 128 + qi);
    bf16x8 qf[4];
#pragma unroll
    for (int s = 0; s < 4; ++s) qf[s] = *(const bf16x8*)(z + qtok * ldz + qcol + 32 * s + 8 * G);
    wg_sync();
    const int m0 = w >> 1;
    f32x4 sc[10];
#pragma unroll
    for (int tt = 0; tt < 10; ++tt) {
        const int t = 2 * m0 + tt; f32x4 a = {0.f, 0.f, 0.f, 0.f};
#pragma unroll
        for (int s = 0; s < 4; ++s) { const bf16x8 kf = *(const LAS bf16x8*)(lds + ATT_K_OFF + att_off_k(16 * t + l15, 4 * s + G)); a = mfma16(kf, qf[s], a); }
        sc[tt] = a;
    }
    const float scale = 0.08838834764831845f * 1.4426950408889634f;
    float mx = -INFINITY;
#pragma unroll
    for (int tt = 0; tt < 10; ++tt)
#pragma unroll
        for (int rr = 0; rr < 4; ++rr) { const int c = 16 * (2 * m0 + tt) + 4 * G + rr; const bool ok = (c >= qi) && (c <= qi + 128) && (blk > 0 || c >= 128);
            const float v = ok ? sc[tt][rr] * scale : -INFINITY; sc[tt][rr] = v; mx = fmaxf(mx, v); }
    mx = fmaxf(mx, shflx(mx, 16)); mx = fmaxf(mx, shflx(mx, 32));
    float sum = 0.f;
#pragma unroll
    for (int tt = 0; tt < 10; ++tt)
#pragma unroll
        for (int rr = 0; rr < 4; ++rr) { const float p = fast_exp2(sc[tt][rr] - mx); sc[tt][rr] = p; sum += p; }
    sum += shflx(sum, 16); sum += shflx(sum, 32);
    f32x4 oacc[8];
#pragma unroll
    for (int dt = 0; dt < 8; ++dt) oacc[dt] = (f32x4){0.f, 0.f, 0.f, 0.f};
#pragma unroll
    for (int mm = 0; mm < 5; ++mm) {
        const f32x4 p0 = sc[2 * mm], p1 = sc[2 * mm + 1];
        u32x4 pw; pw[0] = cvt_pk_bf16(p0[0], p0[1]); pw[1] = cvt_pk_bf16(p0[2], p0[3]); pw[2] = cvt_pk_bf16(p1[0], p1[1]); pw[3] = cvt_pk_bf16(p1[2], p1[3]);
        bf16x8 pf; __builtin_memcpy(&pf, &pw, 16);
        const int krow = 32 * (m0 + mm) + 4 * G + (l15 >> 2);
#pragma unroll
        for (int dh = 0; dh < 2; ++dh) {
            s16x4 lo[4], hi[4];
#pragma unroll
            for (int d4 = 0; d4 < 4; ++d4) { const int dt = dh * 4 + d4; const int ch = 2 * dt + ((l15 >> 1) & 1);
                lo[d4] = tr_read(lds + ATT_V_OFF + att_off_v(krow, ch) + 8 * (l15 & 1)); hi[d4] = tr_read(lds + ATT_V_OFF + att_off_v(krow + 16, ch) + 8 * (l15 & 1)); }
            lds_wait();
#pragma unroll
            for (int d4 = 0; d4 < 4; ++d4) oacc[dh * 4 + d4] = mfma16(pack8(lo[d4], hi[d4]), pf, oacc[dh * 4 + d4]);
        }
    }
    const float inv = fast_rcp(sum);
    bf16* orow = og + ((size_t)g * ATT_ROWS + qtok) * 2048 + h * 128 + 4 * G;
#pragma unroll
    for (int dt = 0; dt < 8; ++dt) { u32x2 wv; wv[0] = cvt_pk_bf16(oacc[dt][0] * inv, oacc[dt][1] * inv); wv[1] = cvt_pk_bf16(oacc[dt][2] * inv, oacc[dt][3] * inv); *(u32x2*)(orow + 16 * dt) = wv; }
    if (G == 0) lse[((size_t)g * ATT_ROWS + qtok) * 16 + h] = (mx + fast_log2(sum)) * 0.6931471805599453f;
    wg_sync();
}
DEV size_t att_zoff(size_t row, int col) { return ((size_t)(col >> 7) * ATT_ROWS + row) * 128 + (col & 127); }
struct AttItem { int b, h, g, r, blk; };
DEV AttItem att_decode(int item) { AttItem a; const int bh = item / 48, rem = item % 48; a.b = bh >> 4; a.h = bh & 15;
    if (rem < 16) { a.g = 0; a.r = 0; a.blk = rem; } else if (rem < 32) { a.g = 1; a.r = (rem - 16) >> 2; a.blk = (rem - 16) & 3; } else { a.g = 2; a.r = rem - 32; a.blk = 0; } return a; }
DEV bool att_continues(int item) { const int rem = item % 48; return rem < 15 || (rem >= 16 && rem < 32 && ((rem - 16) & 3) < 3); }
DEV void att_load_half(const bf16* z, int ldz, const AttItem& a, int pblk, int tid, u32x4 (&kr)[4], u32x4 (&vr)[4]) {
    const int dil = 1 << (2 * a.g), qcol = (a.g * 3) * 2048 + a.h * 128; const size_t tok0 = (size_t)a.b * 2048 + a.r;
#pragma unroll
    for (int j = 0; j < 4; ++j) { const int e = tid + 512 * j, row = e >> 4, ch = e & 15;
        kr[j] = (u32x4){0u, 0u, 0u, 0u}; vr[j] = (u32x4){0u, 0u, 0u, 0u};
        if (pblk >= 0) { const size_t tk = tok0 + (size_t)dil * (pblk * 128 + row); kr[j] = *(const u32x4*)(z + att_zoff(tk, qcol + 2048 + ch * 8)); vr[j] = *(const u32x4*)(z + att_zoff(tk, qcol + 4096 + ch * 8)); } }
}
DEV void att_store_half(LAS unsigned char* lds, int half, int tid, const u32x4 (&kr)[4], const u32x4 (&vr)[4]) {
#pragma unroll
    for (int j = 0; j < 4; ++j) { const int e = tid + 512 * j, prow = half * 128 + (e >> 4), ch = e & 15;
        *(LAS u32x4*)(lds + ATT_K_OFF + 256 * prow + 16 * (ch ^ (prow & 15))) = kr[j]; *(LAS u32x4*)(lds + ATT_V_OFF + 256 * prow + 16 * (ch ^ (2 * (prow & 7)))) = vr[j]; }
}
DEV void att_load_q(const bf16* z, int ldz, const AttItem& a, int w, int l15, int G, bf16x8 (&qf)[4]) {
    const int dil = 1 << (2 * a.g); const size_t qtok = (size_t)a.b * 2048 + a.r + (size_t)dil * (a.blk * 128 + 16 * w + l15);
#pragma unroll
    for (int s = 0; s < 4; ++s) qf[s] = *(const bf16x8*)(z + att_zoff(qtok, (a.g * 3) * 2048 + a.h * 128 + 32 * s + 8 * G));
}
DEV void attn_run(LAS unsigned char* lds, const bf16* z, int ldz, bf16* og, float* lse, int item0, int nitems, int tid) {
    const int lane = tid & 63, w = tid >> 6, G = lane >> 4, l15 = lane & 15;
    int kb[4], vb[8];
#pragma unroll
    for (int s = 0; s < 4; ++s) kb[s] = ATT_K_OFF + 256 * l15 + 16 * ((4 * s + G) ^ l15);
    { const int r7 = 4 * (G & 1) + (l15 >> 2);
#pragma unroll
      for (int dt = 0; dt < 8; ++dt) vb[dt] = ATT_V_OFF + 256 * (4 * G + (l15 >> 2)) + 16 * ((2 * dt + ((l15 >> 1) & 1)) ^ (2 * r7)) + 8 * (l15 & 1); }
    int par = 0;
    AttItem cur = att_decode(item0);
    bf16x8 qf[4];
    {   u32x4 kA[4], vA[4], kB[4], vB[4];
        att_load_half(z, ldz, cur, cur.blk - 1, tid, kA, vA); att_load_half(z, ldz, cur, cur.blk, tid, kB, vB); att_load_q(z, ldz, cur, w, l15, G, qf);
        att_store_half(lds, 0, tid, kA, vA); att_store_half(lds, 1, tid, kB, vB); }
#pragma unroll 1
    for (int it = 0; it < nitems; ++it) {
        wg_sync_lds();
        const bool has_next = it + 1 < nitems; const bool cont = has_next && att_continues(item0 + it);
        AttItem nxt = cur; if (has_next) nxt = att_decode(item0 + it + 1);
        u32x4 kB[4], vB[4]; bf16x8 qn[4];
        if (has_next) { att_load_half(z, ldz, nxt, nxt.blk, tid, kB, vB); att_load_q(z, ldz, nxt, w, l15, G, qn); }
        const int m0 = w >> 1, qi = 16 * w + l15;
        f32x4 sc[10];
#pragma unroll
        for (int tt = 0; tt < 10; ++tt) {
            const int pt = (2 * m0 + tt) ^ (8 * par); f32x4 a = {0.f, 0.f, 0.f, 0.f};
#pragma unroll
            for (int s = 0; s < 4; ++s) { const bf16x8 kf = *(const LAS bf16x8*)(lds + kb[s] + 4096 * pt); a = mfma16(kf, qf[s], a); }
            sc[tt] = a;
        }
        const float scale = 0.08838834764831845f * 1.4426950408889634f;
        float mx = -INFINITY;
#pragma unroll
        for (int tt = 0; tt < 10; ++tt)
#pragma unroll
            for (int rr = 0; rr < 4; ++rr) { const int c = 16 * (2 * m0 + tt) + 4 * G + rr; const bool ok = (c >= qi) && (c <= qi + 128) && (cur.blk > 0 || c >= 128);
                const float v = ok ? sc[tt][rr] * scale : -INFINITY; sc[tt][rr] = v; mx = fmaxf(mx, v); }
        mx = fmaxf(mx, shflx(mx, 16)); mx = fmaxf(mx, shflx(mx, 32));
        float sum = 0.f;
#pragma unroll
        for (int tt = 0; tt < 10; ++tt)
#pragma unroll
            for (int rr = 0; rr < 4; ++rr) { const float p = fast_exp2(sc[tt][rr] - mx); sc[tt][rr] = p; sum += p; }
        sum += shflx(sum, 16); sum += shflx(sum, 32);
        f32x4 oacc[8];
#pragma unroll
        for (int dt = 0; dt < 8; ++dt) oacc[dt] = (f32x4){0.f, 0.f, 0.f, 0.f};
#pragma unroll
        for (int mm = 0; mm < 5; ++mm) {
            const f32x4 p0 = sc[2 * mm], p1 = sc[2 * mm + 1];
            u32x4 pw; pw[0] = cvt_pk_bf16(p0[0], p0[1]); pw[1] = cvt_pk_bf16(p0[2], p0[3]); pw[2] = cvt_pk_bf16(p1[0], p1[1]); pw[3] = cvt_pk_bf16(p1[2], p1[3]);
            bf16x8 pf; __builtin_memcpy(&pf, &pw, 16);
            const int prow = 8192 * ((m0 + mm) ^ (4 * par));
#pragma unroll
            for (int dh = 0; dh < 2; ++dh) {
                s16x4 lo[4], hi[4];
#pragma unroll
                for (int d4 = 0; d4 < 4; ++d4) { lo[d4] = tr_read_o(lds + vb[dh * 4 + d4] + prow, 0); hi[d4] = tr_read_o(lds + vb[dh * 4 + d4] + prow, 4096); }
                lds_wait();
#pragma unroll
                for (int d4 = 0; d4 < 4; ++d4) oacc[dh * 4 + d4] = mfma16(pack8(lo[d4], hi[d4]), pf, oacc[dh * 4 + d4]);
            }
        }
        {   const float inv = fast_rcp(sum); const int dil = 1 << (2 * cur.g); const size_t qtok = (size_t)cur.b * 2048 + cur.r + (size_t)dil * (cur.blk * 128 + qi);
            bf16* orow = og + ((size_t)cur.g * ATT_ROWS + qtok) * 2048 + cur.h * 128 + 4 * G;
#pragma unroll
            for (int dt = 0; dt < 8; ++dt) { u32x2 wv; wv[0] = cvt_pk_bf16(oacc[dt][0] * inv, oacc[dt][1] * inv); wv[1] = cvt_pk_bf16(oacc[dt][2] * inv, oacc[dt][3] * inv); *(u32x2*)(orow + 16 * dt) = wv; }
            if (G == 0) lse[((size_t)cur.g * ATT_ROWS + qtok) * 16 + cur.h] = (mx + fast_log2(sum)) * 0.6931471805599453f; }
        wg_sync_lds();
        if (has_next) {
            if (cont) { att_store_half(lds, par, tid, kB, vB); par ^= 1; }
            else { att_store_half(lds, 1, tid, kB, vB); att_load_half(z, ldz, nxt, nxt.blk - 1, tid, kB, vB); att_store_half(lds, 0, tid, kB, vB); par = 0; }
#pragma unroll
            for (int s = 0; s < 4; ++s) qf[s] = qn[s];
            cur = nxt;
        }
    }
    wg_sync();
}
constexpr int SC_KP = 544, SC_K_OFF = 0, SC_V_OFF = 128 * SC_KP, SC_S_OFF = SC_V_OFF + 20480;
template <int NVT, class OT>
DEV void scan_unit(LAS unsigned char* lds, const bf16* z, int ldz, int qoff, int koff, int voff, int H, int unit, const float* dvec, OT* o, int ldo, float* state_out, int tid) {
    constexpr int VS = 16 * NVT, VP = VS * 2 + 32, KP = SC_KP, NVS = 512 / VS, VCH = VS / 8, NVLD = (128 * VCH) / 512, VROWS = 512 / VCH;
    const int lane = tid & 63, w = tid >> 6, G = lane >> 4, l15 = lane & 15;
    const int vs = unit % NVS, h = (unit / NVS) % H, b = unit / (NVS * H);
    const size_t rowbase = (size_t)b * 2048;
    const bf16* zq = z + qoff + h * 256; const bf16* zk = z + koff + h * 256; const bf16* zv = z + voff + h * 512 + vs * VS;
    float gam128 = 1.f; if (!dvec) { const float gm = 1.0f - exp2f(-5.0f - (float)h); gam128 = exp2f(128.0f * log2f(gm)); }
    LAS unsigned char* const kb_row = lds + SC_K_OFF + l15 * KP + 16 * G;
    LAS unsigned char* const kb_tr = lds + SC_K_OFF + (4 * G + (l15 >> 2)) * KP + 8 * (l15 & 3) + 64 * w;
    LAS unsigned char* const vb_tr = lds + SC_V_OFF + (4 * G + (l15 >> 2)) * VP + 8 * (l15 & 3);
    LAS unsigned char* const sb_row = lds + SC_S_OFF + l15 * KP + 16 * G;
    LAS unsigned char* const sb_wr = lds + SC_S_OFF + l15 * KP + 8 * G + 64 * w;
    LAS unsigned char* const kst = lds + SC_K_OFF + (tid >> 5) * KP + (tid & 31) * 16;
    LAS unsigned char* const vst = lds + SC_V_OFF + (tid / VCH) * VP + (tid % VCH) * 16;
    const size_t kg = (size_t)(tid >> 5) * ldz + (tid & 31) * 8, vg = (size_t)(tid / VCH) * ldz + (tid % VCH) * 8;
    f32x4 sacc[2][NVT];
#pragma unroll
    for (int dd = 0; dd < 2; ++dd)
#pragma unroll
        for (int vt = 0; vt < NVT; ++vt) sacc[dd][vt] = (f32x4){0.f, 0.f, 0.f, 0.f};
    for (int e = tid; e < VS * (KP / 16); e += 512) *(LAS u32x4*)(lds + SC_S_OFF + e * 16) = (u32x4){0u, 0u, 0u, 0u};
    u32x4 kpre[8], vpre[NVLD];
    {   const bf16* kp = zk + rowbase * ldz + kg; const bf16* vp = zv + rowbase * ldz + vg;
#pragma unroll
        for (int j = 0; j < 8; ++j) kpre[j] = *(const u32x4*)(kp + (size_t)(16 * j) * ldz);
#pragma unroll
        for (int j = 0; j < NVLD; ++j) vpre[j] = *(const u32x4*)(vp + (size_t)(VROWS * j) * ldz);
#pragma unroll
        for (int j = 0; j < 8; ++j) *(LAS u32x4*)(kst + 16 * j * KP) = kpre[j];
#pragma unroll
        for (int j = 0; j < NVLD; ++j) *(LAS u32x4*)(vst + VROWS * j * VP) = vpre[j]; }
    wg_sync();
    const int qi = 16 * w + l15;
    bf16x8 qf[8];
#pragma unroll
    for (int s = 0; s < 8; ++s) qf[s] = *(const bf16x8*)(zq + (rowbase + qi) * ldz + 32 * s + 8 * G);
#pragma unroll 1
    for (int c = 0; c < 16; ++c) {
        const size_t crow = rowbase + (size_t)c * 128;
        const bf16* kp = zk + (crow + 128) * ldz + kg; const bf16* vp = zv + (crow + 128) * ldz + vg;
        if (c + 1 < 16) {
#pragma unroll
            for (int j = 0; j < 4; ++j) kpre[j] = *(const u32x4*)(kp + (size_t)(16 * j) * ldz);
#pragma unroll
            for (int j = 0; j < NVLD; ++j) vpre[j] = *(const u32x4*)(vp + (size_t)(VROWS * j) * ldz);
        }
        f32x4 oacc[NVT];
#pragma unroll
        for (int vt = 0; vt < NVT; ++vt) oacc[vt] = (f32x4){0.f, 0.f, 0.f, 0.f};
#pragma unroll 1
        for (int m = 0; m <= (w >> 1); ++m) {
            f32x4 s0 = {0.f, 0.f, 0.f, 0.f}, s1 = {0.f, 0.f, 0.f, 0.f};
            LAS unsigned char* const kr = kb_row + m * (32 * KP); LAS unsigned char* const vr = vb_tr + m * (32 * VP);
#pragma unroll
            for (int s = 0; s < 8; ++s) {
                const bf16x8 k0 = *(const LAS bf16x8*)(kr + 64 * s); const bf16x8 k1 = *(const LAS bf16x8*)(kr + 16 * KP + 64 * s);
                s0 = mfma16(k0, qf[s], s0); s1 = mfma16(k1, qf[s], s1);
                if (s & 1) mem_fence_cc();
            }
#pragma unroll
            for (int rr = 0; rr < 4; ++rr) { const int j0 = 32 * m + 4 * G + rr; s0[rr] = (j0 <= qi) ? s0[rr] : 0.f; s1[rr] = (j0 + 16 <= qi) ? s1[rr] : 0.f; }
            u32x4 pw; pw[0] = cvt_pk_bf16(s0[0], s0[1]); pw[1] = cvt_pk_bf16(s0[2], s0[3]); pw[2] = cvt_pk_bf16(s1[0], s1[1]); pw[3] = cvt_pk_bf16(s1[2], s1[3]);
            bf16x8 pf; __builtin_memcpy(&pf, &pw, 16);
            s16x4 lo[NVT], hi[NVT];
#pragma unroll
            for (int vt = 0; vt < NVT; ++vt) { lo[vt] = tr_read_o(vr, 32 * vt); hi[vt] = tr_read_o(vr, 16 * VP + 32 * vt); }
            lds_wait();
#pragma unroll
            for (int vt = 0; vt < NVT; ++vt) oacc[vt] = mfma16(pack8(lo[vt], hi[vt]), pf, oacc[vt]);
        }
        if (c + 1 < 16) {
#pragma unroll
            for (int j = 4; j < 8; ++j) kpre[j] = *(const u32x4*)(kp + (size_t)(16 * j) * ldz);
        }
#pragma unroll
        for (int s = 0; s < 8; ++s)
#pragma unroll
            for (int vt = 0; vt < NVT; ++vt) { const bf16x8 sf = *(const LAS bf16x8*)(sb_row + 16 * vt * KP + 64 * s); oacc[vt] = mfma16(sf, qf[s], oacc[vt]); if (vt == NVT - 1) mem_fence_cc(); }
        {   OT* orow = o + (crow + qi) * ldo + h * 512 + vs * VS + 4 * G;
#pragma unroll
            for (int vt = 0; vt < NVT; ++vt) {
                if constexpr (sizeof(OT) == 2) { u32x2 wv; wv[0] = cvt_pk_bf16(oacc[vt][0], oacc[vt][1]); wv[1] = cvt_pk_bf16(oacc[vt][2], oacc[vt][3]); *(u32x2*)(orow + 16 * vt) = wv; }
                else *(f32x4*)(orow + 16 * vt) = oacc[vt]; } }
        if (c + 1 < 16) {
#pragma unroll
            for (int s = 0; s < 8; ++s) qf[s] = *(const bf16x8*)(zq + (crow + 128 + qi) * ldz + 32 * s + 8 * G);
        }
#pragma unroll
        for (int ks = 0; ks < 4; ++ks) {
            s16x4 alo[2], ahi[2], blo[NVT], bhi[NVT];
#pragma unroll
            for (int dd = 0; dd < 2; ++dd) { alo[dd] = tr_read_o(kb_tr, 32 * ks * KP + 32 * dd); ahi[dd] = tr_read_o(kb_tr, (32 * ks + 16) * KP + 32 * dd); }
#pragma unroll
            for (int vt = 0; vt < NVT; ++vt) { blo[vt] = tr_read_o(vb_tr, 32 * ks * VP + 32 * vt); bhi[vt] = tr_read_o(vb_tr, (32 * ks + 16) * VP + 32 * vt); }
            lds_wait();
#pragma unroll
            for (int dd = 0; dd < 2; ++dd)
#pragma unroll
                for (int vt = 0; vt < NVT; ++vt) sacc[dd][vt] = mfma16(pack8(alo[dd], ahi[dd]), pack8(blo[vt], bhi[vt]), sacc[dd][vt]);
        }
#pragma unroll
        for (int dd = 0; dd < 2; ++dd) {
            f32x4 dv = {gam128, gam128, gam128, gam128};
            if (dvec) dv = *(const f32x4*)(dvec + ((size_t)(b * H + h) * 16 + c) * 256 + 16 * (2 * w + dd) + 4 * G);
#pragma unroll
            for (int vt = 0; vt < NVT; ++vt) sacc[dd][vt] = sacc[dd][vt] * dv;
        }
        wg_sync_lds();
#pragma unroll
        for (int dd = 0; dd < 2; ++dd)
#pragma unroll
            for (int vt = 0; vt < NVT; ++vt) { u32x2 wv; wv[0] = cvt_pk_bf16(sacc[dd][vt][0], sacc[dd][vt][1]); wv[1] = cvt_pk_bf16(sacc[dd][vt][2], sacc[dd][vt][3]); *(LAS u32x2*)(sb_wr + 16 * vt * KP + 32 * dd) = wv; }
        if (c + 1 < 16) {
#pragma unroll
            for (int j = 0; j < 8; ++j) *(LAS u32x4*)(kst + 16 * j * KP) = kpre[j];
#pragma unroll
            for (int j = 0; j < NVLD; ++j) *(LAS u32x4*)(vst + VROWS * j * VP) = vpre[j];
        }
        wg_sync_lds();
    }
#pragma unroll
    for (int dd = 0; dd < 2; ++dd)
#pragma unroll
        for (int vt = 0; vt < NVT; ++vt)
#pragma unroll
            for (int rr = 0; rr < 4; ++rr) state_out[(((size_t)b * H + h) * 256 + 16 * (2 * w + dd) + 4 * G + rr) * 512 + vs * VS + 16 * vt + l15] = sacc[dd][vt][rr];
}
DEV f32x4 bf4_to_f32(u32x2 w) { return (f32x4){__uint_as_float(w[0] << 16), __uint_as_float(w[0] & 0xffff0000u), __uint_as_float(w[1] << 16), __uint_as_float(w[1] & 0xffff0000u)}; }
DEV float half_sum(float v) { v += shflx(v, 16); v += shflx(v, 8); v += shflx(v, 4); v += shflx(v, 2); v += shflx(v, 1); return v; }
DEV f32x4 sat_rot(f32x4 x, const f32x2* tab, int pi, int c32) {
    f32x4 p;
#pragma unroll
    for (int e = 0; e < 4; ++e) p[e] = shflx(x[e], 4);
    if (c32 < 8) { const f32x4 t0 = *(const f32x4*)(tab + pi * 16 + 4 * (c32 & 3)), t1 = *(const f32x4*)(tab + pi * 16 + 4 * (c32 & 3) + 2);
        const f32x4 c = {t0[0], t0[2], t1[0], t1[2]}, sn = {t0[1], t0[3], t1[1], t1[3]};
        x = c32 < 4 ? x * c - p * sn : p * sn + x * c; }
    return x;
}
DEV void sattn_unit(LAS unsigned char* lds_wave, const bf16* z, int ldz, const float* cache, int g, int b, int t, int h, bf16* og, float* lse, int lane, const f32x2* tab, float* kvout) {
    const int lbuf = 128 << (2 * g), dil = 1 << (2 * g), hf = lane >> 5, c32 = lane & 31;
    const int row = 8192 + b * 4 + t, qcol = g * 3 * 2048 + h * 128, kcol = qcol + 2048, vcol = qcol + 4096;
    const float scale = 0.08838834764831845f * 1.4426950408889634f;
    const f32x4 q4 = sat_rot(bf4_to_f32(*(const u32x2*)(z + att_zoff(row, qcol + 4 * c32))), tab, 2048 + t, c32);
    const int jn = g == 0 ? t + 1 : 1;
    float m = -INFINITY, l = 0.f; f32x4 acc = {0.f, 0.f, 0.f, 0.f};
    for (int j = 0; j < jn; ++j) {
        const int krow = 8192 + b * 4 + (t - dil * j);
        const f32x4 k4 = sat_rot(bf4_to_f32(*(const u32x2*)(z + att_zoff(krow, kcol + 4 * c32))), tab, 2048 + t - dil * j, c32); const f32x4 v4 = bf4_to_f32(*(const u32x2*)(z + att_zoff(krow, vcol + 4 * c32)));
        if (j == 0 && hf == 0) { *(f32x4*)(kvout + (size_t)(t * 2 + 0) * 2048 + h * 128 + 4 * c32) = k4; *(f32x4*)(kvout + (size_t)(t * 2 + 1) * 2048 + h * 128 + 4 * c32) = v4; }
        float s = half_sum(q4[0] * k4[0] + q4[1] * k4[1] + q4[2] * k4[2] + q4[3] * k4[3]) * scale; if (hf) s = -INFINITY;
        const float mn = fmaxf(m, s); const float corr = (m == -INFINITY) ? 0.f : fast_exp2(m - mn); const float p = (s == -INFINITY) ? 0.f : fast_exp2(s - mn);
        l = l * corr + p; acc = acc * corr + v4 * p; m = mn;
    }
    const float* kbase = cache + (size_t)b * lbuf * 4096 + h * 128 + 4 * c32;
    const int nc = 129 - jn;
#pragma unroll 1
    for (int i = 0; i < nc; i += 32) {
        f32x4 k4[16], v4[16];
#pragma unroll
        for (int u = 0; u < 16; ++u) { int j = jn + i + 2 * u + hf; j = j > 128 ? 128 : j; const float* p = kbase + (size_t)(lbuf + t - dil * j) * 4096; k4[u] = *(const f32x4*)p; v4[u] = *(const f32x4*)(p + 2048); }
        float s[16]; float bm = -INFINITY;
#pragma unroll
        for (int u = 0; u < 16; ++u) { const int j = jn + i + 2 * u + hf; const float sv = half_sum(q4[0] * k4[u][0] + q4[1] * k4[u][1] + q4[2] * k4[u][2] + q4[3] * k4[u][3]) * scale; s[u] = j <= 128 ? sv : -INFINITY; bm = fmaxf(bm, s[u]); }
        const float mn = fmaxf(m, bm);
        if (mn != -INFINITY) {
            const float corr = (m == -INFINITY) ? 0.f : fast_exp2(m - mn); l *= corr; acc = acc * corr;
#pragma unroll
            for (int u = 0; u < 16; ++u) { const float p = (s[u] == -INFINITY) ? 0.f : fast_exp2(s[u] - mn); l += p; acc += v4[u] * p; }
            m = mn;
        }
    }
    const float m2 = shflx(m, 32), l2 = shflx(l, 32); f32x4 a2;
#pragma unroll
    for (int e = 0; e < 4; ++e) a2[e] = shflx(acc[e], 32);
    const float M = fmaxf(m, m2); const float c1 = (m == -INFINITY) ? 0.f : fast_exp2(m - M), c2 = (m2 == -INFINITY) ? 0.f : fast_exp2(m2 - M);
    const float L = l * c1 + l2 * c2; const f32x4 A = acc * c1 + a2 * c2;
    const float inv = 1.0f / L;
    if (hf == 0) { u32x2 wv; wv[0] = cvt_pk_bf16(A[0] * inv, A[1] * inv); wv[1] = cvt_pk_bf16(A[2] * inv, A[3] * inv); *(u32x2*)(og + ((size_t)g * ATT_ROWS + row) * 2048 + h * 128 + 4 * c32) = wv; }
    if (lane == 0) lse[((size_t)g * ATT_ROWS + row) * 16 + h] = (M + fast_log2(L)) * 0.6931471805599453f;
}
struct P0Src { const float* W; int K, ld, ncols; const float* gain; bf16* WT; };
__device__ __forceinline__ void p0_tr_load(const P0Src& s, int item, int lane, f32x4 (&v)[16]) {
    const int nblk = s.ncols / 64, kb = item / nblk, nb = item % nblk, k0 = 64 * kb, n0 = 64 * nb;
#pragma unroll
    for (int i = 0; i < 16; ++i) { const int kk = 4 * i + (lane >> 4); v[i] = *(const f32x4*)(s.W + (size_t)(k0 + kk) * s.ld + n0 + 4 * (lane & 15)); }
}
__device__ __forceinline__ void p0_tr_store(const P0Src& s, int item, int lane, const f32x4 (&v)[16], LAS float* scr) {
    const int nblk = s.ncols / 64, kb = item / nblk, nb = item % nblk, k0 = 64 * kb, n0 = 64 * nb;
#pragma unroll
    for (int i = 0; i < 16; ++i) { const int kk = 4 * i + (lane >> 4); const float gk = s.gain ? s.gain[k0 + kk] : 1.0f; LAS float* d = scr + kk * 65 + 4 * (lane & 15);
        d[0] = v[i][0] * gk; d[1] = v[i][1] * gk; d[2] = v[i][2] * gk; d[3] = v[i][3] * gk; }
    asm volatile("s_waitcnt lgkmcnt(0)" ::: "memory");
    const int c = lane & 7;
#pragma unroll
    for (int j = 0; j < 8; ++j) { const int n = (lane >> 3) + 8 * j; const LAS float* sp = scr + (8 * c) * 65 + n;
        u32x4 o; o.x = pk2(sp[0 * 65], sp[1 * 65]); o.y = pk2(sp[2 * 65], sp[3 * 65]); o.z = pk2(sp[4 * 65], sp[5 * 65]); o.w = pk2(sp[6 * 65], sp[7 * 65]);
        *(u32x4*)(s.WT + ((size_t)kb * s.ncols + n0 + n) * 64 + 8 * c) = o; }
    asm volatile("s_waitcnt lgkmcnt(0)" ::: "memory");
}
__device__ __forceinline__ P0Src p0_src(const Ctx& C, int it, int& r) {
    const float* norm_g = C.in(7);
    constexpr int I_A = (D / 64) * (A_IN / 64), I_B = (D / 64) * (B_IN / 64), I_C = (D / 64) * (C_INM / 64), I_OA = (2048 / 64) * (D / 64), I_OB = (4096 / 64) * (D / 64);
    r = it;
        if (r < I_A) return P0Src{C.in(9) + (size_t)D * A_IN, D, A_IN, A_IN, norm_g + 3 * D, C.wsp<bf16>(WS_WIA1)}; r -= I_A;
        if (r < I_B) return P0Src{C.in(11), D, B_IN, B_IN, norm_g + 1 * D, C.wsp<bf16>(WS_WIB)}; r -= I_B;
        if (r < I_C) return P0Src{C.in(14), D, C_IN, C_INM, norm_g + 2 * D, C.wsp<bf16>(WS_WIC)}; r -= I_C;
        if (r < I_OA) return P0Src{C.in(10), 2048, D, D, nullptr, C.wsp<bf16>(WS_WOA0)}; r -= I_OA;
        if (r < I_OA) return P0Src{C.in(10) + (size_t)2048 * D, 2048, D, D, nullptr, C.wsp<bf16>(WS_WOA1)}; r -= I_OA;
        if (r < I_OA) return P0Src{C.in(18), 2048, D, D, nullptr, C.wsp<bf16>(WS_WOC)}; r -= I_OA;
        if (r < I_OB) return P0Src{C.in(13), 4096, D, D, nullptr, C.wsp<bf16>(WS_WOB)}; r -= I_OB;
        return P0Src{C.in(9), D, A_IN, A_IN, norm_g + 0 * D, C.wsp<bf16>(WS_WIA0)};
}
__device__ __forceinline__ void p0_prologue(const Ctx& C, const Params& P) {
    LAS float* scr = (LAS float*)(C.lds + C.wave * 16640);
    const int gw = C.wg * 8 + C.wave, NGW = C.G * 8;
    const float* norm_g = C.in(7);
    constexpr int I_A = (D / 64) * (A_IN / 64), I_B = (D / 64) * (B_IN / 64), I_C = (D / 64) * (C_INM / 64), I_OA = (2048 / 64) * (D / 64), I_OB = (4096 / 64) * (D / 64);
    constexpr int NITEMS = 2 * I_A + I_B + I_C + 3 * I_OA + I_OB;
    if (gw < NITEMS) {
        int it = gw, rc; P0Src sc = p0_src(C, it, rc); f32x4 vc[16]; p0_tr_load(sc, rc, C.lane, vc);
        for (;;) {
            const int itn = it + NGW; const bool has = itn < NITEMS; int rn = 0; P0Src sn = sc; f32x4 vn[16];
            if (has) { sn = p0_src(C, itn, rn); p0_tr_load(sn, rn, C.lane, vn); }
            p0_tr_store(sc, rc, C.lane, vc, scr);
            if (!has) break;
#pragma unroll
            for (int i = 0; i < 16; ++i) vc[i] = vn[i];
            sc = sn; rc = rn; it = itn;
        }
    }
    { bf16* wlr = C.wsp<bf16>(WS_WLR); const float* W = C.in(14); const float* g2 = norm_g + 2 * D;
      for (int e = C.wg * NWG_THREADS + C.tid; e < 32 * D; e += C.G * NWG_THREADS) { const int r = e / D, k = e % D; wlr[e] = r < 16 ? (bf16)f2bf(W[(size_t)k * C_IN + C_INM + r] * g2[k]) : (bf16)0; } }
    { bf16* xb = C.wsp<bf16>(WS_XB); float* ss0 = C.sumsq(0);
      for (int row = gw; row < MT; row += NGW) {
          const float* src = row < MP ? C.in(0) + (size_t)row * D : C.in(1) + (size_t)(row - MP) * D;
          float s = 0.f;
#pragma unroll
          for (int j = 0; j < 8; ++j) { const f32x4 v = *(const f32x4*)(src + 4 * C.lane + 256 * j);
              u32x2 w; w.x = pk2(v[0], v[1]); w.y = pk2(v[2], v[3]); *(u32x2*)(xb + (size_t)row * D + 4 * C.lane + 256 * j) = w; s += (v[0] * v[0] + v[1] * v[1]) + (v[2] * v[2] + v[3] * v[3]); }
          s = wave_sum(s); if (row < MP && C.lane < 32) ss0[(size_t)row * 32 + C.lane] = C.lane == 0 ? s : 0.f; } }
    { f32x2* ta = C.wsp<f32x2>(WS_TABA); f32x2* tb = C.wsp<f32x2>(WS_TABB);
      for (int e = C.wg * NWG_THREADS + C.tid; e < 2052 * 16; e += C.G * NWG_THREADS) { const int pi = e >> 4, i = e & 15; const int pos = pi < 2048 ? pi : PAST + (pi - 2048); float s, c; sincos_d((double)pos * P.inv_a[i], s, c); ta[e] = (f32x2){c, s}; }
      for (int e = C.wg * NWG_THREADS + C.tid; e < 2052 * 128; e += C.G * NWG_THREADS) { const int pi = e >> 7, i = e & 127; const int pos = pi < 2048 ? pi : PAST + (pi - 2048); float s, c; sincos_d((double)pos * P.inv_b[i], s, c); tb[e] = (f32x2){c, s}; } }
}

template <int K, bool BKT, int SK_KS, int SK_MAXT, class EP>
DEV void skinny2(LAS unsigned char* lds, const bf16* A, const bf16* Bt, int N, int wg, int nwg, int tid, const EP& ep) {
    constexpr int NST = K / SK_KS, SK_RP = SK_KS * 2 + 32, CPR = SK_KS / 8  , NPRE = (SK_MAXT * 16 * CPR) / 512, KPW = SK_KS / 256  ;
    static_assert(SK_MAXT * 16 * SK_RP <= 131072 && NPRE >= 1, "skinny2: stage buffer");
    const int lane = tid & 63, w = tid >> 6, G4 = lane >> 4, l15 = lane & 15;
    const int ntiles = N / 16, tpw = (ntiles + nwg - 1) / nwg, t0 = wg * tpw; int nt = ntiles - t0; nt = nt > tpw ? tpw : nt;
    if (nt <= 0) return;
    const int nchunks = nt * 16 * CPR; const size_t n0 = (size_t)t0 * 16;
    u32x4 pre[NPRE];
    const int nr8 = nt * 128; int erow[NPRE], ecc[NPRE];
#pragma unroll
    for (int j = 0; j < NPRE; ++j) { const int e = tid + 512 * j; if (BKT) { const int ktl = e / nr8, rem = e - ktl * nr8; erow[j] = rem >> 3; ecc[j] = ktl * 8 + (rem & 7); } else { erow[j] = e / CPR; ecc[j] = e % CPR; } }
#define SK_SRC(j, st) (BKT ? Bt + ((size_t)((st) * (SK_KS / 64) + (ecc[j] >> 3)) * N + n0 + erow[j]) * 64 + (ecc[j] & 7) * 8 : Bt + (n0 + erow[j]) * K + (st) * SK_KS + ecc[j] * 8)
#pragma unroll
    for (int j = 0; j < NPRE; ++j) { const int e = tid + 512 * j; if (e < nchunks) pre[j] = *(const u32x4*)SK_SRC(j, 0); }
    f32x4 acc[SK_MAXT][2];
#pragma unroll
    for (int t = 0; t < SK_MAXT; ++t) { acc[t][0] = (f32x4){0.f, 0.f, 0.f, 0.f}; acc[t][1] = (f32x4){0.f, 0.f, 0.f, 0.f}; }
#pragma unroll 1
    for (int st = 0; st < NST; ++st) {
#pragma unroll
        for (int j = 0; j < NPRE; ++j) { const int e = tid + 512 * j; if (e < nchunks) *(LAS u32x4*)(lds + erow[j] * SK_RP + ecc[j] * 16) = pre[j]; }
        wg_sync_lds();
        if (st + 1 < NST) {
#pragma unroll
            for (int j = 0; j < NPRE; ++j) { const int e = tid + 512 * j; if (e < nchunks) pre[j] = *(const u32x4*)SK_SRC(j, st + 1); }
        }
        bf16x8 af[KPW][2];
#pragma unroll
        for (int kk = 0; kk < KPW; ++kk)
#pragma unroll
            for (int mt = 0; mt < 2; ++mt) af[kk][mt] = *(const bf16x8*)(A + (size_t)(16 * mt + l15) * K + st * SK_KS + 32 * (KPW * w + kk) + 8 * G4);
#pragma unroll
        for (int t = 0; t < SK_MAXT; ++t) if (t < nt) {
#pragma unroll
            for (int kk = 0; kk < KPW; ++kk) { const bf16x8 bfr = *(const LAS bf16x8*)(lds + (16 * t + l15) * SK_RP + (32 * (KPW * w + kk) + 8 * G4) * 2);
                acc[t][0] = mfma16(bfr, af[kk][0], acc[t][0]); acc[t][1] = mfma16(bfr, af[kk][1], acc[t][1]); }
        }
        wg_sync_lds();
    }
    LAS float* part = (LAS float*)lds;
#pragma unroll
    for (int t = 0; t < SK_MAXT; ++t) if (t < nt) {
#pragma unroll
        for (int mt = 0; mt < 2; ++mt)
#pragma unroll
            for (int r = 0; r < 4; ++r) part[((((size_t)t * 8 + w) * 2 + mt) * 4 + r) * 64 + lane] = acc[t][mt][r];
    }
    wg_sync();
    { const int l2 = tid & 63, mt = (tid >> 6) & 1, reg = tid >> 7;
      for (int t = 0; t < nt; ++t) { float s = 0.f;
#pragma unroll
          for (int ww = 0; ww < 8; ++ww) s += part[((((size_t)t * 8 + ww) * 2 + mt) * 4 + reg) * 64 + l2];
          ep(16 * mt + (l2 & 15), (int)n0 + 16 * t + 4 * (l2 >> 4) + reg, s); } }
    wg_sync();
}
#undef SK_SRC
#ifndef MK_STAGGER_TICKS
#define MK_STAGGER_TICKS 0
#endif
#ifndef MK_ATTN_RUN
#define MK_ATTN_RUN 1
#endif

__device__ __forceinline__ float rstd_of(const float* ss, int row) { return pg8::rstd32(ss, row); }
__device__ __forceinline__ void sample_rstd(const Ctx& C, LAS float* srs) {
    const bf16* xb = C.wsp<bf16>(WS_XB);
#pragma unroll
    for (int k = 0; k < 4; ++k) { const int r = C.wave * 4 + k; float s = 0.f;
#pragma unroll
        for (int j = 0; j < 4; ++j) { const u32x4 v = *(const u32x4*)(xb + (size_t)(MP + r) * D + 8 * C.lane + 512 * j);
#pragma unroll
            for (int i = 0; i < 4; ++i) { const float a = __uint_as_float(v[i] << 16), b = __uint_as_float(v[i] & 0xffff0000u); s += a * a + b * b; } }
        s = wave_sum(s); if (C.lane == 0) srs[r] = rsqrtf(s * (1.0f / 2048.0f) + EPS); }
    __syncthreads();
}
__device__ __forceinline__ void sfix_c(const Ctx& C, int layer) {
    const float* zs = C.wsp<float>(WS_ZSRAW); bf16* z = C.wsp<bf16>(WS_Z); LAS float* srs = (LAS float*)C.lds; sample_rstd(C, srs);
    for (int e = C.wg * NWG_THREADS + C.tid; e < MS * C_INM; e += C.G * NWG_THREADS) {
        const int r = e / C_INM, c = e % C_INM, row = MP + r; const float rs = srs[r];
        float v = zs[e] * rs; if (c < 1024) v *= 0.0625f;
        z[(size_t)row * C_INM + c] = (bf16)f2bf(v);
    }
    const float* lr = C.wsp<float>(WS_LR); float* loga = C.wsp<float>(WS_LOGA); const float* wg2 = C.in(15); const float* bg = C.in(16);
    for (int e = MP * 1024 + C.wg * NWG_THREADS + C.tid; e < MT * 1024; e += C.G * NWG_THREADS) {
        const int row = e >> 10, c = e & 1023; const float rs = srs[row - MP];
        float a = 0.f;
#pragma unroll
        for (int r = 0; r < 16; ++r) a += lr[(size_t)row * 16 + r] * wg2[r * 1024 + c];
        a = a * rs + bg[c];
        loga[e] = (fminf(a, 0.f) - log1pf(__expf(-fabsf(a)))) * 0.0625f;
    }
}

__device__ __forceinline__ void gla_pre(const Ctx& C, int layer) {
    bf16* z = C.wsp<bf16>(WS_Z); const float* ss = C.sumsq(layer); const float* lr = C.wsp<float>(WS_LR); float* dvec = C.wsp<float>(WS_DVEC); const float* wg2 = C.in(15); const float* bg = C.in(16);
    LAS float* lrs = (LAS float*)C.lds; LAS float* tot = lrs + 128 * 16; LAS bf16* ebs = (LAS bf16*)(C.lds + 16384);
    for (int u = C.wg; u < 256; u += C.G) {
        const int chunk = u >> 2, cq = u & 3, cl = C.tid & 255, col = cq * 256 + cl, ih = C.tid >> 8;
        { const int row = chunk * 128 + (C.tid >> 2); const f32x4 v = *(const f32x4*)(lr + (size_t)row * 16 + (C.tid & 3) * 4); *(LAS f32x4*)(lrs + C.tid * 4) = v * rstd_of(ss, row); }
        float wv[16];
#pragma unroll
        for (int r = 0; r < 16; ++r) wv[r] = wg2[r * 1024 + col];
        const float bgc = bg[col];
        __syncthreads();
        float la[64]; float run = 0.f;
#pragma unroll
        for (int j = 0; j < 64; ++j) {
            const LAS f32x4* lp = (const LAS f32x4*)(lrs + (ih * 64 + j) * 16);
            const f32x4 l0 = lp[0], l1 = lp[1], l2 = lp[2], l3 = lp[3];
            float a = bgc + l0[0] * wv[0] + l0[1] * wv[1] + l0[2] * wv[2] + l0[3] * wv[3] + l1[0] * wv[4] + l1[1] * wv[5] + l1[2] * wv[6] + l1[3] * wv[7]
                    + l2[0] * wv[8] + l2[1] * wv[9] + l2[2] * wv[10] + l2[3] * wv[11] + l3[0] * wv[12] + l3[1] * wv[13] + l3[2] * wv[14] + l3[3] * wv[15];
            run += (fminf(a, 0.f) - __logf(1.0f + __expf(-fabsf(a)))) * 0.0625f; la[j] = run;
        }
        if (ih == 0) tot[cl] = run;
        __syncthreads();
        const float off = ih ? tot[cl] : 0.f;
#pragma unroll
        for (int j = 0; j < 64; ++j) ebs[(ih * 64 + j) * 256 + cl] = (bf16)f2bf(__expf(la[j] + off));
        if (ih) dvec[(((size_t)(chunk >> 4) * 4 + (col >> 8)) * 16 + (chunk & 15)) * 256 + (col & 255)] = __expf(la[63] + off);
        __syncthreads();
#pragma unroll
        for (int j = 0; j < 8; ++j) {
            const int pc = C.tid + 512 * j, tk = pc >> 5, cg = pc & 31;
            bf16* zq = z + (size_t)(chunk * 128 + tk) * C_INM + cq * 256 + cg * 8;
            const u32x4 qv = *(const u32x4*)zq, kv = *(const u32x4*)(zq + 1024); const u32x4 ev = *(const LAS u32x4*)(ebs + tk * 256 + cg * 8);
            u32x4 qo, ko;
#pragma unroll
            for (int k = 0; k < 4; ++k) { const float e0 = __uint_as_float(ev[k] << 16), e1 = __uint_as_float(ev[k] & 0xffff0000u); const float i0 = 1.0f / e0, i1 = 1.0f / e1;
                qo[k] = pk2(__uint_as_float(qv[k] << 16) * e0, __uint_as_float(qv[k] & 0xffff0000u) * e1); ko[k] = pk2(__uint_as_float(kv[k] << 16) * i0, __uint_as_float(kv[k] & 0xffff0000u) * i1); }
            *(u32x4*)zq = qo; *(u32x4*)(zq + 1024) = ko;
        }
        __syncthreads();
    }
}
template <int NVT, class OT>
__device__ __forceinline__ void scan_phase(const Ctx& C, int ldz, int qoff, int koff, int voff, int H, const float* dvec, float* state_out) {
    const bf16* z = C.wsp<bf16>(WS_Z); OT* o = C.wsp<OT>(WS_O);
    const int nunits = NB * H * (512 / (16 * NVT));
    for (int u = C.wg; u < nunits; u += C.G) scan_unit<NVT, OT>(C.lds, z, ldz, qoff, koff, voff, H, u, dvec, o, H * 512, state_out, C.tid);
}

__device__ __forceinline__ float dot128_bb(const bf16* q, const bf16* k) {
    float a = 0.f;
#pragma unroll 4
    for (int i = 0; i < 16; ++i) { const u32x4 x = ((const u32x4*)q)[i], y = ((const u32x4*)k)[i];
#pragma unroll
        for (int j = 0; j < 4; ++j) a += __uint_as_float(x[j] << 16) * __uint_as_float(y[j] << 16) + __uint_as_float(x[j] & 0xffff0000u) * __uint_as_float(y[j] & 0xffff0000u); }
    return a;
}
__device__ __forceinline__ float dot128_bf(const bf16* q, const float* k) {
    float a = 0.f;
#pragma unroll 4
    for (int i = 0; i < 16; ++i) { const u32x4 x = ((const u32x4*)q)[i]; const f32x4 y0 = ((const f32x4*)k)[2 * i], y1 = ((const f32x4*)k)[2 * i + 1];
        a += __uint_as_float(x[0] << 16) * y0[0] + __uint_as_float(x[0] & 0xffff0000u) * y0[1] + __uint_as_float(x[1] << 16) * y0[2] + __uint_as_float(x[1] & 0xffff0000u) * y0[3]
           + __uint_as_float(x[2] << 16) * y1[0] + __uint_as_float(x[2] & 0xffff0000u) * y1[1] + __uint_as_float(x[3] << 16) * y1[2] + __uint_as_float(x[3] & 0xffff0000u) * y1[3]; }
    return a;
}
template <bool GLA, class OT, bool ROT>
__device__ __forceinline__ void recur_naive(const Ctx& C, int ldz, int qoff, int koff, int voff, int H, int nseq, int ntok, int row0, const float* state0, float* state_out) {
    static_assert(sizeof(OT) == 4, "f32 o only");
    const bf16* z = C.wsp<bf16>(WS_Z); float* o = C.wsp<float>(WS_O); const float* loga = C.wsp<float>(WS_LOGA); const f32x2* tb = C.wsp<f32x2>(WS_TABB);
    LAS float* red = (LAS float*)C.lds;
    const int lane = C.lane, dg = C.wave;
    for (int item = C.wg; item < nseq * H * 8; item += C.G) {
        const int vs = item & 7, h = (item >> 3) % H, seq = (item >> 3) / H;
        const size_t sbase = (((size_t)seq * H + h) * 256 + dg * 32) * 512 + vs * 64 + lane;
        float Sreg[32];
#pragma unroll
        for (int j = 0; j < 32; ++j) Sreg[j] = state0[sbase + (size_t)j * 512];
        const float gamma = GLA ? 1.f : 1.0f - exp2f(-5.0f - (float)h);
        for (int t = 0; t < ntok; ++t) {
            const int row = row0 + seq * ntok + t; const bf16* zr = z + (size_t)row * ldz;
            const int d = dg * 32 + (lane & 31);
            float qv, kv, dv = gamma;
            if constexpr (ROT) { const int i = d & 127; const f32x2 cs = tb[(2048 + t) * 128 + i];
                const float q1 = bf2f(zr[qoff + h * 256 + i]), q2 = bf2f(zr[qoff + h * 256 + i + 128]), k1 = bf2f(zr[koff + h * 256 + i]), k2 = bf2f(zr[koff + h * 256 + i + 128]);
                qv = d < 128 ? q1 * cs.x - q2 * cs.y : q1 * cs.y + q2 * cs.x; kv = d < 128 ? k1 * cs.x - k2 * cs.y : k1 * cs.y + k2 * cs.x;
            } else { qv = bf2f(zr[qoff + h * 256 + d]); kv = bf2f(zr[koff + h * 256 + d]); }
            if (GLA) dv = __expf(loga[(size_t)row * 1024 + h * 256 + d]);
            const float vv = bf2f(zr[voff + h * 512 + vs * 64 + lane]);
            float p = 0.f;
#pragma unroll
            for (int j = 0; j < 32; ++j) { const float qj = __shfl(qv, j), kj = __shfl(kv, j), dj = GLA ? __shfl(dv, j) : gamma; Sreg[j] = dj * Sreg[j] + kj * vv; p += qj * Sreg[j]; }
            red[((t & 1) * 8 + dg) * 64 + lane] = p;
            __syncthreads();
            if (dg == 0) { const LAS float* rr = red + (t & 1) * 512 + lane; o[(size_t)row * (H * 512) + h * 512 + vs * 64 + lane] = ((rr[0] + rr[64]) + (rr[128] + rr[192])) + ((rr[256] + rr[320]) + (rr[384] + rr[448])); }
        }
#pragma unroll
        for (int j = 0; j < 32; ++j) state_out[sbase + (size_t)j * 512] = Sreg[j];
        __syncthreads();
    }
}
struct NGItem { f32x4 oa[4], ob[4]; u32x4 gw[4]; };
__device__ __forceinline__ void ng_load(NGItem& it, const float* o, const bf16* z, int H, int ldz, int goff, int w0, int lane) {
#pragma unroll
    for (int k = 0; k < 4; ++k) { const int w = w0 + k, row = w / H, h = w % H; const float* orow = o + (size_t)row * (H * 512) + h * 512;
        it.oa[k] = ((const f32x4*)orow)[2 * lane]; it.ob[k] = ((const f32x4*)orow)[2 * lane + 1]; it.gw[k] = ((const u32x4*)(z + (size_t)row * ldz + goff + h * 512))[lane]; }
}
template <bool MEAN, class OT>
__device__ __forceinline__ void norm_gate(const Ctx& C, int H, int ldz, int goff, const float* gn) {
    static_assert(sizeof(OT) == 4, "norm_gate: f32 o only");
    const bf16* z = C.wsp<bf16>(WS_Z); const float* o = C.wsp<float>(WS_O); bf16* y = C.wsp<bf16>(WS_Y); const int lane = C.lane;
    const int total = MT * H, stride = C.G * 8 * 4; int w0 = (C.wg * 8 + C.wave) * 4;
    if (w0 >= total) return;
    f32x4 g0[4], g1[4];
#pragma unroll
    for (int k = 0; k < 4; ++k) { const int h = (w0 + k) % H; g0[k] = ((const f32x4*)(gn + h * 512))[2 * lane]; g1[k] = ((const f32x4*)(gn + h * 512))[2 * lane + 1]; }
    NGItem cur; ng_load(cur, o, z, H, ldz, goff, w0, lane);
    for (;;) {
        const int wn = w0 + stride; const bool has = wn < total; NGItem nxt;
        if (has) ng_load(nxt, o, z, H, ldz, goff, wn, lane);
#pragma unroll
        for (int k = 0; k < 4; ++k) {
            const int w = w0 + k, row = w / H, h = w % H;
            float v[8] = {cur.oa[k][0], cur.oa[k][1], cur.oa[k][2], cur.oa[k][3], cur.ob[k][0], cur.ob[k][1], cur.ob[k][2], cur.ob[k][3]};
            float s = 0.f;
#pragma unroll
            for (int i = 0; i < 8; ++i) s += v[i];
            float mu = 0.f; if (MEAN) mu = wave_sum(s) * (1.f / 512.f);
            float q = 0.f;
#pragma unroll
            for (int i = 0; i < 8; ++i) { v[i] -= mu; q += v[i] * v[i]; }
            const float r = rsqrtf(wave_sum(q) * (1.f / 512.f) + EPS);
            const float gg[8] = {g0[k][0], g0[k][1], g0[k][2], g0[k][3], g1[k][0], g1[k][1], g1[k][2], g1[k][3]};
            float ov[8];
#pragma unroll
            for (int i = 0; i < 4; ++i) { ov[2 * i] = v[2 * i] * r * gg[2 * i] * silu(__uint_as_float(cur.gw[k][i] << 16)); ov[2 * i + 1] = v[2 * i + 1] * r * gg[2 * i + 1] * silu(__uint_as_float(cur.gw[k][i] & 0xffff0000u)); }
            u32x4 ow; ow.x = pk2(ov[0], ov[1]); ow.y = pk2(ov[2], ov[3]); ow.z = pk2(ov[4], ov[5]); ow.w = pk2(ov[6], ov[7]);
            ((u32x4*)(y + (size_t)row * (H * 512) + h * 512))[lane] = ow;
        }
        if (!has) break;
        cur = nxt; w0 = wn;
    }
}
__device__ __forceinline__ void final_norm(const Ctx& C) {
    const bf16* xb = C.wsp<bf16>(WS_XB); const float* fg = C.in(8);
    for (int row = C.wg * 8 + C.wave; row < MT; row += C.G * 8) {
        u32x4 xv[4]; float s = 0.f;
#pragma unroll
        for (int j = 0; j < 4; ++j) { xv[j] = *(const u32x4*)(xb + (size_t)row * D + 8 * C.lane + 512 * j);
#pragma unroll
            for (int i = 0; i < 4; ++i) { const float a = __uint_as_float(xv[j][i] << 16), b = __uint_as_float(xv[j][i] & 0xffff0000u); s += a * a + b * b; } }
        const float rs = rsqrtf(wave_sum(s) * (1.0f / 2048.0f) + EPS);
#pragma unroll
        for (int j = 0; j < 4; ++j) { const int c = 8 * C.lane + 512 * j; const f32x4 g0 = *(const f32x4*)(fg + c), g1 = *(const f32x4*)(fg + c + 4);
            const f32x4 v0 = {__uint_as_float(xv[j][0] << 16), __uint_as_float(xv[j][0] & 0xffff0000u), __uint_as_float(xv[j][1] << 16), __uint_as_float(xv[j][1] & 0xffff0000u)};
            const f32x4 v1 = {__uint_as_float(xv[j][2] << 16), __uint_as_float(xv[j][2] & 0xffff0000u), __uint_as_float(xv[j][3] << 16), __uint_as_float(xv[j][3] & 0xffff0000u)};
            *(f32x4*)(C.out + (size_t)row * D + c) = v0 * rs * g0; *(f32x4*)(C.out + (size_t)row * D + c + 4) = v1 * rs * g1; }
    }
}

__device__ __forceinline__ void attn_fast_phase(const Ctx& C) {
    const bf16* z = C.wsp<bf16>(WS_Z); bf16* og = C.wsp<bf16>(WS_O); float* lse = C.wsp<float>(WS_LOGA);
    const int per = (3072 + C.G - 1) / C.G;
    const int i0 = C.wg * per; int n = 3072 - i0; n = n > per ? per : n;
#if MK_ATTN_RUN
    if (n > 0) attn_run(C.lds, z, A_IN, og, lse, i0, n, C.tid);
#else
    for (int j = 0; j < n; ++j) attn_item(C.lds, z, A_IN, og, lse, i0 + j, C.tid);
#endif
}
__device__ __forceinline__ void sattn_phase(const Ctx& C, int slot, const float* c1, const float* c2, const float* c3) {
    const bf16* z = C.wsp<bf16>(WS_Z); bf16* og = C.wsp<bf16>(WS_O); float* lse = C.wsp<float>(WS_LOGA);
    for (int u0 = C.wg * 6; u0 < 1536; u0 += C.G * 6) {
        const int u = u0 + C.wave;
        if (C.wave < 6 && u < 1536) {
            const int t = u & 3, h = (u >> 2) & 15, b = (u >> 6) & 7, g = u >> 9;
            const float* cache = c1; if (g == 1) cache = c2; if (g == 2) cache = c3;
            float* skv = C.out + (size_t)MP * D + (size_t)MS * D + (size_t)2 * 4 * (128 + 512 + 2048) * 4096 + (size_t)4 * 8 * 256 * 512 + (size_t)4 * 4 * 256 * 512;
            sattn_unit(C.lds + C.wave * 1024, z, A_IN, cache + (size_t)slot * 8 * (128 << (2 * g)) * 4096, g, b, t, h, og, lse, C.lane, C.wsp<f32x2>(WS_TABA), skv + (size_t)g * (2 * 8 * 4 * 4096) + (size_t)(slot * DB + b) * T * 2 * 2048);
        }
    }
}
struct MGItem { u32x4 a[4], b[4], c[4], gt[4]; float l0[4], l1[4], l2[4]; };
__device__ __forceinline__ void mg_load(MGItem& it, const bf16* z, const bf16* og, const float* lse, int row, int lane) {
#pragma unroll
    for (int j = 0; j < 4; ++j) { const int col = (lane + 64 * j) * 8, h = col >> 7;
        it.l0[j] = lse[((size_t)0 * MT + row) * 16 + h]; it.l1[j] = lse[((size_t)1 * MT + row) * 16 + h]; it.l2[j] = lse[((size_t)2 * MT + row) * 16 + h];
        it.a[j] = *(const u32x4*)(og + ((size_t)0 * MT + row) * 2048 + col); it.b[j] = *(const u32x4*)(og + ((size_t)1 * MT + row) * 2048 + col); it.c[j] = *(const u32x4*)(og + ((size_t)2 * MT + row) * 2048 + col);
        it.gt[j] = *(const u32x4*)(z + att_zoff(row, 18432 + col)); }
}
__device__ __forceinline__ void attn_merge(const Ctx& C) {
    const bf16* z = C.wsp<bf16>(WS_Z); const bf16* og = C.wsp<bf16>(WS_O); const float* lse = C.wsp<float>(WS_LOGA); bf16* y = C.wsp<bf16>(WS_Y); const int lane = C.lane;
    int row = C.wg * 8 + C.wave; const int stride = C.G * 8;
    if (row >= MT) return;
    MGItem cur; mg_load(cur, z, og, lse, row, lane);
    for (;;) {
        const int rn = row + stride; const bool has = rn < MT; MGItem nxt;
        if (has) mg_load(nxt, z, og, lse, rn, lane);
#pragma unroll
        for (int j = 0; j < 4; ++j) {
            const int col = (lane + 64 * j) * 8;
            const float m = fmaxf(cur.l0[j], fmaxf(cur.l1[j], cur.l2[j])); float w0 = __expf(cur.l0[j] - m), w1 = __expf(cur.l1[j] - m), w2 = __expf(cur.l2[j] - m); const float inv = 1.0f / (w0 + w1 + w2); w0 *= inv; w1 *= inv; w2 *= inv;
            u32x4 o;
#pragma unroll
            for (int k = 0; k < 4; ++k) {
                const float lo = (w0 * __uint_as_float(cur.a[j][k] << 16) + w1 * __uint_as_float(cur.b[j][k] << 16) + w2 * __uint_as_float(cur.c[j][k] << 16)) * silu(__uint_as_float(cur.gt[j][k] << 16));
                const float hi = (w0 * __uint_as_float(cur.a[j][k] & 0xffff0000u) + w1 * __uint_as_float(cur.b[j][k] & 0xffff0000u) + w2 * __uint_as_float(cur.c[j][k] & 0xffff0000u)) * silu(__uint_as_float(cur.gt[j][k] & 0xffff0000u));
                o[k] = pk2(lo, hi);
            }
            *(u32x4*)(y + (size_t)row * 2048 + col) = o;
        }
        if (!has) break;
        cur = nxt; row = rn;
    }
}

template <int MODE>
__device__ __forceinline__ void gemm_in(const Ctx& C, size_t wt_off, int N, int layer, float* kvb, int slot) {
    if (MODE == 0 && MK_STAGGER_TICKS > 0) {
        const unsigned long long t0 = __builtin_amdgcn_s_memrealtime(); const unsigned long long dl = (unsigned long long)((C.wg & 7) * MK_STAGGER_TICKS / 8);
        while (__builtin_amdgcn_s_memrealtime() - t0 < dl) __builtin_amdgcn_s_sleep(8);
    }
    pg8::Gemm g{C.wsp<pg8::bf16_t>(WS_XB), C.wsp<pg8::bf16_t>(wt_off), MP, N, D}; pg8::StaticOrder So; So.init(MP, N, C.G, C.wg);
    LAS float* rst = (LAS float*)(C.lds + 131072 + 4096); int pm0 = -1;
    { pg8::Unit u0; if (So.next(0, u0)) { pm0 = u0.pm; if (C.tid < 256) rst[C.tid] = pg8::rstd32(C.sumsq(layer), pm0 * 256 + C.tid); } }
    __syncthreads();
    pg8::EpiIn<MODE> E{C.wsp<pg8::bf16_t>(WS_Z), N, C.sumsq(layer), (const pg8::f32x2*)C.wsp<f32x2>(MODE == 0 ? WS_TABA : WS_TABB), kvb, slot, (const PG8_LAS float*)rst, pm0};
    pg8::gemm_phase<pg8::EpiIn<MODE>, pg8::StaticOrder, true, true>((PG8_LAS unsigned char*)C.lds, g, So, E);
}
template <int K>
__device__ __forceinline__ void gemm_out(const Ctx& C, size_t wt_off, int layer) {
    pg8::Gemm g{C.wsp<pg8::bf16_t>(WS_Y), C.wsp<pg8::bf16_t>(wt_off), MP, D, K}; pg8::StaticOrder So; So.init(MP, D, C.G, C.wg);
    pg8::EpiOut E{C.wsp<pg8::bf16_t>(WS_XB), C.sumsq(layer < 3 ? layer + 1 : 0)};
    bf16* xb = C.wsp<bf16>(WS_XB);
    skinny2<K, true, 2048, 1>(C.lds, C.wsp<bf16>(WS_Y) + (size_t)MP * K, C.wsp<bf16>(wt_off), D, C.wg, C.G, C.tid, [=](int m, int n, float v) {
        const size_t o = (size_t)(MP + m) * D + n; xb[o] = (bf16)f2bf(bf2f(xb[o]) + v); });
    pg8::gemm_phase<pg8::EpiOut, pg8::StaticOrder, true, true>((PG8_LAS unsigned char*)C.lds, g, So, E);
}
__device__ __forceinline__ void skinny_in(const Ctx& C, size_t wt_off, int N) {
    float* zs = C.wsp<float>(WS_ZSRAW);
    skinny2<D, true, 512, 5>(C.lds, C.wsp<bf16>(WS_XB) + (size_t)MP * D, C.wsp<bf16>(wt_off), N, C.wg, C.G, C.tid, [=](int m, int n, float v) { zs[(size_t)m * N + n] = v; });
}
__device__ __forceinline__ void skinny_in_z(const Ctx& C, size_t wt_off, int N, bool kscale) {
    bf16* z = C.wsp<bf16>(WS_Z); const LAS float* srs = (const LAS float*)(C.lds + 131072 + 4096 + 1024);
    sample_rstd(C, (LAS float*)(C.lds + 131072 + 4096 + 1024));
    skinny2<D, true, 512, 5>(C.lds, C.wsp<bf16>(WS_XB) + (size_t)MP * D, C.wsp<bf16>(wt_off), N, C.wg, C.G, C.tid, [=](int m, int n, float v) {
        float s = srs[m]; if (kscale && n >= 2048 && n < 4096) s *= 0.0625f;
        const size_t zo = kscale ? (size_t)(MP + m) * N + n : att_zoff(MP + m, n);
        z[zo] = (bf16)f2bf(v * s); });
}

__global__ void __launch_bounds__(NWG_THREADS, 2) mk_fwd(Params P) {
    extern __shared__ __attribute__((aligned(16))) unsigned char lds_raw[];
    Ctx C; C.lds = (LAS unsigned char*)lds_raw; C.tid = threadIdx.x; C.lane = C.tid & 63; C.wave = __builtin_amdgcn_readfirstlane(C.tid >> 6); C.G = gridDim.x; C.wg = blockIdx.x;
    C.P = &P; C.out = P.out; C.ws = P.ws;
    volatile LAS unsigned* MISC = (volatile LAS unsigned*)(C.lds + MISC_OFF);
    if (C.tid < 32) MISC[C.tid] = 0u;
    __syncthreads();
    XcdBarrier bar = xcd_barrier_post((unsigned*)(P.ws + CTL_BAR), MISC + 8);
    int ph = 0;
#define RUN (ph >= P.ph_lo && ph < P.ph_hi)
#define SEAM() do { if (ph >= P.ph_lo && ph + 1 < P.ph_hi) xcd_barrier(bar); ++ph; } while (0)
    float* out = P.out;
    float* pkv1 = out + (size_t)MP * D + (size_t)MS * D; float* pkv2 = pkv1 + (size_t)2 * 4 * 128 * 4096; float* pkv3 = pkv2 + (size_t)2 * 4 * 512 * 4096;
    float* pst_b = pkv3 + (size_t)2 * 4 * 2048 * 4096; float* pst_c = pst_b + (size_t)4 * 8 * 256 * 512;
    float* sst_b = pst_c + (size_t)4 * 4 * 256 * 512 + (size_t)3 * 2 * 8 * 4 * 4096; float* sst_c = sst_b + (size_t)8 * 8 * 256 * 512;

    if (RUN) p0_prologue(C, P);
    SEAM();
    if (RUN) { skinny_in_z(C, WS_WIA0, A_IN, false); gemm_in<0>(C, WS_WIA0, A_IN, 0, pkv1, 0); }
    SEAM();
    if (RUN) { attn_fast_phase(C); sattn_phase(C, 0, P.in[2], P.in[3], P.in[4]); }
    SEAM();
    if (RUN) attn_merge(C);
    SEAM();
    if (RUN) gemm_out<2048>(C, WS_WOA0, 0);
    SEAM();
    if (RUN) { skinny_in_z(C, WS_WIB, B_IN, true); gemm_in<1>(C, WS_WIB, B_IN, 1, nullptr, 0); }
    SEAM();
    if (RUN) { scan_phase<4, float>(C, B_IN, 0, 2048, 4096, 8, nullptr, pst_b); recur_naive<false, float, true>(C, B_IN, 0, 2048, 4096, 8, DB, T, MP, C.in(5), sst_b); }
    SEAM();
    if (RUN) norm_gate<true, float>(C, 8, B_IN, 8192, C.in(12));
    SEAM();
    if (RUN) gemm_out<4096>(C, WS_WOB, 1);
    SEAM();
    if (RUN) { skinny_in(C, WS_WIC, C_INM);
        float* lr = C.wsp<float>(WS_LR);
        skinny2<D, false, 512, 5>(C.lds, C.wsp<bf16>(WS_WLR), C.wsp<bf16>(WS_XB), MT, C.wg, C.G, C.tid, [=](int m, int n, float v) { if (m < 16) lr[(size_t)n * 16 + m] = v; }); gemm_in<2>(C, WS_WIC, C_INM, 2, nullptr, 0); }
    SEAM();
    if (RUN) { sfix_c(C, 2); __syncthreads(); gla_pre(C, 2); }
    SEAM();
    if (RUN) { scan_phase<2, float>(C, C_INM, 0, 1024, 2048, 4, C.wsp<float>(WS_DVEC), pst_c); recur_naive<true, float, false>(C, C_INM, 0, 1024, 2048, 4, DB, T, MP, C.in(6), sst_c); }
    SEAM();
    if (RUN) norm_gate<false, float>(C, 4, C_INM, 4096, C.in(17));
    SEAM();
    if (RUN) gemm_out<2048>(C, WS_WOC, 2);
    SEAM();
    if (RUN) { skinny_in_z(C, WS_WIA1, A_IN, false); gemm_in<0>(C, WS_WIA1, A_IN, 3, pkv1, 1); }
    SEAM();
    if (RUN) { attn_fast_phase(C); sattn_phase(C, 1, P.in[2], P.in[3], P.in[4]); }
    SEAM();
    if (RUN) attn_merge(C);
    SEAM();
    if (RUN) gemm_out<2048>(C, WS_WOA1, 3);
    SEAM();
    if (RUN) final_norm(C);
#undef RUN
#undef SEAM
}
constexpr int NPHASES = 19;
}

#ifndef MK_PRE_LO
#define MK_PRE_LO -1
#endif
#ifndef MK_PRE
#define MK_PRE -1
#endif
#ifndef MK_LAUNCHES
#define MK_LAUNCHES 1
#endif
extern "C" void kernel_launch(void* const* d_in, const int* in_sizes, int n_in, void* d_out, int out_size, void* d_ws, size_t ws_size, hipStream_t stream) {
    using namespace mk;
    static int grid = 0;
    if (grid == 0) {
        int dev = 0, cus = 0;
        if (hipGetDevice(&dev) != hipSuccess || hipDeviceGetAttribute(&cus, hipDeviceAttributeMultiprocessorCount, dev) != hipSuccess) { fprintf(stderr, "kernel_launch: device query failed\n"); grid = -1; return; }
        if (hipFuncSetAttribute((const void*)mk_fwd, hipFuncAttributeMaxDynamicSharedMemorySize, LDS_BYTES) != hipSuccess) { fprintf(stderr, "kernel_launch: hipFuncSetAttribute failed\n"); grid = -1; return; }
        int per_cu = 0;
        if (hipOccupancyMaxActiveBlocksPerMultiprocessor(&per_cu, (const void*)mk_fwd, NWG_THREADS, LDS_BYTES) != hipSuccess || per_cu < 1) fprintf(stderr, "kernel_launch: occupancy query says %d\n", per_cu);
        (void)hipGetLastError();
        if (ws_size < WS_END) { fprintf(stderr, "kernel_launch: workspace too small (%zu < %zu)\n", ws_size, (size_t)WS_END); grid = -1; return; }
        grid = cus;
    }
    if (grid < 0) return;
    (void)hipMemsetAsync((char*)d_ws + WS_CTL, 0, CTL_ZERO_BYTES, stream);
    Params p{};
    for (int i = 0; i < 19; ++i) p.in[i] = (const float*)d_in[i];
    p.out = (float*)d_out; p.ws = (unsigned char*)d_ws;
    for (int i = 0; i < 16; ++i) p.inv_a[i] = pow(500000.0, -(double)i / 16.0);
    for (int i = 0; i < 128; ++i) p.inv_b[i] = pow(10000.0, -(double)i / 128.0);
    if (MK_PRE >= 0) { p.ph_lo = MK_PRE_LO >= 0 ? MK_PRE_LO : MK_PRE; p.ph_hi = MK_PRE + 1; hipLaunchKernelGGL(mk_fwd, dim3(grid), dim3(NWG_THREADS), LDS_BYTES, stream, p); (void)hipMemsetAsync((char*)d_ws + WS_CTL, 0, CTL_ZERO_BYTES, stream); }
    if (MK_LAUNCHES == 1) { p.ph_lo = 0; p.ph_hi = NPHASES; hipLaunchKernelGGL(mk_fwd, dim3(grid), dim3(NWG_THREADS), LDS_BYTES, stream, p); }
    else for (int k = 0; k < NPHASES; ++k) { p.ph_lo = k; p.ph_hi = k + 1; hipLaunchKernelGGL(mk_fwd, dim3(grid), dim3(NWG_THREADS), LDS_BYTES, stream, p); }
}
```

```cpp
#include <hip/hip_runtime.h>
#include <cstdio>
#include <cstdint>
#include <cmath>
namespace pg8 {
#define PG8_LAS __attribute__((address_space(3)))
typedef unsigned short bf16_t;
typedef short bf16x8 __attribute__((ext_vector_type(8)));
typedef float f32x4 __attribute__((ext_vector_type(4)));
typedef unsigned u32x4 __attribute__((ext_vector_type(4)));
constexpr int BM = 256, BK = 64, HALF = 128, HTB = HALF * BK * 2  , STAGE_BYTES = 8 * HTB, NXCD = 8, WGM = 8;

__host__ __device__ __forceinline__ int lds_byte(int r, int c) { const int st = (r >> 4) * 2 + (c >> 5), rr = r & 15, cc = c & 31, ob = rr * 64 + cc * 2; return st * 1024 + (ob ^ (((ob >> 9) & 1) << 5)); }
__host__ __device__ __forceinline__ void stage_rc(int b, int& R, int& C) { const int st = b / 1024, sb = b % 1024, swz = sb ^ (((sb >> 9) & 1) << 5); R = (st >> 1) * 16 + swz / 64; C = (st & 1) * 32 + (swz % 64) / 2; }
__host__ __device__ __forceinline__ int perm32(int rho) { const int n = rho >> 4, i = rho & 15; return 8 * (i >> 2) + 4 * n + (i & 3); }

struct Unit { int pm, pn; };
struct Gemm { const bf16_t* A; const bf16_t* Bt; int M, N, K; };

struct StaticOrder {
    int nM, nN, nwg, G, c;
    __host__ __device__ void init(int M, int N, int G_, int c_) { nM = M / BM; nN = N / BM; nwg = nM * nN; G = G_; c = c_; }
    __host__ __device__ bool next(int i, Unit& u) const {
        const long L = (long)i * G + c; if (L >= nwg) return false;
        int wgid = (int)L; { const int q = nwg / NXCD, r = nwg % NXCD, xcd = wgid % NXCD, off = wgid / NXCD; wgid = (xcd < r ? xcd * (q + 1) : r * (q + 1) + (xcd - r) * q) + off; }
        const int nig = WGM * nN, gid = wgid / nig, fm = gid * WGM, gsz = (nM - fm) < WGM ? (nM - fm) : WGM;
        u.pm = fm + ((wgid % nig) % gsz); u.pn = (wgid % nig) / gsz; return true;
    }
    __device__ __forceinline__ void a_ready(const Unit&) const {}
    __device__ __forceinline__ void done(const Unit&) const {}
};

__device__ __forceinline__ unsigned cvt_pk_bf16(float lo, float hi) { unsigned r; asm volatile("v_cvt_pk_bf16_f32 %0, %1, %2" : "=v"(r) : "v"(lo), "v"(hi)); return r; }
typedef float f32x2 __attribute__((ext_vector_type(2)));
typedef unsigned u32x2 __attribute__((ext_vector_type(2)));

__device__ __forceinline__ float rstd32(const float* part, int row) { const f32x4* p = (const f32x4*)(part + (size_t)row * 32); f32x4 s = p[0];
#pragma unroll
    for (int i = 1; i < 8; ++i) s += p[i];
    return rsqrtf(((s[0] + s[1]) + (s[2] + s[3])) * (1.0f / 2048.0f) + 1e-6f); }
template <int MODE> struct EpiIn {
    static constexpr bool PERM = true, AFTER_DRAIN = false;
    bf16_t* Z; int ldz; const float* sumsq; const f32x2* tab; float* kvb; int slot; const PG8_LAS float* rs_lds; int pm0;
    __device__ __forceinline__ float rs_of(const Unit& u, int row) const { return u.pm == pm0 ? rs_lds[row & 255] : rstd32(sumsq, row); }
    __device__ __forceinline__ void store8(bf16_t* p, const f32x4& a, const f32x4& b) const {
        u32x4 w; w.x = cvt_pk_bf16(a[0], a[1]); w.y = cvt_pk_bf16(a[2], a[3]); w.z = cvt_pk_bf16(b[0], b[1]); w.w = cvt_pk_bf16(b[2], b[3]); *(u32x4*)p = w; }
    __device__ __forceinline__ void operator()(const f32x4 (&acc)[2][2][4][2], const Unit& u, int wr, int wc, int fr, int fq) const {
        const int row0 = u.pm * BM + wr * 64 + fr, colt = u.pn * BM;
        if constexpr (MODE == 0) {
            const int section = u.pn >> 3, kind = section < 9 ? section % 3 : 3, g = section / 3;
            const bool rot = (kind < 2) && (wc == 0);
            const int gg = g > 2 ? 2 : g, keep = 128 << (2 * gg); float* kvo = kvb + (size_t)32768 * (size_t)(128 * (((1 << (2 * gg)) - 1) / 3)) + (size_t)slot * 4 * keep * 4096;
#pragma unroll
            for (int ai = 0; ai < 2; ++ai)
#pragma unroll
                for (int m = 0; m < 4; ++m) {
                    const int row = row0 + ai * HALF + m * 16; const float rs = rs_of(u, row); const int pos = row & 2047, b = row >> 11;
#pragma unroll
                    for (int bj = 0; bj < 2; ++bj) {
                        f32x4 v0 = acc[ai][bj][m][0] * rs, v1 = acc[ai][bj][m][1] * rs;
                        const int col = colt + bj * HALF + wc * 32 + 8 * fq;
                        if (rot) {
                            f32x4 p0, p1;
#pragma unroll
                            for (int j = 0; j < 4; ++j) { p0[j] = __shfl_xor(v0[j], 32); p1[j] = __shfl_xor(v1[j], 32); }
                            const f32x4* tp = (const f32x4*)(tab + pos * 16 + 8 * (fq & 1));
                            const f32x4 t0 = tp[0], t1 = tp[1], t2 = tp[2], t3 = tp[3];
                            const f32x4 c0 = {t0[0], t0[2], t1[0], t1[2]}, s0 = {t0[1], t0[3], t1[1], t1[3]}, c1 = {t2[0], t2[2], t3[0], t3[2]}, s1 = {t2[1], t2[3], t3[1], t3[3]};
                            if (fq < 2) { v0 = v0 * c0 - p0 * s0; v1 = v1 * c1 - p1 * s1; } else { v0 = p0 * s0 + v0 * c0; v1 = p1 * s1 + v1 * c1; }
                        }
                        store8(Z + ((size_t)(col >> 7) * 8224 + row) * 128 + (col & 127), v0, v1);
                        if (kind == 1 || kind == 2) {
                            if (pos >= 2048 - keep) { float* o = kvo + (((size_t)b * keep + (pos - (2048 - keep))) * 2 + (kind - 1)) * 2048 + (col - section * 2048);
                                __builtin_nontemporal_store(v0, (f32x4*)o); __builtin_nontemporal_store(v1, (f32x4*)(o + 4)); }
                        }
                    }
                }
        } else if constexpr (MODE == 1) {
            const bool rot = u.pn < 16; const float sc = (u.pn >= 8 && u.pn < 16) ? 0.0625f : 1.0f;
            const float lg2 = log2f(1.0f - exp2f(-5.0f - (float)(u.pn & 7)));
#pragma unroll
            for (int ai = 0; ai < 2; ++ai)
#pragma unroll
                for (int m = 0; m < 4; ++m) {
                    const int row = row0 + ai * HALF + m * 16; const int pos = row & 2047;
                    float rs = rs_of(u, row) * sc;
                    if (rot) { const float ee = (float)((pos & 127) + 1) * lg2; rs *= exp2f(u.pn < 8 ? ee : -ee); }
                    f32x4 x1[2], x2[2];
#pragma unroll
                    for (int n = 0; n < 2; ++n) { x1[n] = acc[ai][0][m][n] * rs; x2[n] = acc[ai][1][m][n] * rs; }
                    if (rot) {
#pragma unroll
                        for (int n = 0; n < 2; ++n) {
                            const f32x4* tp = (const f32x4*)(tab + pos * 128 + wc * 32 + 8 * fq + 4 * n);
                            const f32x4 t0 = tp[0], t1 = tp[1];
                            const f32x4 c = {t0[0], t0[2], t1[0], t1[2]}, s = {t0[1], t0[3], t1[1], t1[3]};
                            const f32x4 a = x1[n], bb = x2[n];
                            x1[n] = a * c - bb * s; x2[n] = a * s + bb * c;
                        }
                    }
                    bf16_t* zp = Z + (size_t)row * ldz + colt + wc * 32 + 8 * fq;
                    store8(zp, x1[0], x1[1]); store8(zp + HALF, x2[0], x2[1]);
                }
        } else {
            const float sc = u.pn < 4 ? 0.0625f : 1.0f;
#pragma unroll
            for (int ai = 0; ai < 2; ++ai)
#pragma unroll
                for (int m = 0; m < 4; ++m) {
                    const int row = row0 + ai * HALF + m * 16; const float rs = rs_of(u, row) * sc;
                    bf16_t* zp = Z + (size_t)row * ldz + colt + wc * 32 + 8 * fq;
#pragma unroll
                    for (int bj = 0; bj < 2; ++bj) store8(zp + bj * HALF, acc[ai][bj][m][0] * rs, acc[ai][bj][m][1] * rs);
                }
        }
    }
};
struct EpiOut {
    static constexpr bool PERM = false, AFTER_DRAIN = false;
    bf16_t* xb; float* sumsq_next;
    __device__ __forceinline__ void operator()(const f32x4 (&acc)[2][2][4][2], const Unit& u, int wr, int wc, int fr, int fq) const {
        const int row0 = u.pm * BM + wr * 64 + fr, col0 = u.pn * BM + wc * 32 + 4 * fq;
#pragma unroll
        for (int ai = 0; ai < 2; ++ai)
#pragma unroll
            for (int m = 0; m < 4; ++m) {
                const int row = row0 + ai * HALF + m * 16; float ss = 0.f;
                bf16_t* br = xb + (size_t)row * 2048 + col0;
                u32x2 old[2][2];
#pragma unroll
                for (int bj = 0; bj < 2; ++bj)
#pragma unroll
                    for (int n = 0; n < 2; ++n) old[bj][n] = *(const u32x2*)(br + bj * HALF + n * 16);
#pragma unroll
                for (int bj = 0; bj < 2; ++bj)
#pragma unroll
                    for (int n = 0; n < 2; ++n) {
                        const u32x2 o = old[bj][n];
                        const f32x4 xo = {__uint_as_float(o.x << 16), __uint_as_float(o.x & 0xffff0000u), __uint_as_float(o.y << 16), __uint_as_float(o.y & 0xffff0000u)};
                        const f32x4 v = xo + acc[ai][bj][m][n];
                        u32x2 w; w.x = cvt_pk_bf16(v[0], v[1]); w.y = cvt_pk_bf16(v[2], v[3]); *(u32x2*)(br + bj * HALF + n * 16) = w;
                        ss += (v[0] * v[0] + v[1] * v[1]) + (v[2] * v[2] + v[3] * v[3]);
                    }
                ss += __shfl_xor(ss, 16); ss += __shfl_xor(ss, 32);
                if (fq == 0) sumsq_next[(size_t)row * 32 + u.pn * 4 + wc] = ss;
            }
    }
};
template <class Epi, class Sched, bool ALIGN_EPI = false, bool SP2 = false>
__device__ __forceinline__ void gemm_phase(PG8_LAS unsigned char* lds, const Gemm g, const Sched& S, const Epi& E) {
    const int tid = threadIdx.x, wid = __builtin_amdgcn_readfirstlane(tid >> 6), lane = tid & 63, wr = wid >> 2, wc = wid & 3, fr = lane & 15, fq = lane >> 4;
    const int K = g.K, nt = K / BK;
    unsigned voffA[2], voffB[2];
#pragma unroll
    for (int i = 0; i < 2; ++i) { int R, C; stage_rc(tid * 16 + i * 8192, R, C); const int Rb = Epi::PERM ? ((R & ~31) + perm32(R & 31)) : R;
        voffA[i] = (unsigned)(R * K + C) * 2u; voffB[i] = (unsigned)(Rb * 64 + C) * 2u; }
    const size_t kstep = (size_t)(BK * 2);
    const size_t hstep = (size_t)HALF * K * 2;
    const size_t tstep = 2 * hstep;
    const size_t kstepB = (size_t)g.N * 64 * 2, hstepB = (size_t)HALF * 64 * 2, tstepB = 2 * hstepB;
    const unsigned ldsw = (unsigned)wid * 1024u;
    const int aoff = lds_byte(wr * 64 + fr, fq * 8), boff = lds_byte(wc * 32 + fr, fq * 8);
#define PG8_SA(b, h) (((b) * 2 + (h)) * HTB)
#define PG8_SB(b, h) ((4 + (b) * 2 + (h)) * HTB)
#define PG8_STAGE(bufoff, gbase, voff) do { _Pragma("unroll") for (int _i = 0; _i < 2; ++_i) \
        __builtin_amdgcn_global_load_lds((const unsigned*)((const char*)(gbase) + (voff)[_i]), (PG8_LAS unsigned*)(lds + (bufoff) + ldsw + _i * 8192), 16, 0, 0); } while (0)
#define PG8_LDA(dst, b, h) do { _Pragma("unroll") for (int m = 0; m < 4; ++m) _Pragma("unroll") for (int k = 0; k < 2; ++k) dst[m][k] = *(const PG8_LAS bf16x8*)(lds + PG8_SA(b, h) + aoff + m * 2048 + k * 1024); } while (0)
#define PG8_LDB(dst, b, h) do { _Pragma("unroll") for (int n = 0; n < 2; ++n) _Pragma("unroll") for (int k = 0; k < 2; ++k) dst[n][k] = *(const PG8_LAS bf16x8*)(lds + PG8_SB(b, h) + boff + n * 2048 + k * 1024); } while (0)
#define PG8_MMA(ai, bj, At, Bt) do { __builtin_amdgcn_s_setprio(1); _Pragma("unroll") for (int m = 0; m < 4; ++m) _Pragma("unroll") for (int n = 0; n < 2; ++n) _Pragma("unroll") for (int k = 0; k < 2; ++k) \
        acc[ai][bj][m][n] = __builtin_amdgcn_mfma_f32_16x16x32_bf16(Bt[n][k], At[m][k], acc[ai][bj][m][n], 0, 0, 0); __builtin_amdgcn_s_setprio(0); } while (0)
#define PG8_WAIT_V(n) asm volatile("s_waitcnt vmcnt(" #n ")" ::: "memory")
#define PG8_WAIT_L(n) asm volatile("s_waitcnt lgkmcnt(" #n ")" ::: "memory")
#define PG8_BAR __builtin_amdgcn_s_barrier()
#define PG8_SCHED __builtin_amdgcn_sched_barrier(0)
    Unit cur, nxt; int ui = 0;
    if (!S.next(0, cur)) return;
    f32x4 acc[2][2][4][2];
#pragma unroll
    for (int a = 0; a < 2; ++a)
#pragma unroll
        for (int b = 0; b < 2; ++b)
#pragma unroll
            for (int m = 0; m < 4; ++m)
#pragma unroll
                for (int n = 0; n < 2; ++n) acc[a][b][m][n] = (f32x4){0.f, 0.f, 0.f, 0.f};
    bf16x8 At[4][2], B0[2][2], B1[2][2];
    const char* cA = (const char*)g.A + (size_t)cur.pm * tstep; const char* cB = (const char*)g.Bt + (size_t)cur.pn * tstepB;
    S.a_ready(cur);
    if constexpr (SP2) {
        PG8_STAGE(PG8_SB(0, 0), cB, voffB); PG8_STAGE(PG8_SB(0, 1), cB + hstepB, voffB); PG8_STAGE(PG8_SA(0, 0), cA, voffA); PG8_STAGE(PG8_SA(0, 1), cA + hstep, voffA);
        if (wr == 1) PG8_BAR;
        PG8_WAIT_V(2); PG8_BAR;
        PG8_STAGE(PG8_SB(1, 0), cB + kstepB, voffB); PG8_STAGE(PG8_SA(1, 0), cA + kstep, voffA); PG8_STAGE(PG8_SB(1, 1), cB + hstepB + kstepB, voffB);
        PG8_WAIT_V(6); PG8_BAR;
    } else {
        PG8_STAGE(PG8_SB(0, 0), cB, voffB); PG8_STAGE(PG8_SA(0, 0), cA, voffA); PG8_STAGE(PG8_SB(0, 1), cB + hstepB, voffB); PG8_STAGE(PG8_SA(0, 1), cA + hstep, voffA);
        if (wr == 1) PG8_BAR;
        PG8_WAIT_V(4); PG8_BAR;
        PG8_STAGE(PG8_SB(1, 0), cB + kstepB, voffB); PG8_STAGE(PG8_SA(1, 0), cA + kstep, voffA); PG8_STAGE(PG8_SB(1, 1), cB + hstepB + kstepB, voffB);
        PG8_WAIT_V(6); PG8_BAR;
    }
    for (;;) {
        const bool has_next = S.next(ui + 1, nxt);
        const char* nA = has_next ? (const char*)g.A + (size_t)nxt.pm * tstep : cA; const char* nB = has_next ? (const char*)g.Bt + (size_t)nxt.pn * tstepB : cB;
        for (int t = 0; t < nt; t += 2) {
            const bool last = (t == nt - 2);
            const char* a1 = cA + (size_t)(t + 1) * kstep;
            const char* a2 = last ? nA : cA + (size_t)(t + 2) * kstep; const char* b2 = last ? nB : cB + (size_t)(t + 2) * kstepB;
            const char* a3 = a2 + kstep; const char* b3 = b2 + kstepB;
            if (last && has_next) S.a_ready(nxt);
            if constexpr (SP2) {
            PG8_LDB(B0, 0, 0); PG8_LDB(B1, 0, 1); PG8_SCHED; PG8_LDA(At, 0, 0); PG8_STAGE(PG8_SA(1, 1), a1 + hstep, voffA);
            PG8_WAIT_V(8); PG8_WAIT_L(0); PG8_BAR; PG8_MMA(0, 0, At, B0); PG8_MMA(0, 1, At, B1); PG8_BAR; PG8_SCHED;
            PG8_LDA(At, 0, 1); PG8_STAGE(PG8_SB(0, 0), b2, voffB); PG8_STAGE(PG8_SB(0, 1), b2 + hstepB, voffB); PG8_STAGE(PG8_SA(0, 0), a2, voffA);
            PG8_WAIT_V(8); PG8_WAIT_L(0); PG8_BAR; PG8_MMA(1, 0, At, B0); PG8_MMA(1, 1, At, B1); PG8_BAR; PG8_SCHED;
            PG8_LDB(B0, 1, 0); PG8_LDB(B1, 1, 1); PG8_SCHED; PG8_LDA(At, 1, 0); PG8_STAGE(PG8_SA(0, 1), a2 + hstep, voffA);
            PG8_WAIT_V(8); PG8_WAIT_L(0); PG8_BAR; PG8_MMA(0, 0, At, B0); PG8_MMA(0, 1, At, B1); PG8_BAR; PG8_SCHED;
            PG8_LDA(At, 1, 1); PG8_STAGE(PG8_SB(1, 0), b3, voffB); PG8_STAGE(PG8_SB(1, 1), b3 + hstepB, voffB); PG8_STAGE(PG8_SA(1, 0), a3, voffA);
            PG8_WAIT_V(8); PG8_WAIT_L(0); PG8_BAR; PG8_MMA(1, 0, At, B0); PG8_MMA(1, 1, At, B1); PG8_BAR; PG8_SCHED;
            } else {
            PG8_LDB(B0, 0, 0); PG8_SCHED; PG8_LDA(At, 0, 0); PG8_STAGE(PG8_SA(1, 1), a1 + hstep, voffA);
            PG8_WAIT_L(8); PG8_BAR; PG8_WAIT_L(0); PG8_MMA(0, 0, At, B0); PG8_BAR; PG8_SCHED;
            PG8_LDB(B1, 0, 1); PG8_STAGE(PG8_SB(0, 0), b2, voffB);
            PG8_BAR; PG8_WAIT_L(0); PG8_MMA(0, 1, At, B1); PG8_BAR;
            PG8_LDA(At, 0, 1); PG8_STAGE(PG8_SA(0, 0), a2, voffA);
            PG8_BAR; PG8_WAIT_L(0); PG8_MMA(1, 0, At, B0); PG8_BAR; PG8_SCHED;
            PG8_STAGE(PG8_SB(0, 1), b2 + hstepB, voffB);
            PG8_WAIT_V(6); PG8_BAR; PG8_MMA(1, 1, At, B1); PG8_BAR;
            PG8_LDB(B0, 1, 0); PG8_SCHED; PG8_LDA(At, 1, 0); PG8_STAGE(PG8_SA(0, 1), a2 + hstep, voffA);
            PG8_WAIT_L(8); PG8_BAR; PG8_WAIT_L(0); PG8_MMA(0, 0, At, B0); PG8_BAR; PG8_SCHED;
            PG8_LDB(B1, 1, 1); PG8_STAGE(PG8_SB(1, 0), b3, voffB);
            PG8_BAR; PG8_WAIT_L(0); PG8_MMA(0, 1, At, B1); PG8_BAR;
            PG8_LDA(At, 1, 1); PG8_STAGE(PG8_SA(1, 0), a3, voffA);
            PG8_BAR; PG8_WAIT_L(0); PG8_MMA(1, 0, At, B0); PG8_BAR; PG8_SCHED;
            PG8_STAGE(PG8_SB(1, 1), b3 + hstepB, voffB);
            PG8_WAIT_V(6); PG8_BAR; PG8_MMA(1, 1, At, B1); PG8_BAR;
            }
        }
        if constexpr (ALIGN_EPI) { if (wr == 0) PG8_BAR; }
        if constexpr (!Epi::AFTER_DRAIN) { E(acc, cur, wr, wc, fr, fq); S.done(cur); }
        if (!has_next) break;
#pragma unroll
        for (int a = 0; a < 2; ++a)
#pragma unroll
            for (int b = 0; b < 2; ++b)
#pragma unroll
                for (int m = 0; m < 4; ++m)
#pragma unroll
                    for (int n = 0; n < 2; ++n) acc[a][b][m][n] = (f32x4){0.f, 0.f, 0.f, 0.f};
        cur = nxt; cA = nA; cB = nB; ++ui;
        if constexpr (ALIGN_EPI) { if (wr == 1) PG8_BAR; }
    }
    PG8_WAIT_V(0);
    if constexpr (!ALIGN_EPI) { if (wr == 0) PG8_BAR; }
    PG8_BAR;
    if constexpr (Epi::AFTER_DRAIN) { E.fused(acc, cur, wr, wc, fr, fq, lds, wid, lane); S.done(cur); }
#undef PG8_SA
#undef PG8_SB
#undef PG8_STAGE
#undef PG8_LDA
#undef PG8_LDB
#undef PG8_MMA
#undef PG8_WAIT_V
#undef PG8_WAIT_L
#undef PG8_BAR
#undef PG8_SCHED
}
}
#define LAS __attribute__((address_space(3)))
#define XB_TMO      128
#define XB_XCNT(j)  (256  + 64 * (j))
#define XB_XSUB(j)  (1280 + 64 * (j))
#define XB_XGEN(j)  (2304 + 64 * (j))
#define XB_TOP      3328
#define XB_TOPGEN   3392
#define XCD_BAR_WORDS 3456
#define XB_SPIN_CAP (1u << 18)

__device__ __forceinline__ unsigned xb_ld(unsigned* p)              { return __hip_atomic_load(p, __ATOMIC_RELAXED, __HIP_MEMORY_SCOPE_AGENT); }
__device__ __forceinline__ unsigned xb_add(unsigned* p, unsigned v) { return __hip_atomic_fetch_add(p, v, __ATOMIC_RELAXED, __HIP_MEMORY_SCOPE_AGENT); }
__device__ __forceinline__ unsigned xb_xcc_id() { return (unsigned)__builtin_amdgcn_s_getreg((3 << 11) | 20) & 0xFu; }
#define XB_SPIN(cond, bar) do { unsigned _sp = 0; while (cond) { __builtin_amdgcn_s_sleep(1); \
    if ((++_sp & 255u) == 0u) { if (xb_ld(&(bar)[XB_TMO])) break; if (_sp > XB_SPIN_CAP) { atomicAdd(&(bar)[XB_TMO], 1u); break; } } } } while (0)

struct XcdBarrier {
    unsigned* bar; unsigned x;
    volatile LAS unsigned* st;
};

__device__ __forceinline__ XcdBarrier xcd_barrier_post(unsigned* bar, volatile LAS unsigned* st) {
    XcdBarrier b; b.bar = bar; b.x = xb_xcc_id(); b.st = st;
    if (threadIdx.x == 0) (void)xb_add(&bar[XB_XCNT(b.x)], 1u);
    return b;
}
__device__ __forceinline__ void xcd_barrier_complete(unsigned* bar, unsigned x, unsigned& nloc, unsigned& nx) {
    const unsigned G = gridDim.x * gridDim.y * gridDim.z;
    unsigned sum, cnt, mine, sp = 0u;
    for (;;) {
        sum = 0u; cnt = 0u; mine = 0u;
#pragma unroll
        for (unsigned j = 0; j < 16; ++j) { const unsigned c = xb_ld(&bar[XB_XCNT(j)]); sum += c; cnt += (c > 0u) ? 1u : 0u; mine = (j == x) ? c : mine; }
        if (sum == G) break;
        __builtin_amdgcn_s_sleep(1);
        if ((++sp & 255u) == 0u) { if (xb_ld(&bar[XB_TMO])) break; if (sp > XB_SPIN_CAP) { atomicAdd(&bar[XB_TMO], 1u); break; } }
    }
    nloc = mine > 0u ? mine : 1u; nx = cnt > 0u ? cnt : 1u;
}

__device__ __forceinline__ void xcd_barrier(const XcdBarrier& b) {
    asm volatile("s_waitcnt vmcnt(0)" ::: "memory");
    __syncthreads();
    if (threadIdx.x == 0) {
        unsigned* bar = b.bar;
        __builtin_amdgcn_s_waitcnt(0);
        unsigned nloc = b.st[0], nx = b.st[1];
        if (nloc == 0u) { xcd_barrier_complete(bar, b.x, nloc, nx); b.st[0] = nloc; b.st[1] = nx; }
        const unsigned old = xb_add(&bar[XB_XSUB(b.x)], 1u);
        const unsigned gen = old / nloc;
        if (old + 1u == (gen + 1u) * nloc) {
            __builtin_amdgcn_fence(__ATOMIC_RELEASE, "agent");
            asm volatile("s_waitcnt vmcnt(0)" ::: "memory");
            const unsigned og = xb_add(&bar[XB_TOP], 1u);
            const unsigned tg = og / nx;
            if (og + 1u == (tg + 1u) * nx) xb_add(&bar[XB_TOPGEN], 1u);
            else XB_SPIN(xb_ld(&bar[XB_TOPGEN]) == tg, bar);
            __builtin_amdgcn_fence(__ATOMIC_ACQUIRE, "agent");
            xb_add(&bar[XB_XGEN(b.x)], 1u);
            asm volatile("s_waitcnt vmcnt(0)" ::: "memory");
        } else {
            XB_SPIN(xb_ld(&bar[XB_XGEN(b.x)]) == gen, bar);
            __builtin_amdgcn_fence(__ATOMIC_ACQUIRE, "agent");
            asm volatile("s_waitcnt vmcnt(0)" ::: "memory");
        }
    }
    __syncthreads();
}
#ifdef EMU
#include <pthread.h>
#include <cstring>
#include <cstdio>
#include <cstdlib>
#include <cmath>
#include <cstdint>
#define DEV static inline
#define LAS
struct EmuDim { int x; };
static thread_local EmuDim threadIdx;
typedef short bf16x8 __attribute__((ext_vector_type(8)));
typedef short s16x4 __attribute__((ext_vector_type(4)));
typedef float f32x4 __attribute__((ext_vector_type(4)));
typedef float f32x2 __attribute__((ext_vector_type(2)));
typedef unsigned u32x4 __attribute__((ext_vector_type(4)));
typedef unsigned u32x2 __attribute__((ext_vector_type(2)));
struct WaveX { bf16x8 a[64], b[64]; float f[64]; const void* p[64]; pthread_barrier_t bar; };
static WaveX g_wx[8];
static pthread_barrier_t g_wgbar;
static inline float emu_bf2f(short v) { unsigned u = ((unsigned)(unsigned short)v) << 16; float f; memcpy(&f, &u, 4); return f; }
static inline float __uint_as_float(unsigned u) { float f; memcpy(&f, &u, 4); return f; }
static inline unsigned __float_as_uint(float f) { unsigned u; memcpy(&u, &f, 4); return u; }
DEV f32x4 mfma16(bf16x8 a, bf16x8 b, f32x4 c) {
    const int lane = threadIdx.x & 63; WaveX& W = g_wx[threadIdx.x >> 6];
    W.a[lane] = a; W.b[lane] = b; pthread_barrier_wait(&W.bar);
    f32x4 r; const int g = lane >> 4, j = lane & 15;
    for (int rr = 0; rr < 4; ++rr) { const int i = 4 * g + rr; float s = 0.f;
        for (int k = 0; k < 32; ++k) s += emu_bf2f(W.a[i + 16 * (k / 8)][k % 8]) * emu_bf2f(W.b[j + 16 * (k / 8)][k % 8]);
        r[rr] = c[rr] + s; }
    pthread_barrier_wait(&W.bar); return r;
}
DEV s16x4 tr_read(const void* p) {
    const int lane = threadIdx.x & 63; WaveX& W = g_wx[threadIdx.x >> 6];
    W.p[lane] = p; pthread_barrier_wait(&W.bar);
    s16x4 r; const int G = lane >> 4, i = lane & 15;
    for (int q = 0; q < 4; ++q) { const short* src = (const short*)W.p[16 * G + 4 * q + i / 4]; if (((uintptr_t)src) & 7) { fprintf(stderr, "tr_read: unaligned\n"); abort(); } r[q] = src[i % 4]; }
    pthread_barrier_wait(&W.bar); return r;
}
DEV void lds_wait() {}
#define tr_read_o(base, off) tr_read((const unsigned char*)(base) + (off))
DEV float shflx(float v, int m) { const int lane = threadIdx.x & 63; WaveX& W = g_wx[threadIdx.x >> 6]; W.f[lane] = v; pthread_barrier_wait(&W.bar); const float r = W.f[lane ^ m]; pthread_barrier_wait(&W.bar); return r; }
DEV void wg_sync() { pthread_barrier_wait(&g_wgbar); }
DEV void wg_sync_lds() { pthread_barrier_wait(&g_wgbar); }
DEV void mem_fence_cc() {}
DEV void wave_sync() { pthread_barrier_wait(&g_wx[threadIdx.x >> 6].bar); }
DEV float fast_exp(float x) { return expf(x); }
DEV float fast_log(float x) { return logf(x); }
DEV float fast_exp2(float x) { return exp2f(x); }
DEV float fast_log2(float x) { return log2f(x); }
DEV float fast_rcp(float x) { return 1.0f / x; }
DEV unsigned cvt_pk_bf16(float lo, float hi) { auto f = [](float x) { unsigned u = __float_as_uint(x); return (u + 0x7fffu + ((u >> 16) & 1u)) >> 16; }; return f(lo) | (f(hi) << 16); }
#else
#define DEV __device__ __forceinline__
typedef short bf16x8 __attribute__((ext_vector_type(8)));
typedef short s16x4 __attribute__((ext_vector_type(4)));
typedef float f32x4 __attribute__((ext_vector_type(4)));
typedef float f32x2 __attribute__((ext_vector_type(2)));
typedef unsigned u32x4 __attribute__((ext_vector_type(4)));
typedef unsigned u32x2 __attribute__((ext_vector_type(2)));
DEV f32x4 mfma16(bf16x8 a, bf16x8 b, f32x4 c) { return __builtin_amdgcn_mfma_f32_16x16x32_bf16(a, b, c, 0, 0, 0); }
DEV s16x4 tr_read(const LAS void* p) { s16x4 r; asm volatile("ds_read_b64_tr_b16 %0, %1" : "=&v"(r) : "v"((unsigned)(size_t)p) : "memory"); return r; }
DEV s16x4 tr_read_o(const LAS void* p, int off) { s16x4 r; asm volatile("ds_read_b64_tr_b16 %0, %1 offset:%2" : "=&v"(r) : "v"((unsigned)(size_t)p), "i"(off) : "memory"); return r; }
DEV void lds_wait() { asm volatile("s_waitcnt lgkmcnt(0)" ::: "memory"); __builtin_amdgcn_sched_barrier(0); }
DEV float shflx(float v, int m) { return __shfl_xor(v, m); }
DEV void wg_sync() { __syncthreads(); }
DEV void wg_sync_lds() { asm volatile("s_waitcnt lgkmcnt(0)" ::: "memory"); __builtin_amdgcn_s_barrier(); asm volatile("" ::: "memory"); }
DEV void mem_fence_cc() { asm volatile("" ::: "memory"); }
DEV void wave_sync() { asm volatile("s_waitcnt lgkmcnt(0)" ::: "memory"); }
DEV float fast_exp(float x) { return __expf(x); }
DEV float fast_log(float x) { return __logf(x); }
DEV float fast_exp2(float x) { return __builtin_amdgcn_exp2f(x); }
DEV float fast_log2(float x) { return __builtin_amdgcn_logf(x); }
DEV float fast_rcp(float x) { return __builtin_amdgcn_rcpf(x); }
DEV unsigned cvt_pk_bf16(float lo, float hi) { unsigned r; asm volatile("v_cvt_pk_bf16_f32 %0, %1, %2" : "=v"(r) : "v"(lo), "v"(hi)); return r; }
#endif
typedef unsigned short bf16;
DEV bf16x8 pack8(s16x4 lo, s16x4 hi) { return (bf16x8){lo[0], lo[1], lo[2], lo[3], hi[0], hi[1], hi[2], hi[3]}; }

namespace mk {
typedef unsigned short bf16;
typedef float f32x4 __attribute__((ext_vector_type(4)));
typedef float f32x2 __attribute__((ext_vector_type(2)));
typedef unsigned u32x4 __attribute__((ext_vector_type(4)));
typedef unsigned u32x2 __attribute__((ext_vector_type(2)));
typedef short bf16x8 __attribute__((ext_vector_type(8)));
constexpr int D = 2048, NB = 4, S = 2048, MP = NB * S, DB = 8, T = 4, MS = DB * T, MT = MP + MS, PAST = 16384;
constexpr float EPS = 1e-6f;
constexpr int A_IN = 20480, B_IN = 12288, C_IN = 6160, C_INM = 6144;
constexpr int NWG_THREADS = 512;
constexpr size_t MiB = 1u << 20;
constexpr size_t WS_CTL = 0, CTL_ZERO_BYTES = 1 * MiB;
constexpr size_t CTL_BAR = 16384;
constexpr size_t CTL_SUMSQ = 65536;
constexpr size_t WS_TABA = 1 * MiB;
constexpr size_t WS_TABB = WS_TABA + 512 * 1024;
constexpr size_t WS_WIA0 = 4 * MiB;
constexpr size_t WS_WIA1 = WS_WIA0 + (size_t)A_IN * D * 2;
constexpr size_t WS_WIB = WS_WIA1 + (size_t)A_IN * D * 2;
constexpr size_t WS_WIC = WS_WIB + (size_t)B_IN * D * 2;
constexpr size_t WS_WLR = WS_WIC + (size_t)C_INM * D * 2;
constexpr size_t WS_WOA0 = WS_WLR + (size_t)32 * D * 2;
constexpr size_t WS_WOA1 = WS_WOA0 + (size_t)D * 2048 * 2;
constexpr size_t WS_WOB = WS_WOA1 + (size_t)D * 2048 * 2;
constexpr size_t WS_WOC = WS_WOB + (size_t)D * 4096 * 2;
constexpr size_t WS_XRES = WS_WOC + (size_t)D * 2048 * 2;
constexpr size_t WS_XB = WS_XRES + (size_t)MT * D * 4;
constexpr size_t WS_Z = WS_XB + (size_t)MT * D * 2;
constexpr size_t WS_ZSRAW = WS_Z + (size_t)MT * A_IN * 2;
constexpr size_t WS_Y = WS_ZSRAW + (size_t)32 * A_IN * 4;
constexpr size_t WS_O = WS_Y + (size_t)MT * 4096 * 2;
constexpr size_t WS_LOGA = WS_O + (size_t)MT * 4096 * 4;
constexpr size_t WS_LR = WS_LOGA + (size_t)MT * 1024 * 4;
constexpr size_t WS_DVEC = WS_LR + (size_t)32 * MT * 4;
constexpr size_t WS_SSP = WS_DVEC + (size_t)4 * 4 * 16 * 256 * 4;
constexpr size_t WS_END = WS_SSP + (size_t)4 * MP * 32 * 4;
constexpr int LDS_BYTES = 147456, MISC_OFF = 147456 - 256;

struct Params {
    const float* in[19]; float* out; unsigned char* ws;
    double inv_a[16]; double inv_b[128];
    int ph_lo, ph_hi;
};

__device__ __forceinline__ float bf2f(bf16 v) { return __uint_as_float(((unsigned)v) << 16); }
__device__ __forceinline__ unsigned f2bf(float f) { unsigned u = __float_as_uint(f); return (u + 0x7fffu + ((u >> 16) & 1u)) >> 16; }
__device__ __forceinline__ unsigned pk2(float lo, float hi) { return f2bf(lo) | (f2bf(hi) << 16); }
__device__ __forceinline__ float wave_sum(float v) {
#pragma unroll
    for (int o = 32; o >= 1; o >>= 1) v += __shfl_xor(v, o);
    return v;
}
__device__ __forceinline__ float wave_max(float v) {
#pragma unroll
    for (int o = 32; o >= 1; o >>= 1) v = fmaxf(v, __shfl_xor(v, o));
    return v;
}
__device__ __forceinline__ float silu(float x) { return x / (1.f + __expf(-x)); }
__device__ __forceinline__ void sincos_d(double a, float& s, float& c) {
    const double k = rint(a * 0.63661977236758134308);
    double r = fma(-k, 1.57079632679489655800e+00, a); r = fma(-k, 6.12323399573676603587e-17, r);
    const double r2 = r * r;
    const double sp = r * (1.0 + r2 * (-1.0 / 6 + r2 * (1.0 / 120 + r2 * (-1.0 / 5040 + r2 * (1.0 / 362880 + r2 * (-1.0 / 39916800 + r2 * (1.0 / 6227020800.0)))))));
    const double cp = 1.0 + r2 * (-0.5 + r2 * (1.0 / 24 + r2 * (-1.0 / 720 + r2 * (1.0 / 40320 + r2 * (-1.0 / 3628800 + r2 * (1.0 / 479001600.0 + r2 * (-1.0 / 87178291200.0)))))));
    const int q = (int)((long long)k & 3);
    const double ss = (q == 0) ? sp : (q == 1) ? cp : (q == 2) ? -sp : -cp;
    const double cc = (q == 0) ? cp : (q == 1) ? -sp : (q == 2) ? -cp : sp;
    s = (float)ss; c = (float)cc;
}
__device__ __forceinline__ void row_info(int row, int& b, int& t, int& pi, bool& samp) {
    if (row < MP) { b = row >> 11; t = row & 2047; pi = t; samp = false; } else { const int r = row - MP; b = r >> 2; t = r & 3; pi = 2048 + t; samp = true; }
}

struct Ctx {
    LAS unsigned char* lds; int tid, lane, wave, G, wg;
    const Params* P; float* out; unsigned char* ws;
    __device__ __forceinline__ const float* in(int i) const { return P->in[i]; }
    __device__ __forceinline__ float* sumsq(int l) const { return (float*)(ws + WS_SSP) + (size_t)l * MP * 32; }
    template <class Tp> __device__ __forceinline__ Tp* wsp(size_t off) const { return (Tp*)(ws + off); }
};

constexpr int ATT_K_OFF = 0, ATT_V_OFF = 65536, ATT_ROWS = 8192 + 32;
DEV int att_off_k(int row, int ch) { return 256 * row + 16 * (ch ^ (row & 15)); }
DEV int att_off_v(int row, int ch) { return 256 * row + 16 * (ch ^ (2 * (row & 7))); }
DEV void attn_item(LAS unsigned char* lds, const bf16* z, int ldz, bf16* og, float* lse, int item, int tid) {
    const int lane = tid & 63, w = tid >> 6, G = lane >> 4, l15 = lane & 15;
    const int bh = item / 48, rem = item % 48, b = bh >> 4, h = bh & 15;
    int g, r, blk;
    if (rem < 16) { g = 0; r = 0; blk = rem; } else if (rem < 32) { g = 1; r = (rem - 16) >> 2; blk = (rem - 16) & 3; } else { g = 2; r = rem - 32; blk = 0; }
    const int dil = 1 << (2 * g);
    const int qcol = (g * 3) * 2048 + h * 128, kcol = qcol + 2048, vcol = qcol + 4096;
    const size_t tok0 = (size_t)b * 2048 + r;
#pragma unroll
    for (int j = 0; j < 8; ++j) {
        const int e = tid + 512 * j, row = e >> 4, ch = e & 15; const int p = (blk - 1) * 128 + row;
        u32x4 kv = {0u, 0u, 0u, 0u}, vv = {0u, 0u, 0u, 0u};
        if (p >= 0) { const bf16* src = z + (tok0 + (size_t)dil * p) * ldz + ch * 8; kv = *(const u32x4*)(src + kcol); vv = *(const u32x4*)(src + vcol); }
        *(LAS u32x4*)(lds + ATT_K_OFF + att_off_k(row, ch)) = kv;
        *(LAS u32x4*)(lds + ATT_V_OFF + att_off_v(row, ch)) = vv;
    }
    const int qi = 16 * w + l15; const size_t qtok = tok0 + (size_t)dil * (blk * 128 + qi);
    bf16x8 qf[4];
#pragma unroll
    for (int s = 0; s < 4; ++s) qf[s] = *(const bf16x8*)(z + qtok * ldz + qcol + 32 * s + 8 * G);
    wg_sync();
    const int m0 = w >> 1;
    f32x4 sc[10];
#pragma unroll
    for (int tt = 0; tt < 10; ++tt) {
        const int t = 2 * m0 + tt; f32x4 a = {0.f, 0.f, 0.f, 0.f};
#pragma unroll
        for (int s = 0; s < 4; ++s) { const bf16x8 kf = *(const LAS bf16x8*)(lds + ATT_K_OFF + att_off_k(16 * t + l15, 4 * s + G)); a = mfma16(kf, qf[s], a); }
        sc[tt] = a;
    }
    const float scale = 0.08838834764831845f * 1.4426950408889634f;
    float mx = -INFINITY;
#pragma unroll
    for (int tt = 0; tt < 10; ++tt)
#pragma unroll
        for (int rr = 0; rr < 4; ++rr) { const int c = 16 * (2 * m0 + tt) + 4 * G + rr; const bool ok = (c >= qi) && (c <= qi + 128) && (blk > 0 || c >= 128);
            const float v = ok ? sc[tt][rr] * scale : -INFINITY; sc[tt][rr] = v; mx = fmaxf(mx, v); }
    mx = fmaxf(mx, shflx(mx, 16)); mx = fmaxf(mx, shflx(mx, 32));
    float sum = 0.f;
#pragma unroll
    for (int tt = 0; tt < 10; ++tt)
#pragma unroll
        for (int rr = 0; rr < 4; ++rr) { const float p = fast_exp2(sc[tt][rr] - mx); sc[tt][rr] = p; sum += p; }
    sum += shflx(sum, 16); sum += shflx(sum, 32);
    f32x4 oacc[8];
#pragma unroll
    for (int dt = 0; dt < 8; ++dt) oacc[dt] = (f32x4){0.f, 0.f, 0.f, 0.f};
#pragma unroll
    for (int mm = 0; mm < 5; ++mm) {
        const f32x4 p0 = sc[2 * mm], p1 = sc[2 * mm + 1];
        u32x4 pw; pw[0] = cvt_pk_bf16(p0[0], p0[1]); pw[1] = cvt_pk_bf16(p0[2], p0[3]); pw[2] = cvt_pk_bf16(p1[0], p1[1]); pw[3] = cvt_pk_bf16(p1[2], p1[3]);
        bf16x8 pf; __builtin_memcpy(&pf, &pw, 16);
        const int krow = 32 * (m0 + mm) + 4 * G + (l15 >> 2);
#pragma unroll
        for (int dh = 0; dh < 2; ++dh) {
            s16x4 lo[4], hi[4];
#pragma unroll
            for (int d4 = 0; d4 < 4; ++d4) { const int dt = dh * 4 + d4; const int ch = 2 * dt + ((l15 >> 1) & 1);
                lo[d4] = tr_read(lds + ATT_V_OFF + att_off_v(krow, ch) + 8 * (l15 & 1)); hi[d4] = tr_read(lds + ATT_V_OFF + att_off_v(krow + 16, ch) + 8 * (l15 & 1)); }
            lds_wait();
#pragma unroll
            for (int d4 = 0; d4 < 4; ++d4) oacc[dh * 4 + d4] = mfma16(pack8(lo[d4], hi[d4]), pf, oacc[dh * 4 + d4]);
        }
    }
    const float inv = fast_rcp(sum);
    bf16* orow = og + ((size_t)g * ATT_ROWS + qtok) * 2048 + h * 128 + 4 * G;
#pragma unroll
    for (int dt = 0; dt < 8; ++dt) { u32x2 wv; wv[0] = cvt_pk_bf16(oacc[dt][0] * inv, oacc[dt][1] * inv); wv[1] = cvt_pk_bf16(oacc[dt][2] * inv, oacc[dt][3] * inv); *(u32x2*)(orow + 16 * dt) = wv; }
    if (G == 0) lse[((size_t)g * ATT_ROWS + qtok) * 16 + h] = (mx + fast_log2(sum)) * 0.6931471805599453f;
    wg_sync();
}
DEV size_t att_zoff(size_t row, int col) { return ((size_t)(col >> 7) * ATT_ROWS + row) * 128 + (col & 127); }
struct AttItem { int b, h, g, r, blk; };
DEV AttItem att_decode(int item) { AttItem a; const int bh = item / 48, rem = item % 48; a.b = bh >> 4; a.h = bh & 15;
    if (rem < 16) { a.g = 0; a.r = 0; a.blk = rem; } else if (rem < 32) { a.g = 1; a.r = (rem - 16) >> 2; a.blk = (rem - 16) & 3; } else { a.g = 2; a.r = rem - 32; a.blk = 0; } return a; }
DEV bool att_continues(int item) { const int rem = item % 48; return rem < 15 || (rem >= 16 && rem < 32 && ((rem - 16) & 3) < 3); }
DEV void att_load_half(const bf16* z, int ldz, const AttItem& a, int pblk, int tid, u32x4 (&kr)[4], u32x4 (&vr)[4]) {
    const int dil = 1 << (2 * a.g), qcol = (a.g * 3) * 2048 + a.h * 128; const size_t tok0 = (size_t)a.b * 2048 + a.r;
#pragma unroll
    for (int j = 0; j < 4; ++j) { const int e = tid + 512 * j, row = e >> 4, ch = e & 15;
        kr[j] = (u32x4){0u, 0u, 0u, 0u}; vr[j] = (u32x4){0u, 0u, 0u, 0u};
        if (pblk >= 0) { const size_t tk = tok0 + (size_t)dil * (pblk * 128 + row); kr[j] = *(const u32x4*)(z + att_zoff(tk, qcol + 2048 + ch * 8)); vr[j] = *(const u32x4*)(z + att_zoff(tk, qcol + 4096 + ch * 8)); } }
}
DEV void att_store_half(LAS unsigned char* lds, int half, int tid, const u32x4 (&kr)[4], const u32x4 (&vr)[4]) {
#pragma unroll
    for (int j = 0; j < 4; ++j) { const int e = tid + 512 * j, prow = half * 128 + (e >> 4), ch = e & 15;
        *(LAS u32x4*)(lds + ATT_K_OFF + 256 * prow + 16 * (ch ^ (prow & 15))) = kr[j]; *(LAS u32x4*)(lds + ATT_V_OFF + 256 * prow + 16 * (ch ^ (2 * (prow & 7)))) = vr[j]; }
}
DEV void att_load_q(const bf16* z, int ldz, const AttItem& a, int w, int l15, int G, bf16x8 (&qf)[4]) {
    const int dil = 1 << (2 * a.g); const size_t qtok = (size_t)a.b * 2048 + a.r + (size_t)dil * (a.blk * 128 + 16 * w + l15);
#pragma unroll
    for (int s = 0; s < 4; ++s) qf[s] = *(const bf16x8*)(z + att_zoff(qtok, (a.g * 3) * 2048 + a.h * 128 + 32 * s + 8 * G));
}
DEV void attn_run(LAS unsigned char* lds, const bf16* z, int ldz, bf16* og, float* lse, int item0, int nitems, int tid) {
    const int lane = tid & 63, w = tid >> 6, G = lane >> 4, l15 = lane & 15;
    int kb[4], vb[8];
#pragma unroll
    for (int s = 0; s < 4; ++s) kb[s] = ATT_K_OFF + 256 * l15 + 16 * ((4 * s + G) ^ l15);
    { const int r7 = 4 * (G & 1) + (l15 >> 2);
#pragma unroll
      for (int dt = 0; dt < 8; ++dt) vb[dt] = ATT_V_OFF + 256 * (4 * G + (l15 >> 2)) + 16 * ((2 * dt + ((l15 >> 1) & 1)) ^ (2 * r7)) + 8 * (l15 & 1); }
    int par = 0;
    AttItem cur = att_decode(item0);
    bf16x8 qf[4];
    {   u32x4 kA[4], vA[4], kB[4], vB[4];
        att_load_half(z, ldz, cur, cur.blk - 1, tid, kA, vA); att_load_half(z, ldz, cur, cur.blk, tid, kB, vB); att_load_q(z, ldz, cur, w, l15, G, qf);
        att_store_half(lds, 0, tid, kA, vA); att_store_half(lds, 1, tid, kB, vB); }
#pragma unroll 1
    for (int it = 0; it < nitems; ++it) {
        wg_sync_lds();
        const bool has_next = it + 1 < nitems; const bool cont = has_next && att_continues(item0 + it);
        AttItem nxt = cur; if (has_next) nxt = att_decode(item0 + it + 1);
        u32x4 kB[4], vB[4]; bf16x8 qn[4];
        if (has_next) { att_load_half(z, ldz, nxt, nxt.blk, tid, kB, vB); att_load_q(z, ldz, nxt, w, l15, G, qn); }
        const int m0 = w >> 1, qi = 16 * w + l15;
        f32x4 sc[10];
#pragma unroll
        for (int tt = 0; tt < 10; ++tt) {
            const int pt = (2 * m0 + tt) ^ (8 * par); f32x4 a = {0.f, 0.f, 0.f, 0.f};
#pragma unroll
            for (int s = 0; s < 4; ++s) { const bf16x8 kf = *(const LAS bf16x8*)(lds + kb[s] + 4096 * pt); a = mfma16(kf, qf[s], a); }
            sc[tt] = a;
        }
        const float scale = 0.08838834764831845f * 1.4426950408889634f;
        float mx = -INFINITY;
#pragma unroll
        for (int tt = 0; tt < 10; ++tt)
#pragma unroll
            for (int rr = 0; rr < 4; ++rr) { const int c = 16 * (2 * m0 + tt) + 4 * G + rr; const bool ok = (c >= qi) && (c <= qi + 128) && (cur.blk > 0 || c >= 128);
                const float v = ok ? sc[tt][rr] * scale : -INFINITY; sc[tt][rr] = v; mx = fmaxf(mx, v); }
        mx = fmaxf(mx, shflx(mx, 16)); mx = fmaxf(mx, shflx(mx, 32));
        float sum = 0.f;
#pragma unroll
        for (int tt = 0; tt < 10; ++tt)
#pragma unroll
            for (int rr = 0; rr < 4; ++rr) { const float p = fast_exp2(sc[tt][rr] - mx); sc[tt][rr] = p; sum += p; }
        sum += shflx(sum, 16); sum += shflx(sum, 32);
        f32x4 oacc[8];
#pragma unroll
        for (int dt = 0; dt < 8; ++dt) oacc[dt] = (f32x4){0.f, 0.f, 0.f, 0.f};
#pragma unroll
        for (int mm = 0; mm < 5; ++mm) {
            const f32x4 p0 = sc[2 * mm], p1 = sc[2 * mm + 1];
            u32x4 pw; pw[0] = cvt_pk_bf16(p0[0], p0[1]); pw[1] = cvt_pk_bf16(p0[2], p0[3]); pw[2] = cvt_pk_bf16(p1[0], p1[1]); pw[3] = cvt_pk_bf16(p1[2], p1[3]);
            bf16x8 pf; __builtin_memcpy(&pf, &pw, 16);
            const int prow = 8192 * ((m0 + mm) ^ (4 * par));
#pragma unroll
            for (int dh = 0; dh < 2; ++dh) {
                s16x4 lo[4], hi[4];
#pragma unroll
                for (int d4 = 0; d4 < 4; ++d4) { lo[d4] = tr_read_o(lds + vb[dh * 4 + d4] + prow, 0); hi[d4] = tr_read_o(lds + vb[dh * 4 + d4] + prow, 4096); }
                lds_wait();
#pragma unroll
                for (int d4 = 0; d4 < 4; ++d4) oacc[dh * 4 + d4] = mfma16(pack8(lo[d4], hi[d4]), pf, oacc[dh * 4 + d4]);
            }
        }
        {   const float inv = fast_rcp(sum); const int dil = 1 << (2 * cur.g); const size_t qtok = (size_t)cur.b * 2048 + cur.r + (size_t)dil * (cur.blk * 128 + qi);
            bf16* orow = og + ((size_t)cur.g * ATT_ROWS + qtok) * 2048 + cur.h * 128 + 4 * G;
#pragma unroll
            for (int dt = 0; dt < 8; ++dt) { u32x2 wv; wv[0] = cvt_pk_bf16(oacc[dt][0] * inv, oacc[dt][1] * inv); wv[1] = cvt_pk_bf16(oacc[dt][2] * inv, oacc[dt][3] * inv); *(u32x2*)(orow + 16 * dt) = wv; }
            if (G == 0) lse[((size_t)cur.g * ATT_ROWS + qtok) * 16 + cur.h] = (mx + fast_log2(sum)) * 0.6931471805599453f; }
        wg_sync_lds();
        if (has_next) {
            if (cont) { att_store_half(lds, par, tid, kB, vB); par ^= 1; }
            else { att_store_half(lds, 1, tid, kB, vB); att_load_half(z, ldz, nxt, nxt.blk - 1, tid, kB, vB); att_store_half(lds, 0, tid, kB, vB); par = 0; }
#pragma unroll
            for (int s = 0; s < 4; ++s) qf[s] = qn[s];
            cur = nxt;
        }
    }
    wg_sync();
}
constexpr int SC_KP = 544, SC_K_OFF = 0, SC_V_OFF = 128 * SC_KP, SC_S_OFF = SC_V_OFF + 20480;
template <int NVT, class OT>
DEV void scan_unit(LAS unsigned char* lds, const bf16* z, int ldz, int qoff, int koff, int voff, int H, int unit, const float* dvec, OT* o, int ldo, float* state_out, int tid) {
    constexpr int VS = 16 * NVT, VP = VS * 2 + 32, KP = SC_KP, NVS = 512 / VS, VCH = VS / 8, NVLD = (128 * VCH) / 512, VROWS = 512 / VCH;
    const int lane = tid & 63, w = tid >> 6, G = lane >> 4, l15 = lane & 15;
    const int vs = unit % NVS, h = (unit / NVS) % H, b = unit / (NVS * H);
    const size_t rowbase = (size_t)b * 2048;
    const bf16* zq = z + qoff + h * 256; const bf16* zk = z + koff + h * 256; const bf16* zv = z + voff + h * 512 + vs * VS;
    float gam128 = 1.f; if (!dvec) { const float gm = 1.0f - exp2f(-5.0f - (float)h); gam128 = exp2f(128.0f * log2f(gm)); }
    LAS unsigned char* const kb_row = lds + SC_K_OFF + l15 * KP + 16 * G;
    LAS unsigned char* const kb_tr = lds + SC_K_OFF + (4 * G + (l15 >> 2)) * KP + 8 * (l15 & 3) + 64 * w;
    LAS unsigned char* const vb_tr = lds + SC_V_OFF + (4 * G + (l15 >> 2)) * VP + 8 * (l15 & 3);
    LAS unsigned char* const sb_row = lds + SC_S_OFF + l15 * KP + 16 * G;
    LAS unsigned char* const sb_wr = lds + SC_S_OFF + l15 * KP + 8 * G + 64 * w;
    LAS unsigned char* const kst = lds + SC_K_OFF + (tid >> 5) * KP + (tid & 31) * 16;
    LAS unsigned char* const vst = lds + SC_V_OFF + (tid / VCH) * VP + (tid % VCH) * 16;
    const size_t kg = (size_t)(tid >> 5) * ldz + (tid & 31) * 8, vg = (size_t)(tid / VCH) * ldz + (tid % VCH) * 8;
    f32x4 sacc[2][NVT];
#pragma unroll
    for (int dd = 0; dd < 2; ++dd)
#pragma unroll
        for (int vt = 0; vt < NVT; ++vt) sacc[dd][vt] = (f32x4){0.f, 0.f, 0.f, 0.f};
    for (int e = tid; e < VS * (KP / 16); e += 512) *(LAS u32x4*)(lds + SC_S_OFF + e * 16) = (u32x4){0u, 0u, 0u, 0u};
    u32x4 kpre[8], vpre[NVLD];
    {   const bf16* kp = zk + rowbase * ldz + kg; const bf16* vp = zv + rowbase * ldz + vg;
#pragma unroll
        for (int j = 0; j < 8; ++j) kpre[j] = *(const u32x4*)(kp + (size_t)(16 * j) * ldz);
#pragma unroll
        for (int j = 0; j < NVLD; ++j) vpre[j] = *(const u32x4*)(vp + (size_t)(VROWS * j) * ldz);
#pragma unroll
        for (int j = 0; j < 8; ++j) *(LAS u32x4*)(kst + 16 * j * KP) = kpre[j];
#pragma unroll
        for (int j = 0; j < NVLD; ++j) *(LAS u32x4*)(vst + VROWS * j * VP) = vpre[j]; }
    wg_sync();
    const int qi = 16 * w + l15;
    bf16x8 qf[8];
#pragma unroll
    for (int s = 0; s < 8; ++s) qf[s] = *(const bf16x8*)(zq + (rowbase + qi) * ldz + 32 * s + 8 * G);
#pragma unroll 1
    for (int c = 0; c < 16; ++c) {
        const size_t crow = rowbase + (size_t)c * 128;
        const bf16* kp = zk + (crow + 128) * ldz + kg; const bf16* vp = zv + (crow + 128) * ldz + vg;
        if (c + 1 < 16) {
#pragma unroll
            for (int j = 0; j < 4; ++j) kpre[j] = *(const u32x4*)(kp + (size_t)(16 * j) * ldz);
#pragma unroll
            for (int j = 0; j < NVLD; ++j) vpre[j] = *(const u32x4*)(vp + (size_t)(VROWS * j) * ldz);
        }
        f32x4 oacc[NVT];
#pragma unroll
        for (int vt = 0; vt < NVT; ++vt) oacc[vt] = (f32x4){0.f, 0.f, 0.f, 0.f};
#pragma unroll 1
        for (int m = 0; m <= (w >> 1); ++m) {
            f32x4 s0 = {0.f, 0.f, 0.f, 0.f}, s1 = {0.f, 0.f, 0.f, 0.f};
            LAS unsigned char* const kr = kb_row + m * (32 * KP); LAS unsigned char* const vr = vb_tr + m * (32 * VP);
#pragma unroll
            for (int s = 0; s < 8; ++s) {
                const bf16x8 k0 = *(const LAS bf16x8*)(kr + 64 * s); const bf16x8 k1 = *(const LAS bf16x8*)(kr + 16 * KP + 64 * s);
                s0 = mfma16(k0, qf[s], s0); s1 = mfma16(k1, qf[s], s1);
                if (s & 1) mem_fence_cc();
            }
#pragma unroll
            for (int rr = 0; rr < 4; ++rr) { const int j0 = 32 * m + 4 * G + rr; s0[rr] = (j0 <= qi) ? s0[rr] : 0.f; s1[rr] = (j0 + 16 <= qi) ? s1[rr] : 0.f; }
            u32x4 pw; pw[0] = cvt_pk_bf16(s0[0], s0[1]); pw[1] = cvt_pk_bf16(s0[2], s0[3]); pw[2] = cvt_pk_bf16(s1[0], s1[1]); pw[3] = cvt_pk_bf16(s1[2], s1[3]);
            bf16x8 pf; __builtin_memcpy(&pf, &pw, 16);
            s16x4 lo[NVT], hi[NVT];
#pragma unroll
            for (int vt = 0; vt < NVT; ++vt) { lo[vt] = tr_read_o(vr, 32 * vt); hi[vt] = tr_read_o(vr, 16 * VP + 32 * vt); }
            lds_wait();
#pragma unroll
            for (int vt = 0; vt < NVT; ++vt) oacc[vt] = mfma16(pack8(lo[vt], hi[vt]), pf, oacc[vt]);
        }
        if (c + 1 < 16) {
#pragma unroll
            for (int j = 4; j < 8; ++j) kpre[j] = *(const u32x4*)(kp + (size_t)(16 * j) * ldz);
        }
#pragma unroll
        for (int s = 0; s < 8; ++s)
#pragma unroll
            for (int vt = 0; vt < NVT; ++vt) { const bf16x8 sf = *(const LAS bf16x8*)(sb_row + 16 * vt * KP + 64 * s); oacc[vt] = mfma16(sf, qf[s], oacc[vt]); if (vt == NVT - 1) mem_fence_cc(); }
        {   OT* orow = o + (crow + qi) * ldo + h * 512 + vs * VS + 4 * G;
#pragma unroll
            for (int vt = 0; vt < NVT; ++vt) {
                if constexpr (sizeof(OT) == 2) { u32x2 wv; wv[0] = cvt_pk_bf16(oacc[vt][0], oacc[vt][1]); wv[1] = cvt_pk_bf16(oacc[vt][2], oacc[vt][3]); *(u32x2*)(orow + 16 * vt) = wv; }
                else *(f32x4*)(orow + 16 * vt) = oacc[vt]; } }
        if (c + 1 < 16) {
#pragma unroll
            for (int s = 0; s < 8; ++s) qf[s] = *(const bf16x8*)(zq + (crow + 128 + qi) * ldz + 32 * s + 8 * G);
        }
#pragma unroll
        for (int ks = 0; ks < 4; ++ks) {
            s16x4 alo[2], ahi[2], blo[NVT], bhi[NVT];
#pragma unroll
            for (int dd = 0; dd < 2; ++dd) { alo[dd] = tr_read_o(kb_tr, 32 * ks * KP + 32 * dd); ahi[dd] = tr_read_o(kb_tr, (32 * ks + 16) * KP + 32 * dd); }
#pragma unroll
            for (int vt = 0; vt < NVT; ++vt) { blo[vt] = tr_read_o(vb_tr, 32 * ks * VP + 32 * vt); bhi[vt] = tr_read_o(vb_tr, (32 * ks + 16) * VP + 32 * vt); }
            lds_wait();
#pragma unroll
            for (int dd = 0; dd < 2; ++dd)
#pragma unroll
                for (int vt = 0; vt < NVT; ++vt) sacc[dd][vt] = mfma16(pack8(alo[dd], ahi[dd]), pack8(blo[vt], bhi[vt]), sacc[dd][vt]);
        }
#pragma unroll
        for (int dd = 0; dd < 2; ++dd) {
            f32x4 dv = {gam128, gam128, gam128, gam128};
            if (dvec) dv = *(const f32x4*)(dvec + ((size_t)(b * H + h) * 16 + c) * 256 + 16 * (2 * w + dd) + 4 * G);
#pragma unroll
            for (int vt = 0; vt < NVT; ++vt) sacc[dd][vt] = sacc[dd][vt] * dv;
        }
        wg_sync_lds();
#pragma unroll
        for (int dd = 0; dd < 2; ++dd)
#pragma unroll
            for (int vt = 0; vt < NVT; ++vt) { u32x2 wv; wv[0] = cvt_pk_bf16(sacc[dd][vt][0], sacc[dd][vt][1]); wv[1] = cvt_pk_bf16(sacc[dd][vt][2], sacc[dd][vt][3]); *(LAS u32x2*)(sb_wr + 16 * vt * KP + 32 * dd) = wv; }
        if (c + 1 < 16) {
#pragma unroll
            for (int j = 0; j < 8; ++j) *(LAS u32x4*)(kst + 16 * j * KP) = kpre[j];
#pragma unroll
            for (int j = 0; j < NVLD; ++j) *(LAS u32x4*)(vst + VROWS * j * VP) = vpre[j];
        }
        wg_sync_lds();
    }
#pragma unroll
    for (int dd = 0; dd < 2; ++dd)
#pragma unroll
        for (int vt = 0; vt < NVT; ++vt)
#pragma unroll
            for (int rr = 0; rr < 4; ++rr) state_out[(((size_t)b * H + h) * 256 + 16 * (2 * w + dd) + 4 * G + rr) * 512 + vs * VS + 16 * vt + l15] = sacc[dd][vt][rr];
}
DEV f32x4 bf4_to_f32(u32x2 w) { return (f32x4){__uint_as_float(w[0] << 16), __uint_as_float(w[0] & 0xffff0000u), __uint_as_float(w[1] << 16), __uint_as_float(w[1] & 0xffff0000u)}; }
DEV float half_sum(float v) { v += shflx(v, 16); v += shflx(v, 8); v += shflx(v, 4); v += shflx(v, 2); v += shflx(v, 1); return v; }
DEV f32x4 sat_rot(f32x4 x, const f32x2* tab, int pi, int c32) {
    f32x4 p;
#pragma unroll
    for (int e = 0; e < 4; ++e) p[e] = shflx(x[e], 4);
    if (c32 < 8) { const f32x4 t0 = *(const f32x4*)(tab + pi * 16 + 4 * (c32 & 3)), t1 = *(const f32x4*)(tab + pi * 16 + 4 * (c32 & 3) + 2);
        const f32x4 c = {t0[0], t0[2], t1[0], t1[2]}, sn = {t0[1], t0[3], t1[1], t1[3]};
        x = c32 < 4 ? x * c - p * sn : p * sn + x * c; }
    return x;
}
DEV void sattn_unit(LAS unsigned char* lds_wave, const bf16* z, int ldz, const float* cache, int g, int b, int t, int h, bf16* og, float* lse, int lane, const f32x2* tab, float* kvout) {
    const int lbuf = 128 << (2 * g), dil = 1 << (2 * g), hf = lane >> 5, c32 = lane & 31;
    const int row = 8192 + b * 4 + t, qcol = g * 3 * 2048 + h * 128, kcol = qcol + 2048, vcol = qcol + 4096;
    const float scale = 0.08838834764831845f * 1.4426950408889634f;
    const f32x4 q4 = sat_rot(bf4_to_f32(*(const u32x2*)(z + att_zoff(row, qcol + 4 * c32))), tab, 2048 + t, c32);
    const int jn = g == 0 ? t + 1 : 1;
    float m = -INFINITY, l = 0.f; f32x4 acc = {0.f, 0.f, 0.f, 0.f};
    for (int j = 0; j < jn; ++j) {
        const int krow = 8192 + b * 4 + (t - dil * j);
        const f32x4 k4 = sat_rot(bf4_to_f32(*(const u32x2*)(z + att_zoff(krow, kcol + 4 * c32))), tab, 2048 + t - dil * j, c32); const f32x4 v4 = bf4_to_f32(*(const u32x2*)(z + att_zoff(krow, vcol + 4 * c32)));
        if (j == 0 && hf == 0) { *(f32x4*)(kvout + (size_t)(t * 2 + 0) * 2048 + h * 128 + 4 * c32) = k4; *(f32x4*)(kvout + (size_t)(t * 2 + 1) * 2048 + h * 128 + 4 * c32) = v4; }
        float s = half_sum(q4[0] * k4[0] + q4[1] * k4[1] + q4[2] * k4[2] + q4[3] * k4[3]) * scale; if (hf) s = -INFINITY;
        const float mn = fmaxf(m, s); const float corr = (m == -INFINITY) ? 0.f : fast_exp2(m - mn); const float p = (s == -INFINITY) ? 0.f : fast_exp2(s - mn);
        l = l * corr + p; acc = acc * corr + v4 * p; m = mn;
    }
    const float* kbase = cache + (size_t)b * lbuf * 4096 + h * 128 + 4 * c32;
    const int nc = 129 - jn;
#pragma unroll 1
    for (int i = 0; i < nc; i += 32) {
        f32x4 k4[16], v4[16];
#pragma unroll
        for (int u = 0; u < 16; ++u) { int j = jn + i + 2 * u + hf; j = j > 128 ? 128 : j; const float* p = kbase + (size_t)(lbuf + t - dil * j) * 4096; k4[u] = *(const f32x4*)p; v4[u] = *(const f32x4*)(p + 2048); }
        float s[16]; float bm = -INFINITY;
#pragma unroll
        for (int u = 0; u < 16; ++u) { const int j = jn + i + 2 * u + hf; const float sv = half_sum(q4[0] * k4[u][0] + q4[1] * k4[u][1] + q4[2] * k4[u][2] + q4[3] * k4[u][3]) * scale; s[u] = j <= 128 ? sv : -INFINITY; bm = fmaxf(bm, s[u]); }
        const float mn = fmaxf(m, bm);
        if (mn != -INFINITY) {
            const float corr = (m == -INFINITY) ? 0.f : fast_exp2(m - mn); l *= corr; acc = acc * corr;
#pragma unroll
            for (int u = 0; u < 16; ++u) { const float p = (s[u] == -INFINITY) ? 0.f : fast_exp2(s[u] - mn); l += p; acc += v4[u] * p; }
            m = mn;
        }
    }
    const float m2 = shflx(m, 32), l2 = shflx(l, 32); f32x4 a2;
#pragma unroll
    for (int e = 0; e < 4; ++e) a2[e] = shflx(acc[e], 32);
    const float M = fmaxf(m, m2); const float c1 = (m == -INFINITY) ? 0.f : fast_exp2(m - M), c2 = (m2 == -INFINITY) ? 0.f : fast_exp2(m2 - M);
    const float L = l * c1 + l2 * c2; const f32x4 A = acc * c1 + a2 * c2;
    const float inv = 1.0f / L;
    if (hf == 0) { u32x2 wv; wv[0] = cvt_pk_bf16(A[0] * inv, A[1] * inv); wv[1] = cvt_pk_bf16(A[2] * inv, A[3] * inv); *(u32x2*)(og + ((size_t)g * ATT_ROWS + row) * 2048 + h * 128 + 4 * c32) = wv; }
    if (lane == 0) lse[((size_t)g * ATT_ROWS + row) * 16 + h] = (M + fast_log2(L)) * 0.6931471805599453f;
}
struct P0Src { const float* W; int K, ld, ncols; const float* gain; bf16* WT; };
__device__ __forceinline__ void p0_tr_load(const P0Src& s, int item, int lane, f32x4 (&v)[16]) {
    const int nblk = s.ncols / 64, kb = item / nblk, nb = item % nblk, k0 = 64 * kb, n0 = 64 * nb;
#pragma unroll
    for (int i = 0; i < 16; ++i) { const int kk = 4 * i + (lane >> 4); v[i] = *(const f32x4*)(s.W + (size_t)(k0 + kk) * s.ld + n0 + 4 * (lane & 15)); }
}
__device__ __forceinline__ void p0_tr_store(const P0Src& s, int item, int lane, const f32x4 (&v)[16], LAS float* scr) {
    const int nblk = s.ncols / 64, kb = item / nblk, nb = item % nblk, k0 = 64 * kb, n0 = 64 * nb;
#pragma unroll
    for (int i = 0; i < 16; ++i) { const int kk = 4 * i + (lane >> 4); const float gk = s.gain ? s.gain[k0 + kk] : 1.0f; LAS float* d = scr + kk * 65 + 4 * (lane & 15);
        d[0] = v[i][0] * gk; d[1] = v[i][1] * gk; d[2] = v[i][2] * gk; d[3] = v[i][3] * gk; }
    asm volatile("s_waitcnt lgkmcnt(0)" ::: "memory");
    const int c = lane & 7;
#pragma unroll
    for (int j = 0; j < 8; ++j) { const int n = (lane >> 3) + 8 * j; const LAS float* sp = scr + (8 * c) * 65 + n;
        u32x4 o; o.x = pk2(sp[0 * 65], sp[1 * 65]); o.y = pk2(sp[2 * 65], sp[3 * 65]); o.z = pk2(sp[4 * 65], sp[5 * 65]); o.w = pk2(sp[6 * 65], sp[7 * 65]);
        *(u32x4*)(s.WT + ((size_t)kb * s.ncols + n0 + n) * 64 + 8 * c) = o; }
    asm volatile("s_waitcnt lgkmcnt(0)" ::: "memory");
}
__device__ __forceinline__ P0Src p0_src(const Ctx& C, int it, int& r) {
    const float* norm_g = C.in(7);
    constexpr int I_A = (D / 64) * (A_IN / 64), I_B = (D / 64) * (B_IN / 64), I_C = (D / 64) * (C_INM / 64), I_OA = (2048 / 64) * (D / 64), I_OB = (4096 / 64) * (D / 64);
    r = it;
        if (r < I_A) return P0Src{C.in(9) + (size_t)D * A_IN, D, A_IN, A_IN, norm_g + 3 * D, C.wsp<bf16>(WS_WIA1)}; r -= I_A;
        if (r < I_B) return P0Src{C.in(11), D, B_IN, B_IN, norm_g + 1 * D, C.wsp<bf16>(WS_WIB)}; r -= I_B;
        if (r < I_C) return P0Src{C.in(14), D, C_IN, C_INM, norm_g + 2 * D, C.wsp<bf16>(WS_WIC)}; r -= I_C;
        if (r < I_OA) return P0Src{C.in(10), 2048, D, D, nullptr, C.wsp<bf16>(WS_WOA0)}; r -= I_OA;
        if (r < I_OA) return P0Src{C.in(10) + (size_t)2048 * D, 2048, D, D, nullptr, C.wsp<bf16>(WS_WOA1)}; r -= I_OA;
        if (r < I_OA) return P0Src{C.in(18), 2048, D, D, nullptr, C.wsp<bf16>(WS_WOC)}; r -= I_OA;
        if (r < I_OB) return P0Src{C.in(13), 4096, D, D, nullptr, C.wsp<bf16>(WS_WOB)}; r -= I_OB;
        return P0Src{C.in(9), D, A_IN, A_IN, norm_g + 0 * D, C.wsp<bf16>(WS_WIA0)};
}
__device__ __forceinline__ void p0_prologue(const Ctx& C, const Params& P) {
    LAS float* scr = (LAS float*)(C.lds + C.wave * 16640);
    const int gw = C.wg * 8 + C.wave, NGW = C.G * 8;
    const float* norm_g = C.in(7);
    constexpr int I_A = (D / 64) * (A_IN / 64), I_B = (D / 64) * (B_IN / 64), I_C = (D / 64) * (C_INM / 64), I_OA = (2048 / 64) * (D / 64), I_OB = (4096 / 64) * (D / 64);
    constexpr int NITEMS = 2 * I_A + I_B + I_C + 3 * I_OA + I_OB;
    if (gw < NITEMS) {
        int it = gw, rc; P0Src sc = p0_src(C, it, rc); f32x4 vc[16]; p0_tr_load(sc, rc, C.lane, vc);
        for (;;) {
            const int itn = it + NGW; const bool has = itn < NITEMS; int rn = 0; P0Src sn = sc; f32x4 vn[16];
            if (has) { sn = p0_src(C, itn, rn); p0_tr_load(sn, rn, C.lane, vn); }
            p0_tr_store(sc, rc, C.lane, vc, scr);
            if (!has) break;
#pragma unroll
            for (int i = 0; i < 16; ++i) vc[i] = vn[i];
            sc = sn; rc = rn; it = itn;
        }
    }
    { bf16* wlr = C.wsp<bf16>(WS_WLR); const float* W = C.in(14); const float* g2 = norm_g + 2 * D;
      for (int e = C.wg * NWG_THREADS + C.tid; e < 32 * D; e += C.G * NWG_THREADS) { const int r = e / D, k = e % D; wlr[e] = r < 16 ? (bf16)f2bf(W[(size_t)k * C_IN + C_INM + r] * g2[k]) : (bf16)0; } }
    { bf16* xb = C.wsp<bf16>(WS_XB); float* ss0 = C.sumsq(0);
      for (int row = gw; row < MT; row += NGW) {
          const float* src = row < MP ? C.in(0) + (size_t)row * D : C.in(1) + (size_t)(row - MP) * D;
          float s = 0.f;
#pragma unroll
          for (int j = 0; j < 8; ++j) { const f32x4 v = *(const f32x4*)(src + 4 * C.lane + 256 * j);
              u32x2 w; w.x = pk2(v[0], v[1]); w.y = pk2(v[2], v[3]); *(u32x2*)(xb + (size_t)row * D + 4 * C.lane + 256 * j) = w; s += (v[0] * v[0] + v[1] * v[1]) + (v[2] * v[2] + v[3] * v[3]); }
          s = wave_sum(s); if (row < MP && C.lane < 32) ss0[(size_t)row * 32 + C.lane] = C.lane == 0 ? s : 0.f; } }
    { f32x2* ta = C.wsp<f32x2>(WS_TABA); f32x2* tb = C.wsp<f32x2>(WS_TABB);
      for (int e = C.wg * NWG_THREADS + C.tid; e < 2052 * 16; e += C.G * NWG_THREADS) { const int pi = e >> 4, i = e & 15; const int pos = pi < 2048 ? pi : PAST + (pi - 2048); float s, c; sincos_d((double)pos * P.inv_a[i], s, c); ta[e] = (f32x2){c, s}; }
      for (int e = C.wg * NWG_THREADS + C.tid; e < 2052 * 128; e += C.G * NWG_THREADS) { const int pi = e >> 7, i = e & 127; const int pos = pi < 2048 ? pi : PAST + (pi - 2048); float s, c; sincos_d((double)pos * P.inv_b[i], s, c); tb[e] = (f32x2){c, s}; } }
}

template <int K, bool BKT, int SK_KS, int SK_MAXT, class EP>
DEV void skinny2(LAS unsigned char* lds, const bf16* A, const bf16* Bt, int N, int wg, int nwg, int tid, const EP& ep) {
    constexpr int NST = K / SK_KS, SK_RP = SK_KS * 2 + 32, CPR = SK_KS / 8  , NPRE = (SK_MAXT * 16 * CPR) / 512, KPW = SK_KS / 256  ;
    static_assert(SK_MAXT * 16 * SK_RP <= 131072 && NPRE >= 1, "skinny2: stage buffer");
    const int lane = tid & 63, w = tid >> 6, G4 = lane >> 4, l15 = lane & 15;
    const int ntiles = N / 16, tpw = (ntiles + nwg - 1) / nwg, t0 = wg * tpw; int nt = ntiles - t0; nt = nt > tpw ? tpw : nt;
    if (nt <= 0) return;
    const int nchunks = nt * 16 * CPR; const size_t n0 = (size_t)t0 * 16;
    u32x4 pre[NPRE];
    const int nr8 = nt * 128; int erow[NPRE], ecc[NPRE];
#pragma unroll
    for (int j = 0; j < NPRE; ++j) { const int e = tid + 512 * j; if (BKT) { const int ktl = e / nr8, rem = e - ktl * nr8; erow[j] = rem >> 3; ecc[j] = ktl * 8 + (rem & 7); } else { erow[j] = e / CPR; ecc[j] = e % CPR; } }
#define SK_SRC(j, st) (BKT ? Bt + ((size_t)((st) * (SK_KS / 64) + (ecc[j] >> 3)) * N + n0 + erow[j]) * 64 + (ecc[j] & 7) * 8 : Bt + (n0 + erow[j]) * K + (st) * SK_KS + ecc[j] * 8)
#pragma unroll
    for (int j = 0; j < NPRE; ++j) { const int e = tid + 512 * j; if (e < nchunks) pre[j] = *(const u32x4*)SK_SRC(j, 0); }
    f32x4 acc[SK_MAXT][2];
#pragma unroll
    for (int t = 0; t < SK_MAXT; ++t) { acc[t][0] = (f32x4){0.f, 0.f, 0.f, 0.f}; acc[t][1] = (f32x4){0.f, 0.f, 0.f, 0.f}; }
#pragma unroll 1
    for (int st = 0; st < NST; ++st) {
#pragma unroll
        for (int j = 0; j < NPRE; ++j) { const int e = tid + 512 * j; if (e < nchunks) *(LAS u32x4*)(lds + erow[j] * SK_RP + ecc[j] * 16) = pre[j]; }
        wg_sync_lds();
        if (st + 1 < NST) {
#pragma unroll
            for (int j = 0; j < NPRE; ++j) { const int e = tid + 512 * j; if (e < nchunks) pre[j] = *(const u32x4*)SK_SRC(j, st + 1); }
        }
        bf16x8 af[KPW][2];
#pragma unroll
        for (int kk = 0; kk < KPW; ++kk)
#pragma unroll
            for (int mt = 0; mt < 2; ++mt) af[kk][mt] = *(const bf16x8*)(A + (size_t)(16 * mt + l15) * K + st * SK_KS + 32 * (KPW * w + kk) + 8 * G4);
#pragma unroll
        for (int t = 0; t < SK_MAXT; ++t) if (t < nt) {
#pragma unroll
            for (int kk = 0; kk < KPW; ++kk) { const bf16x8 bfr = *(const LAS bf16x8*)(lds + (16 * t + l15) * SK_RP + (32 * (KPW * w + kk) + 8 * G4) * 2);
                acc[t][0] = mfma16(bfr, af[kk][0], acc[t][0]); acc[t][1] = mfma16(bfr, af[kk][1], acc[t][1]); }
        }
        wg_sync_lds();
    }
    LAS float* part = (LAS float*)lds;
#pragma unroll
    for (int t = 0; t < SK_MAXT; ++t) if (t < nt) {
#pragma unroll
        for (int mt = 0; mt < 2; ++mt)
#pragma unroll
            for (int r = 0; r < 4; ++r) part[((((size_t)t * 8 + w) * 2 + mt) * 4 + r) * 64 + lane] = acc[t][mt][r];
    }
    wg_sync();
    { const int l2 = tid & 63, mt = (tid >> 6) & 1, reg = tid >> 7;
      for (int t = 0; t < nt; ++t) { float s = 0.f;
#pragma unroll
          for (int ww = 0; ww < 8; ++ww) s += part[((((size_t)t * 8 + ww) * 2 + mt) * 4 + reg) * 64 + l2];
          ep(16 * mt + (l2 & 15), (int)n0 + 16 * t + 4 * (l2 >> 4) + reg, s); } }
    wg_sync();
}
#undef SK_SRC
#ifndef MK_STAGGER_TICKS
#define MK_STAGGER_TICKS 0
#endif
#ifndef MK_ATTN_RUN
#define MK_ATTN_RUN 1
#endif

__device__ __forceinline__ float rstd_of(const float* ss, int row) { return pg8::rstd32(ss, row); }
__device__ __forceinline__ void sample_rstd(const Ctx& C, LAS float* srs) {
    const bf16* xb = C.wsp<bf16>(WS_XB);
#pragma unroll
    for (int k = 0; k < 4; ++k) { const int r = C.wave * 4 + k; float s = 0.f;
#pragma unroll
        for (int j = 0; j < 4; ++j) { const u32x4 v = *(const u32x4*)(xb + (size_t)(MP + r) * D + 8 * C.lane + 512 * j);
#pragma unroll
            for (int i = 0; i < 4; ++i) { const float a = __uint_as_float(v[i] << 16), b = __uint_as_float(v[i] & 0xffff0000u); s += a * a + b * b; } }
        s = wave_sum(s); if (C.lane == 0) srs[r] = rsqrtf(s * (1.0f / 2048.0f) + EPS); }
    __syncthreads();
}
__device__ __forceinline__ void sfix_c(const Ctx& C, int layer) {
    const float* zs = C.wsp<float>(WS_ZSRAW); bf16* z = C.wsp<bf16>(WS_Z); LAS float* srs = (LAS float*)C.lds; sample_rstd(C, srs);
    for (int e = C.wg * NWG_THREADS + C.tid; e < MS * C_INM; e += C.G * NWG_THREADS) {
        const int r = e / C_INM, c = e % C_INM, row = MP + r; const float rs = srs[r];
        float v = zs[e] * rs; if (c < 1024) v *= 0.0625f;
        z[(size_t)row * C_INM + c] = (bf16)f2bf(v);
    }
    const float* lr = C.wsp<float>(WS_LR); float* loga = C.wsp<float>(WS_LOGA); const float* wg2 = C.in(15); const float* bg = C.in(16);
    for (int e = MP * 1024 + C.wg * NWG_THREADS + C.tid; e < MT * 1024; e += C.G * NWG_THREADS) {
        const int row = e >> 10, c = e & 1023; const float rs = srs[row - MP];
        float a = 0.f;
#pragma unroll
        for (int r = 0; r < 16; ++r) a += lr[(size_t)row * 16 + r] * wg2[r * 1024 + c];
        a = a * rs + bg[c];
        loga[e] = (fminf(a, 0.f) - log1pf(__expf(-fabsf(a)))) * 0.0625f;
    }
}

__device__ __forceinline__ void gla_pre(const Ctx& C, int layer) {
    bf16* z = C.wsp<bf16>(WS_Z); const float* ss = C.sumsq(layer); const float* lr = C.wsp<float>(WS_LR); float* dvec = C.wsp<float>(WS_DVEC); const float* wg2 = C.in(15); const float* bg = C.in(16);
    LAS float* lrs = (LAS float*)C.lds; LAS float* tot = lrs + 128 * 16; LAS bf16* ebs = (LAS bf16*)(C.lds + 16384);
    for (int u = C.wg; u < 256; u += C.G) {
        const int chunk = u >> 2, cq = u & 3, cl = C.tid & 255, col = cq * 256 + cl, ih = C.tid >> 8;
        { const int row = chunk * 128 + (C.tid >> 2); const f32x4 v = *(const f32x4*)(lr + (size_t)row * 16 + (C.tid & 3) * 4); *(LAS f32x4*)(lrs + C.tid * 4) = v * rstd_of(ss, row); }
        float wv[16];
#pragma unroll
        for (int r = 0; r < 16; ++r) wv[r] = wg2[r * 1024 + col];
        const float bgc = bg[col];
        __syncthreads();
        float la[64]; float run = 0.f;
#pragma unroll
        for (int j = 0; j < 64; ++j) {
            const LAS f32x4* lp = (const LAS f32x4*)(lrs + (ih * 64 + j) * 16);
            const f32x4 l0 = lp[0], l1 = lp[1], l2 = lp[2], l3 = lp[3];
            float a = bgc + l0[0] * wv[0] + l0[1] * wv[1] + l0[2] * wv[2] + l0[3] * wv[3] + l1[0] * wv[4] + l1[1] * wv[5] + l1[2] * wv[6] + l1[3] * wv[7]
                    + l2[0] * wv[8] + l2[1] * wv[9] + l2[2] * wv[10] + l2[3] * wv[11] + l3[0] * wv[12] + l3[1] * wv[13] + l3[2] * wv[14] + l3[3] * wv[15];
            run += (fminf(a, 0.f) - __logf(1.0f + __expf(-fabsf(a)))) * 0.0625f; la[j] = run;
        }
        if (ih == 0) tot[cl] = run;
        __syncthreads();
        const float off = ih ? tot[cl] : 0.f;
#pragma unroll
        for (int j = 0; j < 64; ++j) ebs[(ih * 64 + j) * 256 + cl] = (bf16)f2bf(__expf(la[j] + off));
        if (ih) dvec[(((size_t)(chunk >> 4) * 4 + (col >> 8)) * 16 + (chunk & 15)) * 256 + (col & 255)] = __expf(la[63] + off);
        __syncthreads();
#pragma unroll
        for (int j = 0; j < 8; ++j) {
            const int pc = C.tid + 512 * j, tk = pc >> 5, cg = pc & 31;
            bf16* zq = z + (size_t)(chunk * 128 + tk) * C_INM + cq * 256 + cg * 8;
            const u32x4 qv = *(const u32x4*)zq, kv = *(const u32x4*)(zq + 1024); const u32x4 ev = *(const LAS u32x4*)(ebs + tk * 256 + cg * 8);
            u32x4 qo, ko;
#pragma unroll
            for (int k = 0; k < 4; ++k) { const float e0 = __uint_as_float(ev[k] << 16), e1 = __uint_as_float(ev[k] & 0xffff0000u); const float i0 = 1.0f / e0, i1 = 1.0f / e1;
                qo[k] = pk2(__uint_as_float(qv[k] << 16) * e0, __uint_as_float(qv[k] & 0xffff0000u) * e1); ko[k] = pk2(__uint_as_float(kv[k] << 16) * i0, __uint_as_float(kv[k] & 0xffff0000u) * i1); }
            *(u32x4*)zq = qo; *(u32x4*)(zq + 1024) = ko;
        }
        __syncthreads();
    }
}
template <int NVT, class OT>
__device__ __forceinline__ void scan_phase(const Ctx& C, int ldz, int qoff, int koff, int voff, int H, const float* dvec, float* state_out) {
    const bf16* z = C.wsp<bf16>(WS_Z); OT* o = C.wsp<OT>(WS_O);
    const int nunits = NB * H * (512 / (16 * NVT));
    for (int u = C.wg; u < nunits; u += C.G) scan_unit<NVT, OT>(C.lds, z, ldz, qoff, koff, voff, H, u, dvec, o, H * 512, state_out, C.tid);
}

__device__ __forceinline__ float dot128_bb(const bf16* q, const bf16* k) {
    float a = 0.f;
#pragma unroll 4
    for (int i = 0; i < 16; ++i) { const u32x4 x = ((const u32x4*)q)[i], y = ((const u32x4*)k)[i];
#pragma unroll
        for (int j = 0; j < 4; ++j) a += __uint_as_float(x[j] << 16) * __uint_as_float(y[j] << 16) + __uint_as_float(x[j] & 0xffff0000u) * __uint_as_float(y[j] & 0xffff0000u); }
    return a;
}
__device__ __forceinline__ float dot128_bf(const bf16* q, const float* k) {
    float a = 0.f;
#pragma unroll 4
    for (int i = 0; i < 16; ++i) { const u32x4 x = ((const u32x4*)q)[i]; const f32x4 y0 = ((const f32x4*)k)[2 * i], y1 = ((const f32x4*)k)[2 * i + 1];
        a += __uint_as_float(x[0] << 16) * y0[0] + __uint_as_float(x[0] & 0xffff0000u) * y0[1] + __uint_as_float(x[1] << 16) * y0[2] + __uint_as_float(x[1] & 0xffff0000u) * y0[3]
           + __uint_as_float(x[2] << 16) * y1[0] + __uint_as_float(x[2] & 0xffff0000u) * y1[1] + __uint_as_float(x[3] << 16) * y1[2] + __uint_as_float(x[3] & 0xffff0000u) * y1[3]; }
    return a;
}
template <bool GLA, class OT, bool ROT>
__device__ __forceinline__ void recur_naive(const Ctx& C, int ldz, int qoff, int koff, int voff, int H, int nseq, int ntok, int row0, const float* state0, float* state_out) {
    static_assert(sizeof(OT) == 4, "f32 o only");
    const bf16* z = C.wsp<bf16>(WS_Z); float* o = C.wsp<float>(WS_O); const float* loga = C.wsp<float>(WS_LOGA); const f32x2* tb = C.wsp<f32x2>(WS_TABB);
    LAS float* red = (LAS float*)C.lds;
    const int lane = C.lane, dg = C.wave;
    for (int item = C.wg; item < nseq * H * 8; item += C.G) {
        const int vs = item & 7, h = (item >> 3) % H, seq = (item >> 3) / H;
        const size_t sbase = (((size_t)seq * H + h) * 256 + dg * 32) * 512 + vs * 64 + lane;
        float Sreg[32];
#pragma unroll
        for (int j = 0; j < 32; ++j) Sreg[j] = state0[sbase + (size_t)j * 512];
        const float gamma = GLA ? 1.f : 1.0f - exp2f(-5.0f - (float)h);
        for (int t = 0; t < ntok; ++t) {
            const int row = row0 + seq * ntok + t; const bf16* zr = z + (size_t)row * ldz;
            const int d = dg * 32 + (lane & 31);
            float qv, kv, dv = gamma;
            if constexpr (ROT) { const int i = d & 127; const f32x2 cs = tb[(2048 + t) * 128 + i];
                const float q1 = bf2f(zr[qoff + h * 256 + i]), q2 = bf2f(zr[qoff + h * 256 + i + 128]), k1 = bf2f(zr[koff + h * 256 + i]), k2 = bf2f(zr[koff + h * 256 + i + 128]);
                qv = d < 128 ? q1 * cs.x - q2 * cs.y : q1 * cs.y + q2 * cs.x; kv = d < 128 ? k1 * cs.x - k2 * cs.y : k1 * cs.y + k2 * cs.x;
            } else { qv = bf2f(zr[qoff + h * 256 + d]); kv = bf2f(zr[koff + h * 256 + d]); }
            if (GLA) dv = __expf(loga[(size_t)row * 1024 + h * 256 + d]);
            const float vv = bf2f(zr[voff + h * 512 + vs * 64 + lane]);
            float p = 0.f;
#pragma unroll
            for (int j = 0; j < 32; ++j) { const float qj = __shfl(qv, j), kj = __shfl(kv, j), dj = GLA ? __shfl(dv, j) : gamma; Sreg[j] = dj * Sreg[j] + kj * vv; p += qj * Sreg[j]; }
            red[((t & 1) * 8 + dg) * 64 + lane] = p;
            __syncthreads();
            if (dg == 0) { const LAS float* rr = red + (t & 1) * 512 + lane; o[(size_t)row * (H * 512) + h * 512 + vs * 64 + lane] = ((rr[0] + rr[64]) + (rr[128] + rr[192])) + ((rr[256] + rr[320]) + (rr[384] + rr[448])); }
        }
#pragma unroll
        for (int j = 0; j < 32; ++j) state_out[sbase + (size_t)j * 512] = Sreg[j];
        __syncthreads();
    }
}
struct NGItem { f32x4 oa[4], ob[4]; u32x4 gw[4]; };
__device__ __forceinline__ void ng_load(NGItem& it, const float* o, const bf16* z, int H, int ldz, int goff, int w0, int lane) {
#pragma unroll
    for (int k = 0; k < 4; ++k) { const int w = w0 + k, row = w / H, h = w % H; const float* orow = o + (size_t)row * (H * 512) + h * 512;
        it.oa[k] = ((const f32x4*)orow)[2 * lane]; it.ob[k] = ((const f32x4*)orow)[2 * lane + 1]; it.gw[k] = ((const u32x4*)(z + (size_t)row * ldz + goff + h * 512))[lane]; }
}
template <bool MEAN, class OT>
__device__ __forceinline__ void norm_gate(const Ctx& C, int H, int ldz, int goff, const float* gn) {
    static_assert(sizeof(OT) == 4, "norm_gate: f32 o only");
    const bf16* z = C.wsp<bf16>(WS_Z); const float* o = C.wsp<float>(WS_O); bf16* y = C.wsp<bf16>(WS_Y); const int lane = C.lane;
    const int total = MT * H, stride = C.G * 8 * 4; int w0 = (C.wg * 8 + C.wave) * 4;
    if (w0 >= total) return;
    f32x4 g0[4], g1[4];
#pragma unroll
    for (int k = 0; k < 4; ++k) { const int h = (w0 + k) % H; g0[k] = ((const f32x4*)(gn + h * 512))[2 * lane]; g1[k] = ((const f32x4*)(gn + h * 512))[2 * lane + 1]; }
    NGItem cur; ng_load(cur, o, z, H, ldz, goff, w0, lane);
    for (;;) {
        const int wn = w0 + stride; const bool has = wn < total; NGItem nxt;
        if (has) ng_load(nxt, o, z, H, ldz, goff, wn, lane);
#pragma unroll
        for (int k = 0; k < 4; ++k) {
            const int w = w0 + k, row = w / H, h = w % H;
            float v[8] = {cur.oa[k][0], cur.oa[k][1], cur.oa[k][2], cur.oa[k][3], cur.ob[k][0], cur.ob[k][1], cur.ob[k][2], cur.ob[k][3]};
            float s = 0.f;
#pragma unroll
            for (int i = 0; i < 8; ++i) s += v[i];
            float mu = 0.f; if (MEAN) mu = wave_sum(s) * (1.f / 512.f);
            float q = 0.f;
#pragma unroll
            for (int i = 0; i < 8; ++i) { v[i] -= mu; q += v[i] * v[i]; }
            const float r = rsqrtf(wave_sum(q) * (1.f / 512.f) + EPS);
            const float gg[8] = {g0[k][0], g0[k][1], g0[k][2], g0[k][3], g1[k][0], g1[k][1], g1[k][2], g1[k][3]};
            float ov[8];
#pragma unroll
            for (int i = 0; i < 4; ++i) { ov[2 * i] = v[2 * i] * r * gg[2 * i] * silu(__uint_as_float(cur.gw[k][i] << 16)); ov[2 * i + 1] = v[2 * i + 1] * r * gg[2 * i + 1] * silu(__uint_as_float(cur.gw[k][i] & 0xffff0000u)); }
            u32x4 ow; ow.x = pk2(ov[0], ov[1]); ow.y = pk2(ov[2], ov[3]); ow.z = pk2(ov[4], ov[5]); ow.w = pk2(ov[6], ov[7]);
            ((u32x4*)(y + (size_t)row * (H * 512) + h * 512))[lane] = ow;
        }
        if (!has) break;
        cur = nxt; w0 = wn;
    }
}
__device__ __forceinline__ void final_norm(const Ctx& C) {
    const bf16* xb = C.wsp<bf16>(WS_XB); const float* fg = C.in(8);
    for (int row = C.wg * 8 + C.wave; row < MT; row += C.G * 8) {
        u32x4 xv[4]; float s = 0.f;
#pragma unroll
        for (int j = 0; j < 4; ++j) { xv[j] = *(const u32x4*)(xb + (size_t)row * D + 8 * C.lane + 512 * j);
#pragma unroll
            for (int i = 0; i < 4; ++i) { const float a = __uint_as_float(xv[j][i] << 16), b = __uint_as_float(xv[j][i] & 0xffff0000u); s += a * a + b * b; } }
        const float rs = rsqrtf(wave_sum(s) * (1.0f / 2048.0f) + EPS);
#pragma unroll
        for (int j = 0; j < 4; ++j) { const int c = 8 * C.lane + 512 * j; const f32x4 g0 = *(const f32x4*)(fg + c), g1 = *(const f32x4*)(fg + c + 4);
            const f32x4 v0 = {__uint_as_float(xv[j][0] << 16), __uint_as_float(xv[j][0] & 0xffff0000u), __uint_as_float(xv[j][1] << 16), __uint_as_float(xv[j][1] & 0xffff0000u)};
            const f32x4 v1 = {__uint_as_float(xv[j][2] << 16), __uint_as_float(xv[j][2] & 0xffff0000u), __uint_as_float(xv[j][3] << 16), __uint_as_float(xv[j][3] & 0xffff0000u)};
            *(f32x4*)(C.out + (size_t)row * D + c) = v0 * rs * g0; *(f32x4*)(C.out + (size_t)row * D + c + 4) = v1 * rs * g1; }
    }
}

__device__ __forceinline__ void attn_fast_phase(const Ctx& C) {
    const bf16* z = C.wsp<bf16>(WS_Z); bf16* og = C.wsp<bf16>(WS_O); float* lse = C.wsp<float>(WS_LOGA);
    const int per = (3072 + C.G - 1) / C.G;
    const int i0 = C.wg * per; int n = 3072 - i0; n = n > per ? per : n;
#if MK_ATTN_RUN
    if (n > 0) attn_run(C.lds, z, A_IN, og, lse, i0, n, C.tid);
#else
    for (int j = 0; j < n; ++j) attn_item(C.lds, z, A_IN, og, lse, i0 + j, C.tid);
#endif
}
__device__ __forceinline__ void sattn_phase(const Ctx& C, int slot, const float* c1, const float* c2, const float* c3) {
    const bf16* z = C.wsp<bf16>(WS_Z); bf16* og = C.wsp<bf16>(WS_O); float* lse = C.wsp<float>(WS_LOGA);
    for (int u0 = C.wg * 6; u0 < 1536; u0 += C.G * 6) {
        const int u = u0 + C.wave;
        if (C.wave < 6 && u < 1536) {
            const int t = u & 3, h = (u >> 2) & 15, b = (u >> 6) & 7, g = u >> 9;
            const float* cache = c1; if (g == 1) cache = c2; if (g == 2) cache = c3;
            float* skv = C.out + (size_t)MP * D + (size_t)MS * D + (size_t)2 * 4 * (128 + 512 + 2048) * 4096 + (size_t)4 * 8 * 256 * 512 + (size_t)4 * 4 * 256 * 512;
            sattn_unit(C.lds + C.wave * 1024, z, A_IN, cache + (size_t)slot * 8 * (128 << (2 * g)) * 4096, g, b, t, h, og, lse, C.lane, C.wsp<f32x2>(WS_TABA), skv + (size_t)g * (2 * 8 * 4 * 4096) + (size_t)(slot * DB + b) * T * 2 * 2048);
        }
    }
}
struct MGItem { u32x4 a[4], b[4], c[4], gt[4]; float l0[4], l1[4], l2[4]; };
__device__ __forceinline__ void mg_load(MGItem& it, const bf16* z, const bf16* og, const float* lse, int row, int lane) {
#pragma unroll
    for (int j = 0; j < 4; ++j) { const int col = (lane + 64 * j) * 8, h = col >> 7;
        it.l0[j] = lse[((size_t)0 * MT + row) * 16 + h]; it.l1[j] = lse[((size_t)1 * MT + row) * 16 + h]; it.l2[j] = lse[((size_t)2 * MT + row) * 16 + h];
        it.a[j] = *(const u32x4*)(og + ((size_t)0 * MT + row) * 2048 + col); it.b[j] = *(const u32x4*)(og + ((size_t)1 * MT + row) * 2048 + col); it.c[j] = *(const u32x4*)(og + ((size_t)2 * MT + row) * 2048 + col);
        it.gt[j] = *(const u32x4*)(z + att_zoff(row, 18432 + col)); }
}
__device__ __forceinline__ void attn_merge(const Ctx& C) {
    const bf16* z = C.wsp<bf16>(WS_Z); const bf16* og = C.wsp<bf16>(WS_O); const float* lse = C.wsp<float>(WS_LOGA); bf16* y = C.wsp<bf16>(WS_Y); const int lane = C.lane;
    int row = C.wg * 8 + C.wave; const int stride = C.G * 8;
    if (row >= MT) return;
    MGItem cur; mg_load(cur, z, og, lse, row, lane);
    for (;;) {
        const int rn = row + stride; const bool has = rn < MT; MGItem nxt;
        if (has) mg_load(nxt, z, og, lse, rn, lane);
#pragma unroll
        for (int j = 0; j < 4; ++j) {
            const int col = (lane + 64 * j) * 8;
            const float m = fmaxf(cur.l0[j], fmaxf(cur.l1[j], cur.l2[j])); float w0 = __expf(cur.l0[j] - m), w1 = __expf(cur.l1[j] - m), w2 = __expf(cur.l2[j] - m); const float inv = 1.0f / (w0 + w1 + w2); w0 *= inv; w1 *= inv; w2 *= inv;
            u32x4 o;
#pragma unroll
            for (int k = 0; k < 4; ++k) {
                const float lo = (w0 * __uint_as_float(cur.a[j][k] << 16) + w1 * __uint_as_float(cur.b[j][k] << 16) + w2 * __uint_as_float(cur.c[j][k] << 16)) * silu(__uint_as_float(cur.gt[j][k] << 16));
                const float hi = (w0 * __uint_as_float(cur.a[j][k] & 0xffff0000u) + w1 * __uint_as_float(cur.b[j][k] & 0xffff0000u) + w2 * __uint_as_float(cur.c[j][k] & 0xffff0000u)) * silu(__uint_as_float(cur.gt[j][k] & 0xffff0000u));
                o[k] = pk2(lo, hi);
            }
            *(u32x4*)(y + (size_t)row * 2048 + col) = o;
        }
        if (!has) break;
        cur = nxt; row = rn;
    }
}

template <int MODE>
__device__ __forceinline__ void gemm_in(const Ctx& C, size_t wt_off, int N, int layer, float* kvb, int slot) {
    if (MODE == 0 && MK_STAGGER_TICKS > 0) {
        const unsigned long long t0 = __builtin_amdgcn_s_memrealtime(); const unsigned long long dl = (unsigned long long)((C.wg & 7) * MK_STAGGER_TICKS / 8);
        while (__builtin_amdgcn_s_memrealtime() - t0 < dl) __builtin_amdgcn_s_sleep(8);
    }
    pg8::Gemm g{C.wsp<pg8::bf16_t>(WS_XB), C.wsp<pg8::bf16_t>(wt_off), MP, N, D}; pg8::StaticOrder So; So.init(MP, N, C.G, C.wg);
    LAS float* rst = (LAS float*)(C.lds + 131072 + 4096); int pm0 = -1;
    { pg8::Unit u0; if (So.next(0, u0)) { pm0 = u0.pm; if (C.tid < 256) rst[C.tid] = pg8::rstd32(C.sumsq(layer), pm0 * 256 + C.tid); } }
    __syncthreads();
    pg8::EpiIn<MODE> E{C.wsp<pg8::bf16_t>(WS_Z), N, C.sumsq(layer), (const pg8::f32x2*)C.wsp<f32x2>(MODE == 0 ? WS_TABA : WS_TABB), kvb, slot, (const PG8_LAS float*)rst, pm0};
    pg8::gemm_phase<pg8::EpiIn<MODE>, pg8::StaticOrder, true, true>((PG8_LAS unsigned char*)C.lds, g, So, E);
}
template <int K>
__device__ __forceinline__ void gemm_out(const Ctx& C, size_t wt_off, int layer) {
    pg8::Gemm g{C.wsp<pg8::bf16_t>(WS_Y), C.wsp<pg8::bf16_t>(wt_off), MP, D, K}; pg8::StaticOrder So; So.init(MP, D, C.G, C.wg);
    pg8::EpiOut E{C.wsp<pg8::bf16_t>(WS_XB), C.sumsq(layer < 3 ? layer + 1 : 0)};
    bf16* xb = C.wsp<bf16>(WS_XB);
    skinny2<K, true, 2048, 1>(C.lds, C.wsp<bf16>(WS_Y) + (size_t)MP * K, C.wsp<bf16>(wt_off), D, C.wg, C.G, C.tid, [=](int m, int n, float v) {
        const size_t o = (size_t)(MP + m) * D + n; xb[o] = (bf16)f2bf(bf2f(xb[o]) + v); });
    pg8::gemm_phase<pg8::EpiOut, pg8::StaticOrder, true, true>((PG8_LAS unsigned char*)C.lds, g, So, E);
}
__device__ __forceinline__ void skinny_in(const Ctx& C, size_t wt_off, int N) {
    float* zs = C.wsp<float>(WS_ZSRAW);
    skinny2<D, true, 512, 5>(C.lds, C.wsp<bf16>(WS_XB) + (size_t)MP * D, C.wsp<bf16>(wt_off), N, C.wg, C.G, C.tid, [=](int m, int n, float v) { zs[(size_t)m * N + n] = v; });
}
__device__ __forceinline__ void skinny_in_z(const Ctx& C, size_t wt_off, int N, bool kscale) {
    bf16* z = C.wsp<bf16>(WS_Z); const LAS float* srs = (const LAS float*)(C.lds + 131072 + 4096 + 1024);
    sample_rstd(C, (LAS float*)(C.lds + 131072 + 4096 + 1024));
    skinny2<D, true, 512, 5>(C.lds, C.wsp<bf16>(WS_XB) + (size_t)MP * D, C.wsp<bf16>(wt_off), N, C.wg, C.G, C.tid, [=](int m, int n, float v) {
        float s = srs[m]; if (kscale && n >= 2048 && n < 4096) s *= 0.0625f;
        const size_t zo = kscale ? (size_t)(MP + m) * N + n : att_zoff(MP + m, n);
        z[zo] = (bf16)f2bf(v * s); });
}

__global__ void __launch_bounds__(NWG_THREADS, 2) mk_fwd(Params P) {
    extern __shared__ __attribute__((aligned(16))) unsigned char lds_raw[];
    Ctx C; C.lds = (LAS unsigned char*)lds_raw; C.tid = threadIdx.x; C.lane = C.tid & 63; C.wave = __builtin_amdgcn_readfirstlane(C.tid >> 6); C.G = gridDim.x; C.wg = blockIdx.x;
    C.P = &P; C.out = P.out; C.ws = P.ws;
    volatile LAS unsigned* MISC = (volatile LAS unsigned*)(C.lds + MISC_OFF);
    if (C.tid < 32) MISC[C.tid] = 0u;
    __syncthreads();
    XcdBarrier bar = xcd_barrier_post((unsigned*)(P.ws + CTL_BAR), MISC + 8);
    int ph = 0;
#define RUN (ph >= P.ph_lo && ph < P.ph_hi)
#define SEAM() do { if (ph >= P.ph_lo && ph + 1 < P.ph_hi) xcd_barrier(bar); ++ph; } while (0)
    float* out = P.out;
    float* pkv1 = out + (size_t)MP * D + (size_t)MS * D; float* pkv2 = pkv1 + (size_t)2 * 4 * 128 * 4096; float* pkv3 = pkv2 + (size_t)2 * 4 * 512 * 4096;
    float* pst_b = pkv3 + (size_t)2 * 4 * 2048 * 4096; float* pst_c = pst_b + (size_t)4 * 8 * 256 * 512;
    float* sst_b = pst_c + (size_t)4 * 4 * 256 * 512 + (size_t)3 * 2 * 8 * 4 * 4096; float* sst_c = sst_b + (size_t)8 * 8 * 256 * 512;

    if (RUN) p0_prologue(C, P);
    SEAM();
    if (RUN) { skinny_in_z(C, WS_WIA0, A_IN, false); gemm_in<0>(C, WS_WIA0, A_IN, 0, pkv1, 0); }
    SEAM();
    if (RUN) { attn_fast_phase(C); sattn_phase(C, 0, P.in[2], P.in[3], P.in[4]); }
    SEAM();
    if (RUN) attn_merge(C);
    SEAM();
    if (RUN) gemm_out<2048>(C, WS_WOA0, 0);
    SEAM();
    if (RUN) { skinny_in_z(C, WS_WIB, B_IN, true); gemm_in<1>(C, WS_WIB, B_IN, 1, nullptr, 0); }
    SEAM();
    if (RUN) { scan_phase<4, float>(C, B_IN, 0, 2048, 4096, 8, nullptr, pst_b); recur_naive<false, float, true>(C, B_IN, 0, 2048, 4096, 8, DB, T, MP, C.in(5), sst_b); }
    SEAM();
    if (RUN) norm_gate<true, float>(C, 8, B_IN, 8192, C.in(12));
    SEAM();
    if (RUN) gemm_out<4096>(C, WS_WOB, 1);
    SEAM();
    if (RUN) { skinny_in(C, WS_WIC, C_INM);
        float* lr = C.wsp<float>(WS_LR);
        skinny2<D, false, 512, 5>(C.lds, C.wsp<bf16>(WS_WLR), C.wsp<bf16>(WS_XB), MT, C.wg, C.G, C.tid, [=](int m, int n, float v) { if (m < 16) lr[(size_t)n * 16 + m] = v; }); gemm_in<2>(C, WS_WIC, C_INM, 2, nullptr, 0); }
    SEAM();
    if (RUN) { sfix_c(C, 2); __syncthreads(); gla_pre(C, 2); }
    SEAM();
    if (RUN) { scan_phase<2, float>(C, C_INM, 0, 1024, 2048, 4, C.wsp<float>(WS_DVEC), pst_c); recur_naive<true, float, false>(C, C_INM, 0, 1024, 2048, 4, DB, T, MP, C.in(6), sst_c); }
    SEAM();
    if (RUN) norm_gate<false, float>(C, 4, C_INM, 4096, C.in(17));
    SEAM();
    if (RUN) gemm_out<2048>(C, WS_WOC, 2);
    SEAM();
    if (RUN) { skinny_in_z(C, WS_WIA1, A_IN, false); gemm_in<0>(C, WS_WIA1, A_IN, 3, pkv1, 1); }
    SEAM();
    if (RUN) { attn_fast_phase(C); sattn_phase(C, 1, P.in[2], P.in[3], P.in[4]); }
    SEAM();
    if (RUN) attn_merge(C);
    SEAM();
    if (RUN) gemm_out<2048>(C, WS_WOA1, 3);
    SEAM();
    if (RUN) final_norm(C);
#undef RUN
#undef SEAM
}
constexpr int NPHASES = 19;
}

#ifndef MK_PRE_LO
#define MK_PRE_LO -1
#endif
#ifndef MK_PRE
#define MK_PRE -1
#endif
#ifndef MK_LAUNCHES
#define MK_LAUNCHES 1
#endif
extern "C" void kernel_launch(void* const* d_in, const int* in_sizes, int n_in, void* d_out, int out_size, void* d_ws, size_t ws_size, hipStream_t stream) {
    using namespace mk;
    static int grid = 0;
    if (grid == 0) {
        int dev = 0, cus = 0;
        if (hipGetDevice(&dev) != hipSuccess || hipDeviceGetAttribute(&cus, hipDeviceAttributeMultiprocessorCount, dev) != hipSuccess) { fprintf(stderr, "kernel_launch: device query failed\n"); grid = -1; return; }
        if (hipFuncSetAttribute((const void*)mk_fwd, hipFuncAttributeMaxDynamicSharedMemorySize, LDS_BYTES) != hipSuccess) { fprintf(stderr, "kernel_launch: hipFuncSetAttribute failed\n"); grid = -1; return; }
        int per_cu = 0;
        if (hipOccupancyMaxActiveBlocksPerMultiprocessor(&per_cu, (const void*)mk_fwd, NWG_THREADS, LDS_BYTES) != hipSuccess || per_cu < 1) fprintf(stderr, "kernel_launch: occupancy query says %d\n", per_cu);
        (void)hipGetLastError();
        if (ws_size < WS_END) { fprintf(stderr, "kernel_launch: workspace too small (%zu < %zu)\n", ws_size, (size_t)WS_END); grid = -1; return; }
        grid = cus;
    }
    if (grid < 0) return;
    (void)hipMemsetAsync((char*)d_ws + WS_CTL, 0, CTL_ZERO_BYTES, stream);
    Params p{};
    for (int i = 0; i < 19; ++i) p.in[i] = (const float*)d_in[i];
    p.out = (float*)d_out; p.ws = (unsigned char*)d_ws;
    for (int i = 0; i < 16; ++i) p.inv_a[i] = pow(500000.0, -(double)i / 16.0);
    for (int i = 0; i < 128; ++i) p.inv_b[i] = pow(10000.0, -(double)i / 128.0);
    if (MK_PRE >= 0) { p.ph_lo = MK_PRE_LO >= 0 ? MK_PRE_LO : MK_PRE; p.ph_hi = MK_PRE + 1; hipLaunchKernelGGL(mk_fwd, dim3(grid), dim3(NWG_THREADS), LDS_BYTES, stream, p); (void)hipMemsetAsync((char*)d_ws + WS_CTL, 0, CTL_ZERO_BYTES, stream); }
    if (MK_LAUNCHES == 1) { p.ph_lo = 0; p.ph_hi = NPHASES; hipLaunchKernelGGL(mk_fwd, dim3(grid), dim3(NWG_THREADS), LDS_BYTES, stream, p); }
    else for (int k = 0; k < NPHASES; ++k) { p.ph_lo = k; p.ph_hi = k + 1; hipLaunchKernelGGL(mk_fwd, dim3(grid), dim3(NWG_THREADS), LDS_BYTES, stream, p); }
}
```

```cpp
#include <hip/hip_runtime.h>
#include <cstdio>
#include <cstdint>
#include <cmath>
namespace pg8 {
#define PG8_LAS __attribute__((address_space(3)))
typedef unsigned short bf16_t;
typedef short bf16x8 __attribute__((ext_vector_type(8)));
typedef float f32x4 __attribute__((ext_vector_type(4)));
typedef unsigned u32x4 __attribute__((ext_vector_type(4)));
constexpr int BM = 256, BK = 64, HALF = 128, HTB = HALF * BK * 2  , STAGE_BYTES = 8 * HTB, NXCD = 8, WGM = 8;

__host__ __device__ __forceinline__ int lds_byte(int r, int c) { const int st = (r >> 4) * 2 + (c >> 5), rr = r & 15, cc = c & 31, ob = rr * 64 + cc * 2; return st * 1024 + (ob ^ (((ob >> 9) & 1) << 5)); }
__host__ __device__ __forceinline__ void stage_rc(int b, int& R, int& C) { const int st = b / 1024, sb = b % 1024, swz = sb ^ (((sb >> 9) & 1) << 5); R = (st >> 1) * 16 + swz / 64; C = (st & 1) * 32 + (swz % 64) / 2; }
__host__ __device__ __forceinline__ int perm32(int rho) { const int n = rho >> 4, i = rho & 15; return 8 * (i >> 2) + 4 * n + (i & 3); }

struct Unit { int pm, pn; };
struct Gemm { const bf16_t* A; const bf16_t* Bt; int M, N, K; };

struct StaticOrder {
    int nM, nN, nwg, G, c;
    __host__ __device__ void init(int M, int N, int G_, int c_) { nM = M / BM; nN = N / BM; nwg = nM * nN; G = G_; c = c_; }
    __host__ __device__ bool next(int i, Unit& u) const {
        const long L = (long)i * G + c; if (L >= nwg) return false;
        int wgid = (int)L; { const int q = nwg / NXCD, r = nwg % NXCD, xcd = wgid % NXCD, off = wgid / NXCD; wgid = (xcd < r ? xcd * (q + 1) : r * (q + 1) + (xcd - r) * q) + off; }
        const int nig = WGM * nN, gid = wgid / nig, fm = gid * WGM, gsz = (nM - fm) < WGM ? (nM - fm) : WGM;
        u.pm = fm + ((wgid % nig) % gsz); u.pn = (wgid % nig) / gsz; return true;
    }
    __device__ __forceinline__ void a_ready(const Unit&) const {}
    __device__ __forceinline__ void done(const Unit&) const {}
};

__device__ __forceinline__ unsigned cvt_pk_bf16(float lo, float hi) { unsigned r; asm volatile("v_cvt_pk_bf16_f32 %0, %1, %2" : "=v"(r) : "v"(lo), "v"(hi)); return r; }
typedef float f32x2 __attribute__((ext_vector_type(2)));
typedef unsigned u32x2 __attribute__((ext_vector_type(2)));

__device__ __forceinline__ float rstd32(const float* part, int row) { const f32x4* p = (const f32x4*)(part + (size_t)row * 32); f32x4 s = p[0];
#pragma unroll
    for (int i = 1; i < 8; ++i) s += p[i];
    return rsqrtf(((s[0] + s[1]) + (s[2] + s[3])) * (1.0f / 2048.0f) + 1e-6f); }
template <int MODE> struct EpiIn {
    static constexpr bool PERM = true, AFTER_DRAIN = false;
    bf16_t* Z; int ldz; const float* sumsq; const f32x2* tab; float* kvb; int slot; const PG8_LAS float* rs_lds; int pm0;
    __device__ __forceinline__ float rs_of(const Unit& u, int row) const { return u.pm == pm0 ? rs_lds[row & 255] : rstd32(sumsq, row); }
    __device__ __forceinline__ void store8(bf16_t* p, const f32x4& a, const f32x4& b) const {
        u32x4 w; w.x = cvt_pk_bf16(a[0], a[1]); w.y = cvt_pk_bf16(a[2], a[3]); w.z = cvt_pk_bf16(b[0], b[1]); w.w = cvt_pk_bf16(b[2], b[3]); *(u32x4*)p = w; }
    __device__ __forceinline__ void operator()(const f32x4 (&acc)[2][2][4][2], const Unit& u, int wr, int wc, int fr, int fq) const {
        const int row0 = u.pm * BM + wr * 64 + fr, colt = u.pn * BM;
        if constexpr (MODE == 0) {
            const int section = u.pn >> 3, kind = section < 9 ? section % 3 : 3, g = section / 3;
            const bool rot = (kind < 2) && (wc == 0);
            const int gg = g > 2 ? 2 : g, keep = 128 << (2 * gg); float* kvo = kvb + (size_t)32768 * (size_t)(128 * (((1 << (2 * gg)) - 1) / 3)) + (size_t)slot * 4 * keep * 4096;
#pragma unroll
            for (int ai = 0; ai < 2; ++ai)
#pragma unroll
                for (int m = 0; m < 4; ++m) {
                    const int row = row0 + ai * HALF + m * 16; const float rs = rs_of(u, row); const int pos = row & 2047, b = row >> 11;
#pragma unroll
                    for (int bj = 0; bj < 2; ++bj) {
                        f32x4 v0 = acc[ai][bj][m][0] * rs, v1 = acc[ai][bj][m][1] * rs;
                        const int col = colt + bj * HALF + wc * 32 + 8 * fq;
                        if (rot) {
                            f32x4 p0, p1;
#pragma unroll
                            for (int j = 0; j < 4; ++j) { p0[j] = __shfl_xor(v0[j], 32); p1[j] = __shfl_xor(v1[j], 32); }
                            const f32x4* tp = (const f32x4*)(tab + pos * 16 + 8 * (fq & 1));
                            const f32x4 t0 = tp[0], t1 = tp[1], t2 = tp[2], t3 = tp[3];
                            const f32x4 c0 = {t0[0], t0[2], t1[0], t1[2]}, s0 = {t0[1], t0[3], t1[1], t1[3]}, c1 = {t2[0], t2[2], t3[0], t3[2]}, s1 = {t2[1], t2[3], t3[1], t3[3]};
                            if (fq < 2) { v0 = v0 * c0 - p0 * s0; v1 = v1 * c1 - p1 * s1; } else { v0 = p0 * s0 + v0 * c0; v1 = p1 * s1 + v1 * c1; }
                        }
                        if (kind == 0) { u32x4 w; w.x = cvt_pk_bf16(v0[0], v0[1]); w.y = cvt_pk_bf16(v0[2], v0[3]); w.z = cvt_pk_bf16(v1[0], v1[1]); w.w = cvt_pk_bf16(v1[2], v1[3]);
                            __builtin_nontemporal_store(w, (u32x4*)(Z + ((size_t)(col >> 7) * 8224 + row) * 128 + (col & 127))); }
                        else store8(Z + ((size_t)(col >> 7) * 8224 + row) * 128 + (col & 127), v0, v1);
                        if (kind == 1 || kind == 2) {
                            if (pos >= 2048 - keep) { float* o = kvo + (((size_t)b * keep + (pos - (2048 - keep))) * 2 + (kind - 1)) * 2048 + (col - section * 2048);
                                __builtin_nontemporal_store(v0, (f32x4*)o); __builtin_nontemporal_store(v1, (f32x4*)(o + 4)); }
                        }
                    }
                }
        } else if constexpr (MODE == 1) {
            const bool rot = u.pn < 16; const float sc = (u.pn >= 8 && u.pn < 16) ? 0.0625f : 1.0f;
            const float lg2 = log2f(1.0f - exp2f(-5.0f - (float)(u.pn & 7)));
#pragma unroll
            for (int ai = 0; ai < 2; ++ai)
#pragma unroll
                for (int m = 0; m < 4; ++m) {
                    const int row = row0 + ai * HALF + m * 16; const int pos = row & 2047;
                    float rs = rs_of(u, row) * sc;
                    if (rot) { const float ee = (float)((pos & 127) + 1) * lg2; rs *= exp2f(u.pn < 8 ? ee : -ee); }
                    f32x4 x1[2], x2[2];
#pragma unroll
                    for (int n = 0; n < 2; ++n) { x1[n] = acc[ai][0][m][n] * rs; x2[n] = acc[ai][1][m][n] * rs; }
                    if (rot) {
#pragma unroll
                        for (int n = 0; n < 2; ++n) {
                            const f32x4* tp = (const f32x4*)(tab + pos * 128 + wc * 32 + 8 * fq + 4 * n);
                            const f32x4 t0 = tp[0], t1 = tp[1];
                            const f32x4 c = {t0[0], t0[2], t1[0], t1[2]}, s = {t0[1], t0[3], t1[1], t1[3]};
                            const f32x4 a = x1[n], bb = x2[n];
                            x1[n] = a * c - bb * s; x2[n] = a * s + bb * c;
                        }
                    }
                    bf16_t* zp = Z + (size_t)row * ldz + colt + wc * 32 + 8 * fq;
                    store8(zp, x1[0], x1[1]); store8(zp + HALF, x2[0], x2[1]);
                }
        } else {
            const float sc = u.pn < 4 ? 0.0625f : 1.0f;
#pragma unroll
            for (int ai = 0; ai < 2; ++ai)
#pragma unroll
                for (int m = 0; m < 4; ++m) {
                    const int row = row0 + ai * HALF + m * 16; const float rs = rs_of(u, row) * sc;
                    bf16_t* zp = Z + (size_t)row * ldz + colt + wc * 32 + 8 * fq;
#pragma unroll
                    for (int bj = 0; bj < 2; ++bj) store8(zp + bj * HALF, acc[ai][bj][m][0] * rs, acc[ai][bj][m][1] * rs);
                }
        }
    }
};
struct EpiOut {
    static constexpr bool PERM = false, AFTER_DRAIN = false;
    bf16_t* xb; float* sumsq_next;
    __device__ __forceinline__ void operator()(const f32x4 (&acc)[2][2][4][2], const Unit& u, int wr, int wc, int fr, int fq) const {
        const int row0 = u.pm * BM + wr * 64 + fr, col0 = u.pn * BM + wc * 32 + 4 * fq;
#pragma unroll
        for (int ai = 0; ai < 2; ++ai)
#pragma unroll
            for (int m = 0; m < 4; ++m) {
                const int row = row0 + ai * HALF + m * 16; float ss = 0.f;
                bf16_t* br = xb + (size_t)row * 2048 + col0;
                u32x2 old[2][2];
#pragma unroll
                for (int bj = 0; bj < 2; ++bj)
#pragma unroll
                    for (int n = 0; n < 2; ++n) old[bj][n] = *(const u32x2*)(br + bj * HALF + n * 16);
#pragma unroll
                for (int bj = 0; bj < 2; ++bj)
#pragma unroll
                    for (int n = 0; n < 2; ++n) {
                        const u32x2 o = old[bj][n];
                        const f32x4 xo = {__uint_as_float(o.x << 16), __uint_as_float(o.x & 0xffff0000u), __uint_as_float(o.y << 16), __uint_as_float(o.y & 0xffff0000u)};
                        const f32x4 v = xo + acc[ai][bj][m][n];
                        u32x2 w; w.x = cvt_pk_bf16(v[0], v[1]); w.y = cvt_pk_bf16(v[2], v[3]); *(u32x2*)(br + bj * HALF + n * 16) = w;
                        ss += (v[0] * v[0] + v[1] * v[1]) + (v[2] * v[2] + v[3] * v[3]);
                    }
                ss += __shfl_xor(ss, 16); ss += __shfl_xor(ss, 32);
                if (fq == 0) sumsq_next[(size_t)row * 32 + u.pn * 4 + wc] = ss;
            }
    }
};
template <class Epi, class Sched, bool ALIGN_EPI = false, bool SP2 = false>
__device__ __forceinline__ void gemm_phase(PG8_LAS unsigned char* lds, const Gemm g, const Sched& S, const Epi& E) {
    const int tid = threadIdx.x, wid = __builtin_amdgcn_readfirstlane(tid >> 6), lane = tid & 63, wr = wid >> 2, wc = wid & 3, fr = lane & 15, fq = lane >> 4;
    const int K = g.K, nt = K / BK;
    unsigned voffA[2], voffB[2];
#pragma unroll
    for (int i = 0; i < 2; ++i) { int R, C; stage_rc(tid * 16 + i * 8192, R, C); const int Rb = Epi::PERM ? ((R & ~31) + perm32(R & 31)) : R;
        voffA[i] = (unsigned)(R * K + C) * 2u; voffB[i] = (unsigned)(Rb * 64 + C) * 2u; }
    const size_t kstep = (size_t)(BK * 2);
    const size_t hstep = (size_t)HALF * K * 2;
    const size_t tstep = 2 * hstep;
    const size_t kstepB = (size_t)g.N * 64 * 2, hstepB = (size_t)HALF * 64 * 2, tstepB = 2 * hstepB;
    const unsigned ldsw = (unsigned)wid * 1024u;
    const int aoff = lds_byte(wr * 64 + fr, fq * 8), boff = lds_byte(wc * 32 + fr, fq * 8);
#define PG8_SA(b, h) (((b) * 2 + (h)) * HTB)
#define PG8_SB(b, h) ((4 + (b) * 2 + (h)) * HTB)
#define PG8_STAGE(bufoff, gbase, voff) do { _Pragma("unroll") for (int _i = 0; _i < 2; ++_i) \
        __builtin_amdgcn_global_load_lds((const unsigned*)((const char*)(gbase) + (voff)[_i]), (PG8_LAS unsigned*)(lds + (bufoff) + ldsw + _i * 8192), 16, 0, 0); } while (0)
#define PG8_LDA(dst, b, h) do { _Pragma("unroll") for (int m = 0; m < 4; ++m) _Pragma("unroll") for (int k = 0; k < 2; ++k) dst[m][k] = *(const PG8_LAS bf16x8*)(lds + PG8_SA(b, h) + aoff + m * 2048 + k * 1024); } while (0)
#define PG8_LDB(dst, b, h) do { _Pragma("unroll") for (int n = 0; n < 2; ++n) _Pragma("unroll") for (int k = 0; k < 2; ++k) dst[n][k] = *(const PG8_LAS bf16x8*)(lds + PG8_SB(b, h) + boff + n * 2048 + k * 1024); } while (0)
#define PG8_MMA(ai, bj, At, Bt) do { __builtin_amdgcn_s_setprio(1); _Pragma("unroll") for (int m = 0; m < 4; ++m) _Pragma("unroll") for (int n = 0; n < 2; ++n) _Pragma("unroll") for (int k = 0; k < 2; ++k) \
        acc[ai][bj][m][n] = __builtin_amdgcn_mfma_f32_16x16x32_bf16(Bt[n][k], At[m][k], acc[ai][bj][m][n], 0, 0, 0); __builtin_amdgcn_s_setprio(0); } while (0)
#define PG8_WAIT_V(n) asm volatile("s_waitcnt vmcnt(" #n ")" ::: "memory")
#define PG8_WAIT_L(n) asm volatile("s_waitcnt lgkmcnt(" #n ")" ::: "memory")
#define PG8_BAR __builtin_amdgcn_s_barrier()
#define PG8_SCHED __builtin_amdgcn_sched_barrier(0)
    Unit cur, nxt; int ui = 0;
    if (!S.next(0, cur)) return;
    f32x4 acc[2][2][4][2];
#pragma unroll
    for (int a = 0; a < 2; ++a)
#pragma unroll
        for (int b = 0; b < 2; ++b)
#pragma unroll
            for (int m = 0; m < 4; ++m)
#pragma unroll
                for (int n = 0; n < 2; ++n) acc[a][b][m][n] = (f32x4){0.f, 0.f, 0.f, 0.f};
    bf16x8 At[4][2], B0[2][2], B1[2][2];
    const char* cA = (const char*)g.A + (size_t)cur.pm * tstep; const char* cB = (const char*)g.Bt + (size_t)cur.pn * tstepB;
    S.a_ready(cur);
    if constexpr (SP2) {
        PG8_STAGE(PG8_SB(0, 0), cB, voffB); PG8_STAGE(PG8_SB(0, 1), cB + hstepB, voffB); PG8_STAGE(PG8_SA(0, 0), cA, voffA); PG8_STAGE(PG8_SA(0, 1), cA + hstep, voffA);
        if (wr == 1) PG8_BAR;
        PG8_WAIT_V(2); PG8_BAR;
        PG8_STAGE(PG8_SB(1, 0), cB + kstepB, voffB); PG8_STAGE(PG8_SA(1, 0), cA + kstep, voffA); PG8_STAGE(PG8_SB(1, 1), cB + hstepB + kstepB, voffB);
        PG8_WAIT_V(6); PG8_BAR;
    } else {
        PG8_STAGE(PG8_SB(0, 0), cB, voffB); PG8_STAGE(PG8_SA(0, 0), cA, voffA); PG8_STAGE(PG8_SB(0, 1), cB + hstepB, voffB); PG8_STAGE(PG8_SA(0, 1), cA + hstep, voffA);
        if (wr == 1) PG8_BAR;
        PG8_WAIT_V(4); PG8_BAR;
        PG8_STAGE(PG8_SB(1, 0), cB + kstepB, voffB); PG8_STAGE(PG8_SA(1, 0), cA + kstep, voffA); PG8_STAGE(PG8_SB(1, 1), cB + hstepB + kstepB, voffB);
        PG8_WAIT_V(6); PG8_BAR;
    }
    for (;;) {
        const bool has_next = S.next(ui + 1, nxt);
        const char* nA = has_next ? (const char*)g.A + (size_t)nxt.pm * tstep : cA; const char* nB = has_next ? (const char*)g.Bt + (size_t)nxt.pn * tstepB : cB;
        for (int t = 0; t < nt; t += 2) {
            const bool last = (t == nt - 2);
            const char* a1 = cA + (size_t)(t + 1) * kstep;
            const char* a2 = last ? nA : cA + (size_t)(t + 2) * kstep; const char* b2 = last ? nB : cB + (size_t)(t + 2) * kstepB;
            const char* a3 = a2 + kstep; const char* b3 = b2 + kstepB;
            if (last && has_next) S.a_ready(nxt);
            if constexpr (SP2) {
            PG8_LDB(B0, 0, 0); PG8_LDB(B1, 0, 1); PG8_SCHED; PG8_LDA(At, 0, 0); PG8_STAGE(PG8_SA(1, 1), a1 + hstep, voffA);
            PG8_WAIT_V(8); PG8_WAIT_L(0); PG8_BAR; PG8_MMA(0, 0, At, B0); PG8_MMA(0, 1, At, B1); PG8_BAR; PG8_SCHED;
            PG8_LDA(At, 0, 1); PG8_STAGE(PG8_SB(0, 0), b2, voffB); PG8_STAGE(PG8_SB(0, 1), b2 + hstepB, voffB); PG8_STAGE(PG8_SA(0, 0), a2, voffA);
            PG8_WAIT_V(8); PG8_WAIT_L(0); PG8_BAR; PG8_MMA(1, 0, At, B0); PG8_MMA(1, 1, At, B1); PG8_BAR; PG8_SCHED;
            PG8_LDB(B0, 1, 0); PG8_LDB(B1, 1, 1); PG8_SCHED; PG8_LDA(At, 1, 0); PG8_STAGE(PG8_SA(0, 1), a2 + hstep, voffA);
            PG8_WAIT_V(8); PG8_WAIT_L(0); PG8_BAR; PG8_MMA(0, 0, At, B0); PG8_MMA(0, 1, At, B1); PG8_BAR; PG8_SCHED;
            PG8_LDA(At, 1, 1); PG8_STAGE(PG8_SB(1, 0), b3, voffB); PG8_STAGE(PG8_SB(1, 1), b3 + hstepB, voffB); PG8_STAGE(PG8_SA(1, 0), a3, voffA);
            PG8_WAIT_V(8); PG8_WAIT_L(0); PG8_BAR; PG8_MMA(1, 0, At, B0); PG8_MMA(1, 1, At, B1); PG8_BAR; PG8_SCHED;
            } else {
            PG8_LDB(B0, 0, 0); PG8_SCHED; PG8_LDA(At, 0, 0); PG8_STAGE(PG8_SA(1, 1), a1 + hstep, voffA);
            PG8_WAIT_L(8); PG8_BAR; PG8_WAIT_L(0); PG8_MMA(0, 0, At, B0); PG8_BAR; PG8_SCHED;
            PG8_LDB(B1, 0, 1); PG8_STAGE(PG8_SB(0, 0), b2, voffB);
            PG8_BAR; PG8_WAIT_L(0); PG8_MMA(0, 1, At, B1); PG8_BAR;
            PG8_LDA(At, 0, 1); PG8_STAGE(PG8_SA(0, 0), a2, voffA);
            PG8_BAR; PG8_WAIT_L(0); PG8_MMA(1, 0, At, B0); PG8_BAR; PG8_SCHED;
            PG8_STAGE(PG8_SB(0, 1), b2 + hstepB, voffB);
            PG8_WAIT_V(6); PG8_BAR; PG8_MMA(1, 1, At, B1); PG8_BAR;
            PG8_LDB(B0, 1, 0); PG8_SCHED; PG8_LDA(At, 1, 0); PG8_STAGE(PG8_SA(0, 1), a2 + hstep, voffA);
            PG8_WAIT_L(8); PG8_BAR; PG8_WAIT_L(0); PG8_MMA(0, 0, At, B0); PG8_BAR; PG8_SCHED;
            PG8_LDB(B1, 1, 1); PG8_STAGE(PG8_SB(1, 0), b3, voffB);
            PG8_BAR; PG8_WAIT_L(0); PG8_MMA(0, 1, At, B1); PG8_BAR;
            PG8_LDA(At, 1, 1); PG8_STAGE(PG8_SA(1, 0), a3, voffA);
            PG8_BAR; PG8_WAIT_L(0); PG8_MMA(1, 0, At, B0); PG8_BAR; PG8_SCHED;
            PG8_STAGE(PG8_SB(1, 1), b3 + hstepB, voffB);
            PG8_WAIT_V(6); PG8_BAR; PG8_MMA(1, 1, At, B1); PG8_BAR;
            }
        }
        if constexpr (ALIGN_EPI) { if (wr == 0) PG8_BAR; }
        if constexpr (!Epi::AFTER_DRAIN) { E(acc, cur, wr, wc, fr, fq); S.done(cur); }
        if (!has_next) break;
#pragma unroll
        for (int a = 0; a < 2; ++a)
#pragma unroll
            for (int b = 0; b < 2; ++b)
#pragma unroll
                for (int m = 0; m < 4; ++m)
#pragma unroll
                    for (int n = 0; n < 2; ++n) acc[a][b][m][n] = (f32x4){0.f, 0.f, 0.f, 0.f};
        cur = nxt; cA = nA; cB = nB; ++ui;
        if constexpr (ALIGN_EPI) { if (wr == 1) PG8_BAR; }
    }
    PG8_WAIT_V(0);
    if constexpr (!ALIGN_EPI) { if (wr == 0) PG8_BAR; }
    PG8_BAR;
    if constexpr (Epi::AFTER_DRAIN) { E.fused(acc, cur, wr, wc, fr, fq, lds, wid, lane); S.done(cur); }
#undef PG8_SA
#undef PG8_SB
#undef PG8_STAGE
#undef PG8_LDA
#undef PG8_LDB
#undef PG8_MMA
#undef PG8_WAIT_V
#undef PG8_WAIT_L
#undef PG8_BAR
#undef PG8_SCHED
}
}
#define LAS __attribute__((address_space(3)))
#define XB_TMO      128
#define XB_XCNT(j)  (256  + 64 * (j))
#define XB_XSUB(j)  (1280 + 64 * (j))
#define XB_XGEN(j)  (2304 + 64 * (j))
#define XB_TOP      3328
#define XB_TOPGEN   3392
#define XCD_BAR_WORDS 3456
#define XB_SPIN_CAP (1u << 18)

__device__ __forceinline__ unsigned xb_ld(unsigned* p)              { return __hip_atomic_load(p, __ATOMIC_RELAXED, __HIP_MEMORY_SCOPE_AGENT); }
__device__ __forceinline__ unsigned xb_add(unsigned* p, unsigned v) { return __hip_atomic_fetch_add(p, v, __ATOMIC_RELAXED, __HIP_MEMORY_SCOPE_AGENT); }
__device__ __forceinline__ unsigned xb_xcc_id() { return (unsigned)__builtin_amdgcn_s_getreg((3 << 11) | 20) & 0xFu; }
#define XB_SPIN(cond, bar) do { unsigned _sp = 0; while (cond) { __builtin_amdgcn_s_sleep(1); \
    if ((++_sp & 255u) == 0u) { if (xb_ld(&(bar)[XB_TMO])) break; if (_sp > XB_SPIN_CAP) { atomicAdd(&(bar)[XB_TMO], 1u); break; } } } } while (0)

struct XcdBarrier {
    unsigned* bar; unsigned x;
    volatile LAS unsigned* st;
};

__device__ __forceinline__ XcdBarrier xcd_barrier_post(unsigned* bar, volatile LAS unsigned* st) {
    XcdBarrier b; b.bar = bar; b.x = xb_xcc_id(); b.st = st;
    if (threadIdx.x == 0) (void)xb_add(&bar[XB_XCNT(b.x)], 1u);
    return b;
}
__device__ __forceinline__ void xcd_barrier_complete(unsigned* bar, unsigned x, unsigned& nloc, unsigned& nx) {
    const unsigned G = gridDim.x * gridDim.y * gridDim.z;
    unsigned sum, cnt, mine, sp = 0u;
    for (;;) {
        sum = 0u; cnt = 0u; mine = 0u;
#pragma unroll
        for (unsigned j = 0; j < 16; ++j) { const unsigned c = xb_ld(&bar[XB_XCNT(j)]); sum += c; cnt += (c > 0u) ? 1u : 0u; mine = (j == x) ? c : mine; }
        if (sum == G) break;
        __builtin_amdgcn_s_sleep(1);
        if ((++sp & 255u) == 0u) { if (xb_ld(&bar[XB_TMO])) break; if (sp > XB_SPIN_CAP) { atomicAdd(&bar[XB_TMO], 1u); break; } }
    }
    nloc = mine > 0u ? mine : 1u; nx = cnt > 0u ? cnt : 1u;
}

__device__ __forceinline__ void xcd_barrier(const XcdBarrier& b) {
    asm volatile("s_waitcnt vmcnt(0)" ::: "memory");
    __syncthreads();
    if (threadIdx.x == 0) {
        unsigned* bar = b.bar;
        __builtin_amdgcn_s_waitcnt(0);
        unsigned nloc = b.st[0], nx = b.st[1];
        if (nloc == 0u) { xcd_barrier_complete(bar, b.x, nloc, nx); b.st[0] = nloc; b.st[1] = nx; }
        const unsigned old = xb_add(&bar[XB_XSUB(b.x)], 1u);
        const unsigned gen = old / nloc;
        if (old + 1u == (gen + 1u) * nloc) {
            __builtin_amdgcn_fence(__ATOMIC_RELEASE, "agent");
            asm volatile("s_waitcnt vmcnt(0)" ::: "memory");
            const unsigned og = xb_add(&bar[XB_TOP], 1u);
            const unsigned tg = og / nx;
            if (og + 1u == (tg + 1u) * nx) xb_add(&bar[XB_TOPGEN], 1u);
            else XB_SPIN(xb_ld(&bar[XB_TOPGEN]) == tg, bar);
            __builtin_amdgcn_fence(__ATOMIC_ACQUIRE, "agent");
            xb_add(&bar[XB_XGEN(b.x)], 1u);
            asm volatile("s_waitcnt vmcnt(0)" ::: "memory");
        } else {
            XB_SPIN(xb_ld(&bar[XB_XGEN(b.x)]) == gen, bar);
            __builtin_amdgcn_fence(__ATOMIC_ACQUIRE, "agent");
            asm volatile("s_waitcnt vmcnt(0)" ::: "memory");
        }
    }
    __syncthreads();
}
#ifdef EMU
#include <pthread.h>
#include <cstring>
#include <cstdio>
#include <cstdlib>
#include <cmath>
#include <cstdint>
#define DEV static inline
#define LAS
struct EmuDim { int x; };
static thread_local EmuDim threadIdx;
typedef short bf16x8 __attribute__((ext_vector_type(8)));
typedef short s16x4 __attribute__((ext_vector_type(4)));
typedef float f32x4 __attribute__((ext_vector_type(4)));
typedef float f32x2 __attribute__((ext_vector_type(2)));
typedef unsigned u32x4 __attribute__((ext_vector_type(4)));
typedef unsigned u32x2 __attribute__((ext_vector_type(2)));
struct WaveX { bf16x8 a[64], b[64]; float f[64]; const void* p[64]; pthread_barrier_t bar; };
static WaveX g_wx[8];
static pthread_barrier_t g_wgbar;
static inline float emu_bf2f(short v) { unsigned u = ((unsigned)(unsigned short)v) << 16; float f; memcpy(&f, &u, 4); return f; }
static inline float __uint_as_float(unsigned u) { float f; memcpy(&f, &u, 4); return f; }
static inline unsigned __float_as_uint(float f) { unsigned u; memcpy(&u, &f, 4); return u; }
DEV f32x4 mfma16(bf16x8 a, bf16x8 b, f32x4 c) {
    const int lane = threadIdx.x & 63; WaveX& W = g_wx[threadIdx.x >> 6];
    W.a[lane] = a; W.b[lane] = b; pthread_barrier_wait(&W.bar);
    f32x4 r; const int g = lane >> 4, j = lane & 15;
    for (int rr = 0; rr < 4; ++rr) { const int i = 4 * g + rr; float s = 0.f;
        for (int k = 0; k < 32; ++k) s += emu_bf2f(W.a[i + 16 * (k / 8)][k % 8]) * emu_bf2f(W.b[j + 16 * (k / 8)][k % 8]);
        r[rr] = c[rr] + s; }
    pthread_barrier_wait(&W.bar); return r;
}
DEV s16x4 tr_read(const void* p) {
    const int lane = threadIdx.x & 63; WaveX& W = g_wx[threadIdx.x >> 6];
    W.p[lane] = p; pthread_barrier_wait(&W.bar);
    s16x4 r; const int G = lane >> 4, i = lane & 15;
    for (int q = 0; q < 4; ++q) { const short* src = (const short*)W.p[16 * G + 4 * q + i / 4]; if (((uintptr_t)src) & 7) { fprintf(stderr, "tr_read: unaligned\n"); abort(); } r[q] = src[i % 4]; }
    pthread_barrier_wait(&W.bar); return r;
}
DEV void lds_wait() {}
#define tr_read_o(base, off) tr_read((const unsigned char*)(base) + (off))
DEV float shflx(float v, int m) { const int lane = threadIdx.x & 63; WaveX& W = g_wx[threadIdx.x >> 6]; W.f[lane] = v; pthread_barrier_wait(&W.bar); const float r = W.f[lane ^ m]; pthread_barrier_wait(&W.bar); return r; }
DEV void wg_sync() { pthread_barrier_wait(&g_wgbar); }
DEV void wg_sync_lds() { pthread_barrier_wait(&g_wgbar); }
DEV void mem_fence_cc() {}
DEV void wave_sync() { pthread_barrier_wait(&g_wx[threadIdx.x >> 6].bar); }
DEV float fast_exp(float x) { return expf(x); }
DEV float fast_log(float x) { return logf(x); }
DEV float fast_exp2(float x) { return exp2f(x); }
DEV float fast_log2(float x) { return log2f(x); }
DEV float fast_rcp(float x) { return 1.0f / x; }
DEV unsigned cvt_pk_bf16(float lo, float hi) { auto f = [](float x) { unsigned u = __float_as_uint(x); return (u + 0x7fffu + ((u >> 16) & 1u)) >> 16; }; return f(lo) | (f(hi) << 16); }
#else
#define DEV __device__ __forceinline__
typedef short bf16x8 __attribute__((ext_vector_type(8)));
typedef short s16x4 __attribute__((ext_vector_type(4)));
typedef float f32x4 __attribute__((ext_vector_type(4)));
typedef float f32x2 __attribute__((ext_vector_type(2)));
typedef unsigned u32x4 __attribute__((ext_vector_type(4)));
typedef unsigned u32x2 __attribute__((ext_vector_type(2)));
DEV f32x4 mfma16(bf16x8 a, bf16x8 b, f32x4 c) { return __builtin_amdgcn_mfma_f32_16x16x32_bf16(a, b, c, 0, 0, 0); }
DEV s16x4 tr_read(const LAS void* p) { s16x4 r; asm volatile("ds_read_b64_tr_b16 %0, %1" : "=&v"(r) : "v"((unsigned)(size_t)p) : "memory"); return r; }
DEV s16x4 tr_read_o(const LAS void* p, int off) { s16x4 r; asm volatile("ds_read_b64_tr_b16 %0, %1 offset:%2" : "=&v"(r) : "v"((unsigned)(size_t)p), "i"(off) : "memory"); return r; }
DEV void lds_wait() { asm volatile("s_waitcnt lgkmcnt(0)" ::: "memory"); __builtin_amdgcn_sched_barrier(0); }
DEV float shflx(float v, int m) { return __shfl_xor(v, m); }
DEV void wg_sync() { __syncthreads(); }
DEV void wg_sync_lds() { asm volatile("s_waitcnt lgkmcnt(0)" ::: "memory"); __builtin_amdgcn_s_barrier(); asm volatile("" ::: "memory"); }
DEV void mem_fence_cc() { asm volatile("" ::: "memory"); }
DEV void wave_sync() { asm volatile("s_waitcnt lgkmcnt(0)" ::: "memory"); }
DEV float fast_exp(float x) { return __expf(x); }
DEV float fast_log(float x) { return __logf(x); }
DEV float fast_exp2(float x) { return __builtin_amdgcn_exp2f(x); }
DEV float fast_log2(float x) { return __builtin_amdgcn_logf(x); }
DEV float fast_rcp(float x) { return __builtin_amdgcn_rcpf(x); }
DEV unsigned cvt_pk_bf16(float lo, float hi) { unsigned r; asm volatile("v_cvt_pk_bf16_f32 %0, %1, %2" : "=v"(r) : "v"(lo), "v"(hi)); return r; }
#endif
typedef unsigned short bf16;
DEV bf16x8 pack8(s16x4 lo, s16x4 hi) { return (bf16x8){lo[0], lo[1], lo[2], lo[3], hi[0], hi[1], hi[2], hi[3]}; }

namespace mk {
typedef unsigned short bf16;
typedef float f32x4 __attribute__((ext_vector_type(4)));
typedef float f32x2 __attribute__((ext_vector_type(2)));
typedef unsigned u32x4 __attribute__((ext_vector_type(4)));
typedef unsigned u32x2 __attribute__((ext_vector_type(2)));
typedef short bf16x8 __attribute__((ext_vector_type(8)));
constexpr int D = 2048, NB = 4, S = 2048, MP = NB * S, DB = 8, T = 4, MS = DB * T, MT = MP + MS, PAST = 16384;
constexpr float EPS = 1e-6f;
constexpr int A_IN = 20480, B_IN = 12288, C_IN = 6160, C_INM = 6144;
constexpr int NWG_THREADS = 512;
constexpr size_t MiB = 1u << 20;
constexpr size_t WS_CTL = 0, CTL_ZERO_BYTES = 1 * MiB;
constexpr size_t CTL_BAR = 16384;
constexpr size_t CTL_SUMSQ = 65536;
constexpr size_t WS_TABA = 1 * MiB;
constexpr size_t WS_TABB = WS_TABA + 512 * 1024;
constexpr size_t WS_WIA0 = 4 * MiB;
constexpr size_t WS_WIA1 = WS_WIA0 + (size_t)A_IN * D * 2;
constexpr size_t WS_WIB = WS_WIA1 + (size_t)A_IN * D * 2;
constexpr size_t WS_WIC = WS_WIB + (size_t)B_IN * D * 2;
constexpr size_t WS_WLR = WS_WIC + (size_t)C_INM * D * 2;
constexpr size_t WS_WOA0 = WS_WLR + (size_t)32 * D * 2;
constexpr size_t WS_WOA1 = WS_WOA0 + (size_t)D * 2048 * 2;
constexpr size_t WS_WOB = WS_WOA1 + (size_t)D * 2048 * 2;
constexpr size_t WS_WOC = WS_WOB + (size_t)D * 4096 * 2;
constexpr size_t WS_XRES = WS_WOC + (size_t)D * 2048 * 2;
constexpr size_t WS_XB = WS_XRES + (size_t)MT * D * 4;
constexpr size_t WS_Z = WS_XB + (size_t)MT * D * 2;
constexpr size_t WS_ZSRAW = WS_Z + (size_t)MT * A_IN * 2;
constexpr size_t WS_Y = WS_ZSRAW + (size_t)32 * A_IN * 4;
constexpr size_t WS_O = WS_Y + (size_t)MT * 4096 * 2;
constexpr size_t WS_LOGA = WS_O + (size_t)MT * 4096 * 4;
constexpr size_t WS_LR = WS_LOGA + (size_t)MT * 1024 * 4;
constexpr size_t WS_DVEC = WS_LR + (size_t)32 * MT * 4;
constexpr size_t WS_SSP = WS_DVEC + (size_t)4 * 4 * 16 * 256 * 4;
constexpr size_t WS_END = WS_SSP + (size_t)4 * MP * 32 * 4;
constexpr int LDS_BYTES = 147456, MISC_OFF = 147456 - 256;

struct Params {
    const float* in[19]; float* out; unsigned char* ws;
    double inv_a[16]; double inv_b[128];
    int ph_lo, ph_hi;
};

__device__ __forceinline__ float bf2f(bf16 v) { return __uint_as_float(((unsigned)v) << 16); }
__device__ __forceinline__ unsigned f2bf(float f) { unsigned u = __float_as_uint(f); return (u + 0x7fffu + ((u >> 16) & 1u)) >> 16; }
__device__ __forceinline__ unsigned pk2(float lo, float hi) { return f2bf(lo) | (f2bf(hi) << 16); }
__device__ __forceinline__ float wave_sum(float v) {
#pragma unroll
    for (int o = 32; o >= 1; o >>= 1) v += __shfl_xor(v, o);
    return v;
}
__device__ __forceinline__ float wave_max(float v) {
#pragma unroll
    for (int o = 32; o >= 1; o >>= 1) v = fmaxf(v, __shfl_xor(v, o));
    return v;
}
__device__ __forceinline__ float silu(float x) { return x / (1.f + __expf(-x)); }
__device__ __forceinline__ void sincos_d(double a, float& s, float& c) {
    const double k = rint(a * 0.63661977236758134308);
    double r = fma(-k, 1.57079632679489655800e+00, a); r = fma(-k, 6.12323399573676603587e-17, r);
    const double r2 = r * r;
    const double sp = r * (1.0 + r2 * (-1.0 / 6 + r2 * (1.0 / 120 + r2 * (-1.0 / 5040 + r2 * (1.0 / 362880 + r2 * (-1.0 / 39916800 + r2 * (1.0 / 6227020800.0)))))));
    const double cp = 1.0 + r2 * (-0.5 + r2 * (1.0 / 24 + r2 * (-1.0 / 720 + r2 * (1.0 / 40320 + r2 * (-1.0 / 3628800 + r2 * (1.0 / 479001600.0 + r2 * (-1.0 / 87178291200.0)))))));
    const int q = (int)((long long)k & 3);
    const double ss = (q == 0) ? sp : (q == 1) ? cp : (q == 2) ? -sp : -cp;
    const double cc = (q == 0) ? cp : (q == 1) ? -sp : (q == 2) ? -cp : sp;
    s = (float)ss; c = (float)cc;
}
__device__ __forceinline__ void row_info(int row, int& b, int& t, int& pi, bool& samp) {
    if (row < MP) { b = row >> 11; t = row & 2047; pi = t; samp = false; } else { const int r = row - MP; b = r >> 2; t = r & 3; pi = 2048 + t; samp = true; }
}

struct Ctx {
    LAS unsigned char* lds; int tid, lane, wave, G, wg;
    const Params* P; float* out; unsigned char* ws;
    __device__ __forceinline__ const float* in(int i) const { return P->in[i]; }
    __device__ __forceinline__ float* sumsq(int l) const { return (float*)(ws + WS_SSP) + (size_t)l * MP * 32; }
    template <class Tp> __device__ __forceinline__ Tp* wsp(size_t off) const { return (Tp*)(ws + off); }
};

constexpr int ATT_K_OFF = 0, ATT_V_OFF = 65536, ATT_ROWS = 8192 + 32;
DEV int att_off_k(int row, int ch) { return 256 * row + 16 * (ch ^ (row & 15)); }
DEV int att_off_v(int row, int ch) { return 256 * row + 16 * (ch ^ (2 * (row & 7))); }
DEV void attn_item(LAS unsigned char* lds, const bf16* z, int ldz, bf16* og, float* lse, int item, int tid) {
    const int lane = tid & 63, w = tid >> 6, G = lane >> 4, l15 = lane & 15;
    const int bh = item / 48, rem = item % 48, b = bh >> 4, h = bh & 15;
    int g, r, blk;
    if (rem < 16) { g = 0; r = 0; blk = rem; } else if (rem < 32) { g = 1; r = (rem - 16) >> 2; blk = (rem - 16) & 3; } else { g = 2; r = rem - 32; blk = 0; }
    const int dil = 1 << (2 * g);
    const int qcol = (g * 3) * 2048 + h * 128, kcol = qcol + 2048, vcol = qcol + 4096;
    const size_t tok0 = (size_t)b * 2048 + r;
#pragma unroll
    for (int j = 0; j < 8; ++j) {
        const int e = tid + 512 * j, row = e >> 4, ch = e & 15; const int p = (blk - 1) * 128 + row;
        u32x4 kv = {0u, 0u, 0u, 0u}, vv = {0u, 0u, 0u, 0u};
        if (p >= 0) { const bf16* src = z + (tok0 + (size_t)dil * p) * ldz + ch * 8; kv = *(const u32x4*)(src + kcol); vv = *(const u32x4*)(src + vcol); }
        *(LAS u32x4*)(lds + ATT_K_OFF + att_off_k(row, ch)) = kv;
        *(LAS u32x4*)(lds + ATT_V_OFF + att_off_v(row, ch)) = vv;
    }
    const int qi = 16 * w + l15; const size_t qtok = tok0 + (size_t)dil * (blk * 128 + qi);
    bf16x8 qf[4];
#pragma unroll
    for (int s = 0; s < 4; ++s) qf[s] = *(const bf16x8*)(z + qtok * ldz + qcol + 32 * s + 8 * G);
    wg_sync();
    const int m0 = w >> 1;
    f32x4 sc[10];
#pragma unroll
    for (int tt = 0; tt < 10; ++tt) {
        const int t = 2 * m0 + tt; f32x4 a = {0.f, 0.f, 0.f, 0.f};
#pragma unroll
        for (int s = 0; s < 4; ++s) { const bf16x8 kf = *(const LAS bf16x8*)(lds + ATT_K_OFF + att_off_k(16 * t + l15, 4 * s + G)); a = mfma16(kf, qf[s], a); }
        sc[tt] = a;
    }
    const float scale = 0.08838834764831845f * 1.4426950408889634f;
    float mx = -INFINITY;
#pragma unroll
    for (int tt = 0; tt < 10; ++tt)
#pragma unroll
        for (int rr = 0; rr < 4; ++rr) { const int c = 16 * (2 * m0 + tt) + 4 * G + rr; const bool ok = (c >= qi) && (c <= qi + 128) && (blk > 0 || c >= 128);
            const float v = ok ? sc[tt][rr] * scale : -INFINITY; sc[tt][rr] = v; mx = fmaxf(mx, v); }
    mx = fmaxf(mx, shflx(mx, 16)); mx = fmaxf(mx, shflx(mx, 32));
    float sum = 0.f;
#pragma unroll
    for (int tt = 0; tt < 10; ++tt)
#pragma unroll
        for (int rr = 0; rr < 4; ++rr) { const float p = fast_exp2(sc[tt][rr] - mx); sc[tt][rr] = p; sum += p; }
    sum += shflx(sum, 16); sum += shflx(sum, 32);
    f32x4 oacc[8];
#pragma unroll
    for (int dt = 0; dt < 8; ++dt) oacc[dt] = (f32x4){0.f, 0.f, 0.f, 0.f};
#pragma unroll
    for (int mm = 0; mm < 5; ++mm) {
        const f32x4 p0 = sc[2 * mm], p1 = sc[2 * mm + 1];
        u32x4 pw; pw[0] = cvt_pk_bf16(p0[0], p0[1]); pw[1] = cvt_pk_bf16(p0[2], p0[3]); pw[2] = cvt_pk_bf16(p1[0], p1[1]); pw[3] = cvt_pk_bf16(p1[2], p1[3]);
        bf16x8 pf; __builtin_memcpy(&pf, &pw, 16);
        const int krow = 32 * (m0 + mm) + 4 * G + (l15 >> 2);
#pragma unroll
        for (int dh = 0; dh < 2; ++dh) {
            s16x4 lo[4], hi[4];
#pragma unroll
            for (int d4 = 0; d4 < 4; ++d4) { const int dt = dh * 4 + d4; const int ch = 2 * dt + ((l15 >> 1) & 1);
                lo[d4] = tr_read(lds + ATT_V_OFF + att_off_v(krow, ch) + 8 * (l15 & 1)); hi[d4] = tr_read(lds + ATT_V_OFF + att_off_v(krow + 16, ch) + 8 * (l15 & 1)); }
            lds_wait();
#pragma unroll
            for (int d4 = 0; d4 < 4; ++d4) oacc[dh * 4 + d4] = mfma16(pack8(lo[d4], hi[d4]), pf, oacc[dh * 4 + d4]);
        }
    }
    const float inv = fast_rcp(sum);
    bf16* orow = og + ((size_t)g * ATT_ROWS + qtok) * 2048 + h * 128 + 4 * G;
#pragma unroll
    for (int dt = 0; dt < 8; ++dt) { u32x2 wv; wv[0] = cvt_pk_bf16(oacc[dt][0] * inv, oacc[dt][1] * inv); wv[1] = cvt_pk_bf16(oacc[dt][2] * inv, oacc[dt][3] * inv); *(u32x2*)(orow + 16 * dt) = wv; }
    if (G == 0) lse[((size_t)g * ATT_ROWS + qtok) * 16 + h] = (mx + fast_log2(sum)) * 0.6931471805599453f;
    wg_sync();
}
DEV size_t att_zoff(size_t row, int col) { return ((size_t)(col >> 7) * ATT_ROWS + row) * 128 + (col & 127); }
struct AttItem { int b, h, g, r, blk; };
DEV AttItem att_decode(int item) { AttItem a; const int bh = item / 48, rem = item % 48; a.b = bh >> 4; a.h = bh & 15;
    if (rem < 16) { a.g = 0; a.r = 0; a.blk = rem; } else if (rem < 32) { a.g = 1; a.r = (rem - 16) >> 2; a.blk = (rem - 16) & 3; } else { a.g = 2; a.r = rem - 32; a.blk = 0; } return a; }
DEV bool att_continues(int item) { const int rem = item % 48; return rem < 15 || (rem >= 16 && rem < 32 && ((rem - 16) & 3) < 3); }
DEV void att_load_half(const bf16* z, int ldz, const AttItem& a, int pblk, int tid, u32x4 (&kr)[4], u32x4 (&vr)[4]) {
    const int dil = 1 << (2 * a.g), qcol = (a.g * 3) * 2048 + a.h * 128; const size_t tok0 = (size_t)a.b * 2048 + a.r;
#pragma unroll
    for (int j = 0; j < 4; ++j) { const int e = tid + 512 * j, row = e >> 4, ch = e & 15;
        kr[j] = (u32x4){0u, 0u, 0u, 0u}; vr[j] = (u32x4){0u, 0u, 0u, 0u};
        if (pblk >= 0) { const size_t tk = tok0 + (size_t)dil * (pblk * 128 + row); kr[j] = *(const u32x4*)(z + att_zoff(tk, qcol + 2048 + ch * 8)); vr[j] = *(const u32x4*)(z + att_zoff(tk, qcol + 4096 + ch * 8)); } }
}
DEV void att_store_half(LAS unsigned char* lds, int half, int tid, const u32x4 (&kr)[4], const u32x4 (&vr)[4]) {
#pragma unroll
    for (int j = 0; j < 4; ++j) { const int e = tid + 512 * j, prow = half * 128 + (e >> 4), ch = e & 15;
        *(LAS u32x4*)(lds + ATT_K_OFF + 256 * prow + 16 * (ch ^ (prow & 15))) = kr[j]; *(LAS u32x4*)(lds + ATT_V_OFF + 256 * prow + 16 * (ch ^ (2 * (prow & 7)))) = vr[j]; }
}
DEV void att_load_q(const bf16* z, int ldz, const AttItem& a, int w, int l15, int G, bf16x8 (&qf)[4]) {
    const int dil = 1 << (2 * a.g); const size_t qtok = (size_t)a.b * 2048 + a.r + (size_t)dil * (a.blk * 128 + 16 * w + l15);
#pragma unroll
    for (int s = 0; s < 4; ++s) qf[s] = *(const bf16x8*)(z + att_zoff(qtok, (a.g * 3) * 2048 + a.h * 128 + 32 * s + 8 * G));
}
DEV void attn_run(LAS unsigned char* lds, const bf16* z, int ldz, bf16* og, float* lse, int item0, int nitems, int tid) {
    const int lane = tid & 63, w = tid >> 6, G = lane >> 4, l15 = lane & 15;
    int kb[4], vb[8];
#pragma unroll
    for (int s = 0; s < 4; ++s) kb[s] = ATT_K_OFF + 256 * l15 + 16 * ((4 * s + G) ^ l15);
    { const int r7 = 4 * (G & 1) + (l15 >> 2);
#pragma unroll
      for (int dt = 0; dt < 8; ++dt) vb[dt] = ATT_V_OFF + 256 * (4 * G + (l15 >> 2)) + 16 * ((2 * dt + ((l15 >> 1) & 1)) ^ (2 * r7)) + 8 * (l15 & 1); }
    int par = 0;
    AttItem cur = att_decode(item0);
    bf16x8 qf[4];
    {   u32x4 kA[4], vA[4], kB[4], vB[4];
        att_load_half(z, ldz, cur, cur.blk - 1, tid, kA, vA); att_load_half(z, ldz, cur, cur.blk, tid, kB, vB); att_load_q(z, ldz, cur, w, l15, G, qf);
        att_store_half(lds, 0, tid, kA, vA); att_store_half(lds, 1, tid, kB, vB); }
#pragma unroll 1
    for (int it = 0; it < nitems; ++it) {
        wg_sync_lds();
        const bool has_next = it + 1 < nitems; const bool cont = has_next && att_continues(item0 + it);
        AttItem nxt = cur; if (has_next) nxt = att_decode(item0 + it + 1);
        u32x4 kB[4], vB[4]; bf16x8 qn[4];
        if (has_next) { att_load_half(z, ldz, nxt, nxt.blk, tid, kB, vB); att_load_q(z, ldz, nxt, w, l15, G, qn); }
        const int m0 = w >> 1, qi = 16 * w + l15;
        f32x4 sc[10];
#pragma unroll
        for (int tt = 0; tt < 10; ++tt) {
            const int pt = (2 * m0 + tt) ^ (8 * par); f32x4 a = {0.f, 0.f, 0.f, 0.f};
#pragma unroll
            for (int s = 0; s < 4; ++s) { const bf16x8 kf = *(const LAS bf16x8*)(lds + kb[s] + 4096 * pt); a = mfma16(kf, qf[s], a); }
            sc[tt] = a;
        }
        const float scale = 0.08838834764831845f * 1.4426950408889634f;
        float mx = -INFINITY;
#pragma unroll
        for (int tt = 0; tt < 10; ++tt)
#pragma unroll
            for (int rr = 0; rr < 4; ++rr) { const int c = 16 * (2 * m0 + tt) + 4 * G + rr; const bool ok = (c >= qi) && (c <= qi + 128) && (cur.blk > 0 || c >= 128);
                const float v = ok ? sc[tt][rr] * scale : -INFINITY; sc[tt][rr] = v; mx = fmaxf(mx, v); }
        mx = fmaxf(mx, shflx(mx, 16)); mx = fmaxf(mx, shflx(mx, 32));
        float sum = 0.f;
#pragma unroll
        for (int tt = 0; tt < 10; ++tt)
#pragma unroll
            for (int rr = 0; rr < 4; ++rr) { const float p = fast_exp2(sc[tt][rr] - mx); sc[tt][rr] = p; sum += p; }
        sum += shflx(sum, 16); sum += shflx(sum, 32);
        f32x4 oacc[8];
#pragma unroll
        for (int dt = 0; dt < 8; ++dt) oacc[dt] = (f32x4){0.f, 0.f, 0.f, 0.f};
#pragma unroll
        for (int mm = 0; mm < 5; ++mm) {
            const f32x4 p0 = sc[2 * mm], p1 = sc[2 * mm + 1];
            u32x4 pw; pw[0] = cvt_pk_bf16(p0[0], p0[1]); pw[1] = cvt_pk_bf16(p0[2], p0[3]); pw[2] = cvt_pk_bf16(p1[0], p1[1]); pw[3] = cvt_pk_bf16(p1[2], p1[3]);
            bf16x8 pf; __builtin_memcpy(&pf, &pw, 16);
            const int prow = 8192 * ((m0 + mm) ^ (4 * par));
#pragma unroll
            for (int dh = 0; dh < 2; ++dh) {
                s16x4 lo[4], hi[4];
#pragma unroll
                for (int d4 = 0; d4 < 4; ++d4) { lo[d4] = tr_read_o(lds + vb[dh * 4 + d4] + prow, 0); hi[d4] = tr_read_o(lds + vb[dh * 4 + d4] + prow, 4096); }
                lds_wait();
#pragma unroll
                for (int d4 = 0; d4 < 4; ++d4) oacc[dh * 4 + d4] = mfma16(pack8(lo[d4], hi[d4]), pf, oacc[dh * 4 + d4]);
            }
        }
        {   const float inv = fast_rcp(sum); const int dil = 1 << (2 * cur.g); const size_t qtok = (size_t)cur.b * 2048 + cur.r + (size_t)dil * (cur.blk * 128 + qi);
            bf16* orow = og + ((size_t)cur.g * ATT_ROWS + qtok) * 2048 + cur.h * 128 + 4 * G;
#pragma unroll
            for (int dt = 0; dt < 8; ++dt) { u32x2 wv; wv[0] = cvt_pk_bf16(oacc[dt][0] * inv, oacc[dt][1] * inv); wv[1] = cvt_pk_bf16(oacc[dt][2] * inv, oacc[dt][3] * inv); *(u32x2*)(orow + 16 * dt) = wv; }
            if (G == 0) lse[((size_t)cur.g * ATT_ROWS + qtok) * 16 + cur.h] = (mx + fast_log2(sum)) * 0.6931471805599453f; }
        wg_sync_lds();
        if (has_next) {
            if (cont) { att_store_half(lds, par, tid, kB, vB); par ^= 1; }
            else { att_store_half(lds, 1, tid, kB, vB); att_load_half(z, ldz, nxt, nxt.blk - 1, tid, kB, vB); att_store_half(lds, 0, tid, kB, vB); par = 0; }
#pragma unroll
            for (int s = 0; s < 4; ++s) qf[s] = qn[s];
            cur = nxt;
        }
    }
    wg_sync();
}
constexpr int SC_KP = 544, SC_K_OFF = 0, SC_V_OFF = 128 * SC_KP, SC_S_OFF = SC_V_OFF + 20480;
template <int NVT, class OT>
DEV void scan_unit(LAS unsigned char* lds, const bf16* z, int ldz, int qoff, int koff, int voff, int H, int unit, const float* dvec, OT* o, int ldo, float* state_out, int tid) {
    constexpr int VS = 16 * NVT, VP = VS * 2 + 32, KP = SC_KP, NVS = 512 / VS, VCH = VS / 8, NVLD = (128 * VCH) / 512, VROWS = 512 / VCH;
    const int lane = tid & 63, w = tid >> 6, G = lane >> 4, l15 = lane & 15;
    const int vs = unit % NVS, h = (unit / NVS) % H, b = unit / (NVS * H);
    const size_t rowbase = (size_t)b * 2048;
    const bf16* zq = z + qoff + h * 256; const bf16* zk = z + koff + h * 256; const bf16* zv = z + voff + h * 512 + vs * VS;
    float gam128 = 1.f; if (!dvec) { const float gm = 1.0f - exp2f(-5.0f - (float)h); gam128 = exp2f(128.0f * log2f(gm)); }
    LAS unsigned char* const kb_row = lds + SC_K_OFF + l15 * KP + 16 * G;
    LAS unsigned char* const kb_tr = lds + SC_K_OFF + (4 * G + (l15 >> 2)) * KP + 8 * (l15 & 3) + 64 * w;
    LAS unsigned char* const vb_tr = lds + SC_V_OFF + (4 * G + (l15 >> 2)) * VP + 8 * (l15 & 3);
    LAS unsigned char* const sb_row = lds + SC_S_OFF + l15 * KP + 16 * G;
    LAS unsigned char* const sb_wr = lds + SC_S_OFF + l15 * KP + 8 * G + 64 * w;
    LAS unsigned char* const kst = lds + SC_K_OFF + (tid >> 5) * KP + (tid & 31) * 16;
    LAS unsigned char* const vst = lds + SC_V_OFF + (tid / VCH) * VP + (tid % VCH) * 16;
    const size_t kg = (size_t)(tid >> 5) * ldz + (tid & 31) * 8, vg = (size_t)(tid / VCH) * ldz + (tid % VCH) * 8;
    f32x4 sacc[2][NVT];
#pragma unroll
    for (int dd = 0; dd < 2; ++dd)
#pragma unroll
        for (int vt = 0; vt < NVT; ++vt) sacc[dd][vt] = (f32x4){0.f, 0.f, 0.f, 0.f};
    for (int e = tid; e < VS * (KP / 16); e += 512) *(LAS u32x4*)(lds + SC_S_OFF + e * 16) = (u32x4){0u, 0u, 0u, 0u};
    u32x4 kpre[8], vpre[NVLD];
    {   const bf16* kp = zk + rowbase * ldz + kg; const bf16* vp = zv + rowbase * ldz + vg;
#pragma unroll
        for (int j = 0; j < 8; ++j) kpre[j] = *(const u32x4*)(kp + (size_t)(16 * j) * ldz);
#pragma unroll
        for (int j = 0; j < NVLD; ++j) vpre[j] = *(const u32x4*)(vp + (size_t)(VROWS * j) * ldz);
#pragma unroll
        for (int j = 0; j < 8; ++j) *(LAS u32x4*)(kst + 16 * j * KP) = kpre[j];
#pragma unroll
        for (int j = 0; j < NVLD; ++j) *(LAS u32x4*)(vst + VROWS * j * VP) = vpre[j]; }
    wg_sync();
    const int qi = 16 * w + l15;
    bf16x8 qf[8];
#pragma unroll
    for (int s = 0; s < 8; ++s) qf[s] = *(const bf16x8*)(zq + (rowbase + qi) * ldz + 32 * s + 8 * G);
#pragma unroll 1
    for (int c = 0; c < 16; ++c) {
        const size_t crow = rowbase + (size_t)c * 128;
        const bf16* kp = zk + (crow + 128) * ldz + kg; const bf16* vp = zv + (crow + 128) * ldz + vg;
        if (c + 1 < 16) {
#pragma unroll
            for (int j = 0; j < 4; ++j) kpre[j] = *(const u32x4*)(kp + (size_t)(16 * j) * ldz);
#pragma unroll
            for (int j = 0; j < NVLD; ++j) vpre[j] = *(const u32x4*)(vp + (size_t)(VROWS * j) * ldz);
        }
        f32x4 oacc[NVT];
#pragma unroll
        for (int vt = 0; vt < NVT; ++vt) oacc[vt] = (f32x4){0.f, 0.f, 0.f, 0.f};
#pragma unroll 1
        for (int m = 0; m <= (w >> 1); ++m) {
            f32x4 s0 = {0.f, 0.f, 0.f, 0.f}, s1 = {0.f, 0.f, 0.f, 0.f};
            LAS unsigned char* const kr = kb_row + m * (32 * KP); LAS unsigned char* const vr = vb_tr + m * (32 * VP);
#pragma unroll
            for (int s = 0; s < 8; ++s) {
                const bf16x8 k0 = *(const LAS bf16x8*)(kr + 64 * s); const bf16x8 k1 = *(const LAS bf16x8*)(kr + 16 * KP + 64 * s);
                s0 = mfma16(k0, qf[s], s0); s1 = mfma16(k1, qf[s], s1);
                if (s & 1) mem_fence_cc();
            }
#pragma unroll
            for (int rr = 0; rr < 4; ++rr) { const int j0 = 32 * m + 4 * G + rr; s0[rr] = (j0 <= qi) ? s0[rr] : 0.f; s1[rr] = (j0 + 16 <= qi) ? s1[rr] : 0.f; }
            u32x4 pw; pw[0] = cvt_pk_bf16(s0[0], s0[1]); pw[1] = cvt_pk_bf16(s0[2], s0[3]); pw[2] = cvt_pk_bf16(s1[0], s1[1]); pw[3] = cvt_pk_bf16(s1[2], s1[3]);
            bf16x8 pf; __builtin_memcpy(&pf, &pw, 16);
            s16x4 lo[NVT], hi[NVT];
#pragma unroll
            for (int vt = 0; vt < NVT; ++vt) { lo[vt] = tr_read_o(vr, 32 * vt); hi[vt] = tr_read_o(vr, 16 * VP + 32 * vt); }
            lds_wait();
#pragma unroll
            for (int vt = 0; vt < NVT; ++vt) oacc[vt] = mfma16(pack8(lo[vt], hi[vt]), pf, oacc[vt]);
        }
        if (c + 1 < 16) {
#pragma unroll
            for (int j = 4; j < 8; ++j) kpre[j] = *(const u32x4*)(kp + (size_t)(16 * j) * ldz);
        }
#pragma unroll
        for (int s = 0; s < 8; ++s)
#pragma unroll
            for (int vt = 0; vt < NVT; ++vt) { const bf16x8 sf = *(const LAS bf16x8*)(sb_row + 16 * vt * KP + 64 * s); oacc[vt] = mfma16(sf, qf[s], oacc[vt]); if (vt == NVT - 1) mem_fence_cc(); }
        {   OT* orow = o + (crow + qi) * ldo + h * 512 + vs * VS + 4 * G;
#pragma unroll
            for (int vt = 0; vt < NVT; ++vt) {
                if constexpr (sizeof(OT) == 2) { u32x2 wv; wv[0] = cvt_pk_bf16(oacc[vt][0], oacc[vt][1]); wv[1] = cvt_pk_bf16(oacc[vt][2], oacc[vt][3]); *(u32x2*)(orow + 16 * vt) = wv; }
                else *(f32x4*)(orow + 16 * vt) = oacc[vt]; } }
        if (c + 1 < 16) {
#pragma unroll
            for (int s = 0; s < 8; ++s) qf[s] = *(const bf16x8*)(zq + (crow + 128 + qi) * ldz + 32 * s + 8 * G);
        }
#pragma unroll
        for (int ks = 0; ks < 4; ++ks) {
            s16x4 alo[2], ahi[2], blo[NVT], bhi[NVT];
#pragma unroll
            for (int dd = 0; dd < 2; ++dd) { alo[dd] = tr_read_o(kb_tr, 32 * ks * KP + 32 * dd); ahi[dd] = tr_read_o(kb_tr, (32 * ks + 16) * KP + 32 * dd); }
#pragma unroll
            for (int vt = 0; vt < NVT; ++vt) { blo[vt] = tr_read_o(vb_tr, 32 * ks * VP + 32 * vt); bhi[vt] = tr_read_o(vb_tr, (32 * ks + 16) * VP + 32 * vt); }
            lds_wait();
#pragma unroll
            for (int dd = 0; dd < 2; ++dd)
#pragma unroll
                for (int vt = 0; vt < NVT; ++vt) sacc[dd][vt] = mfma16(pack8(alo[dd], ahi[dd]), pack8(blo[vt], bhi[vt]), sacc[dd][vt]);
        }
#pragma unroll
        for (int dd = 0; dd < 2; ++dd) {
            f32x4 dv = {gam128, gam128, gam128, gam128};
            if (dvec) dv = *(const f32x4*)(dvec + ((size_t)(b * H + h) * 16 + c) * 256 + 16 * (2 * w + dd) + 4 * G);
#pragma unroll
            for (int vt = 0; vt < NVT; ++vt) sacc[dd][vt] = sacc[dd][vt] * dv;
        }
        wg_sync_lds();
#pragma unroll
        for (int dd = 0; dd < 2; ++dd)
#pragma unroll
            for (int vt = 0; vt < NVT; ++vt) { u32x2 wv; wv[0] = cvt_pk_bf16(sacc[dd][vt][0], sacc[dd][vt][1]); wv[1] = cvt_pk_bf16(sacc[dd][vt][2], sacc[dd][vt][3]); *(LAS u32x2*)(sb_wr + 16 * vt * KP + 32 * dd) = wv; }
        if (c + 1 < 16) {
#pragma unroll
            for (int j = 0; j < 8; ++j) *(LAS u32x4*)(kst + 16 * j * KP) = kpre[j];
#pragma unroll
            for (int j = 0; j < NVLD; ++j) *(LAS u32x4*)(vst + VROWS * j * VP) = vpre[j];
        }
        wg_sync_lds();
    }
#pragma unroll
    for (int dd = 0; dd < 2; ++dd)
#pragma unroll
        for (int vt = 0; vt < NVT; ++vt)
#pragma unroll
            for (int rr = 0; rr < 4; ++rr) state_out[(((size_t)b * H + h) * 256 + 16 * (2 * w + dd) + 4 * G + rr) * 512 + vs * VS + 16 * vt + l15] = sacc[dd][vt][rr];
}
DEV f32x4 bf4_to_f32(u32x2 w) { return (f32x4){__uint_as_float(w[0] << 16), __uint_as_float(w[0] & 0xffff0000u), __uint_as_float(w[1] << 16), __uint_as_float(w[1] & 0xffff0000u)}; }
DEV float half_sum(float v) { v += shflx(v, 16); v += shflx(v, 8); v += shflx(v, 4); v += shflx(v, 2); v += shflx(v, 1); return v; }
DEV f32x4 sat_rot(f32x4 x, const f32x2* tab, int pi, int c32) {
    f32x4 p;
#pragma unroll
    for (int e = 0; e < 4; ++e) p[e] = shflx(x[e], 4);
    if (c32 < 8) { const f32x4 t0 = *(const f32x4*)(tab + pi * 16 + 4 * (c32 & 3)), t1 = *(const f32x4*)(tab + pi * 16 + 4 * (c32 & 3) + 2);
        const f32x4 c = {t0[0], t0[2], t1[0], t1[2]}, sn = {t0[1], t0[3], t1[1], t1[3]};
        x = c32 < 4 ? x * c - p * sn : p * sn + x * c; }
    return x;
}
DEV void sattn_unit(LAS unsigned char* lds_wave, const bf16* z, int ldz, const float* cache, int g, int b, int t, int h, bf16* og, float* lse, int lane, const f32x2* tab, float* kvout) {
    const int lbuf = 128 << (2 * g), dil = 1 << (2 * g), hf = lane >> 5, c32 = lane & 31;
    const int row = 8192 + b * 4 + t, qcol = g * 3 * 2048 + h * 128, kcol = qcol + 2048, vcol = qcol + 4096;
    const float scale = 0.08838834764831845f * 1.4426950408889634f;
    const f32x4 q4 = sat_rot(bf4_to_f32(*(const u32x2*)(z + att_zoff(row, qcol + 4 * c32))), tab, 2048 + t, c32);
    const int jn = g == 0 ? t + 1 : 1;
    float m = -INFINITY, l = 0.f; f32x4 acc = {0.f, 0.f, 0.f, 0.f};
    for (int j = 0; j < jn; ++j) {
        const int krow = 8192 + b * 4 + (t - dil * j);
        const f32x4 k4 = sat_rot(bf4_to_f32(*(const u32x2*)(z + att_zoff(krow, kcol + 4 * c32))), tab, 2048 + t - dil * j, c32); const f32x4 v4 = bf4_to_f32(*(const u32x2*)(z + att_zoff(krow, vcol + 4 * c32)));
        if (j == 0 && hf == 0) { *(f32x4*)(kvout + (size_t)(t * 2 + 0) * 2048 + h * 128 + 4 * c32) = k4; *(f32x4*)(kvout + (size_t)(t * 2 + 1) * 2048 + h * 128 + 4 * c32) = v4; }
        float s = half_sum(q4[0] * k4[0] + q4[1] * k4[1] + q4[2] * k4[2] + q4[3] * k4[3]) * scale; if (hf) s = -INFINITY;
        const float mn = fmaxf(m, s); const float corr = (m == -INFINITY) ? 0.f : fast_exp2(m - mn); const float p = (s == -INFINITY) ? 0.f : fast_exp2(s - mn);
        l = l * corr + p; acc = acc * corr + v4 * p; m = mn;
    }
    const float* kbase = cache + (size_t)b * lbuf * 4096 + h * 128 + 4 * c32;
    const int nc = 129 - jn;
#pragma unroll 1
    for (int i = 0; i < nc; i += 32) {
        f32x4 k4[16], v4[16];
#pragma unroll
        for (int u = 0; u < 16; ++u) { int j = jn + i + 2 * u + hf; j = j > 128 ? 128 : j; const float* p = kbase + (size_t)(lbuf + t - dil * j) * 4096; k4[u] = *(const f32x4*)p; v4[u] = *(const f32x4*)(p + 2048); }
        float s[16]; float bm = -INFINITY;
#pragma unroll
        for (int u = 0; u < 16; ++u) { const int j = jn + i + 2 * u + hf; const float sv = half_sum(q4[0] * k4[u][0] + q4[1] * k4[u][1] + q4[2] * k4[u][2] + q4[3] * k4[u][3]) * scale; s[u] = j <= 128 ? sv : -INFINITY; bm = fmaxf(bm, s[u]); }
        const float mn = fmaxf(m, bm);
        if (mn != -INFINITY) {
            const float corr = (m == -INFINITY) ? 0.f : fast_exp2(m - mn); l *= corr; acc = acc * corr;
#pragma unroll
            for (int u = 0; u < 16; ++u) { const float p = (s[u] == -INFINITY) ? 0.f : fast_exp2(s[u] - mn); l += p; acc += v4[u] * p; }
            m = mn;
        }
    }
    const float m2 = shflx(m, 32), l2 = shflx(l, 32); f32x4 a2;
#pragma unroll
    for (int e = 0; e < 4; ++e) a2[e] = shflx(acc[e], 32);
    const float M = fmaxf(m, m2); const float c1 = (m == -INFINITY) ? 0.f : fast_exp2(m - M), c2 = (m2 == -INFINITY) ? 0.f : fast_exp2(m2 - M);
    const float L = l * c1 + l2 * c2; const f32x4 A = acc * c1 + a2 * c2;
    const float inv = 1.0f / L;
    if (hf == 0) { u32x2 wv; wv[0] = cvt_pk_bf16(A[0] * inv, A[1] * inv); wv[1] = cvt_pk_bf16(A[2] * inv, A[3] * inv); *(u32x2*)(og + ((size_t)g * ATT_ROWS + row) * 2048 + h * 128 + 4 * c32) = wv; }
    if (lane == 0) lse[((size_t)g * ATT_ROWS + row) * 16 + h] = (M + fast_log2(L)) * 0.6931471805599453f;
}
struct P0Src { const float* W; int K, ld, ncols; const float* gain; bf16* WT; };
__device__ __forceinline__ void p0_tr_load(const P0Src& s, int item, int lane, f32x4 (&v)[16]) {
    const int nblk = s.ncols / 64, kb = item / nblk, nb = item % nblk, k0 = 64 * kb, n0 = 64 * nb;
#pragma unroll
    for (int i = 0; i < 16; ++i) { const int kk = 4 * i + (lane >> 4); v[i] = *(const f32x4*)(s.W + (size_t)(k0 + kk) * s.ld + n0 + 4 * (lane & 15)); }
}
__device__ __forceinline__ void p0_tr_store(const P0Src& s, int item, int lane, const f32x4 (&v)[16], LAS float* scr) {
    const int nblk = s.ncols / 64, kb = item / nblk, nb = item % nblk, k0 = 64 * kb, n0 = 64 * nb;
#pragma unroll
    for (int i = 0; i < 16; ++i) { const int kk = 4 * i + (lane >> 4); const float gk = s.gain ? s.gain[k0 + kk] : 1.0f; LAS float* d = scr + kk * 65 + 4 * (lane & 15);
        d[0] = v[i][0] * gk; d[1] = v[i][1] * gk; d[2] = v[i][2] * gk; d[3] = v[i][3] * gk; }
    asm volatile("s_waitcnt lgkmcnt(0)" ::: "memory");
    const int c = lane & 7;
#pragma unroll
    for (int j = 0; j < 8; ++j) { const int n = (lane >> 3) + 8 * j; const LAS float* sp = scr + (8 * c) * 65 + n;
        u32x4 o; o.x = pk2(sp[0 * 65], sp[1 * 65]); o.y = pk2(sp[2 * 65], sp[3 * 65]); o.z = pk2(sp[4 * 65], sp[5 * 65]); o.w = pk2(sp[6 * 65], sp[7 * 65]);
        *(u32x4*)(s.WT + ((size_t)kb * s.ncols + n0 + n) * 64 + 8 * c) = o; }
    asm volatile("s_waitcnt lgkmcnt(0)" ::: "memory");
}
__device__ __forceinline__ P0Src p0_src(const Ctx& C, int it, int& r) {
    const float* norm_g = C.in(7);
    constexpr int I_A = (D / 64) * (A_IN / 64), I_B = (D / 64) * (B_IN / 64), I_C = (D / 64) * (C_INM / 64), I_OA = (2048 / 64) * (D / 64), I_OB = (4096 / 64) * (D / 64);
    r = it;
        if (r < I_A) return P0Src{C.in(9) + (size_t)D * A_IN, D, A_IN, A_IN, norm_g + 3 * D, C.wsp<bf16>(WS_WIA1)}; r -= I_A;
        if (r < I_B) return P0Src{C.in(11), D, B_IN, B_IN, norm_g + 1 * D, C.wsp<bf16>(WS_WIB)}; r -= I_B;
        if (r < I_C) return P0Src{C.in(14), D, C_IN, C_INM, norm_g + 2 * D, C.wsp<bf16>(WS_WIC)}; r -= I_C;
        if (r < I_OA) return P0Src{C.in(10), 2048, D, D, nullptr, C.wsp<bf16>(WS_WOA0)}; r -= I_OA;
        if (r < I_OA) return P0Src{C.in(10) + (size_t)2048 * D, 2048, D, D, nullptr, C.wsp<bf16>(WS_WOA1)}; r -= I_OA;
        if (r < I_OA) return P0Src{C.in(18), 2048, D, D, nullptr, C.wsp<bf16>(WS_WOC)}; r -= I_OA;
        if (r < I_OB) return P0Src{C.in(13), 4096, D, D, nullptr, C.wsp<bf16>(WS_WOB)}; r -= I_OB;
        return P0Src{C.in(9), D, A_IN, A_IN, norm_g + 0 * D, C.wsp<bf16>(WS_WIA0)};
}
__device__ __forceinline__ void p0_prologue(const Ctx& C, const Params& P) {
    LAS float* scr = (LAS float*)(C.lds + C.wave * 16640);
    const int gw = C.wg * 8 + C.wave, NGW = C.G * 8;
    const float* norm_g = C.in(7);
    constexpr int I_A = (D / 64) * (A_IN / 64), I_B = (D / 64) * (B_IN / 64), I_C = (D / 64) * (C_INM / 64), I_OA = (2048 / 64) * (D / 64), I_OB = (4096 / 64) * (D / 64);
    constexpr int NITEMS = 2 * I_A + I_B + I_C + 3 * I_OA + I_OB;
    if (gw < NITEMS) {
        int it = gw, rc; P0Src sc = p0_src(C, it, rc); f32x4 vc[16]; p0_tr_load(sc, rc, C.lane, vc);
        for (;;) {
            const int itn = it + NGW; const bool has = itn < NITEMS; int rn = 0; P0Src sn = sc; f32x4 vn[16];
            if (has) { sn = p0_src(C, itn, rn); p0_tr_load(sn, rn, C.lane, vn); }
            p0_tr_store(sc, rc, C.lane, vc, scr);
            if (!has) break;
#pragma unroll
            for (int i = 0; i < 16; ++i) vc[i] = vn[i];
            sc = sn; rc = rn; it = itn;
        }
    }
    { bf16* wlr = C.wsp<bf16>(WS_WLR); const float* W = C.in(14); const float* g2 = norm_g + 2 * D;
      for (int e = C.wg * NWG_THREADS + C.tid; e < 32 * D; e += C.G * NWG_THREADS) { const int r = e / D, k = e % D; wlr[e] = r < 16 ? (bf16)f2bf(W[(size_t)k * C_IN + C_INM + r] * g2[k]) : (bf16)0; } }
    { bf16* xb = C.wsp<bf16>(WS_XB); float* ss0 = C.sumsq(0);
      for (int row = gw; row < MT; row += NGW) {
          const float* src = row < MP ? C.in(0) + (size_t)row * D : C.in(1) + (size_t)(row - MP) * D;
          float s = 0.f;
#pragma unroll
          for (int j = 0; j < 8; ++j) { const f32x4 v = *(const f32x4*)(src + 4 * C.lane + 256 * j);
              u32x2 w; w.x = pk2(v[0], v[1]); w.y = pk2(v[2], v[3]); *(u32x2*)(xb + (size_t)row * D + 4 * C.lane + 256 * j) = w; s += (v[0] * v[0] + v[1] * v[1]) + (v[2] * v[2] + v[3] * v[3]); }
          s = wave_sum(s); if (row < MP && C.lane < 32) ss0[(size_t)row * 32 + C.lane] = C.lane == 0 ? s : 0.f; } }
    { f32x2* ta = C.wsp<f32x2>(WS_TABA); f32x2* tb = C.wsp<f32x2>(WS_TABB);
      for (int e = C.wg * NWG_THREADS + C.tid; e < 2052 * 16; e += C.G * NWG_THREADS) { const int pi = e >> 4, i = e & 15; const int pos = pi < 2048 ? pi : PAST + (pi - 2048); float s, c; sincos_d((double)pos * P.inv_a[i], s, c); ta[e] = (f32x2){c, s}; }
      for (int e = C.wg * NWG_THREADS + C.tid; e < 2052 * 128; e += C.G * NWG_THREADS) { const int pi = e >> 7, i = e & 127; const int pos = pi < 2048 ? pi : PAST + (pi - 2048); float s, c; sincos_d((double)pos * P.inv_b[i], s, c); tb[e] = (f32x2){c, s}; } }
}

template <int K, bool BKT, int SK_KS, int SK_MAXT, class EP>
DEV void skinny2(LAS unsigned char* lds, const bf16* A, const bf16* Bt, int N, int wg, int nwg, int tid, const EP& ep) {
    constexpr int NST = K / SK_KS, SK_RP = SK_KS * 2 + 32, CPR = SK_KS / 8  , NPRE = (SK_MAXT * 16 * CPR) / 512, KPW = SK_KS / 256  ;
    static_assert(SK_MAXT * 16 * SK_RP <= 131072 && NPRE >= 1, "skinny2: stage buffer");
    const int lane = tid & 63, w = tid >> 6, G4 = lane >> 4, l15 = lane & 15;
    const int ntiles = N / 16, tpw = (ntiles + nwg - 1) / nwg, t0 = wg * tpw; int nt = ntiles - t0; nt = nt > tpw ? tpw : nt;
    if (nt <= 0) return;
    const int nchunks = nt * 16 * CPR; const size_t n0 = (size_t)t0 * 16;
    u32x4 pre[NPRE];
    const int nr8 = nt * 128; int erow[NPRE], ecc[NPRE];
#pragma unroll
    for (int j = 0; j < NPRE; ++j) { const int e = tid + 512 * j; if (BKT) { const int ktl = e / nr8, rem = e - ktl * nr8; erow[j] = rem >> 3; ecc[j] = ktl * 8 + (rem & 7); } else { erow[j] = e / CPR; ecc[j] = e % CPR; } }
#define SK_SRC(j, st) (BKT ? Bt + ((size_t)((st) * (SK_KS / 64) + (ecc[j] >> 3)) * N + n0 + erow[j]) * 64 + (ecc[j] & 7) * 8 : Bt + (n0 + erow[j]) * K + (st) * SK_KS + ecc[j] * 8)
#pragma unroll
    for (int j = 0; j < NPRE; ++j) { const int e = tid + 512 * j; if (e < nchunks) pre[j] = *(const u32x4*)SK_SRC(j, 0); }
    f32x4 acc[SK_MAXT][2];
#pragma unroll
    for (int t = 0; t < SK_MAXT; ++t) { acc[t][0] = (f32x4){0.f, 0.f, 0.f, 0.f}; acc[t][1] = (f32x4){0.f, 0.f, 0.f, 0.f}; }
#pragma unroll 1
    for (int st = 0; st < NST; ++st) {
#pragma unroll
        for (int j = 0; j < NPRE; ++j) { const int e = tid + 512 * j; if (e < nchunks) *(LAS u32x4*)(lds + erow[j] * SK_RP + ecc[j] * 16) = pre[j]; }
        wg_sync_lds();
        if (st + 1 < NST) {
#pragma unroll
            for (int j = 0; j < NPRE; ++j) { const int e = tid + 512 * j; if (e < nchunks) pre[j] = *(const u32x4*)SK_SRC(j, st + 1); }
        }
        bf16x8 af[KPW][2];
#pragma unroll
        for (int kk = 0; kk < KPW; ++kk)
#pragma unroll
            for (int mt = 0; mt < 2; ++mt) af[kk][mt] = *(const bf16x8*)(A + (size_t)(16 * mt + l15) * K + st * SK_KS + 32 * (KPW * w + kk) + 8 * G4);
#pragma unroll
        for (int t = 0; t < SK_MAXT; ++t) if (t < nt) {
#pragma unroll
            for (int kk = 0; kk < KPW; ++kk) { const bf16x8 bfr = *(const LAS bf16x8*)(lds + (16 * t + l15) * SK_RP + (32 * (KPW * w + kk) + 8 * G4) * 2);
                acc[t][0] = mfma16(bfr, af[kk][0], acc[t][0]); acc[t][1] = mfma16(bfr, af[kk][1], acc[t][1]); }
        }
        wg_sync_lds();
    }
    LAS float* part = (LAS float*)lds;
#pragma unroll
    for (int t = 0; t < SK_MAXT; ++t) if (t < nt) {
#pragma unroll
        for (int mt = 0; mt < 2; ++mt)
#pragma unroll
            for (int r = 0; r < 4; ++r) part[((((size_t)t * 8 + w) * 2 + mt) * 4 + r) * 64 + lane] = acc[t][mt][r];
    }
    wg_sync();
    { const int l2 = tid & 63, mt = (tid >> 6) & 1, reg = tid >> 7;
      for (int t = 0; t < nt; ++t) { float s = 0.f;
#pragma unroll
          for (int ww = 0; ww < 8; ++ww) s += part[((((size_t)t * 8 + ww) * 2 + mt) * 4 + reg) * 64 + l2];
          ep(16 * mt + (l2 & 15), (int)n0 + 16 * t + 4 * (l2 >> 4) + reg, s); } }
    wg_sync();
}
#undef SK_SRC
#ifndef MK_STAGGER_TICKS
#define MK_STAGGER_TICKS 0
#endif
#ifndef MK_ATTN_RUN
#define MK_ATTN_RUN 1
#endif

__device__ __forceinline__ float rstd_of(const float* ss, int row) { return pg8::rstd32(ss, row); }
__device__ __forceinline__ void sample_rstd(const Ctx& C, LAS float* srs) {
    const bf16* xb = C.wsp<bf16>(WS_XB);
#pragma unroll
    for (int k = 0; k < 4; ++k) { const int r = C.wave * 4 + k; float s = 0.f;
#pragma unroll
        for (int j = 0; j < 4; ++j) { const u32x4 v = *(const u32x4*)(xb + (size_t)(MP + r) * D + 8 * C.lane + 512 * j);
#pragma unroll
            for (int i = 0; i < 4; ++i) { const float a = __uint_as_float(v[i] << 16), b = __uint_as_float(v[i] & 0xffff0000u); s += a * a + b * b; } }
        s = wave_sum(s); if (C.lane == 0) srs[r] = rsqrtf(s * (1.0f / 2048.0f) + EPS); }
    __syncthreads();
}
__device__ __forceinline__ void sfix_c(const Ctx& C, int layer) {
    const float* zs = C.wsp<float>(WS_ZSRAW); bf16* z = C.wsp<bf16>(WS_Z); LAS float* srs = (LAS float*)C.lds; sample_rstd(C, srs);
    for (int e = C.wg * NWG_THREADS + C.tid; e < MS * C_INM; e += C.G * NWG_THREADS) {
        const int r = e / C_INM, c = e % C_INM, row = MP + r; const float rs = srs[r];
        float v = zs[e] * rs; if (c < 1024) v *= 0.0625f;
        z[(size_t)row * C_INM + c] = (bf16)f2bf(v);
    }
    const float* lr = C.wsp<float>(WS_LR); float* loga = C.wsp<float>(WS_LOGA); const float* wg2 = C.in(15); const float* bg = C.in(16);
    for (int e = MP * 1024 + C.wg * NWG_THREADS + C.tid; e < MT * 1024; e += C.G * NWG_THREADS) {
        const int row = e >> 10, c = e & 1023; const float rs = srs[row - MP];
        float a = 0.f;
#pragma unroll
        for (int r = 0; r < 16; ++r) a += lr[(size_t)row * 16 + r] * wg2[r * 1024 + c];
        a = a * rs + bg[c];
        loga[e] = (fminf(a, 0.f) - log1pf(__expf(-fabsf(a)))) * 0.0625f;
    }
}

__device__ __forceinline__ void gla_pre(const Ctx& C, int layer) {
    bf16* z = C.wsp<bf16>(WS_Z); const float* ss = C.sumsq(layer); const float* lr = C.wsp<float>(WS_LR); float* dvec = C.wsp<float>(WS_DVEC); const float* wg2 = C.in(15); const float* bg = C.in(16);
    LAS float* lrs = (LAS float*)C.lds; LAS float* tot = lrs + 128 * 16; LAS bf16* ebs = (LAS bf16*)(C.lds + 16384);
    for (int u = C.wg; u < 256; u += C.G) {
        const int chunk = u >> 2, cq = u & 3, cl = C.tid & 255, col = cq * 256 + cl, ih = C.tid >> 8;
        { const int row = chunk * 128 + (C.tid >> 2); const f32x4 v = *(const f32x4*)(lr + (size_t)row * 16 + (C.tid & 3) * 4); *(LAS f32x4*)(lrs + C.tid * 4) = v * rstd_of(ss, row); }
        float wv[16];
#pragma unroll
        for (int r = 0; r < 16; ++r) wv[r] = wg2[r * 1024 + col];
        const float bgc = bg[col];
        __syncthreads();
        float la[64]; float run = 0.f;
#pragma unroll
        for (int j = 0; j < 64; ++j) {
            const LAS f32x4* lp = (const LAS f32x4*)(lrs + (ih * 64 + j) * 16);
            const f32x4 l0 = lp[0], l1 = lp[1], l2 = lp[2], l3 = lp[3];
            float a = bgc + l0[0] * wv[0] + l0[1] * wv[1] + l0[2] * wv[2] + l0[3] * wv[3] + l1[0] * wv[4] + l1[1] * wv[5] + l1[2] * wv[6] + l1[3] * wv[7]
                    + l2[0] * wv[8] + l2[1] * wv[9] + l2[2] * wv[10] + l2[3] * wv[11] + l3[0] * wv[12] + l3[1] * wv[13] + l3[2] * wv[14] + l3[3] * wv[15];
            run += (fminf(a, 0.f) - __logf(1.0f + __expf(-fabsf(a)))) * 0.0625f; la[j] = run;
        }
        if (ih == 0) tot[cl] = run;
        __syncthreads();
        const float off = ih ? tot[cl] : 0.f;
#pragma unroll
        for (int j = 0; j < 64; ++j) ebs[(ih * 64 + j) * 256 + cl] = (bf16)f2bf(__expf(la[j] + off));
        if (ih) dvec[(((size_t)(chunk >> 4) * 4 + (col >> 8)) * 16 + (chunk & 15)) * 256 + (col & 255)] = __expf(la[63] + off);
        __syncthreads();
#pragma unroll
        for (int j = 0; j < 8; ++j) {
            const int pc = C.tid + 512 * j, tk = pc >> 5, cg = pc & 31;
            bf16* zq = z + (size_t)(chunk * 128 + tk) * C_INM + cq * 256 + cg * 8;
            const u32x4 qv = *(const u32x4*)zq, kv = *(const u32x4*)(zq + 1024); const u32x4 ev = *(const LAS u32x4*)(ebs + tk * 256 + cg * 8);
            u32x4 qo, ko;
#pragma unroll
            for (int k = 0; k < 4; ++k) { const float e0 = __uint_as_float(ev[k] << 16), e1 = __uint_as_float(ev[k] & 0xffff0000u); const float i0 = 1.0f / e0, i1 = 1.0f / e1;
                qo[k] = pk2(__uint_as_float(qv[k] << 16) * e0, __uint_as_float(qv[k] & 0xffff0000u) * e1); ko[k] = pk2(__uint_as_float(kv[k] << 16) * i0, __uint_as_float(kv[k] & 0xffff0000u) * i1); }
            *(u32x4*)zq = qo; *(u32x4*)(zq + 1024) = ko;
        }
        __syncthreads();
    }
}
template <int NVT, class OT>
__device__ __forceinline__ void scan_phase(const Ctx& C, int ldz, int qoff, int koff, int voff, int H, const float* dvec, float* state_out) {
    const bf16* z = C.wsp<bf16>(WS_Z); OT* o = C.wsp<OT>(WS_O);
    const int nunits = NB * H * (512 / (16 * NVT));
    constexpr int NVS = 512 / (16 * NVT);
    if (C.G == 256 && nunits == 256) { const int x = C.wg & 7, i = C.wg >> 3; const int u = (x * (32 / NVS) + i / NVS) * NVS + (i % NVS);
        scan_unit<NVT, OT>(C.lds, z, ldz, qoff, koff, voff, H, u, dvec, o, H * 512, state_out, C.tid); }
    else for (int u = C.wg; u < nunits; u += C.G) scan_unit<NVT, OT>(C.lds, z, ldz, qoff, koff, voff, H, u, dvec, o, H * 512, state_out, C.tid);
}

__device__ __forceinline__ float dot128_bb(const bf16* q, const bf16* k) {
    float a = 0.f;
#pragma unroll 4
    for (int i = 0; i < 16; ++i) { const u32x4 x = ((const u32x4*)q)[i], y = ((const u32x4*)k)[i];
#pragma unroll
        for (int j = 0; j < 4; ++j) a += __uint_as_float(x[j] << 16) * __uint_as_float(y[j] << 16) + __uint_as_float(x[j] & 0xffff0000u) * __uint_as_float(y[j] & 0xffff0000u); }
    return a;
}
__device__ __forceinline__ float dot128_bf(const bf16* q, const float* k) {
    float a = 0.f;
#pragma unroll 4
    for (int i = 0; i < 16; ++i) { const u32x4 x = ((const u32x4*)q)[i]; const f32x4 y0 = ((const f32x4*)k)[2 * i], y1 = ((const f32x4*)k)[2 * i + 1];
        a += __uint_as_float(x[0] << 16) * y0[0] + __uint_as_float(x[0] & 0xffff0000u) * y0[1] + __uint_as_float(x[1] << 16) * y0[2] + __uint_as_float(x[1] & 0xffff0000u) * y0[3]
           + __uint_as_float(x[2] << 16) * y1[0] + __uint_as_float(x[2] & 0xffff0000u) * y1[1] + __uint_as_float(x[3] << 16) * y1[2] + __uint_as_float(x[3] & 0xffff0000u) * y1[3]; }
    return a;
}
template <bool GLA, class OT, bool ROT>
__device__ __forceinline__ void recur_naive(const Ctx& C, int ldz, int qoff, int koff, int voff, int H, int nseq, int ntok, int row0, const float* state0, float* state_out) {
    static_assert(sizeof(OT) == 4, "f32 o only");
    const bf16* z = C.wsp<bf16>(WS_Z); float* o = C.wsp<float>(WS_O); const float* loga = C.wsp<float>(WS_LOGA); const f32x2* tb = C.wsp<f32x2>(WS_TABB);
    LAS float* red = (LAS float*)C.lds;
    const int lane = C.lane, dg = C.wave;
    for (int item = C.wg; item < nseq * H * 8; item += C.G) {
        const int vs = item & 7, h = (item >> 3) % H, seq = (item >> 3) / H;
        const size_t sbase = (((size_t)seq * H + h) * 256 + dg * 32) * 512 + vs * 64 + lane;
        float Sreg[32];
#pragma unroll
        for (int j = 0; j < 32; ++j) Sreg[j] = state0[sbase + (size_t)j * 512];
        const float gamma = GLA ? 1.f : 1.0f - exp2f(-5.0f - (float)h);
        for (int t = 0; t < ntok; ++t) {
            const int row = row0 + seq * ntok + t; const bf16* zr = z + (size_t)row * ldz;
            const int d = dg * 32 + (lane & 31);
            float qv, kv, dv = gamma;
            if constexpr (ROT) { const int i = d & 127; const f32x2 cs = tb[(2048 + t) * 128 + i];
                const float q1 = bf2f(zr[qoff + h * 256 + i]), q2 = bf2f(zr[qoff + h * 256 + i + 128]), k1 = bf2f(zr[koff + h * 256 + i]), k2 = bf2f(zr[koff + h * 256 + i + 128]);
                qv = d < 128 ? q1 * cs.x - q2 * cs.y : q1 * cs.y + q2 * cs.x; kv = d < 128 ? k1 * cs.x - k2 * cs.y : k1 * cs.y + k2 * cs.x;
            } else { qv = bf2f(zr[qoff + h * 256 + d]); kv = bf2f(zr[koff + h * 256 + d]); }
            if (GLA) dv = __expf(loga[(size_t)row * 1024 + h * 256 + d]);
            const float vv = bf2f(zr[voff + h * 512 + vs * 64 + lane]);
            float p = 0.f;
#pragma unroll
            for (int j = 0; j < 32; ++j) { const float qj = __shfl(qv, j), kj = __shfl(kv, j), dj = GLA ? __shfl(dv, j) : gamma; Sreg[j] = dj * Sreg[j] + kj * vv; p += qj * Sreg[j]; }
            red[((t & 1) * 8 + dg) * 64 + lane] = p;
            __syncthreads();
            if (dg == 0) { const LAS float* rr = red + (t & 1) * 512 + lane; o[(size_t)row * (H * 512) + h * 512 + vs * 64 + lane] = ((rr[0] + rr[64]) + (rr[128] + rr[192])) + ((rr[256] + rr[320]) + (rr[384] + rr[448])); }
        }
#pragma unroll
        for (int j = 0; j < 32; ++j) state_out[sbase + (size_t)j * 512] = Sreg[j];
        __syncthreads();
    }
}
struct NGItem { f32x4 oa[4], ob[4]; u32x4 gw[4]; };
__device__ __forceinline__ void ng_load(NGItem& it, const float* o, const bf16* z, int H, int ldz, int goff, int w0, int lane) {
#pragma unroll
    for (int k = 0; k < 4; ++k) { const int w = w0 + k, row = w / H, h = w % H; const float* orow = o + (size_t)row * (H * 512) + h * 512;
        it.oa[k] = ((const f32x4*)orow)[2 * lane]; it.ob[k] = ((const f32x4*)orow)[2 * lane + 1]; it.gw[k] = ((const u32x4*)(z + (size_t)row * ldz + goff + h * 512))[lane]; }
}
template <bool MEAN, class OT>
__device__ __forceinline__ void norm_gate(const Ctx& C, int H, int ldz, int goff, const float* gn) {
    static_assert(sizeof(OT) == 4, "norm_gate: f32 o only");
    const bf16* z = C.wsp<bf16>(WS_Z); const float* o = C.wsp<float>(WS_O); bf16* y = C.wsp<bf16>(WS_Y); const int lane = C.lane;
    const int total = MT * H, stride = C.G * 8 * 4; int w0 = (C.wg * 8 + C.wave) * 4;
    if (w0 >= total) return;
    f32x4 g0[4], g1[4];
#pragma unroll
    for (int k = 0; k < 4; ++k) { const int h = (w0 + k) % H; g0[k] = ((const f32x4*)(gn + h * 512))[2 * lane]; g1[k] = ((const f32x4*)(gn + h * 512))[2 * lane + 1]; }
    NGItem cur; ng_load(cur, o, z, H, ldz, goff, w0, lane);
    for (;;) {
        const int wn = w0 + stride; const bool has = wn < total; NGItem nxt;
        if (has) ng_load(nxt, o, z, H, ldz, goff, wn, lane);
#pragma unroll
        for (int k = 0; k < 4; ++k) {
            const int w = w0 + k, row = w / H, h = w % H;
            float v[8] = {cur.oa[k][0], cur.oa[k][1], cur.oa[k][2], cur.oa[k][3], cur.ob[k][0], cur.ob[k][1], cur.ob[k][2], cur.ob[k][3]};
            float s = 0.f;
#pragma unroll
            for (int i = 0; i < 8; ++i) s += v[i];
            float mu = 0.f; if (MEAN) mu = wave_sum(s) * (1.f / 512.f);
            float q = 0.f;
#pragma unroll
            for (int i = 0; i < 8; ++i) { v[i] -= mu; q += v[i] * v[i]; }
            const float r = rsqrtf(wave_sum(q) * (1.f / 512.f) + EPS);
            const float gg[8] = {g0[k][0], g0[k][1], g0[k][2], g0[k][3], g1[k][0], g1[k][1], g1[k][2], g1[k][3]};
            float ov[8];
#pragma unroll
            for (int i = 0; i < 4; ++i) { ov[2 * i] = v[2 * i] * r * gg[2 * i] * silu(__uint_as_float(cur.gw[k][i] << 16)); ov[2 * i + 1] = v[2 * i + 1] * r * gg[2 * i + 1] * silu(__uint_as_float(cur.gw[k][i] & 0xffff0000u)); }
            u32x4 ow; ow.x = pk2(ov[0], ov[1]); ow.y = pk2(ov[2], ov[3]); ow.z = pk2(ov[4], ov[5]); ow.w = pk2(ov[6], ov[7]);
            ((u32x4*)(y + (size_t)row * (H * 512) + h * 512))[lane] = ow;
        }
        if (!has) break;
        cur = nxt; w0 = wn;
    }
}
__device__ __forceinline__ void final_norm(const Ctx& C) {
    const bf16* xb = C.wsp<bf16>(WS_XB); const float* fg = C.in(8);
    for (int row = C.wg * 8 + C.wave; row < MT; row += C.G * 8) {
        u32x4 xv[4]; float s = 0.f;
#pragma unroll
        for (int j = 0; j < 4; ++j) { xv[j] = *(const u32x4*)(xb + (size_t)row * D + 8 * C.lane + 512 * j);
#pragma unroll
            for (int i = 0; i < 4; ++i) { const float a = __uint_as_float(xv[j][i] << 16), b = __uint_as_float(xv[j][i] & 0xffff0000u); s += a * a + b * b; } }
        const float rs = rsqrtf(wave_sum(s) * (1.0f / 2048.0f) + EPS);
#pragma unroll
        for (int j = 0; j < 4; ++j) { const int c = 8 * C.lane + 512 * j; const f32x4 g0 = *(const f32x4*)(fg + c), g1 = *(const f32x4*)(fg + c + 4);
            const f32x4 v0 = {__uint_as_float(xv[j][0] << 16), __uint_as_float(xv[j][0] & 0xffff0000u), __uint_as_float(xv[j][1] << 16), __uint_as_float(xv[j][1] & 0xffff0000u)};
            const f32x4 v1 = {__uint_as_float(xv[j][2] << 16), __uint_as_float(xv[j][2] & 0xffff0000u), __uint_as_float(xv[j][3] << 16), __uint_as_float(xv[j][3] & 0xffff0000u)};
            *(f32x4*)(C.out + (size_t)row * D + c) = v0 * rs * g0; *(f32x4*)(C.out + (size_t)row * D + c + 4) = v1 * rs * g1; }
    }
}

__device__ __forceinline__ void attn_fast_phase(const Ctx& C) {
    const bf16* z = C.wsp<bf16>(WS_Z); bf16* og = C.wsp<bf16>(WS_O); float* lse = C.wsp<float>(WS_LOGA);
    const int per = (3072 + C.G - 1) / C.G;
    const int i0 = C.wg * per; int n = 3072 - i0; n = n > per ? per : n;
#if MK_ATTN_RUN
    if (n > 0) attn_run(C.lds, z, A_IN, og, lse, i0, n, C.tid);
#else
    for (int j = 0; j < n; ++j) attn_item(C.lds, z, A_IN, og, lse, i0 + j, C.tid);
#endif
}
__device__ __forceinline__ void sattn_phase(const Ctx& C, int slot, const float* c1, const float* c2, const float* c3) {
    const bf16* z = C.wsp<bf16>(WS_Z); bf16* og = C.wsp<bf16>(WS_O); float* lse = C.wsp<float>(WS_LOGA);
    for (int u0 = C.wg * 6; u0 < 1536; u0 += C.G * 6) {
        const int u = u0 + C.wave;
        if (C.wave < 6 && u < 1536) {
            const int t = u & 3, h = (u >> 2) & 15, b = (u >> 6) & 7, g = u >> 9;
            const float* cache = c1; if (g == 1) cache = c2; if (g == 2) cache = c3;
            float* skv = C.out + (size_t)MP * D + (size_t)MS * D + (size_t)2 * 4 * (128 + 512 + 2048) * 4096 + (size_t)4 * 8 * 256 * 512 + (size_t)4 * 4 * 256 * 512;
            sattn_unit(C.lds + C.wave * 1024, z, A_IN, cache + (size_t)slot * 8 * (128 << (2 * g)) * 4096, g, b, t, h, og, lse, C.lane, C.wsp<f32x2>(WS_TABA), skv + (size_t)g * (2 * 8 * 4 * 4096) + (size_t)(slot * DB + b) * T * 2 * 2048);
        }
    }
}
struct MGItem { u32x4 a[4], b[4], c[4], gt[4]; float l0[4], l1[4], l2[4]; };
__device__ __forceinline__ void mg_load(MGItem& it, const bf16* z, const bf16* og, const float* lse, int row, int lane) {
#pragma unroll
    for (int j = 0; j < 4; ++j) { const int col = (lane + 64 * j) * 8, h = col >> 7;
        it.l0[j] = lse[((size_t)0 * MT + row) * 16 + h]; it.l1[j] = lse[((size_t)1 * MT + row) * 16 + h]; it.l2[j] = lse[((size_t)2 * MT + row) * 16 + h];
        it.a[j] = *(const u32x4*)(og + ((size_t)0 * MT + row) * 2048 + col); it.b[j] = *(const u32x4*)(og + ((size_t)1 * MT + row) * 2048 + col); it.c[j] = *(const u32x4*)(og + ((size_t)2 * MT + row) * 2048 + col);
        it.gt[j] = *(const u32x4*)(z + att_zoff(row, 18432 + col)); }
}
__device__ __forceinline__ void attn_merge(const Ctx& C) {
    const bf16* z = C.wsp<bf16>(WS_Z); const bf16* og = C.wsp<bf16>(WS_O); const float* lse = C.wsp<float>(WS_LOGA); bf16* y = C.wsp<bf16>(WS_Y); const int lane = C.lane;
    int row = C.wg * 8 + C.wave; const int stride = C.G * 8;
    if (row >= MT) return;
    MGItem cur; mg_load(cur, z, og, lse, row, lane);
    for (;;) {
        const int rn = row + stride; const bool has = rn < MT; MGItem nxt;
        if (has) mg_load(nxt, z, og, lse, rn, lane);
#pragma unroll
        for (int j = 0; j < 4; ++j) {
            const int col = (lane + 64 * j) * 8;
            const float m = fmaxf(cur.l0[j], fmaxf(cur.l1[j], cur.l2[j])); float w0 = __expf(cur.l0[j] - m), w1 = __expf(cur.l1[j] - m), w2 = __expf(cur.l2[j] - m); const float inv = 1.0f / (w0 + w1 + w2); w0 *= inv; w1 *= inv; w2 *= inv;
            u32x4 o;
#pragma unroll
            for (int k = 0; k < 4; ++k) {
                const float lo = (w0 * __uint_as_float(cur.a[j][k] << 16) + w1 * __uint_as_float(cur.b[j][k] << 16) + w2 * __uint_as_float(cur.c[j][k] << 16)) * silu(__uint_as_float(cur.gt[j][k] << 16));
                const float hi = (w0 * __uint_as_float(cur.a[j][k] & 0xffff0000u) + w1 * __uint_as_float(cur.b[j][k] & 0xffff0000u) + w2 * __uint_as_float(cur.c[j][k] & 0xffff0000u)) * silu(__uint_as_float(cur.gt[j][k] & 0xffff0000u));
                o[k] = pk2(lo, hi);
            }
            *(u32x4*)(y + (size_t)row * 2048 + col) = o;
        }
        if (!has) break;
        cur = nxt; row = rn;
    }
}

template <int MODE>
__device__ __forceinline__ void gemm_in(const Ctx& C, size_t wt_off, int N, int layer, float* kvb, int slot) {
    if (MODE == 0 && MK_STAGGER_TICKS > 0) {
        const unsigned long long t0 = __builtin_amdgcn_s_memrealtime(); const unsigned long long dl = (unsigned long long)((C.wg & 7) * MK_STAGGER_TICKS / 8);
        while (__builtin_amdgcn_s_memrealtime() - t0 < dl) __builtin_amdgcn_s_sleep(8);
    }
    pg8::Gemm g{C.wsp<pg8::bf16_t>(WS_XB), C.wsp<pg8::bf16_t>(wt_off), MP, N, D}; pg8::StaticOrder So; So.init(MP, N, C.G, C.wg);
    LAS float* rst = (LAS float*)(C.lds + 131072 + 4096); int pm0 = -1;
    { pg8::Unit u0; if (So.next(0, u0)) { pm0 = u0.pm; if (C.tid < 256) rst[C.tid] = pg8::rstd32(C.sumsq(layer), pm0 * 256 + C.tid); } }
    __syncthreads();
    pg8::EpiIn<MODE> E{C.wsp<pg8::bf16_t>(WS_Z), N, C.sumsq(layer), (const pg8::f32x2*)C.wsp<f32x2>(MODE == 0 ? WS_TABA : WS_TABB), kvb, slot, (const PG8_LAS float*)rst, pm0};
    pg8::gemm_phase<pg8::EpiIn<MODE>, pg8::StaticOrder, true, true>((PG8_LAS unsigned char*)C.lds, g, So, E);
}
template <int K>
__device__ __forceinline__ void gemm_out(const Ctx& C, size_t wt_off, int layer) {
    pg8::Gemm g{C.wsp<pg8::bf16_t>(WS_Y), C.wsp<pg8::bf16_t>(wt_off), MP, D, K}; pg8::StaticOrder So; So.init(MP, D, C.G, C.wg);
    pg8::EpiOut E{C.wsp<pg8::bf16_t>(WS_XB), C.sumsq(layer < 3 ? layer + 1 : 0)};
    bf16* xb = C.wsp<bf16>(WS_XB);
    skinny2<K, true, 2048, 1>(C.lds, C.wsp<bf16>(WS_Y) + (size_t)MP * K, C.wsp<bf16>(wt_off), D, C.wg, C.G, C.tid, [=](int m, int n, float v) {
        const size_t o = (size_t)(MP + m) * D + n; xb[o] = (bf16)f2bf(bf2f(xb[o]) + v); });
    pg8::gemm_phase<pg8::EpiOut, pg8::StaticOrder, true, true>((PG8_LAS unsigned char*)C.lds, g, So, E);
}
__device__ __forceinline__ void skinny_in(const Ctx& C, size_t wt_off, int N) {
    float* zs = C.wsp<float>(WS_ZSRAW);
    skinny2<D, true, 512, 5>(C.lds, C.wsp<bf16>(WS_XB) + (size_t)MP * D, C.wsp<bf16>(wt_off), N, C.wg, C.G, C.tid, [=](int m, int n, float v) { zs[(size_t)m * N + n] = v; });
}
__device__ __forceinline__ void skinny_in_z(const Ctx& C, size_t wt_off, int N, bool kscale) {
    bf16* z = C.wsp<bf16>(WS_Z); const LAS float* srs = (const LAS float*)(C.lds + 131072 + 4096 + 1024);
    sample_rstd(C, (LAS float*)(C.lds + 131072 + 4096 + 1024));
    skinny2<D, true, 512, 5>(C.lds, C.wsp<bf16>(WS_XB) + (size_t)MP * D, C.wsp<bf16>(wt_off), N, C.wg, C.G, C.tid, [=](int m, int n, float v) {
        float s = srs[m]; if (kscale && n >= 2048 && n < 4096) s *= 0.0625f;
        const size_t zo = kscale ? (size_t)(MP + m) * N + n : att_zoff(MP + m, n);
        z[zo] = (bf16)f2bf(v * s); });
}

__global__ void __launch_bounds__(NWG_THREADS, 2) mk_fwd(Params P) {
    extern __shared__ __attribute__((aligned(16))) unsigned char lds_raw[];
    Ctx C; C.lds = (LAS unsigned char*)lds_raw; C.tid = threadIdx.x; C.lane = C.tid & 63; C.wave = __builtin_amdgcn_readfirstlane(C.tid >> 6); C.G = gridDim.x; C.wg = blockIdx.x;
    C.P = &P; C.out = P.out; C.ws = P.ws;
    volatile LAS unsigned* MISC = (volatile LAS unsigned*)(C.lds + MISC_OFF);
    if (C.tid < 32) MISC[C.tid] = 0u;
    __syncthreads();
    XcdBarrier bar = xcd_barrier_post((unsigned*)(P.ws + CTL_BAR), MISC + 8);
    int ph = 0;
#define RUN (ph >= P.ph_lo && ph < P.ph_hi)
#define SEAM() do { if (ph >= P.ph_lo && ph + 1 < P.ph_hi) xcd_barrier(bar); ++ph; } while (0)
    float* out = P.out;
    float* pkv1 = out + (size_t)MP * D + (size_t)MS * D; float* pkv2 = pkv1 + (size_t)2 * 4 * 128 * 4096; float* pkv3 = pkv2 + (size_t)2 * 4 * 512 * 4096;
    float* pst_b = pkv3 + (size_t)2 * 4 * 2048 * 4096; float* pst_c = pst_b + (size_t)4 * 8 * 256 * 512;
    float* sst_b = pst_c + (size_t)4 * 4 * 256 * 512 + (size_t)3 * 2 * 8 * 4 * 4096; float* sst_c = sst_b + (size_t)8 * 8 * 256 * 512;

    if (RUN) p0_prologue(C, P);
    SEAM();
    if (RUN) { skinny_in_z(C, WS_WIA0, A_IN, false); gemm_in<0>(C, WS_WIA0, A_IN, 0, pkv1, 0); }
    SEAM();
    if (RUN) { attn_fast_phase(C); sattn_phase(C, 0, P.in[2], P.in[3], P.in[4]); }
    SEAM();
    if (RUN) attn_merge(C);
    SEAM();
    if (RUN) gemm_out<2048>(C, WS_WOA0, 0);
    SEAM();
    if (RUN) { skinny_in_z(C, WS_WIB, B_IN, true); gemm_in<1>(C, WS_WIB, B_IN, 1, nullptr, 0); }
    SEAM();
    if (RUN) { scan_phase<4, float>(C, B_IN, 0, 2048, 4096, 8, nullptr, pst_b); recur_naive<false, float, true>(C, B_IN, 0, 2048, 4096, 8, DB, T, MP, C.in(5), sst_b); }
    SEAM();
    if (RUN) norm_gate<true, float>(C, 8, B_IN, 8192, C.in(12));
    SEAM();
    if (RUN) gemm_out<4096>(C, WS_WOB, 1);
    SEAM();
    if (RUN) { skinny_in(C, WS_WIC, C_INM);
        float* lr = C.wsp<float>(WS_LR);
        skinny2<D, false, 512, 5>(C.lds, C.wsp<bf16>(WS_WLR), C.wsp<bf16>(WS_XB), MT, C.wg, C.G, C.tid, [=](int m, int n, float v) { if (m < 16) lr[(size_t)n * 16 + m] = v; }); gemm_in<2>(C, WS_WIC, C_INM, 2, nullptr, 0); }
    SEAM();
    if (RUN) { sfix_c(C, 2); __syncthreads(); gla_pre(C, 2); }
    SEAM();
    if (RUN) { scan_phase<2, float>(C, C_INM, 0, 1024, 2048, 4, C.wsp<float>(WS_DVEC), pst_c); recur_naive<true, float, false>(C, C_INM, 0, 1024, 2048, 4, DB, T, MP, C.in(6), sst_c); }
    SEAM();
    if (RUN) norm_gate<false, float>(C, 4, C_INM, 4096, C.in(17));
    SEAM();
    if (RUN) gemm_out<2048>(C, WS_WOC, 2);
    SEAM();
    if (RUN) { skinny_in_z(C, WS_WIA1, A_IN, false); gemm_in<0>(C, WS_WIA1, A_IN, 3, pkv1, 1); }
    SEAM();
    if (RUN) { attn_fast_phase(C); sattn_phase(C, 1, P.in[2], P.in[3], P.in[4]); }
    SEAM();
    if (RUN) attn_merge(C);
    SEAM();
    if (RUN) gemm_out<2048>(C, WS_WOA1, 3);
    SEAM();
    if (RUN) final_norm(C);
#undef RUN
#undef SEAM
}
constexpr int NPHASES = 19;
}

#ifndef MK_PRE_LO
#define MK_PRE_LO -1
#endif
#ifndef MK_PRE
#define MK_PRE -1
#endif
#ifndef MK_LAUNCHES
#define MK_LAUNCHES 1
#endif
extern "C" void kernel_launch(void* const* d_in, const int* in_sizes, int n_in, void* d_out, int out_size, void* d_ws, size_t ws_size, hipStream_t stream) {
    using namespace mk;
    static int grid = 0;
    if (grid == 0) {
        int dev = 0, cus = 0;
        if (hipGetDevice(&dev) != hipSuccess || hipDeviceGetAttribute(&cus, hipDeviceAttributeMultiprocessorCount, dev) != hipSuccess) { fprintf(stderr, "kernel_launch: device query failed\n"); grid = -1; return; }
        if (hipFuncSetAttribute((const void*)mk_fwd, hipFuncAttributeMaxDynamicSharedMemorySize, LDS_BYTES) != hipSuccess) { fprintf(stderr, "kernel_launch: hipFuncSetAttribute failed\n"); grid = -1; return; }
        int per_cu = 0;
        if (hipOccupancyMaxActiveBlocksPerMultiprocessor(&per_cu, (const void*)mk_fwd, NWG_THREADS, LDS_BYTES) != hipSuccess || per_cu < 1) fprintf(stderr, "kernel_launch: occupancy query says %d\n", per_cu);
        (void)hipGetLastError();
        if (ws_size < WS_END) { fprintf(stderr, "kernel_launch: workspace too small (%zu < %zu)\n", ws_size, (size_t)WS_END); grid = -1; return; }
        grid = cus;
    }
    if (grid < 0) return;
    (void)hipMemsetAsync((char*)d_ws + WS_CTL + CTL_BAR, 0, 16384, stream);
    Params p{};
    for (int i = 0; i < 19; ++i) p.in[i] = (const float*)d_in[i];
    p.out = (float*)d_out; p.ws = (unsigned char*)d_ws;
    for (int i = 0; i < 16; ++i) p.inv_a[i] = pow(500000.0, -(double)i / 16.0);
    for (int i = 0; i < 128; ++i) p.inv_b[i] = pow(10000.0, -(double)i / 128.0);
    if (MK_PRE >= 0) { p.ph_lo = MK_PRE_LO >= 0 ? MK_PRE_LO : MK_PRE; p.ph_hi = MK_PRE + 1; hipLaunchKernelGGL(mk_fwd, dim3(grid), dim3(NWG_THREADS), LDS_BYTES, stream, p); (void)hipMemsetAsync((char*)d_ws + WS_CTL + CTL_BAR, 0, 16384, stream); }
    if (MK_LAUNCHES == 1) { p.ph_lo = 0; p.ph_hi = NPHASES; hipLaunchKernelGGL(mk_fwd, dim3(grid), dim3(NWG_THREADS), LDS_BYTES, stream, p); }
    else for (int k = 0; k < NPHASES; ++k) { p.ph_lo = k; p.ph_hi = k + 1; hipLaunchKernelGGL(mk_fwd, dim3(grid), dim3(NWG_THREADS), LDS_BYTES, stream, p); }
}
```
